# Optimizing an MI355X kernel written in HIP

```python
import jax, jax.numpy as jnp
from jax import lax
import numpy as np

D_MODEL = 1024
BATCH = 8
SEQ = 2048
DEPTH = 1
DEC_BATCH = 128
DEC_SEQ = 4
PAST_LEN = 16384
PAGE_SIZE = 128

D_MIX = D_MODEL
GLA_WIDTH = D_MIX // 2
GLA_HEADS = 4
GLA_DK = GLA_WIDTH // 2 // GLA_HEADS
GLA_DV = GLA_WIDTH // GLA_HEADS
GLA_RANK = 16
GLA_TAU = 16.0
GLA_CHUNK = 64
SGU_WIDTH = D_MIX - GLA_WIDTH
SGU_HEADS = 4
SGU_DH = SGU_WIDTH // SGU_HEADS
SGU_CHUNK = 128
N_MEM = 256
MEM_HEADS = 4
MEM_DH = D_MODEL // MEM_HEADS
D_FF = 2816
CONV_W = 3
EPS = 1e-6

QK_COLS = GLA_HEADS * GLA_DK
SPLIT_SIZES = (QK_COLS, QK_COLS, GLA_WIDTH, GLA_WIDTH, GLA_RANK, SGU_WIDTH, SGU_WIDTH)
D_IN = 2 * QK_COLS + 2 * GLA_WIDTH + GLA_RANK + 2 * SGU_WIDTH

kernel_name = "hymba_gla_sgu_mem_convffn_step"


def rmsnorm(x, g):
    xf = x.astype(jnp.float32)
    y = xf * lax.rsqrt(jnp.mean(xf * xf, axis=-1, keepdims=True) + EPS)
    return (y * g.astype(jnp.float32)).astype(x.dtype)


def split_cols(p):
    out, start = [], 0
    for s in SPLIT_SIZES:
        out.append(p[..., start:start + s])
        start += s
    return out


def gla_chunked(q, k, v, logg, s0):
    B, T, H, DK = q.shape
    DV = v.shape[-1]
    C = min(GLA_CHUNK, T)
    n = T // C
    f32 = jnp.float32

    def chunks(a):
        return jnp.moveaxis(a.astype(f32).reshape((B, n, C) + a.shape[2:]), 1, 0)

    causal = jnp.tril(jnp.ones((C, C), dtype=bool))[None, :, :, None, None]

    def step(S, inp):
        qc, kc, vc, gc = inp
        b = jnp.cumsum(gc, axis=1)
        decay = jnp.exp(jnp.where(causal, b[:, :, None] - b[:, None, :], -jnp.inf))
        scores = jnp.einsum('bihd,bjhd,bijhd->bijh', qc, kc, decay)
        o = (jnp.einsum('bijh,bjhv->bihv', scores, vc)
             + jnp.einsum('bihd,bhdv->bihv', qc * jnp.exp(b), S))
        b_last = b[:, -1]
        S = (jnp.exp(b_last)[..., None] * S
             + jnp.einsum('bjhd,bjhv->bhdv', kc * jnp.exp(b_last[:, None] - b), vc))
        return S, o

    S, o = lax.scan(step, s0.astype(f32), (chunks(q), chunks(k), chunks(v), chunks(logg)))
    o = jnp.moveaxis(o, 0, 1).reshape(B, T, H, DV)
    return o, S


def sgu_spatial(v, w_s, b_s):
    B, T, H, Dh = v.shape
    C = min(SGU_CHUNK, T)
    n = T // C
    w = jnp.tril(w_s[:, :C, :C])
    vc = v.reshape(B, n, C, H, Dh)
    z = jnp.einsum('hij,bnjhd->bnihd', w, vc) + b_s[:, :C].T[None, None, :, :, None]
    return z.reshape(B, T, H, Dh)


def mixer(xn, s0, lp):
    (g_mix, w_in, w_alpha, b_alpha, g_gla_out, g_sgu, w_s, b_s, w_out) = lp
    B, T, _ = xn.shape
    q, k, v, r, a, u, sv = split_cols(xn @ w_in)
    q = q.reshape(B, T, GLA_HEADS, GLA_DK) * (GLA_DK ** -0.5)
    k = k.reshape(B, T, GLA_HEADS, GLA_DK)
    v = v.reshape(B, T, GLA_HEADS, GLA_DV)
    logg = jax.nn.log_sigmoid((a @ w_alpha + b_alpha).astype(jnp.float32)) / GLA_TAU
    logg = logg.reshape(B, T, GLA_HEADS, GLA_DK)
    o, S = gla_chunked(q, k, v, logg, s0)
    o = rmsnorm(o, g_gla_out).astype(xn.dtype)
    o = o.reshape(B, T, GLA_WIDTH) * jax.nn.silu(r)
    u = jax.nn.gelu(u)
    sv = rmsnorm(jax.nn.gelu(sv).reshape(B, T, SGU_HEADS, SGU_DH), g_sgu)
    z = sgu_spatial(sv, w_s, b_s)
    s_out = u * z.reshape(B, T, SGU_WIDTH)
    y = jnp.concatenate([o, s_out], axis=-1) @ w_out
    return y, S.astype(s0.dtype), sv


def mem_kv(mem, g_mem, wk_x, wv_x):
    B = mem.shape[0]
    mn = rmsnorm(mem, g_mem)
    mk = (mn @ wk_x).reshape(B, N_MEM, MEM_HEADS, MEM_DH)
    mv = (mn @ wv_x).reshape(B, N_MEM, MEM_HEADS, MEM_DH)
    return mk, mv


def mem_attend(hn, mk, mv, wq_x, wo_x):
    B, T, _ = hn.shape
    q = (hn @ wq_x).reshape(B, T, MEM_HEADS, MEM_DH)
    s = jnp.einsum('bthd,bmhd->bhtm', q, mk).astype(jnp.float32) * (MEM_DH ** -0.5)
    p = jax.nn.softmax(s, axis=-1).astype(mv.dtype)
    o = jnp.einsum('bhtm,bmhd->bthd', p, mv).reshape(B, T, D_MODEL)
    return o @ wo_x


def conv_ffn(hn, buf, w_gate, w_up, conv_w, conv_b, w_down):
    T = hn.shape[1]
    g = hn @ w_gate
    gp = jnp.concatenate([buf.astype(g.dtype), g], axis=1)
    c = conv_b + sum(conv_w[j] * gp[:, j:j + T] for j in range(CONV_W))
    out = (jax.nn.gelu(c) * (hn @ w_up)) @ w_down
    return out, gp[:, -(CONV_W - 1):]


def layer(x, mk, mv, s0, buf, mix_p, g_x, wq_x, wo_x, g_ffn, w_gate, w_up, conv_w, conv_b, w_down):
    m, S, sv = mixer(rmsnorm(x, mix_p[0]), s0, mix_p)
    h = x + m
    h = h + mem_attend(rmsnorm(h, g_x), mk, mv, wq_x, wo_x)
    f, new_buf = conv_ffn(rmsnorm(h, g_ffn), buf, w_gate, w_up, conv_w, conv_b, w_down)
    return h + f, S, new_buf, sv


def setup_inputs(seed: int = 0) -> dict:
    key = jax.random.key(seed)
    ks = iter(jax.random.split(key, 40))
    nrm = lambda shape, s=1.0: jax.random.normal(next(ks), shape, jnp.float32) * s
    L = DEPTH
    return {
        "x_prompt": nrm((BATCH, SEQ, D_MODEL)),
        "x_sample": nrm((DEC_BATCH, DEC_SEQ, D_MODEL)),
        "mem_prompt": nrm((BATCH, N_MEM, D_MODEL)),
        "state_gla": nrm((L, DEC_BATCH, GLA_HEADS, GLA_DK, GLA_DV), 0.5),
        "state_conv": nrm((L, DEC_BATCH, CONV_W - 1, D_FF)),
        "cache_mem_k": nrm((L, DEC_BATCH, N_MEM, MEM_HEADS, MEM_DH)),
        "cache_mem_v": nrm((L, DEC_BATCH, N_MEM, MEM_HEADS, MEM_DH)),
        "g_mix": 1.0 + nrm((L, D_MODEL), 0.02),
        "w_in": nrm((L, D_MODEL, D_IN), D_MODEL ** -0.5),
        "w_alpha": nrm((L, GLA_RANK, QK_COLS), GLA_RANK ** -0.5),
        "b_alpha": nrm((L, QK_COLS), 0.02),
        "g_gla_out": 1.0 + nrm((L, GLA_HEADS, GLA_DV), 0.02),
        "g_sgu": 1.0 + nrm((L, SGU_HEADS, SGU_DH), 0.02),
        "w_s": nrm((L, SGU_HEADS, SGU_CHUNK, SGU_CHUNK), 0.5 * SGU_CHUNK ** -0.5),
        "b_s": 1.0 + nrm((L, SGU_HEADS, SGU_CHUNK), 0.02),
        "w_out": nrm((L, D_MIX, D_MODEL), D_MIX ** -0.5),
        "g_x": 1.0 + nrm((L, D_MODEL), 0.02),
        "g_mem": 1.0 + nrm((L, D_MODEL), 0.02),
        "wq_x": nrm((L, D_MODEL, D_MODEL), D_MODEL ** -0.5),
        "wk_x": nrm((L, D_MODEL, D_MODEL), D_MODEL ** -0.5),
        "wv_x": nrm((L, D_MODEL, D_MODEL), D_MODEL ** -0.5),
        "wo_x": nrm((L, D_MODEL, D_MODEL), D_MODEL ** -0.5),
        "g_ffn": 1.0 + nrm((L, D_MODEL), 0.02),
        "w_gate": nrm((L, D_MODEL, D_FF), D_MODEL ** -0.5),
        "w_up": nrm((L, D_MODEL, D_FF), D_MODEL ** -0.5),
        "conv_w": nrm((L, CONV_W, D_FF), CONV_W ** -0.5),
        "conv_b": nrm((L, D_FF), 0.02),
        "w_down": nrm((L, D_FF, D_MODEL), D_FF ** -0.5),
        "g_final": 1.0 + nrm((D_MODEL,), 0.02),
    }


def reference(x_prompt, x_sample, mem_prompt, state_gla, state_conv, cache_mem_k, cache_mem_v,
              g_mix, w_in, w_alpha, b_alpha, g_gla_out, g_sgu, w_s, b_s, w_out,
              g_x, g_mem, wq_x, wk_x, wv_x, wo_x,
              g_ffn, w_gate, w_up, conv_w, conv_b, w_down, g_final):
    hp, hs = x_prompt, x_sample
    sg_p, sc_p, mk_p, mv_p, sg_s, sc_s, sv_s = [], [], [], [], [], [], []
    for l in range(DEPTH):
        mix_p = (g_mix[l], w_in[l], w_alpha[l], b_alpha[l], g_gla_out[l], g_sgu[l], w_s[l], b_s[l], w_out[l])
        rest = (g_x[l], wq_x[l], wo_x[l], g_ffn[l], w_gate[l], w_up[l], conv_w[l], conv_b[l], w_down[l])
        mk, mv = mem_kv(mem_prompt, g_mem[l], wk_x[l], wv_x[l])
        s0 = jnp.zeros((hp.shape[0], GLA_HEADS, GLA_DK, GLA_DV), hp.dtype)
        b0 = jnp.zeros((hp.shape[0], CONV_W - 1, D_FF), hp.dtype)
        hp, S_p, buf_p, _ = layer(hp, mk, mv, s0, b0, mix_p, *rest)
        sg_p.append(S_p); sc_p.append(buf_p); mk_p.append(mk); mv_p.append(mv)
        hs, S_s, buf_s, sv = layer(hs, cache_mem_k[l], cache_mem_v[l], state_gla[l], state_conv[l],
                                   mix_p, *rest)
        sg_s.append(S_s); sc_s.append(buf_s); sv_s.append(sv)
    y_prompt = rmsnorm(hp, g_final)
    y_sample = rmsnorm(hs, g_final)
    return (y_prompt, y_sample,
            jnp.stack(sg_p), jnp.stack(sc_p), jnp.stack(mk_p), jnp.stack(mv_p),
            jnp.stack(sg_s), jnp.stack(sc_s), jnp.stack(sv_s))
```

```cpp
#include <hip/hip_runtime.h>
namespace pg8 {
#define PG8_LAS __attribute__((address_space(3)))
typedef unsigned short bf16_t;
typedef short bf16x8 __attribute__((ext_vector_type(8)));
typedef float f32x4 __attribute__((ext_vector_type(4)));
typedef unsigned u32x4 __attribute__((ext_vector_type(4)));
constexpr int BM = 256, BK = 64, HALF = 128, HTB = HALF * BK * 2  , STAGE_BYTES = 8 * HTB, NXCD = 8, WGM = 8;

__host__ __device__ __forceinline__ int lds_byte(int r, int c) { const int st = (r >> 4) * 2 + (c >> 5), rr = r & 15, cc = c & 31, ob = rr * 64 + cc * 2; return st * 1024 + (ob ^ (((ob >> 9) & 1) << 5)); }
__host__ __device__ __forceinline__ void stage_rc(int b, int& R, int& C) { const int st = b / 1024, sb = b % 1024, swz = sb ^ (((sb >> 9) & 1) << 5); R = (st >> 1) * 16 + swz / 64; C = (st & 1) * 32 + (swz % 64) / 2; }
__host__ __device__ __forceinline__ int perm32(int rho) { const int n = rho >> 4, i = rho & 15; return 8 * (i >> 2) + 4 * n + (i & 3); }

struct Unit { int pm, pn; };
struct Gemm { const bf16_t* A; const bf16_t* Bt; int M, N, K; };

struct StaticOrder {
    int nM, nN, nwg, G, c;
    __host__ __device__ void init(int M, int N, int G_, int c_) { nM = M / BM; nN = N / BM; nwg = nM * nN; G = G_; c = c_; }
    __host__ __device__ bool next(int i, Unit& u) const {
        const long L = (long)i * G + c; if (L >= nwg) return false;
        int wgid = (int)L; { const int q = nwg / NXCD, r = nwg % NXCD, xcd = wgid % NXCD, off = wgid / NXCD; wgid = (xcd < r ? xcd * (q + 1) : r * (q + 1) + (xcd - r) * q) + off; }
        const int nig = WGM * nN, gid = wgid / nig, fm = gid * WGM, gsz = (nM - fm) < WGM ? (nM - fm) : WGM;
        u.pm = fm + ((wgid % nig) % gsz); u.pn = (wgid % nig) / gsz; return true;
    }
    __device__ __forceinline__ void a_ready(const Unit&) const {}
    __device__ __forceinline__ void done(const Unit&) const {}
};
struct CountedOrder : StaticOrder {
    const unsigned* ready; unsigned need; unsigned* tmo;
    __device__ __forceinline__ void a_ready(const Unit& u) const {
        if (threadIdx.x < 64) {
            const unsigned long long t0 = __builtin_amdgcn_s_memrealtime(); unsigned polls = 0;
            while ((unsigned)__builtin_amdgcn_readfirstlane(__hip_atomic_load(ready + 64 * u.pm, __ATOMIC_RELAXED, __HIP_MEMORY_SCOPE_AGENT)) < need) {
                if ((++polls & 255u) == 0u && __builtin_amdgcn_readfirstlane(__hip_atomic_load(tmo, __ATOMIC_RELAXED, __HIP_MEMORY_SCOPE_AGENT)) != 0u) break;
                if (__builtin_amdgcn_s_memrealtime() - t0 > 2000000ull) {
                    if (threadIdx.x == 0) { unsigned expect = 0u; __hip_atomic_compare_exchange_strong(tmo + 1, &expect, 0x600u | (unsigned)(u.pm & 0xff), __ATOMIC_RELAXED, __ATOMIC_RELAXED, __HIP_MEMORY_SCOPE_AGENT); __hip_atomic_store(tmo, 1u, __ATOMIC_RELAXED, __HIP_MEMORY_SCOPE_AGENT); }
                    break; }
                __builtin_amdgcn_s_sleep(2); }
            __builtin_amdgcn_fence(__ATOMIC_ACQUIRE, "agent");
            asm volatile("s_waitcnt vmcnt(0)" ::: "memory");
        }
#if !defined(BROKEN_HOOK_NO_BARRIER)
        asm volatile("" ::: "memory"); __builtin_amdgcn_s_barrier(); asm volatile("" ::: "memory");
#endif
    }
};

__device__ __forceinline__ unsigned cvt_pk_bf16(float lo, float hi) { unsigned r; asm volatile("v_cvt_pk_bf16_f32 %0, %1, %2" : "=v"(r) : "v"(lo), "v"(hi)); return r; }
typedef float f32x2 __attribute__((ext_vector_type(2)));
__device__ __forceinline__ f32x2 gelu_pk(f32x2 v) {
    const f32x2 av = __builtin_elementwise_abs(v), d = av * 0.2316418882f + 1.0f;
    f32x2 t; t.x = __builtin_amdgcn_rcpf(d.x); t.y = __builtin_amdgcn_rcpf(d.y);
    f32x2 q = t * 0.5307027145f + (-0.7265760135f); q = q * t + 0.7107068705f; q = q * t + (-0.142248368f); q = q * t + 0.127414796f; q = q * t;
    const f32x2 s = (v * v) * (-0.72134752044f);
    f32x2 e; e.x = __builtin_amdgcn_exp2f(s.x); e.y = __builtin_amdgcn_exp2f(s.y);
    const f32x2 m = v * (q * e), r = v - m;
    f32x2 o; o.x = v.x < 0.f ? m.x : r.x; o.y = v.y < 0.f ? m.y : r.y; return o;
}

struct EpiF32 {
    static constexpr bool PERM = false, AFTER_DRAIN = false;
    float* C; int ldc; const float* bias;
    __device__ __forceinline__ void operator()(const f32x4 (&acc)[2][2][4][2], const Unit& u, int wr, int wc, int fr, int fq) const {
        const int row0 = u.pm * BM + wr * 64 + fr, col0 = u.pn * BM + wc * 32 + 4 * fq;
        f32x4 bv[2][2];
#pragma unroll
        for (int bj = 0; bj < 2; ++bj)
#pragma unroll
            for (int n = 0; n < 2; ++n) bv[bj][n] = bias ? *(const f32x4*)(bias + col0 + bj * HALF + n * 16) : (f32x4){0.f, 0.f, 0.f, 0.f};
#pragma unroll
        for (int ai = 0; ai < 2; ++ai)
#pragma unroll
            for (int m = 0; m < 4; ++m) { float* rowp = C + (size_t)(row0 + ai * HALF + m * 16) * ldc + col0;
#pragma unroll
                for (int bj = 0; bj < 2; ++bj)
#pragma unroll
                    for (int n = 0; n < 2; ++n) *(f32x4*)(rowp + bj * HALF + n * 16) = acc[ai][bj][m][n] + bv[bj][n]; }
    }
};
template <int ACT  > struct EpiBf16 {
    static constexpr bool PERM = true, AFTER_DRAIN = false;
    bf16_t* O; int ldc; const float* bias; int split_cols; size_t split_stride;
    __device__ __forceinline__ void operator()(const f32x4 (&acc)[2][2][4][2], const Unit& u, int wr, int wc, int fr, int fq) const {
        const int row0 = u.pm * BM + wr * 64 + fr; int colt = u.pn * BM; bf16_t* base = O;
        if (split_cols) { const int t = colt / split_cols; base += (size_t)t * split_stride; colt -= t * split_cols; }
        const int col0 = colt + wc * 32 + 8 * fq, bcol0 = u.pn * BM + wc * 32 + 8 * fq;
        f32x4 bv[2][2];
#pragma unroll
        for (int bj = 0; bj < 2; ++bj)
#pragma unroll
            for (int n = 0; n < 2; ++n) bv[bj][n] = bias ? *(const f32x4*)(bias + bcol0 + bj * HALF + 4 * n) : (f32x4){0.f, 0.f, 0.f, 0.f};
#pragma unroll
        for (int ai = 0; ai < 2; ++ai)
#pragma unroll
            for (int m = 0; m < 4; ++m) { bf16_t* rowp = base + (size_t)(row0 + ai * HALF + m * 16) * ldc + col0;
#pragma unroll
                for (int bj = 0; bj < 2; ++bj) { f32x4 v0 = acc[ai][bj][m][0] + bv[bj][0], v1 = acc[ai][bj][m][1] + bv[bj][1];
                    if (ACT == 1) { f32x2 a = gelu_pk((f32x2){v0[0], v0[1]}), b = gelu_pk((f32x2){v0[2], v0[3]}), c = gelu_pk((f32x2){v1[0], v1[1]}), d = gelu_pk((f32x2){v1[2], v1[3]});
                        v0 = (f32x4){a.x, a.y, b.x, b.y}; v1 = (f32x4){c.x, c.y, d.x, d.y}; }
                    if (ACT == 2) {
#pragma unroll
                        for (int j = 0; j < 4; ++j) { v0[j] = 0.5f * v0[j] * (1.0f + erff(v0[j] * 0.70710678f)); v1[j] = 0.5f * v1[j] * (1.0f + erff(v1[j] * 0.70710678f)); } }
                    u32x4 w; w.x = cvt_pk_bf16(v0[0], v0[1]); w.y = cvt_pk_bf16(v0[2], v0[3]); w.z = cvt_pk_bf16(v1[0], v1[1]); w.w = cvt_pk_bf16(v1[2], v1[3]);
                    *(u32x4*)(rowp + bj * HALF) = w; } }
    }
};

struct PanelStats {
    unsigned* xbuf;
    unsigned* cnt;
    unsigned* tmo;
    int ntn; float eps;
    unsigned code;
    __device__ __forceinline__ bool run(const f32x4 (&v)[2][2][4][2], const Unit& u, int wr, int wc, int fr, int fq, PG8_LAS unsigned char* lds, int wid, int lane) const {
        typedef float f32x2v __attribute__((ext_vector_type(2)));
        PG8_LAS f32x2v* P = (PG8_LAS f32x2v*)lds;
        PG8_LAS f32x2v* S = (PG8_LAS f32x2v*)(lds + 8192);
        PG8_LAS unsigned* flag = (PG8_LAS unsigned*)(lds + 8192 + 2048);
#pragma unroll
        for (int ai = 0; ai < 2; ++ai)
#pragma unroll
            for (int m = 0; m < 4; ++m) {
                float s = 0.f;
#pragma unroll
                for (int bj = 0; bj < 2; ++bj)
#pragma unroll
                    for (int n = 0; n < 2; ++n) { const f32x4 x = v[ai][bj][m][n]; s += (x[0] + x[1]) + (x[2] + x[3]); }
                s += __shfl_xor(s, 16); s += __shfl_xor(s, 32);
                const float mw = s * (1.0f / 64.0f); float q = 0.f;
#pragma unroll
                for (int bj = 0; bj < 2; ++bj)
#pragma unroll
                    for (int n = 0; n < 2; ++n) { const f32x4 d = v[ai][bj][m][n] - mw; q += (d[0] * d[0] + d[1] * d[1]) + (d[2] * d[2] + d[3] * d[3]); }
                q += __shfl_xor(q, 16); q += __shfl_xor(q, 32);
                if (fq == 0) P[(ai * HALF + wr * 64 + m * 16 + fr) * 4 + wc] = (f32x2v){mw, q};
            }
        asm volatile("s_waitcnt lgkmcnt(0)" ::: "memory"); __builtin_amdgcn_s_barrier(); asm volatile("" ::: "memory");
#if defined(BROKEN_NO_WAIT)
        if (blockIdx.x >= 64) { const long long t0 = clock64(); while (clock64() - t0 < 60000) __builtin_amdgcn_s_sleep(8); }
#endif
        const int row = wid * 32 + (lane & 31);
        if (lane < 32) {
            const f32x2v a = P[row * 4 + 0], b = P[row * 4 + 1], c = P[row * 4 + 2], d = P[row * 4 + 3];
            const float mt = (a.x + b.x + c.x + d.x) * 0.25f;
            const float da = a.x - mt, db = b.x - mt, dc = c.x - mt, dd = d.x - mt;
            const float m2 = (a.y + b.y) + (c.y + d.y) + 64.0f * ((da * da + db * db) + (dc * dc + dd * dd));
            unsigned long long* slot = (unsigned long long*)xbuf + ((size_t)(u.pm * BM + row) * 4 + u.pn);
            __hip_atomic_store(slot, ((unsigned long long)__float_as_uint(m2) << 32) | __float_as_uint(mt), __ATOMIC_RELAXED, __HIP_MEMORY_SCOPE_AGENT);
        }
        asm volatile("s_waitcnt vmcnt(0)" ::: "memory");
        if (lane == 0) __hip_atomic_fetch_add(cnt + 64 * u.pm, 1u, __ATOMIC_RELAXED, __HIP_MEMORY_SCOPE_AGENT);
        if (wid == 0) {
            bool dead = false; const unsigned long long t0 = __builtin_amdgcn_s_memrealtime(); const unsigned want = 8u * (unsigned)ntn;
            for (;;) {
#if defined(BROKEN_NO_WAIT)
                break;
#endif
                if ((unsigned)__builtin_amdgcn_readfirstlane(__hip_atomic_load(cnt + 64 * u.pm, __ATOMIC_RELAXED, __HIP_MEMORY_SCOPE_AGENT)) >= want) break;
                if (__builtin_amdgcn_s_memrealtime() - t0 > 2000000ull) {
                    if (lane == 0) { unsigned expect = 0u; __hip_atomic_compare_exchange_strong(tmo + 1, &expect, code | (unsigned)(u.pm & 0xff), __ATOMIC_RELAXED, __ATOMIC_RELAXED, __HIP_MEMORY_SCOPE_AGENT);
                                     __hip_atomic_store(tmo, 1u, __ATOMIC_RELAXED, __HIP_MEMORY_SCOPE_AGENT); }
                    dead = true; break; }
                __builtin_amdgcn_s_sleep(2);
            }
            __builtin_amdgcn_fence(__ATOMIC_ACQUIRE, "agent");
            if (lane == 0) flag[0] = dead ? 1u : 0u;
        }
        asm volatile("s_waitcnt vmcnt(0) lgkmcnt(0)" ::: "memory"); __builtin_amdgcn_s_barrier(); asm volatile("" ::: "memory");
        const bool bad = flag[0] != 0u;
        if (lane < 32) {
            const unsigned long long* slot = (const unsigned long long*)xbuf + (size_t)(u.pm * BM + row) * 4; float mt[4], m2[4]; float ms = 0.f;
#pragma unroll
            for (int t = 0; t < 4; ++t) { if (t < ntn) { const unsigned long long w = __hip_atomic_load(slot + t, __ATOMIC_RELAXED, __HIP_MEMORY_SCOPE_AGENT); mt[t] = __uint_as_float((unsigned)w); m2[t] = __uint_as_float((unsigned)(w >> 32)); } else { mt[t] = 0.f; m2[t] = 0.f; } ms += mt[t]; }
            const float mean = ms / (float)ntn; float q = 0.f;
#pragma unroll
            for (int t = 0; t < 4; ++t) if (t < ntn) { const float dm = mt[t] - mean; q += m2[t] + 256.0f * dm * dm; }
            S[row] = (f32x2v){mean, 1.0f / sqrtf(q / (256.0f * (float)ntn) + eps)};
        }
        asm volatile("s_waitcnt lgkmcnt(0)" ::: "memory"); __builtin_amdgcn_s_barrier(); asm volatile("" ::: "memory");
        return bad;
    }
};
struct EpiLnRes {
    static constexpr bool PERM = false, AFTER_DRAIN = true;
    const float* base; float* out; int ldc; const float* bias; PanelStats st; unsigned poison;
    __device__ __forceinline__ void refuse(size_t i0, size_t stride, int M, int N) const { const float q = __builtin_nanf(""); for (size_t i = i0; i < (size_t)M * N; i += stride) out[(i / N) * ldc + i % N] = q;
        if (i0 == 0) { unsigned expect = 0u; __hip_atomic_compare_exchange_strong(st.tmo + 1, &expect, 0x7f0u, __ATOMIC_RELAXED, __ATOMIC_RELAXED, __HIP_MEMORY_SCOPE_AGENT); __hip_atomic_store(st.tmo, 1u, __ATOMIC_RELAXED, __HIP_MEMORY_SCOPE_AGENT); } }
    __device__ __forceinline__ void fused(f32x4 (&acc)[2][2][4][2], const Unit& u, int wr, int wc, int fr, int fq, PG8_LAS unsigned char* lds, int wid, int lane) const {
        typedef float f32x2v __attribute__((ext_vector_type(2)));
        const PG8_LAS f32x2v* S = (const PG8_LAS f32x2v*)(lds + 8192);
        const int col0 = u.pn * BM + wc * 32 + 4 * fq;
#pragma unroll
        for (int bj = 0; bj < 2; ++bj)
#pragma unroll
            for (int n = 0; n < 2; ++n) { const f32x4 bv = bias ? *(const f32x4*)(bias + col0 + bj * HALF + n * 16) : (f32x4){0.f, 0.f, 0.f, 0.f};
#pragma unroll
                for (int ai = 0; ai < 2; ++ai)
#pragma unroll
                    for (int m = 0; m < 4; ++m) acc[ai][bj][m][n] += bv; }
        const bool bad = st.run(acc, u, wr, wc, fr, fq, lds, wid, lane) || poison != 0u;
        const float qnan = __builtin_nanf("");
#pragma unroll
        for (int ai = 0; ai < 2; ++ai)
#pragma unroll
            for (int m = 0; m < 4; ++m) { const int r = ai * HALF + wr * 64 + m * 16 + fr; const f32x2v sr = S[r]; const size_t off = (size_t)(u.pm * BM + r) * ldc + col0;
#pragma unroll
                for (int bj = 0; bj < 2; ++bj)
#pragma unroll
                    for (int n = 0; n < 2; ++n) { const f32x4 bs = *(const f32x4*)(base + off + bj * HALF + n * 16); f32x4 o = bs + (acc[ai][bj][m][n] - sr.x) * sr.y;
                        if (bad) o = (f32x4){qnan, qnan, qnan, qnan}; *(f32x4*)(out + off + bj * HALF + n * 16) = o; }
                asm volatile("" ::: "memory"); }
    }
};
struct EpiLnResLn {
    static constexpr bool PERM = false, AFTER_DRAIN = true;
    const float* base; float* out; bf16_t* xn; int ldc; const float* bias; PanelStats st1, st2; unsigned poison;
    __device__ __forceinline__ void refuse(size_t i0, size_t stride, int M, int N) const { const float q = __builtin_nanf(""); for (size_t i = i0; i < (size_t)M * N; i += stride) { const size_t o = (i / N) * ldc + i % N; out[o] = q; xn[o] = (bf16_t)0x7fc0u; }
        if (i0 == 0) { unsigned expect = 0u; __hip_atomic_compare_exchange_strong(st1.tmo + 1, &expect, 0x7f0u, __ATOMIC_RELAXED, __ATOMIC_RELAXED, __HIP_MEMORY_SCOPE_AGENT); __hip_atomic_store(st1.tmo, 1u, __ATOMIC_RELAXED, __HIP_MEMORY_SCOPE_AGENT); } }
    __device__ __forceinline__ void fused(f32x4 (&acc)[2][2][4][2], const Unit& u, int wr, int wc, int fr, int fq, PG8_LAS unsigned char* lds, int wid, int lane) const {
        typedef float f32x2v __attribute__((ext_vector_type(2))); typedef unsigned u32x2v __attribute__((ext_vector_type(2)));
        const PG8_LAS f32x2v* S = (const PG8_LAS f32x2v*)(lds + 8192);
        const int col0 = u.pn * BM + wc * 32 + 4 * fq;
#pragma unroll
        for (int bj = 0; bj < 2; ++bj)
#pragma unroll
            for (int n = 0; n < 2; ++n) { const f32x4 bv = bias ? *(const f32x4*)(bias + col0 + bj * HALF + n * 16) : (f32x4){0.f, 0.f, 0.f, 0.f};
#pragma unroll
                for (int ai = 0; ai < 2; ++ai)
#pragma unroll
                    for (int m = 0; m < 4; ++m) acc[ai][bj][m][n] += bv; }
        bool bad = st1.run(acc, u, wr, wc, fr, fq, lds, wid, lane) || poison != 0u;
        const float qnan = __builtin_nanf("");
#pragma unroll
        for (int ai = 0; ai < 2; ++ai)
#pragma unroll
            for (int m = 0; m < 4; ++m) { const int r = ai * HALF + wr * 64 + m * 16 + fr; const f32x2v sr = S[r]; const size_t off = (size_t)(u.pm * BM + r) * ldc + col0;
#pragma unroll
                for (int bj = 0; bj < 2; ++bj)
#pragma unroll
                    for (int n = 0; n < 2; ++n) { const f32x4 bs = *(const f32x4*)(base + off + bj * HALF + n * 16); acc[ai][bj][m][n] = bs + (acc[ai][bj][m][n] - sr.x) * sr.y; }
                asm volatile("" : "+v"(acc[ai][0][m][0]), "+v"(acc[ai][0][m][1]), "+v"(acc[ai][1][m][0]), "+v"(acc[ai][1][m][1]));
                if (m & 1) asm volatile("" ::: "memory"); }
        const bool bad1 = bad;
        bad = st2.run(acc, u, wr, wc, fr, fq, lds, wid, lane) || bad;
#pragma unroll
        for (int ai = 0; ai < 2; ++ai)
#pragma unroll
            for (int m = 0; m < 4; ++m) { const int r = ai * HALF + wr * 64 + m * 16 + fr; const f32x2v sr = S[r]; const size_t off = (size_t)(u.pm * BM + r) * ldc + col0;
#pragma unroll
                for (int bj = 0; bj < 2; ++bj)
#pragma unroll
                    for (int n = 0; n < 2; ++n) { const f32x4 x1 = acc[ai][bj][m][n]; *(f32x4*)(out + off + bj * HALF + n * 16) = bad1 ? (f32x4){qnan, qnan, qnan, qnan} : x1;
                        const f32x4 o = (x1 - sr.x) * sr.y; u32x2v w; w.x = cvt_pk_bf16(o[0], o[1]); w.y = cvt_pk_bf16(o[2], o[3]);
                        if (bad) { w.x = 0x7fc07fc0u; w.y = 0x7fc07fc0u; } *(u32x2v*)(xn + off + bj * HALF + n * 16) = w; }
                asm volatile("" ::: "memory"); }
    }
};

template <class Epi, class Sched, bool STAMP = false>
__device__ __forceinline__ void gemm_phase(PG8_LAS unsigned char* lds, const Gemm g, const Sched& S, const Epi& E, unsigned long long* stamps) {
    const int tid = threadIdx.x, wid = __builtin_amdgcn_readfirstlane(tid >> 6), lane = tid & 63, wr = wid >> 2, wc = wid & 3, fr = lane & 15, fq = lane >> 4;
    const int K = g.K, nt = K / BK;
    int ts_lo = 0, ts_hi = 0, nts = 0; const unsigned long long rt_entry = STAMP ? (unsigned long long)wall_clock64() : 0ull;
#define PG8_STAMP() do { if (STAMP && wid == 0 && nts < 64) { const unsigned long long _c = (unsigned long long)clock64(); \
        ts_lo = (lane == nts) ? (int)(unsigned)_c : ts_lo; ts_hi = (lane == nts) ? (int)(unsigned)(_c >> 32) : ts_hi; ++nts; } } while (0)
    PG8_STAMP();
    unsigned voffA[2], voffB[2];
#pragma unroll
    for (int i = 0; i < 2; ++i) { int R, C; stage_rc(tid * 16 + i * 8192, R, C); const int Rb = Epi::PERM ? ((R & ~31) + perm32(R & 31)) : R;
        voffA[i] = (unsigned)(R * K + C) * 2u; voffB[i] = (unsigned)(Rb * K + C) * 2u; }
    const size_t kstep = (size_t)(BK * 2);
    const size_t hstep = (size_t)HALF * K * 2;
    const size_t tstep = 2 * hstep;
    const unsigned ldsw = (unsigned)wid * 1024u;
    const int aoff = lds_byte(wr * 64 + fr, fq * 8), boff = lds_byte(wc * 32 + fr, fq * 8);
#define PG8_SA(b, h) (((b) * 2 + (h)) * HTB)
#define PG8_SB(b, h) ((4 + (b) * 2 + (h)) * HTB)
#define PG8_STAGE(bufoff, gbase, voff) do { _Pragma("unroll") for (int _i = 0; _i < 2; ++_i) \
        __builtin_amdgcn_global_load_lds((const unsigned*)((const char*)(gbase) + (voff)[_i]), (PG8_LAS unsigned*)(lds + (bufoff) + ldsw + _i * 8192), 16, 0, 0); } while (0)
#define PG8_LDA(dst, b, h) do { _Pragma("unroll") for (int m = 0; m < 4; ++m) _Pragma("unroll") for (int k = 0; k < 2; ++k) dst[m][k] = *(const PG8_LAS bf16x8*)(lds + PG8_SA(b, h) + aoff + m * 2048 + k * 1024); } while (0)
#define PG8_LDB(dst, b, h) do { _Pragma("unroll") for (int n = 0; n < 2; ++n) _Pragma("unroll") for (int k = 0; k < 2; ++k) dst[n][k] = *(const PG8_LAS bf16x8*)(lds + PG8_SB(b, h) + boff + n * 2048 + k * 1024); } while (0)
#define PG8_MMA(ai, bj, At, Bt) do { __builtin_amdgcn_s_setprio(1); _Pragma("unroll") for (int m = 0; m < 4; ++m) _Pragma("unroll") for (int n = 0; n < 2; ++n) _Pragma("unroll") for (int k = 0; k < 2; ++k) \
        acc[ai][bj][m][n] = __builtin_amdgcn_mfma_f32_16x16x32_bf16(Bt[n][k], At[m][k], acc[ai][bj][m][n], 0, 0, 0); __builtin_amdgcn_s_setprio(0); } while (0)
#define PG8_WAIT_V(n) asm volatile("s_waitcnt vmcnt(" #n ")" ::: "memory")
#define PG8_WAIT_L(n) asm volatile("s_waitcnt lgkmcnt(" #n ")" ::: "memory")
#define PG8_BAR __builtin_amdgcn_s_barrier()
#define PG8_SCHED __builtin_amdgcn_sched_barrier(0)
    Unit cur, nxt; int ui = 0;
    if (!S.next(0, cur)) return;
    f32x4 acc[2][2][4][2];
#pragma unroll
    for (int a = 0; a < 2; ++a)
#pragma unroll
        for (int b = 0; b < 2; ++b)
#pragma unroll
            for (int m = 0; m < 4; ++m)
#pragma unroll
                for (int n = 0; n < 2; ++n) acc[a][b][m][n] = (f32x4){0.f, 0.f, 0.f, 0.f};
    bf16x8 At[4][2], B0[2][2], B1[2][2];
    const char* cA = (const char*)g.A + (size_t)cur.pm * tstep; const char* cB = (const char*)g.Bt + (size_t)cur.pn * tstep;
    S.a_ready(cur);
    PG8_STAGE(PG8_SB(0, 0), cB, voffB); PG8_STAGE(PG8_SA(0, 0), cA, voffA); PG8_STAGE(PG8_SB(0, 1), cB + hstep, voffB); PG8_STAGE(PG8_SA(0, 1), cA + hstep, voffA);
    if (wr == 1) PG8_BAR;
    PG8_WAIT_V(4); PG8_BAR;
    PG8_STAGE(PG8_SB(1, 0), cB + kstep, voffB); PG8_STAGE(PG8_SA(1, 0), cA + kstep, voffA); PG8_STAGE(PG8_SB(1, 1), cB + hstep + kstep, voffB);
    PG8_WAIT_V(6); PG8_BAR;
    PG8_STAMP();
    for (;;) {
        const bool has_next = S.next(ui + 1, nxt);
        const char* nA = has_next ? (const char*)g.A + (size_t)nxt.pm * tstep : cA; const char* nB = has_next ? (const char*)g.Bt + (size_t)nxt.pn * tstep : cB;
        for (int t = 0; t < nt; t += 2) {
            const bool last = (t == nt - 2);
            const char* a1 = cA + (size_t)(t + 1) * kstep;
            const char* a2 = last ? nA : cA + (size_t)(t + 2) * kstep; const char* b2 = last ? nB : cB + (size_t)(t + 2) * kstep;
            const char* a3 = a2 + kstep; const char* b3 = b2 + kstep;
            if (last && has_next) S.a_ready(nxt);
            PG8_LDB(B0, 0, 0); PG8_SCHED; PG8_LDA(At, 0, 0); PG8_STAGE(PG8_SA(1, 1), a1 + hstep, voffA);
            PG8_WAIT_L(8); PG8_BAR; PG8_WAIT_L(0); PG8_MMA(0, 0, At, B0); PG8_BAR; PG8_SCHED;
            PG8_LDB(B1, 0, 1); PG8_STAGE(PG8_SB(0, 0), b2, voffB);
            PG8_BAR; PG8_WAIT_L(0); PG8_MMA(0, 1, At, B1); PG8_BAR;
            PG8_LDA(At, 0, 1); PG8_STAGE(PG8_SA(0, 0), a2, voffA);
            PG8_BAR; PG8_WAIT_L(0); PG8_MMA(1, 0, At, B0); PG8_BAR; PG8_SCHED;
            PG8_STAGE(PG8_SB(0, 1), b2 + hstep, voffB);
            PG8_WAIT_V(6); PG8_BAR; PG8_MMA(1, 1, At, B1); PG8_BAR;
            PG8_LDB(B0, 1, 0); PG8_SCHED; PG8_LDA(At, 1, 0); PG8_STAGE(PG8_SA(0, 1), a2 + hstep, voffA);
            PG8_WAIT_L(8); PG8_BAR; PG8_WAIT_L(0); PG8_MMA(0, 0, At, B0); PG8_BAR; PG8_SCHED;
            PG8_LDB(B1, 1, 1); PG8_STAGE(PG8_SB(1, 0), b3, voffB);
            PG8_BAR; PG8_WAIT_L(0); PG8_MMA(0, 1, At, B1); PG8_BAR;
            PG8_LDA(At, 1, 1); PG8_STAGE(PG8_SA(1, 0), a3, voffA);
            PG8_BAR; PG8_WAIT_L(0); PG8_MMA(1, 0, At, B0); PG8_BAR; PG8_SCHED;
            PG8_STAGE(PG8_SB(1, 1), b3 + hstep, voffB);
            PG8_WAIT_V(6); PG8_BAR; PG8_MMA(1, 1, At, B1); PG8_BAR;
        }
        PG8_STAMP();
        if constexpr (!Epi::AFTER_DRAIN) { E(acc, cur, wr, wc, fr, fq); S.done(cur); }
        PG8_STAMP();
        if (!has_next) break;
#pragma unroll
        for (int a = 0; a < 2; ++a)
#pragma unroll
            for (int b = 0; b < 2; ++b)
#pragma unroll
                for (int m = 0; m < 4; ++m)
#pragma unroll
                    for (int n = 0; n < 2; ++n) acc[a][b][m][n] = (f32x4){0.f, 0.f, 0.f, 0.f};
        cur = nxt; cA = nA; cB = nB; ++ui;
    }
    PG8_WAIT_V(0);
    if (wr == 0) PG8_BAR;
    PG8_BAR;
    if constexpr (Epi::AFTER_DRAIN) { E.fused(acc, cur, wr, wc, fr, fq, lds, wid, lane); S.done(cur); }
    PG8_STAMP();
    if (STAMP && wid == 0) { stamps[lane] = lane < nts ? (((unsigned long long)(unsigned)ts_hi << 32) | (unsigned)ts_lo) : 0ull;
        if (lane == 62) stamps[62] = rt_entry; if (lane == 63) stamps[63] = (unsigned long long)wall_clock64(); }
#undef PG8_STAMP
#undef PG8_SA
#undef PG8_SB
#undef PG8_STAGE
#undef PG8_LDA
#undef PG8_LDB
#undef PG8_MMA
#undef PG8_WAIT_V
#undef PG8_WAIT_L
#undef PG8_BAR
#undef PG8_SCHED
}
}

#include <hip/hip_cooperative_groups.h>
#include <cstdio>
namespace cg = cooperative_groups;
using pg8::bf16_t; using pg8::bf16x8; using pg8::f32x4; using pg8::Unit;
typedef float f32x16 __attribute__((ext_vector_type(16)));
typedef unsigned u32x2 __attribute__((ext_vector_type(2)));
typedef unsigned u32x4v __attribute__((ext_vector_type(4)));
#define LAS __attribute__((address_space(3)))

constexpr int MT = 16896, MPR = 16384, DM = 1024, NIN = 2816, DFF = 2816;
constexpr float EPS = 1e-6f;
constexpr int LDS_BYTES = 143360;
#ifndef N_LAUNCH_MODE
#define N_LAUNCH_MODE 1
#endif
constexpr int NPHASE = 13;

constexpr size_t WS_WIN = 0;
constexpr size_t WS_WOUT = WS_WIN + (size_t)2816 * 1024 * 2;
constexpr size_t WS_WQ = WS_WOUT + (size_t)1024 * 1024 * 2;
constexpr size_t WS_WKV = WS_WQ + (size_t)1024 * 1024 * 2;
constexpr size_t WS_WO = WS_WKV + (size_t)2048 * 1024 * 2;
constexpr size_t WS_WGU = WS_WO + (size_t)1024 * 1024 * 2;
constexpr size_t WS_WD = WS_WGU + (size_t)5632 * 1024 * 2;
constexpr size_t WS_A = WS_WD + (size_t)1024 * 2816 * 2;
constexpr size_t WS_MN = WS_A + (size_t)MT * 1024 * 2;
constexpr size_t WS_MKB = WS_MN + (size_t)2048 * 1024 * 2;
constexpr size_t WS_MVT = WS_MKB + (size_t)2048 * 1024 * 2;
constexpr size_t WS_P = WS_MVT + (size_t)2048 * 1024 * 2;
constexpr size_t WS_U = WS_P + (size_t)MT * 2816 * 2;
constexpr size_t WS_DS = WS_U;
constexpr size_t WS_ST = WS_DS + (size_t)1024 * 8192 * 4;
constexpr size_t WS_AF = WS_ST + (size_t)1024 * 8192 * 2;
constexpr size_t WS_DEC = WS_AF + (size_t)MT * 16 * 4;
constexpr size_t WS_H = WS_U + (size_t)MT * 2816 * 2;
constexpr size_t WS_HB = WS_H + (size_t)MT * 1024 * 4;
constexpr size_t WS_SSQ = WS_HB + (size_t)MT * 1024 * 2;
constexpr size_t WS_END = WS_SSQ + (size_t)3 * MT * 16 * 4;

constexpr size_t O_Y = 0;
constexpr size_t O_SGP = 17301504;
constexpr size_t O_SCP = 17563648;
constexpr size_t O_MK = 17608704;
constexpr size_t O_MV = 19705856;
constexpr size_t O_SGS = 21803008;
constexpr size_t O_SCS = 25997312;
constexpr size_t O_SV = 26718208;

struct Params { const float* in[29]; float* out; unsigned char* ws; int ph_lo, ph_hi; };

__device__ __forceinline__ unsigned pk2(float lo, float hi) { return pg8::cvt_pk_bf16(lo, hi); }
__device__ __forceinline__ bf16_t f2bf(float f) { return (bf16_t)(pk2(f, 0.f) & 0xffffu); }
__device__ __forceinline__ float bf2f(bf16_t b) { return __uint_as_float(((unsigned)b) << 16); }
__device__ __forceinline__ float bflo(unsigned w) { return __uint_as_float(w << 16); }
__device__ __forceinline__ float bfhi(unsigned w) { return __uint_as_float(w & 0xffff0000u); }
__device__ __forceinline__ float gelu_t(float x) { const float y = 0.7978845608f * (x + 0.044715f * x * x * x); return x * __frcp_rn(1.0f + __expf(-2.0f * y)); }
__device__ __forceinline__ float silu_f(float x) { return x * __frcp_rn(1.0f + __expf(-x)); }
__device__ __forceinline__ float logsig(float z) { return fminf(z, 0.f) - __logf(1.0f + __expf(-fabsf(z))); }
__device__ __forceinline__ float wave_sum(float s) { for (int o = 32; o >= 1; o >>= 1) s += __shfl_xor(s, o); return s; }
__device__ __forceinline__ float wave_max(float s) { for (int o = 32; o >= 1; o >>= 1) s = fmaxf(s, __shfl_xor(s, o)); return s; }
__device__ __forceinline__ f32x16 mma32(bf16x8 a, bf16x8 b, f32x16 c) { return __builtin_amdgcn_mfma_f32_32x32x16_bf16(a, b, c, 0, 0, 0); }
__device__ __forceinline__ f32x16 zero16() { f32x16 z; for (int i = 0; i < 16; ++i) z[i] = 0.f; return z; }
__device__ __forceinline__ float row_rs(const float* ssq, int row) {
    const f32x4* p = (const f32x4*)(ssq + (size_t)row * 16); f32x4 a = p[0], b = p[1], c = p[2], d = p[3];
    const float s = ((a[0] + a[1]) + (a[2] + a[3])) + ((b[0] + b[1]) + (b[2] + b[3])) + ((c[0] + c[1]) + (c[2] + c[3])) + ((d[0] + d[1]) + (d[2] + d[3]));
    return rsqrtf(s * (1.0f / 1024.0f) + EPS);
}

#define EPI_LOOP_ROWS for (int ai = 0; ai < 2; ++ai) _Pragma("unroll") for (int m = 0; m < 4; ++m)
#define EPI_LOOP_COLS for (int bj = 0; bj < 2; ++bj) _Pragma("unroll") for (int n = 0; n < 2; ++n)
struct EpiIn {
    static constexpr bool PERM = false, AFTER_DRAIN = false;
    bf16_t* P; float* af;
    __device__ __forceinline__ void operator()(const f32x4 (&acc)[2][2][4][2], const Unit& u, int wr, int wc, int fr, int fq) const {
        const int row0 = u.pm * 256 + wr * 64 + fr, col0 = u.pn * 256 + wc * 32 + 4 * fq;
#pragma unroll
        EPI_LOOP_ROWS { const int row = row0 + ai * 128 + m * 16;
#pragma unroll
            EPI_LOOP_COLS { const f32x4 v = acc[ai][bj][m][n]; u32x2 w; w.x = pk2(v[0], v[1]); w.y = pk2(v[2], v[3]);
                *(u32x2*)(P + (size_t)row * NIN + col0 + bj * 128 + n * 16) = w; }
            if (u.pn == 10 && wc == 0) *(f32x4*)(af + (size_t)row * 16 + 4 * fq) = acc[ai][0][m][0];
        }
    }
};
struct EpiKV {
    static constexpr bool PERM = false, AFTER_DRAIN = false;
    float* omk; float* omv; bf16_t* mkb; bf16_t* mvt;
    __device__ __forceinline__ void operator()(const f32x4 (&acc)[2][2][4][2], const Unit& u, int wr, int wc, int fr, int fq) const {
        const int row0 = u.pm * 256 + wr * 64 + fr, col0 = u.pn * 256 + wc * 32 + 4 * fq;
#pragma unroll
        EPI_LOOP_ROWS { const int row = row0 + ai * 128 + m * 16;
#pragma unroll
            EPI_LOOP_COLS { const f32x4 v = acc[ai][bj][m][n]; const int col = col0 + bj * 128 + n * 16;
                if (col < 1024) { *(f32x4*)(omk + (size_t)row * 1024 + col) = v; u32x2 w; w.x = pk2(v[0], v[1]); w.y = pk2(v[2], v[3]); *(u32x2*)(mkb + (size_t)row * 1024 + col) = w; }
                else { const int c2 = col - 1024; *(f32x4*)(omv + (size_t)row * 1024 + c2) = v;
                    const int b = row >> 8, mt = row & 255, h = c2 >> 8, d = c2 & 255; bf16_t* t = mvt + ((size_t)(b * 4 + h) * 256 + d) * 256 + mt;
                    t[0] = f2bf(v[0]); t[256] = f2bf(v[1]); t[512] = f2bf(v[2]); t[768] = f2bf(v[3]); } }
        }
    }
};
struct EpiRes {
    static constexpr bool PERM = false, AFTER_DRAIN = false;
    const float* baseP; const float* baseS; float* h32; bf16_t* hb; float* ssq;
    __device__ __forceinline__ void operator()(const f32x4 (&acc)[2][2][4][2], const Unit& u, int wr, int wc, int fr, int fq) const {
        const int row0 = u.pm * 256 + wr * 64 + fr, col0 = u.pn * 256 + wc * 32 + 4 * fq;
        const float* base = (u.pm < 64) ? baseP : baseS - (size_t)MPR * 1024;
#pragma unroll
        EPI_LOOP_ROWS { const int row = row0 + ai * 128 + m * 16; float s = 0.f;
#pragma unroll
            EPI_LOOP_COLS { const size_t off = (size_t)row * 1024 + col0 + bj * 128 + n * 16; const f32x4 v = acc[ai][bj][m][n] + *(const f32x4*)(base + off);
                *(f32x4*)(h32 + off) = v; if (hb) { u32x2 w; w.x = pk2(v[0], v[1]); w.y = pk2(v[2], v[3]); *(u32x2*)(hb + off) = w; }
                s += (v[0] * v[0] + v[1] * v[1]) + (v[2] * v[2] + v[3] * v[3]); }
            s += __shfl_xor(s, 16); s += __shfl_xor(s, 32);
            if (fq == 0) ssq[(size_t)row * 16 + u.pn * 4 + wc] = s;
        }
    }
};
struct EpiQ {
    static constexpr bool PERM = false, AFTER_DRAIN = false;
    bf16_t* Q; const float* ssq;
    __device__ __forceinline__ void operator()(const f32x4 (&acc)[2][2][4][2], const Unit& u, int wr, int wc, int fr, int fq) const {
        const int row0 = u.pm * 256 + wr * 64 + fr, col0 = u.pn * 256 + wc * 32 + 4 * fq;
#pragma unroll
        EPI_LOOP_ROWS { const int row = row0 + ai * 128 + m * 16; const float rs = row_rs(ssq, row);
#pragma unroll
            EPI_LOOP_COLS { const f32x4 v = acc[ai][bj][m][n] * rs; u32x2 w; w.x = pk2(v[0], v[1]); w.y = pk2(v[2], v[3]);
                *(u32x2*)(Q + (size_t)row * 1024 + col0 + bj * 128 + n * 16) = w; }
        }
    }
};
struct EpiGU {
    static constexpr bool PERM = false, AFTER_DRAIN = false;
    bf16_t* G; bf16_t* U; const float* ssq; float* scp; float* scs;
    __device__ __forceinline__ void operator()(const f32x4 (&acc)[2][2][4][2], const Unit& u, int wr, int wc, int fr, int fq) const {
        const int row0 = u.pm * 256 + wr * 64 + fr, col0 = u.pn * 256 + wc * 32 + 4 * fq;
        const bool isg = u.pn < 11;
#pragma unroll
        EPI_LOOP_ROWS { const int row = row0 + ai * 128 + m * 16; const float rs = row_rs(ssq, row);
            float* sc = nullptr;
            if (isg) { if (row < MPR) { const int t = row & 2047; if (t >= 2046) sc = scp + (size_t)((row >> 11) * 2 + (t - 2046)) * DFF; }
                       else { const int r2 = row - MPR, t = r2 & 3; if (t >= 2) sc = scs + (size_t)((r2 >> 2) * 2 + (t - 2)) * DFF; } }
#pragma unroll
            EPI_LOOP_COLS { const f32x4 v = acc[ai][bj][m][n] * rs; u32x2 w; w.x = pk2(v[0], v[1]); w.y = pk2(v[2], v[3]); const int col = col0 + bj * 128 + n * 16;
                if (isg) { *(u32x2*)(G + (size_t)row * DFF + col) = w; if (sc) *(f32x4*)(sc + col) = v; }
                else *(u32x2*)(U + (size_t)row * DFF + (col - DFF)) = w; }
        }
    }
};

__device__ __forceinline__ int win_src_col(int n) { return n < 1536 ? n : (n < 2560 ? n + 16 : (n < 2576 ? n - 1024 : -1)); }
__device__ __forceinline__ void tr_tile(LAS float* T, const float* src, int ldn, bf16_t* dst, int K, int k0, int n0, const float* ksc, bool cmap) {
    const int tid = threadIdx.x;
#pragma unroll
    for (int i = 0; i < 2; ++i) { const int kk = (tid >> 4) + 32 * i, n4 = (tid & 15) * 4; int sc = n0 + n4; if (cmap) sc = win_src_col(sc);
        f32x4 v = (f32x4){0.f, 0.f, 0.f, 0.f}; if (sc >= 0) v = *(const f32x4*)(src + (size_t)(k0 + kk) * ldn + sc);
        if (ksc) v = v * ksc[k0 + kk];
        T[kk * 65 + n4] = v[0]; T[kk * 65 + n4 + 1] = v[1]; T[kk * 65 + n4 + 2] = v[2]; T[kk * 65 + n4 + 3] = v[3]; }
    __syncthreads();
    { const int n = tid >> 3, k8 = (tid & 7) * 8; u32x4v w;
      w.x = pk2(T[(k8 + 0) * 65 + n], T[(k8 + 1) * 65 + n]); w.y = pk2(T[(k8 + 2) * 65 + n], T[(k8 + 3) * 65 + n]);
      w.z = pk2(T[(k8 + 4) * 65 + n], T[(k8 + 5) * 65 + n]); w.w = pk2(T[(k8 + 6) * 65 + n], T[(k8 + 7) * 65 + n]);
      *(u32x4v*)(dst + (size_t)(n0 + n) * K + k0 + k8) = w; }
    __syncthreads();
}
__device__ __forceinline__ void norm_row(const float* x, const float* g, bf16_t* o, int lane) {
    f32x4 v[4]; float s = 0.f;
#pragma unroll
    for (int i = 0; i < 4; ++i) { v[i] = *(const f32x4*)(x + i * 256 + lane * 4); s += (v[i][0] * v[i][0] + v[i][1] * v[i][1]) + (v[i][2] * v[i][2] + v[i][3] * v[i][3]); }
    s = wave_sum(s); const float rs = rsqrtf(s * (1.0f / 1024.0f) + EPS);
#pragma unroll
    for (int i = 0; i < 4; ++i) { const f32x4 gg = *(const f32x4*)(g + i * 256 + lane * 4); const f32x4 y = v[i] * rs * gg; u32x2 w; w.x = pk2(y[0], y[1]); w.y = pk2(y[2], y[3]);
        *(u32x2*)(o + i * 256 + lane * 4) = w; }
}
__device__ void phase_prep(const Params& p, LAS unsigned char* lds) {
    unsigned char* ws = p.ws; LAS float* T = (LAS float*)lds;
    const int tid = threadIdx.x, lane = tid & 63, wave = tid >> 6;
    for (int j = blockIdx.x; j < 4096; j += gridDim.x) {
        const float* src; int ldn, K, nt; bf16_t* dst; const float* ksc = nullptr; bool cmap = false; int jj = j;
        if (jj < 704) { src = p.in[8]; ldn = 2576; K = 1024; nt = 44; dst = (bf16_t*)(ws + WS_WIN); cmap = true; }
        else if ((jj -= 704) < 256) { src = p.in[15]; ldn = 1024; K = 1024; nt = 16; dst = (bf16_t*)(ws + WS_WOUT); }
        else if ((jj -= 256) < 256) { src = p.in[18]; ldn = 1024; K = 1024; nt = 16; dst = (bf16_t*)(ws + WS_WQ); ksc = p.in[16]; }
        else if ((jj -= 256) < 256) { src = p.in[19]; ldn = 1024; K = 1024; nt = 16; dst = (bf16_t*)(ws + WS_WKV); }
        else if ((jj -= 256) < 256) { src = p.in[20]; ldn = 1024; K = 1024; nt = 16; dst = (bf16_t*)(ws + WS_WKV) + (size_t)1024 * 1024; }
        else if ((jj -= 256) < 256) { src = p.in[21]; ldn = 1024; K = 1024; nt = 16; dst = (bf16_t*)(ws + WS_WO); }
        else if ((jj -= 256) < 704) { src = p.in[23]; ldn = 2816; K = 1024; nt = 44; dst = (bf16_t*)(ws + WS_WGU); ksc = p.in[22]; }
        else if ((jj -= 704) < 704) { src = p.in[24]; ldn = 2816; K = 1024; nt = 44; dst = (bf16_t*)(ws + WS_WGU) + (size_t)2816 * 1024; ksc = p.in[22]; }
        else { jj -= 704; src = p.in[27]; ldn = 1024; K = 2816; nt = 16; dst = (bf16_t*)(ws + WS_WD); }
        const int kt = jj / nt, ntile = jj % nt;
        tr_tile(T, src, ldn, dst, K, kt * 64, ntile * 64, ksc, cmap);
    }
    for (int r = blockIdx.x * 8 + wave; r < MT + 2048; r += gridDim.x * 8) {
        if (r < MPR) norm_row(p.in[0] + (size_t)r * 1024, p.in[7], (bf16_t*)(ws + WS_A) + (size_t)r * 1024, lane);
        else if (r < MT) norm_row(p.in[1] + (size_t)(r - MPR) * 1024, p.in[7], (bf16_t*)(ws + WS_A) + (size_t)r * 1024, lane);
        else norm_row(p.in[2] + (size_t)(r - MT) * 1024, p.in[17], (bf16_t*)(ws + WS_MN) + (size_t)(r - MT) * 1024, lane);
    }
}

constexpr int G_Q = 0, G_K = 9216, G_B = 18432, G_A = 35072, G_WA = 39168, G_BA = 43264, G_VT = 43520, G_X = 61952  , G_ST = 71168, G_RED = 89600, G_SEG = 90624, G_END = 92672;
__device__ __forceinline__ void gla_load(const Params& p, LAS unsigned char* lds, int b, int h, int c) {
    const int tid = threadIdx.x; const bf16_t* P = (const bf16_t*)(p.ws + WS_P); const float* af = (const float*)(p.ws + WS_AF);
    const int row0 = b * 2048 + c * 64;
    LAS bf16_t* Lq = (LAS bf16_t*)(lds + G_Q); LAS bf16_t* Lk = (LAS bf16_t*)(lds + G_K); LAS float* Lb = (LAS float*)(lds + G_B);
    LAS float* La = (LAS float*)(lds + G_A); LAS float* Lwa = (LAS float*)(lds + G_WA); LAS float* Lba = (LAS float*)(lds + G_BA);
    LAS bf16_t* LVt = (LAS bf16_t*)(lds + G_VT); LAS float* Lseg = (LAS float*)(lds + G_SEG);
    { const int i = tid >> 3, d8 = (tid & 7) * 8; const bf16_t* src = P + (size_t)(row0 + i) * NIN + h * 64 + d8;
      *(LAS u32x4v*)(Lq + i * 72 + d8) = *(const u32x4v*)src; *(LAS u32x4v*)(Lk + i * 72 + d8) = *(const u32x4v*)(src + 256); }
    if (tid < 256) { const int i = tid >> 2, r4 = (tid & 3) * 4; *(LAS f32x4*)(La + i * 16 + r4) = *(const f32x4*)(af + (size_t)(row0 + i) * 16 + r4); }
    else { const int t2 = tid - 256, r = t2 >> 4, d4 = (t2 & 15) * 4; *(LAS f32x4*)(Lwa + r * 64 + d4) = *(const f32x4*)(p.in[9] + r * 256 + h * 64 + d4); }
    if (tid < 64) Lba[tid] = p.in[10][h * 64 + tid];
#pragma unroll
    for (int i2 = 0; i2 < 2; ++i2) { const int idx = tid + 512 * i2, j = idx >> 4, v8 = (idx & 15) * 8;
        const u32x4v w = *(const u32x4v*)(P + (size_t)(row0 + j) * NIN + 512 + h * 128 + v8);
        LVt[(v8 + 0) * 72 + j] = (bf16_t)(w.x & 0xffff); LVt[(v8 + 1) * 72 + j] = (bf16_t)(w.x >> 16); LVt[(v8 + 2) * 72 + j] = (bf16_t)(w.y & 0xffff); LVt[(v8 + 3) * 72 + j] = (bf16_t)(w.y >> 16);
        LVt[(v8 + 4) * 72 + j] = (bf16_t)(w.z & 0xffff); LVt[(v8 + 5) * 72 + j] = (bf16_t)(w.z >> 16); LVt[(v8 + 6) * 72 + j] = (bf16_t)(w.w & 0xffff); LVt[(v8 + 7) * 72 + j] = (bf16_t)(w.w >> 16); }
    __syncthreads();
    { const int d = tid & 63, seg = tid >> 6; float acc = 0.f; float pre[8];
#pragma unroll
      for (int ii = 0; ii < 8; ++ii) { const int i = seg * 8 + ii; float z = Lba[d];
#pragma unroll
          for (int r = 0; r < 16; ++r) z += La[i * 16 + r] * Lwa[r * 64 + d];
          acc += logsig(z) * (1.0f / 16.0f); pre[ii] = acc; }
      Lseg[seg * 64 + d] = acc;
      __syncthreads();
      float off = 0.f;
#pragma unroll
      for (int s = 0; s < 8; ++s) if (s < seg) off += Lseg[s * 64 + d];
#pragma unroll
      for (int ii = 0; ii < 8; ++ii) Lb[(seg * 8 + ii) * 65 + d] = pre[ii] + off;
    }
    __syncthreads();
}
__device__ void gla_local(const Params& p, LAS unsigned char* lds, int item) {
    const int b = item >> 7, h = (item >> 5) & 3, c = item & 31; const int tid = threadIdx.x, lane = tid & 63, wave = tid >> 6;
    gla_load(p, lds, b, h, c);
    LAS bf16_t* Lk = (LAS bf16_t*)(lds + G_K); LAS float* Lb = (LAS float*)(lds + G_B); LAS bf16_t* LVt = (LAS bf16_t*)(lds + G_VT); LAS bf16_t* LKt = (LAS bf16_t*)(lds + G_X);
    float* dS = (float*)(p.ws + WS_DS) + (size_t)item * 8192; float* dec = (float*)(p.ws + WS_DEC) + (size_t)item * 64;
    { const int j = tid >> 3, d8 = (tid & 7) * 8;
#pragma unroll
      for (int e = 0; e < 8; ++e) { const float kv = bf2f(Lk[j * 72 + d8 + e]); LKt[(d8 + e) * 72 + j] = f2bf(kv * __expf(Lb[63 * 65 + d8 + e] - Lb[j * 65 + d8 + e])); } }
    if (tid < 64) dec[tid] = __expf(Lb[63 * 65 + tid]);
    __syncthreads();
    const int db = wave & 1, vb = wave >> 1, r = lane & 31, hh = lane >> 5;
    f32x16 acc = zero16();
#pragma unroll
    for (int ks = 0; ks < 4; ++ks) { const bf16x8 a = *(const LAS bf16x8*)(LKt + (db * 32 + r) * 72 + ks * 16 + 8 * hh); const bf16x8 bb = *(const LAS bf16x8*)(LVt + (vb * 32 + r) * 72 + ks * 16 + 8 * hh); acc = mma32(a, bb, acc); }
#pragma unroll
    for (int i = 0; i < 16; ++i) { const int d = db * 32 + (i & 3) + 8 * (i >> 2) + 4 * hh; dS[d * 128 + vb * 32 + r] = acc[i]; }
    __syncthreads();
}
__device__ void gla_out(const Params& p, LAS unsigned char* lds, int item) {
    const int b = item >> 7, h = (item >> 5) & 3, c = item & 31; const int tid = threadIdx.x, lane = tid & 63, wave = tid >> 6;
    gla_load(p, lds, b, h, c);
    LAS bf16_t* Lq = (LAS bf16_t*)(lds + G_Q); LAS bf16_t* Lk = (LAS bf16_t*)(lds + G_K); LAS float* Lb = (LAS float*)(lds + G_B); LAS bf16_t* LVt = (LAS bf16_t*)(lds + G_VT);
    LAS bf16_t* Lsc = (LAS bf16_t*)(lds + G_X); LAS bf16_t* LSt = (LAS bf16_t*)(lds + G_ST); LAS float* Lred = (LAS float*)(lds + G_RED);
    const bf16_t* St = (const bf16_t*)(p.ws + WS_ST) + (size_t)item * 8192; const bf16_t* P = (const bf16_t*)(p.ws + WS_P); bf16_t* mix = (bf16_t*)(p.ws + WS_A);
    const int row0 = b * 2048 + c * 64;
    { const int i = tid >> 3, d8 = (tid & 7) * 8;
#pragma unroll
      for (int e = 0; e < 8; e += 2) { const float b0 = Lb[i * 65 + d8 + e], b1 = Lb[i * 65 + d8 + e + 1];
          const float q0 = bf2f(Lq[i * 72 + d8 + e]) * __expf(b0) * 0.125f, q1 = bf2f(Lq[i * 72 + d8 + e + 1]) * __expf(b1) * 0.125f;
          const float k0 = bf2f(Lk[i * 72 + d8 + e]) * __expf(-b0), k1 = bf2f(Lk[i * 72 + d8 + e + 1]) * __expf(-b1);
          *(LAS unsigned*)(Lq + i * 72 + d8 + e) = pk2(q0, q1); *(LAS unsigned*)(Lk + i * 72 + d8 + e) = pk2(k0, k1); } }
#pragma unroll
    for (int i2 = 0; i2 < 2; ++i2) { const int idx = tid + 512 * i2, v = idx >> 3, d8 = (idx & 7) * 8; *(LAS u32x4v*)(LSt + v * 72 + d8) = *(const u32x4v*)(St + v * 64 + d8); }
    __syncthreads();
    const int r = lane & 31, hh = lane >> 5;
    if (wave < 4) { const int ib = wave & 1, jb = wave >> 1;
        f32x16 acc = zero16();
        if (jb <= ib) {
#pragma unroll
            for (int ks = 0; ks < 4; ++ks) { const bf16x8 a = *(const LAS bf16x8*)(Lq + (ib * 32 + r) * 72 + ks * 16 + 8 * hh); const bf16x8 bb = *(const LAS bf16x8*)(Lk + (jb * 32 + r) * 72 + ks * 16 + 8 * hh); acc = mma32(a, bb, acc); } }
#pragma unroll
        for (int i = 0; i < 16; ++i) { const int ii = ib * 32 + (i & 3) + 8 * (i >> 2) + 4 * hh, jj = jb * 32 + r; Lsc[ii * 72 + jj] = f2bf(jj <= ii ? acc[i] : 0.f); } }
    __syncthreads();
    const int ib = wave & 1, vb = wave >> 1;
    f32x16 acc = zero16();
#pragma unroll
    for (int ks = 0; ks < 4; ++ks) { const bf16x8 a = *(const LAS bf16x8*)(Lsc + (ib * 32 + r) * 72 + ks * 16 + 8 * hh); const bf16x8 bb = *(const LAS bf16x8*)(LVt + (vb * 32 + r) * 72 + ks * 16 + 8 * hh); acc = mma32(a, bb, acc); }
#pragma unroll
    for (int ks = 0; ks < 4; ++ks) { const bf16x8 a = *(const LAS bf16x8*)(Lq + (ib * 32 + r) * 72 + ks * 16 + 8 * hh); const bf16x8 bb = *(const LAS bf16x8*)(LSt + (vb * 32 + r) * 72 + ks * 16 + 8 * hh); acc = mma32(a, bb, acc); }
#pragma unroll
    for (int i = 0; i < 16; ++i) { float s = acc[i] * acc[i]; s += __shfl_xor(s, 1); s += __shfl_xor(s, 2); s += __shfl_xor(s, 4); s += __shfl_xor(s, 8); s += __shfl_xor(s, 16);
        if (r == 0) Lred[(ib * 32 + (i & 3) + 8 * (i >> 2) + 4 * hh) * 4 + vb] = s; }
    __syncthreads();
    const float gg = p.in[11][h * 128 + vb * 32 + r];
#pragma unroll
    for (int i = 0; i < 16; ++i) { const int ii = ib * 32 + (i & 3) + 8 * (i >> 2) + 4 * hh; const f32x4 q = *(const LAS f32x4*)(Lred + ii * 4);
        const float rs = rsqrtf(((q[0] + q[1]) + (q[2] + q[3])) * (1.0f / 128.0f) + EPS);
        const float rg = bf2f(P[(size_t)(row0 + ii) * NIN + 1024 + h * 128 + vb * 32 + r]);
        mix[(size_t)(row0 + ii) * 1024 + h * 128 + vb * 32 + r] = f2bf(acc[i] * rs * gg * silu_f(rg)); }
    __syncthreads();
}
__device__ void gla_scan(const Params& p) {
    for (int gt = blockIdx.x * 512 + threadIdx.x; gt < 131072; gt += gridDim.x * 512) {
    const int bh = gt >> 12, rem = gt & 4095, v = rem & 127, d = (rem >> 7) * 2;
    const float* dS = (const float*)(p.ws + WS_DS); const float* dec = (const float*)(p.ws + WS_DEC); bf16_t* St = (bf16_t*)(p.ws + WS_ST);
    float s0 = 0.f, s1 = 0.f;
#pragma unroll 8
    for (int c = 0; c < 32; ++c) { const size_t item = (size_t)bh * 32 + c;
        *(unsigned*)(St + item * 8192 + v * 64 + d) = pk2(s0, s1);
        const float a0 = dec[item * 64 + d], a1 = dec[item * 64 + d + 1];
        s0 = a0 * s0 + dS[item * 8192 + d * 128 + v]; s1 = a1 * s1 + dS[item * 8192 + (d + 1) * 128 + v]; }
    float* o = p.out + O_SGP + (size_t)bh * 8192; o[d * 128 + v] = s0; o[(d + 1) * 128 + v] = s1; }
}

__device__ void sgu_item(const Params& p, LAS unsigned char* lds, int item) {
    const int b = item >> 6, nck = (item >> 2) & 15, h = item & 3; const int tid = threadIdx.x, lane = tid & 63, wave = tid >> 6;
    LAS bf16_t* LW = (LAS bf16_t*)lds; LAS bf16_t* LsvT = (LAS bf16_t*)(lds + 34816);
    const bf16_t* P = (const bf16_t*)(p.ws + WS_P); bf16_t* mix = (bf16_t*)(p.ws + WS_A); const int row0 = b * 2048 + nck * 128;
    const float* Wsrc = p.in[13] + (size_t)h * 16384;
#pragma unroll
    for (int k = 0; k < 8; ++k) { const int idx = tid + 512 * k, i = idx >> 5, j4 = (idx & 31) * 4; const f32x4 w = *(const f32x4*)(Wsrc + i * 128 + j4);
        u32x2 o; o.x = pk2(j4 <= i ? w[0] : 0.f, j4 + 1 <= i ? w[1] : 0.f); o.y = pk2(j4 + 2 <= i ? w[2] : 0.f, j4 + 3 <= i ? w[3] : 0.f); *(LAS u32x2*)(LW + i * 136 + j4) = o; }
    { const int j = tid >> 2, q4 = tid & 3; const bf16_t* src = P + (size_t)(row0 + j) * NIN + 2048 + h * 128 + q4 * 32; float g[32]; float ss = 0.f;
#pragma unroll
      for (int k = 0; k < 4; ++k) { const u32x4v w = *(const u32x4v*)(src + k * 8); const unsigned ww[4] = {w.x, w.y, w.z, w.w};
#pragma unroll
          for (int e = 0; e < 4; ++e) { const float a = gelu_t(bflo(ww[e])), c = gelu_t(bfhi(ww[e])); g[k * 8 + e * 2] = a; g[k * 8 + e * 2 + 1] = c; ss += a * a + c * c; } }
      ss += __shfl_xor(ss, 1); ss += __shfl_xor(ss, 2); const float rs = rsqrtf(ss * (1.0f / 128.0f) + EPS);
#pragma unroll
      for (int e = 0; e < 32; ++e) { const int d = q4 * 32 + e; LsvT[d * 136 + j] = f2bf(g[e] * rs * p.in[12][h * 128 + d]); } }
    __syncthreads();
    const int r = lane & 31, hh = lane >> 5, ib = wave & 3;
#pragma unroll
    for (int t = 0; t < 2; ++t) { const int db = (wave >> 2) * 2 + t; f32x16 acc = zero16();
        for (int ks = 0; ks <= ib * 2 + 1; ++ks) { const bf16x8 a = *(const LAS bf16x8*)(LW + (ib * 32 + r) * 136 + ks * 16 + 8 * hh); const bf16x8 bb = *(const LAS bf16x8*)(LsvT + (db * 32 + r) * 136 + ks * 16 + 8 * hh); acc = mma32(a, bb, acc); }
#pragma unroll
        for (int i = 0; i < 16; ++i) { const int ii = ib * 32 + (i & 3) + 8 * (i >> 2) + 4 * hh, d = db * 32 + r; const float z = acc[i] + p.in[14][h * 128 + ii];
            const float u = gelu_t(bf2f(P[(size_t)(row0 + ii) * NIN + 1536 + h * 128 + d])); mix[(size_t)(row0 + ii) * 1024 + 512 + h * 128 + d] = f2bf(u * z); } }
    __syncthreads();
}

constexpr int SM_Q = 0, SM_K = 4096, SM_B = 8192, SM_V = 12288, SM_A = 20480, SM_RED = 21504, SM_O = 22016, SM_END = 30208;
__device__ void sample_mixer(const Params& p, LAS unsigned char* lds, int b) {
    const int tid = threadIdx.x, lane = tid & 63, wave = tid >> 6; const int rowb = MPR + b * 4;
    const bf16_t* P = (const bf16_t*)(p.ws + WS_P); const float* af = (const float*)(p.ws + WS_AF); bf16_t* mix = (bf16_t*)(p.ws + WS_A);
    LAS float* Lq = (LAS float*)(lds + SM_Q); LAS float* Lk = (LAS float*)(lds + SM_K); LAS float* Lb = (LAS float*)(lds + SM_B); LAS float* Lv = (LAS float*)(lds + SM_V);
    LAS float* LA = (LAS float*)(lds + SM_A); LAS float* Lred = (LAS float*)(lds + SM_RED); LAS float* Lo = (LAS float*)(lds + SM_O);
    { const int ch = tid, h = tid >> 7; float g[4], u[4];
#pragma unroll
      for (int t = 0; t < 4; ++t) { g[t] = gelu_t(bf2f(P[(size_t)(rowb + t) * NIN + 2048 + ch])); u[t] = gelu_t(bf2f(P[(size_t)(rowb + t) * NIN + 1536 + ch])); const float s = wave_sum(g[t] * g[t]); if (lane == 0) Lred[wave * 4 + t] = s; }
      __syncthreads();
      const float gs = p.in[12][ch]; float sv[4];
#pragma unroll
      for (int t = 0; t < 4; ++t) { const float tot = Lred[(2 * h) * 4 + t] + Lred[(2 * h + 1) * 4 + t]; sv[t] = g[t] * rsqrtf(tot * (1.0f / 128.0f) + EPS) * gs; p.out[O_SV + (size_t)(b * 4 + t) * 512 + ch] = sv[t]; }
#pragma unroll
      for (int i = 0; i < 4; ++i) { float z = p.in[14][h * 128 + i];
#pragma unroll
          for (int j = 0; j < 4; ++j) if (j <= i) z += p.in[13][(size_t)h * 16384 + i * 128 + j] * sv[j];
          mix[(size_t)(rowb + i) * 1024 + 512 + ch] = f2bf(u[i] * z); }
      __syncthreads();
    }
#pragma unroll
    for (int k = 0; k < 2; ++k) { const int idx = tid + 512 * k, t = idx >> 8, c = idx & 255;
        Lq[t * 256 + c] = bf2f(P[(size_t)(rowb + t) * NIN + c]); Lk[t * 256 + c] = bf2f(P[(size_t)(rowb + t) * NIN + 256 + c]);
        float z = p.in[10][c];
#pragma unroll
        for (int r = 0; r < 16; ++r) z += af[(size_t)(rowb + t) * 16 + r] * p.in[9][r * 256 + c];
        Lb[t * 256 + c] = logsig(z) * (1.0f / 16.0f); }
#pragma unroll
    for (int t = 0; t < 4; ++t) Lv[t * 512 + tid] = bf2f(P[(size_t)(rowb + t) * NIN + 512 + tid]);
    __syncthreads();
    if (tid < 256) { float a = 0.f;
#pragma unroll
        for (int t = 0; t < 4; ++t) { a += Lb[t * 256 + tid]; Lb[t * 256 + tid] = a; } }
    __syncthreads();
    { const int h = tid >> 7, pr = (tid >> 3) & 15, i = pr >> 2, j = pr & 3, part = tid & 7; float s = 0.f;
      if (j <= i) {
#pragma unroll
          for (int e = 0; e < 8; ++e) { const int c = h * 64 + part * 8 + e; s += Lq[i * 256 + c] * Lk[j * 256 + c] * __expf(Lb[i * 256 + c] - Lb[j * 256 + c]); } }
      s += __shfl_xor(s, 1); s += __shfl_xor(s, 2); s += __shfl_xor(s, 4);
      if (part == 0) LA[h * 16 + pr] = s * 0.125f; }
    __syncthreads();
    const int v = tid & 127, dq = tid >> 7;
    for (int h = 0; h < 4; ++h) {
        const float* S0 = p.in[3] + (size_t)(b * 4 + h) * 8192; float* So = p.out + O_SGS + (size_t)(b * 4 + h) * 8192;
        float op[4] = {0.f, 0.f, 0.f, 0.f}; float vv[4];
#pragma unroll
        for (int t = 0; t < 4; ++t) vv[t] = Lv[t * 512 + h * 128 + v];
#pragma unroll 4
        for (int dd = 0; dd < 16; ++dd) { const int d = dq * 16 + dd, c = h * 64 + d; const float s0 = S0[d * 128 + v];
            const float b3 = Lb[3 * 256 + c]; float sn = __expf(b3) * s0;
#pragma unroll
            for (int t = 0; t < 4; ++t) { const float bt = Lb[t * 256 + c]; op[t] += Lq[t * 256 + c] * __expf(bt) * 0.125f * s0; sn += Lk[t * 256 + c] * __expf(b3 - bt) * vv[t]; }
            So[d * 128 + v] = sn; }
#pragma unroll
        for (int t = 0; t < 4; ++t) Lo[(dq * 4 + t) * 128 + v] = op[t];
        __syncthreads();
        { const int i = tid >> 7; float o = Lo[(0 * 4 + i) * 128 + v] + Lo[(1 * 4 + i) * 128 + v] + Lo[(2 * 4 + i) * 128 + v] + Lo[(3 * 4 + i) * 128 + v];
#pragma unroll
          for (int j = 0; j < 4; ++j) if (j <= i) o += LA[h * 16 + i * 4 + j] * Lv[j * 512 + h * 128 + v];
          const float s = wave_sum(o * o); if (lane == 0) Lred[wave] = s;
          __syncthreads();
          const float tot = Lred[2 * i] + Lred[2 * i + 1]; const float rg = bf2f(P[(size_t)(rowb + i) * NIN + 1024 + h * 128 + v]);
          mix[(size_t)(rowb + i) * 1024 + h * 128 + v] = f2bf(o * rsqrtf(tot * (1.0f / 128.0f) + EPS) * p.in[11][h * 128 + v] * silu_f(rg)); }
        __syncthreads();
    }
}

__device__ void attn_prompt(const Params& p, LAS unsigned char* lds, int item) {
    const int b = item >> 5, h = (item >> 3) & 3, rt = item & 7; const int tid = threadIdx.x, lane = tid & 63, wave = tid >> 6, r = lane & 31, hh = lane >> 5;
    LAS bf16_t* LK = (LAS bf16_t*)lds; bf16_t* qx = (bf16_t*)(p.ws + WS_A);
    const bf16_t* mkb = (const bf16_t*)(p.ws + WS_MKB) + (size_t)b * 256 * 1024 + h * 256; const bf16_t* mvt = (const bf16_t*)(p.ws + WS_MVT) + (size_t)(b * 4 + h) * 65536;
#pragma unroll 4
    for (int k = 0; k < 16; ++k) { const int idx = tid + 512 * k, m = idx >> 5, d8 = (idx & 31) * 8; *(LAS u32x4v*)(LK + m * 264 + d8) = *(const u32x4v*)(mkb + (size_t)m * 1024 + d8); }
    __syncthreads();
    const int r0 = b * 2048 + rt * 256 + wave * 32; const bf16_t* qrow = qx + (size_t)(r0 + r) * 1024 + h * 256 + 8 * hh;
    f32x16 s[8];
#pragma unroll
    for (int mb = 0; mb < 8; ++mb) s[mb] = zero16();
#pragma unroll 2
    for (int ks = 0; ks < 16; ++ks) { const bf16x8 qf = *(const bf16x8*)(qrow + ks * 16);
#pragma unroll
        for (int mb = 0; mb < 8; ++mb) { const bf16x8 kf = *(const LAS bf16x8*)(LK + (mb * 32 + r) * 264 + ks * 16 + 8 * hh); s[mb] = mma32(kf, qf, s[mb]); } }
    float mx = -3.0e38f;
#pragma unroll
    for (int mb = 0; mb < 8; ++mb)
#pragma unroll
        for (int i = 0; i < 16; ++i) mx = fmaxf(mx, s[mb][i]);
    mx = fmaxf(mx, __shfl_xor(mx, 32)); float sum = 0.f;
#pragma unroll
    for (int mb = 0; mb < 8; ++mb)
#pragma unroll
        for (int i = 0; i < 16; ++i) { const float e = __expf((s[mb][i] - mx) * 0.0625f); s[mb][i] = e; sum += e; }
    sum += __shfl_xor(sum, 32); const float inv = __frcp_rn(sum);
    bf16x8 pf[8][2];
#pragma unroll
    for (int mb = 0; mb < 8; ++mb)
#pragma unroll
        for (int sI = 0; sI < 2; ++sI) { u32x4v w; w.x = pk2(s[mb][8 * sI + 0] * inv, s[mb][8 * sI + 1] * inv); w.y = pk2(s[mb][8 * sI + 2] * inv, s[mb][8 * sI + 3] * inv);
            w.z = pk2(s[mb][8 * sI + 4] * inv, s[mb][8 * sI + 5] * inv); w.w = pk2(s[mb][8 * sI + 6] * inv, s[mb][8 * sI + 7] * inv); pf[mb][sI] = __builtin_bit_cast(bf16x8, w); }
    __syncthreads();
#pragma unroll 4
    for (int k = 0; k < 16; ++k) { const int idx = tid + 512 * k, d = idx >> 5, m8 = (idx & 31) * 8; *(LAS u32x4v*)(LK + d * 264 + m8) = *(const u32x4v*)(mvt + (size_t)d * 256 + m8); }
    __syncthreads();
    for (int dh = 0; dh < 2; ++dh) {
        f32x16 o[4];
#pragma unroll
        for (int q = 0; q < 4; ++q) o[q] = zero16();
#pragma unroll
        for (int mb = 0; mb < 8; ++mb)
#pragma unroll
            for (int sI = 0; sI < 2; ++sI)
#pragma unroll
                for (int q = 0; q < 4; ++q) { const LAS bf16_t* vp = LK + ((dh * 4 + q) * 32 + r) * 264 + mb * 32 + 16 * sI + 4 * hh;
                    const u32x2 lo = *(const LAS u32x2*)vp, hi = *(const LAS u32x2*)(vp + 8); u32x4v w; w.x = lo.x; w.y = lo.y; w.z = hi.x; w.w = hi.y;
                    o[q] = mma32(pf[mb][sI], __builtin_bit_cast(bf16x8, w), o[q]); }
#pragma unroll
        for (int q = 0; q < 4; ++q)
#pragma unroll
            for (int i = 0; i < 16; ++i) { const int ii = (i & 3) + 8 * (i >> 2) + 4 * hh; qx[(size_t)(r0 + ii) * 1024 + h * 256 + (dh * 4 + q) * 32 + r] = f2bf(o[q][i]); }
    }
    __syncthreads();
}
__device__ void attn_sample(const Params& p, LAS unsigned char* lds, int item) {
    const int b = item >> 2, h = item & 3; const int tid = threadIdx.x, lane = tid & 63, wave = tid >> 6; const int rowb = MPR + b * 4;
    bf16_t* qx = (bf16_t*)(p.ws + WS_A); LAS float* Ls = (LAS float*)lds;   LAS float* Lred = (LAS float*)(lds + 4096); LAS float* Lo = (LAS float*)(lds + 8192);
    const float* Kc = p.in[5] + ((size_t)b * 256 * 4 + h) * 256; const float* Vc = p.in[6] + ((size_t)b * 256 * 4 + h) * 256;
    f32x4 q[4];
#pragma unroll
    for (int t = 0; t < 4; ++t) { const u32x2 w = *(const u32x2*)(qx + (size_t)(rowb + t) * 1024 + h * 256 + lane * 4); q[t] = (f32x4){bflo(w.x), bfhi(w.x), bflo(w.y), bfhi(w.y)}; }
#pragma unroll 4
    for (int mm = 0; mm < 32; ++mm) { const int m = wave * 32 + mm; const f32x4 kv = *(const f32x4*)(Kc + (size_t)m * 1024 + lane * 4);
        float d0 = (kv[0] * q[0][0] + kv[1] * q[0][1]) + (kv[2] * q[0][2] + kv[3] * q[0][3]); float d1 = (kv[0] * q[1][0] + kv[1] * q[1][1]) + (kv[2] * q[1][2] + kv[3] * q[1][3]);
        float d2 = (kv[0] * q[2][0] + kv[1] * q[2][1]) + (kv[2] * q[2][2] + kv[3] * q[2][3]); float d3 = (kv[0] * q[3][0] + kv[1] * q[3][1]) + (kv[2] * q[3][2] + kv[3] * q[3][3]);
        d0 = wave_sum(d0); d1 = wave_sum(d1); d2 = wave_sum(d2); d3 = wave_sum(d3);
        if (lane == 0) { Ls[0 * 256 + m] = d0 * 0.0625f; Ls[1 * 256 + m] = d1 * 0.0625f; Ls[2 * 256 + m] = d2 * 0.0625f; Ls[3 * 256 + m] = d3 * 0.0625f; } }
    __syncthreads();
    { const int t = tid >> 7, m0 = tid & 127; const float a = Ls[t * 256 + m0], c = Ls[t * 256 + m0 + 128]; const float mx = wave_max(fmaxf(a, c)); if (lane == 0) Lred[wave] = mx;
      __syncthreads();
      const float mxx = fmaxf(Lred[2 * t], Lred[2 * t + 1]); const float ea = __expf(a - mxx), ec = __expf(c - mxx); const float sm = wave_sum(ea + ec); if (lane == 0) Lred[16 + wave] = sm;
      __syncthreads();
      const float inv = __frcp_rn(Lred[16 + 2 * t] + Lred[16 + 2 * t + 1]); Ls[t * 256 + m0] = ea * inv; Ls[t * 256 + m0 + 128] = ec * inv; }
    __syncthreads();
    f32x4 o[4];
#pragma unroll
    for (int t = 0; t < 4; ++t) o[t] = (f32x4){0.f, 0.f, 0.f, 0.f};
#pragma unroll 4
    for (int mm = 0; mm < 32; ++mm) { const int m = wave * 32 + mm; const f32x4 vv = *(const f32x4*)(Vc + (size_t)m * 1024 + lane * 4);
#pragma unroll
        for (int t = 0; t < 4; ++t) o[t] += vv * Ls[t * 256 + m]; }
#pragma unroll
    for (int t = 0; t < 4; ++t) *(LAS f32x4*)(Lo + (wave * 4 + t) * 256 + lane * 4) = o[t];
    __syncthreads();
#pragma unroll
    for (int k = 0; k < 2; ++k) { const int idx = tid + 512 * k, t = idx >> 8, d = idx & 255; float s = 0.f;
#pragma unroll
        for (int w = 0; w < 8; ++w) s += Lo[(w * 4 + t) * 256 + d];
        qx[(size_t)(rowb + t) * 1024 + h * 256 + d] = f2bf(s); }
    __syncthreads();
}

__device__ void phase_act(const Params& p) {
    const bf16_t* G = (const bf16_t*)(p.ws + WS_P); bf16_t* U = (bf16_t*)(p.ws + WS_U);
    const float* cw = p.in[25]; const float* cb = p.in[26];
    const int nthr = gridDim.x * 512, gt = blockIdx.x * 512 + threadIdx.x;
    for (int it = gt; it < 1024 * 352; it += nthr) { const int run = it / 352, cc = (it % 352) * 8; const int row0 = run * 16; const bool first = (row0 & 2047) == 0;
        float w0[8], w1[8], w2[8], bb[8], g2[8], g1[8];
#pragma unroll
        for (int e = 0; e < 8; ++e) { w0[e] = cw[cc + e]; w1[e] = cw[DFF + cc + e]; w2[e] = cw[2 * DFF + cc + e]; bb[e] = cb[cc + e]; g2[e] = 0.f; g1[e] = 0.f; }
        if (!first) { const u32x4v a = *(const u32x4v*)(G + (size_t)(row0 - 2) * DFF + cc), c = *(const u32x4v*)(G + (size_t)(row0 - 1) * DFF + cc);
            g2[0] = bflo(a.x); g2[1] = bfhi(a.x); g2[2] = bflo(a.y); g2[3] = bfhi(a.y); g2[4] = bflo(a.z); g2[5] = bfhi(a.z); g2[6] = bflo(a.w); g2[7] = bfhi(a.w);
            g1[0] = bflo(c.x); g1[1] = bfhi(c.x); g1[2] = bflo(c.y); g1[3] = bfhi(c.y); g1[4] = bflo(c.z); g1[5] = bfhi(c.z); g1[6] = bflo(c.w); g1[7] = bfhi(c.w); }
#pragma unroll 4
        for (int t = 0; t < 16; ++t) { const size_t off = (size_t)(row0 + t) * DFF + cc; const u32x4v a = *(const u32x4v*)(G + off), uu = *(const u32x4v*)(U + off);
            float g0[8] = {bflo(a.x), bfhi(a.x), bflo(a.y), bfhi(a.y), bflo(a.z), bfhi(a.z), bflo(a.w), bfhi(a.w)};
            const float uf[8] = {bflo(uu.x), bfhi(uu.x), bflo(uu.y), bfhi(uu.y), bflo(uu.z), bfhi(uu.z), bflo(uu.w), bfhi(uu.w)}; float r[8];
#pragma unroll
            for (int e = 0; e < 8; ++e) { r[e] = gelu_t(bb[e] + w0[e] * g2[e] + w1[e] * g1[e] + w2[e] * g0[e]) * uf[e]; g2[e] = g1[e]; g1[e] = g0[e]; }
            u32x4v o; o.x = pk2(r[0], r[1]); o.y = pk2(r[2], r[3]); o.z = pk2(r[4], r[5]); o.w = pk2(r[6], r[7]); *(u32x4v*)(U + off) = o; }
    }
    for (int it = gt; it < 128 * 352; it += nthr) { const int b = it / 352, cc = (it % 352) * 8; const int row0 = MPR + b * 4;
        float w0[8], w1[8], w2[8], bb[8], g2[8], g1[8];
#pragma unroll
        for (int e = 0; e < 8; ++e) { w0[e] = cw[cc + e]; w1[e] = cw[DFF + cc + e]; w2[e] = cw[2 * DFF + cc + e]; bb[e] = cb[cc + e]; g2[e] = p.in[4][(size_t)(b * 2) * DFF + cc + e]; g1[e] = p.in[4][(size_t)(b * 2 + 1) * DFF + cc + e]; }
#pragma unroll
        for (int t = 0; t < 4; ++t) { const size_t off = (size_t)(row0 + t) * DFF + cc; const u32x4v a = *(const u32x4v*)(G + off), uu = *(const u32x4v*)(U + off);
            float g0[8] = {bflo(a.x), bfhi(a.x), bflo(a.y), bfhi(a.y), bflo(a.z), bfhi(a.z), bflo(a.w), bfhi(a.w)};
            const float uf[8] = {bflo(uu.x), bfhi(uu.x), bflo(uu.y), bfhi(uu.y), bflo(uu.z), bfhi(uu.z), bflo(uu.w), bfhi(uu.w)}; float r[8];
#pragma unroll
            for (int e = 0; e < 8; ++e) { r[e] = gelu_t(bb[e] + w0[e] * g2[e] + w1[e] * g1[e] + w2[e] * g0[e]) * uf[e]; g2[e] = g1[e]; g1[e] = g0[e]; }
            u32x4v o; o.x = pk2(r[0], r[1]); o.y = pk2(r[2], r[3]); o.z = pk2(r[4], r[5]); o.w = pk2(r[6], r[7]); *(u32x4v*)(U + off) = o; }
    }
}
__device__ void phase_final(const Params& p) {
    const float* h32 = (const float*)(p.ws + WS_H); const float* ssq = (const float*)(p.ws + WS_SSQ) + (size_t)2 * MT * 16; const float* g = p.in[28];
    const int lane = threadIdx.x & 63, wave = threadIdx.x >> 6;
    for (int r = blockIdx.x * 8 + wave; r < MT; r += gridDim.x * 8) { const float rs = row_rs(ssq, r);
#pragma unroll
        for (int i = 0; i < 4; ++i) { const size_t off = (size_t)r * 1024 + i * 256 + lane * 4; *(f32x4*)(p.out + O_Y + off) = *(const f32x4*)(h32 + off) * rs * *(const f32x4*)(g + i * 256 + lane * 4); } }
}

__global__ void __launch_bounds__(512) mega(Params p) {
    extern __shared__ __attribute__((aligned(16))) unsigned char lds_raw[];
    LAS unsigned char* lds = (LAS unsigned char*)lds_raw;
    cg::grid_group grid = cg::this_grid();
    const int lo = p.ph_lo, hi = p.ph_hi; unsigned char* ws = p.ws; const int G = gridDim.x, bx = blockIdx.x;
#define IN(k) (lo <= (k) && (k) < hi)
#define SEAM(k) do { if (IN(k) && IN((k) + 1)) grid.sync(); } while (0)
    if (IN(0)) { phase_prep(p, lds); } SEAM(0);
    if (IN(1)) {
        { pg8::Gemm g{(const bf16_t*)(ws + WS_A), (const bf16_t*)(ws + WS_WIN), MT, NIN, 1024}; pg8::StaticOrder S; S.init(MT, NIN, G, bx);
          EpiIn E{(bf16_t*)(ws + WS_P), (float*)(ws + WS_AF)}; pg8::gemm_phase<EpiIn, pg8::StaticOrder>(lds, g, S, E, nullptr); }
        __syncthreads();
        { pg8::Gemm g{(const bf16_t*)(ws + WS_MN), (const bf16_t*)(ws + WS_WKV), 2048, 2048, 1024}; pg8::StaticOrder S; S.init(2048, 2048, G, (bx + 40) % G);
          EpiKV E{p.out + O_MK, p.out + O_MV, (bf16_t*)(ws + WS_MKB), (bf16_t*)(ws + WS_MVT)}; pg8::gemm_phase<EpiKV, pg8::StaticOrder>(lds, g, S, E, nullptr); }
        __syncthreads();
    } SEAM(1);
    if (IN(2)) {
        for (int it = bx; it < 1024 + 512 + 128; it += G) { if (it < 1024) gla_local(p, lds, it); else if (it < 1536) sgu_item(p, lds, it - 1024); else sample_mixer(p, lds, it - 1536); }
    } SEAM(2);
    if (IN(3)) { gla_scan(p); } SEAM(3);
    if (IN(4)) { for (int it = bx; it < 1024; it += G) gla_out(p, lds, it); } SEAM(4);
    if (IN(5)) {
        pg8::Gemm g{(const bf16_t*)(ws + WS_A), (const bf16_t*)(ws + WS_WOUT), MT, 1024, 1024}; pg8::StaticOrder S; S.init(MT, 1024, G, bx);
        EpiRes E{p.in[0], p.in[1], (float*)(ws + WS_H), (bf16_t*)(ws + WS_HB), (float*)(ws + WS_SSQ)}; pg8::gemm_phase<EpiRes, pg8::StaticOrder>(lds, g, S, E, nullptr);
        __syncthreads();
    } SEAM(5);
    if (IN(6)) {
        pg8::Gemm g{(const bf16_t*)(ws + WS_HB), (const bf16_t*)(ws + WS_WQ), MT, 1024, 1024}; pg8::StaticOrder S; S.init(MT, 1024, G, bx);
        EpiQ E{(bf16_t*)(ws + WS_A), (const float*)(ws + WS_SSQ)}; pg8::gemm_phase<EpiQ, pg8::StaticOrder>(lds, g, S, E, nullptr);
        __syncthreads();
    } SEAM(6);
    if (IN(7)) {
        for (int it = bx; it < 256 + 512; it += G) { if (it < 256) attn_prompt(p, lds, it); else attn_sample(p, lds, it - 256); }
    } SEAM(7);
    if (IN(8)) {
        pg8::Gemm g{(const bf16_t*)(ws + WS_A), (const bf16_t*)(ws + WS_WO), MT, 1024, 1024}; pg8::StaticOrder S; S.init(MT, 1024, G, bx);
        EpiRes E{(const float*)(ws + WS_H), (const float*)(ws + WS_H) + (size_t)MPR * 1024, (float*)(ws + WS_H), (bf16_t*)(ws + WS_HB), (float*)(ws + WS_SSQ) + (size_t)MT * 16};
        pg8::gemm_phase<EpiRes, pg8::StaticOrder>(lds, g, S, E, nullptr);
        __syncthreads();
    } SEAM(8);
    if (IN(9)) {
        pg8::Gemm g{(const bf16_t*)(ws + WS_HB), (const bf16_t*)(ws + WS_WGU), MT, 5632, 1024}; pg8::StaticOrder S; S.init(MT, 5632, G, bx);
        EpiGU E{(bf16_t*)(ws + WS_P), (bf16_t*)(ws + WS_U), (const float*)(ws + WS_SSQ) + (size_t)MT * 16, p.out + O_SCP, p.out + O_SCS}; pg8::gemm_phase<EpiGU, pg8::StaticOrder>(lds, g, S, E, nullptr);
        __syncthreads();
    } SEAM(9);
    if (IN(10)) { phase_act(p); } SEAM(10);
    if (IN(11)) {
        pg8::Gemm g{(const bf16_t*)(ws + WS_U), (const bf16_t*)(ws + WS_WD), MT, 1024, 2816}; pg8::StaticOrder S; S.init(MT, 1024, G, bx);
        EpiRes E{(const float*)(ws + WS_H), (const float*)(ws + WS_H) + (size_t)MPR * 1024, (float*)(ws + WS_H), nullptr, (float*)(ws + WS_SSQ) + (size_t)2 * MT * 16};
        pg8::gemm_phase<EpiRes, pg8::StaticOrder>(lds, g, S, E, nullptr);
        __syncthreads();
    } SEAM(11);
    if (IN(12)) { phase_final(p); }
#undef IN
#undef SEAM
}

extern "C" void kernel_launch(void* const* d_in, const int* in_sizes, int n_in, void* d_out, int out_size, void* d_ws, size_t ws_size, hipStream_t stream) {
    static int grid = 0;
    if (grid == 0) {
        if (n_in != 29 || ws_size < WS_END) { fprintf(stderr, "kernel_launch: unexpected n_in %d / ws %zu (need %zu)\n", n_in, ws_size, (size_t)WS_END); grid = -1; return; }
        int dev = 0, cus = 0, per_cu = 0;
        hipGetDevice(&dev); hipDeviceGetAttribute(&cus, hipDeviceAttributeMultiprocessorCount, dev);
        if (hipFuncSetAttribute((const void*)mega, hipFuncAttributeMaxDynamicSharedMemorySize, LDS_BYTES) != hipSuccess) { fprintf(stderr, "kernel_launch: hipFuncSetAttribute failed\n"); grid = -1; return; }
        if (hipOccupancyMaxActiveBlocksPerMultiprocessor(&per_cu, (const void*)mega, 512, LDS_BYTES) != hipSuccess || per_cu < 1) { fprintf(stderr, "kernel_launch: occupancy query gives %d\n", per_cu); (void)hipGetLastError(); per_cu = 1; }
        grid = cus;
    }
    if (grid < 0) return;
    Params p{};
    for (int i = 0; i < 29; ++i) p.in[i] = (const float*)d_in[i];
    p.out = (float*)d_out; p.ws = (unsigned char*)d_ws;
#if N_LAUNCH_MODE == 1
    p.ph_lo = 0; p.ph_hi = NPHASE;
    void* args[] = {&p};
    hipError_t e = hipLaunchCooperativeKernel((const void*)mega, dim3(grid), dim3(512), args, LDS_BYTES, stream);
    if (e != hipSuccess) fprintf(stderr, "cooperative launch failed: %s (grid %d)\n", hipGetErrorString(e), grid);
#else
    for (int ph = 0; ph < NPHASE; ++ph) { p.ph_lo = ph; p.ph_hi = ph + 1; hipLaunchKernelGGL(mega, dim3(grid), dim3(512), LDS_BYTES, stream, p); }
#endif
}
```

```cpp
#include <hip/hip_runtime.h>
namespace pg8 {
#define PG8_LAS __attribute__((address_space(3)))
typedef unsigned short bf16_t;
typedef short bf16x8 __attribute__((ext_vector_type(8)));
typedef float f32x4 __attribute__((ext_vector_type(4)));
typedef unsigned u32x4 __attribute__((ext_vector_type(4)));
constexpr int BM = 256, BK = 64, HALF = 128, HTB = HALF * BK * 2  , STAGE_BYTES = 8 * HTB, NXCD = 8, WGM = 8;

__host__ __device__ __forceinline__ int lds_byte(int r, int c) { const int st = (r >> 4) * 2 + (c >> 5), rr = r & 15, cc = c & 31, ob = rr * 64 + cc * 2; return st * 1024 + (ob ^ (((ob >> 9) & 1) << 5)); }
__host__ __device__ __forceinline__ void stage_rc(int b, int& R, int& C) { const int st = b / 1024, sb = b % 1024, swz = sb ^ (((sb >> 9) & 1) << 5); R = (st >> 1) * 16 + swz / 64; C = (st & 1) * 32 + (swz % 64) / 2; }
__host__ __device__ __forceinline__ int perm32(int rho) { const int n = rho >> 4, i = rho & 15; return 8 * (i >> 2) + 4 * n + (i & 3); }

struct Unit { int pm, pn; };
struct Gemm { const bf16_t* A; const bf16_t* Bt; int M, N, K; };

struct StaticOrder {
    int nM, nN, nwg, G, c;
    __host__ __device__ void init(int M, int N, int G_, int c_) { nM = M / BM; nN = N / BM; nwg = nM * nN; G = G_; c = c_; }
    __host__ __device__ __forceinline__ bool next(int i, Unit& u) const {
        const long L = (long)i * G + c; if (L >= nwg) return false;
        int wgid = (int)L; { const int q = nwg / NXCD, r = nwg % NXCD, xcd = wgid % NXCD, off = wgid / NXCD; wgid = (xcd < r ? xcd * (q + 1) : r * (q + 1) + (xcd - r) * q) + off; }
        const int nig = WGM * nN, gid = wgid / nig, fm = gid * WGM, gsz = (nM - fm) < WGM ? (nM - fm) : WGM;
        u.pm = fm + ((wgid % nig) % gsz); u.pn = (wgid % nig) / gsz; return true;
    }
    __device__ __forceinline__ void a_ready(const Unit&) const {}
    __device__ __forceinline__ void done(const Unit&) const {}
};
struct CountedOrder : StaticOrder {
    const unsigned* ready; unsigned need; unsigned* tmo;
    __device__ __forceinline__ void a_ready(const Unit& u) const {
        if (threadIdx.x < 64) {
            const unsigned long long t0 = __builtin_amdgcn_s_memrealtime(); unsigned polls = 0;
            while ((unsigned)__builtin_amdgcn_readfirstlane(__hip_atomic_load(ready + 64 * u.pm, __ATOMIC_RELAXED, __HIP_MEMORY_SCOPE_AGENT)) < need) {
                if ((++polls & 255u) == 0u && __builtin_amdgcn_readfirstlane(__hip_atomic_load(tmo, __ATOMIC_RELAXED, __HIP_MEMORY_SCOPE_AGENT)) != 0u) break;
                if (__builtin_amdgcn_s_memrealtime() - t0 > 2000000ull) {
                    if (threadIdx.x == 0) { unsigned expect = 0u; __hip_atomic_compare_exchange_strong(tmo + 1, &expect, 0x600u | (unsigned)(u.pm & 0xff), __ATOMIC_RELAXED, __ATOMIC_RELAXED, __HIP_MEMORY_SCOPE_AGENT); __hip_atomic_store(tmo, 1u, __ATOMIC_RELAXED, __HIP_MEMORY_SCOPE_AGENT); }
                    break; }
                __builtin_amdgcn_s_sleep(2); }
            __builtin_amdgcn_fence(__ATOMIC_ACQUIRE, "agent");
            asm volatile("s_waitcnt vmcnt(0)" ::: "memory");
        }
#if !defined(BROKEN_HOOK_NO_BARRIER)
        asm volatile("" ::: "memory"); __builtin_amdgcn_s_barrier(); asm volatile("" ::: "memory");
#endif
    }
};

__device__ __forceinline__ unsigned cvt_pk_bf16(float lo, float hi) { unsigned r; asm volatile("v_cvt_pk_bf16_f32 %0, %1, %2" : "=v"(r) : "v"(lo), "v"(hi)); return r; }
typedef float f32x2 __attribute__((ext_vector_type(2)));
__device__ __forceinline__ f32x2 gelu_pk(f32x2 v) {
    const f32x2 av = __builtin_elementwise_abs(v), d = av * 0.2316418882f + 1.0f;
    f32x2 t; t.x = __builtin_amdgcn_rcpf(d.x); t.y = __builtin_amdgcn_rcpf(d.y);
    f32x2 q = t * 0.5307027145f + (-0.7265760135f); q = q * t + 0.7107068705f; q = q * t + (-0.142248368f); q = q * t + 0.127414796f; q = q * t;
    const f32x2 s = (v * v) * (-0.72134752044f);
    f32x2 e; e.x = __builtin_amdgcn_exp2f(s.x); e.y = __builtin_amdgcn_exp2f(s.y);
    const f32x2 m = v * (q * e), r = v - m;
    f32x2 o; o.x = v.x < 0.f ? m.x : r.x; o.y = v.y < 0.f ? m.y : r.y; return o;
}

struct EpiF32 {
    static constexpr bool PERM = false, AFTER_DRAIN = false;
    float* C; int ldc; const float* bias;
    __device__ __forceinline__ void operator()(const f32x4 (&acc)[2][2][4][2], const Unit& u, int wr, int wc, int fr, int fq) const {
        const int row0 = u.pm * BM + wr * 64 + fr, col0 = u.pn * BM + wc * 32 + 4 * fq;
        f32x4 bv[2][2];
#pragma unroll
        for (int bj = 0; bj < 2; ++bj)
#pragma unroll
            for (int n = 0; n < 2; ++n) bv[bj][n] = bias ? *(const f32x4*)(bias + col0 + bj * HALF + n * 16) : (f32x4){0.f, 0.f, 0.f, 0.f};
#pragma unroll
        for (int ai = 0; ai < 2; ++ai)
#pragma unroll
            for (int m = 0; m < 4; ++m) { float* rowp = C + (size_t)(row0 + ai * HALF + m * 16) * ldc + col0;
#pragma unroll
                for (int bj = 0; bj < 2; ++bj)
#pragma unroll
                    for (int n = 0; n < 2; ++n) *(f32x4*)(rowp + bj * HALF + n * 16) = acc[ai][bj][m][n] + bv[bj][n]; }
    }
};
template <int ACT  > struct EpiBf16 {
    static constexpr bool PERM = true, AFTER_DRAIN = false;
    bf16_t* O; int ldc; const float* bias; int split_cols; size_t split_stride;
    __device__ __forceinline__ void operator()(const f32x4 (&acc)[2][2][4][2], const Unit& u, int wr, int wc, int fr, int fq) const {
        const int row0 = u.pm * BM + wr * 64 + fr; int colt = u.pn * BM; bf16_t* base = O;
        if (split_cols) { const int t = colt / split_cols; base += (size_t)t * split_stride; colt -= t * split_cols; }
        const int col0 = colt + wc * 32 + 8 * fq, bcol0 = u.pn * BM + wc * 32 + 8 * fq;
        f32x4 bv[2][2];
#pragma unroll
        for (int bj = 0; bj < 2; ++bj)
#pragma unroll
            for (int n = 0; n < 2; ++n) bv[bj][n] = bias ? *(const f32x4*)(bias + bcol0 + bj * HALF + 4 * n) : (f32x4){0.f, 0.f, 0.f, 0.f};
#pragma unroll
        for (int ai = 0; ai < 2; ++ai)
#pragma unroll
            for (int m = 0; m < 4; ++m) { bf16_t* rowp = base + (size_t)(row0 + ai * HALF + m * 16) * ldc + col0;
#pragma unroll
                for (int bj = 0; bj < 2; ++bj) { f32x4 v0 = acc[ai][bj][m][0] + bv[bj][0], v1 = acc[ai][bj][m][1] + bv[bj][1];
                    if (ACT == 1) { f32x2 a = gelu_pk((f32x2){v0[0], v0[1]}), b = gelu_pk((f32x2){v0[2], v0[3]}), c = gelu_pk((f32x2){v1[0], v1[1]}), d = gelu_pk((f32x2){v1[2], v1[3]});
                        v0 = (f32x4){a.x, a.y, b.x, b.y}; v1 = (f32x4){c.x, c.y, d.x, d.y}; }
                    if (ACT == 2) {
#pragma unroll
                        for (int j = 0; j < 4; ++j) { v0[j] = 0.5f * v0[j] * (1.0f + erff(v0[j] * 0.70710678f)); v1[j] = 0.5f * v1[j] * (1.0f + erff(v1[j] * 0.70710678f)); } }
                    u32x4 w; w.x = cvt_pk_bf16(v0[0], v0[1]); w.y = cvt_pk_bf16(v0[2], v0[3]); w.z = cvt_pk_bf16(v1[0], v1[1]); w.w = cvt_pk_bf16(v1[2], v1[3]);
                    *(u32x4*)(rowp + bj * HALF) = w; } }
    }
};

struct PanelStats {
    unsigned* xbuf;
    unsigned* cnt;
    unsigned* tmo;
    int ntn; float eps;
    unsigned code;
    __device__ __forceinline__ bool run(const f32x4 (&v)[2][2][4][2], const Unit& u, int wr, int wc, int fr, int fq, PG8_LAS unsigned char* lds, int wid, int lane) const {
        typedef float f32x2v __attribute__((ext_vector_type(2)));
        PG8_LAS f32x2v* P = (PG8_LAS f32x2v*)lds;
        PG8_LAS f32x2v* S = (PG8_LAS f32x2v*)(lds + 8192);
        PG8_LAS unsigned* flag = (PG8_LAS unsigned*)(lds + 8192 + 2048);
#pragma unroll
        for (int ai = 0; ai < 2; ++ai)
#pragma unroll
            for (int m = 0; m < 4; ++m) {
                float s = 0.f;
#pragma unroll
                for (int bj = 0; bj < 2; ++bj)
#pragma unroll
                    for (int n = 0; n < 2; ++n) { const f32x4 x = v[ai][bj][m][n]; s += (x[0] + x[1]) + (x[2] + x[3]); }
                s += __shfl_xor(s, 16); s += __shfl_xor(s, 32);
                const float mw = s * (1.0f / 64.0f); float q = 0.f;
#pragma unroll
                for (int bj = 0; bj < 2; ++bj)
#pragma unroll
                    for (int n = 0; n < 2; ++n) { const f32x4 d = v[ai][bj][m][n] - mw; q += (d[0] * d[0] + d[1] * d[1]) + (d[2] * d[2] + d[3] * d[3]); }
                q += __shfl_xor(q, 16); q += __shfl_xor(q, 32);
                if (fq == 0) P[(ai * HALF + wr * 64 + m * 16 + fr) * 4 + wc] = (f32x2v){mw, q};
            }
        asm volatile("s_waitcnt lgkmcnt(0)" ::: "memory"); __builtin_amdgcn_s_barrier(); asm volatile("" ::: "memory");
#if defined(BROKEN_NO_WAIT)
        if (blockIdx.x >= 64) { const long long t0 = clock64(); while (clock64() - t0 < 60000) __builtin_amdgcn_s_sleep(8); }
#endif
        const int row = wid * 32 + (lane & 31);
        if (lane < 32) {
            const f32x2v a = P[row * 4 + 0], b = P[row * 4 + 1], c = P[row * 4 + 2], d = P[row * 4 + 3];
            const float mt = (a.x + b.x + c.x + d.x) * 0.25f;
            const float da = a.x - mt, db = b.x - mt, dc = c.x - mt, dd = d.x - mt;
            const float m2 = (a.y + b.y) + (c.y + d.y) + 64.0f * ((da * da + db * db) + (dc * dc + dd * dd));
            unsigned long long* slot = (unsigned long long*)xbuf + ((size_t)(u.pm * BM + row) * 4 + u.pn);
            __hip_atomic_store(slot, ((unsigned long long)__float_as_uint(m2) << 32) | __float_as_uint(mt), __ATOMIC_RELAXED, __HIP_MEMORY_SCOPE_AGENT);
        }
        asm volatile("s_waitcnt vmcnt(0)" ::: "memory");
        if (lane == 0) __hip_atomic_fetch_add(cnt + 64 * u.pm, 1u, __ATOMIC_RELAXED, __HIP_MEMORY_SCOPE_AGENT);
        if (wid == 0) {
            bool dead = false; const unsigned long long t0 = __builtin_amdgcn_s_memrealtime(); const unsigned want = 8u * (unsigned)ntn;
            for (;;) {
#if defined(BROKEN_NO_WAIT)
                break;
#endif
                if ((unsigned)__builtin_amdgcn_readfirstlane(__hip_atomic_load(cnt + 64 * u.pm, __ATOMIC_RELAXED, __HIP_MEMORY_SCOPE_AGENT)) >= want) break;
                if (__builtin_amdgcn_s_memrealtime() - t0 > 2000000ull) {
                    if (lane == 0) { unsigned expect = 0u; __hip_atomic_compare_exchange_strong(tmo + 1, &expect, code | (unsigned)(u.pm & 0xff), __ATOMIC_RELAXED, __ATOMIC_RELAXED, __HIP_MEMORY_SCOPE_AGENT);
                                     __hip_atomic_store(tmo, 1u, __ATOMIC_RELAXED, __HIP_MEMORY_SCOPE_AGENT); }
                    dead = true; break; }
                __builtin_amdgcn_s_sleep(2);
            }
            __builtin_amdgcn_fence(__ATOMIC_ACQUIRE, "agent");
            if (lane == 0) flag[0] = dead ? 1u : 0u;
        }
        asm volatile("s_waitcnt vmcnt(0) lgkmcnt(0)" ::: "memory"); __builtin_amdgcn_s_barrier(); asm volatile("" ::: "memory");
        const bool bad = flag[0] != 0u;
        if (lane < 32) {
            const unsigned long long* slot = (const unsigned long long*)xbuf + (size_t)(u.pm * BM + row) * 4; float mt[4], m2[4]; float ms = 0.f;
#pragma unroll
            for (int t = 0; t < 4; ++t) { if (t < ntn) { const unsigned long long w = __hip_atomic_load(slot + t, __ATOMIC_RELAXED, __HIP_MEMORY_SCOPE_AGENT); mt[t] = __uint_as_float((unsigned)w); m2[t] = __uint_as_float((unsigned)(w >> 32)); } else { mt[t] = 0.f; m2[t] = 0.f; } ms += mt[t]; }
            const float mean = ms / (float)ntn; float q = 0.f;
#pragma unroll
            for (int t = 0; t < 4; ++t) if (t < ntn) { const float dm = mt[t] - mean; q += m2[t] + 256.0f * dm * dm; }
            S[row] = (f32x2v){mean, 1.0f / sqrtf(q / (256.0f * (float)ntn) + eps)};
        }
        asm volatile("s_waitcnt lgkmcnt(0)" ::: "memory"); __builtin_amdgcn_s_barrier(); asm volatile("" ::: "memory");
        return bad;
    }
};
struct EpiLnRes {
    static constexpr bool PERM = false, AFTER_DRAIN = true;
    const float* base; float* out; int ldc; const float* bias; PanelStats st; unsigned poison;
    __device__ __forceinline__ void refuse(size_t i0, size_t stride, int M, int N) const { const float q = __builtin_nanf(""); for (size_t i = i0; i < (size_t)M * N; i += stride) out[(i / N) * ldc + i % N] = q;
        if (i0 == 0) { unsigned expect = 0u; __hip_atomic_compare_exchange_strong(st.tmo + 1, &expect, 0x7f0u, __ATOMIC_RELAXED, __ATOMIC_RELAXED, __HIP_MEMORY_SCOPE_AGENT); __hip_atomic_store(st.tmo, 1u, __ATOMIC_RELAXED, __HIP_MEMORY_SCOPE_AGENT); } }
    __device__ __forceinline__ void fused(f32x4 (&acc)[2][2][4][2], const Unit& u, int wr, int wc, int fr, int fq, PG8_LAS unsigned char* lds, int wid, int lane) const {
        typedef float f32x2v __attribute__((ext_vector_type(2)));
        const PG8_LAS f32x2v* S = (const PG8_LAS f32x2v*)(lds + 8192);
        const int col0 = u.pn * BM + wc * 32 + 4 * fq;
#pragma unroll
        for (int bj = 0; bj < 2; ++bj)
#pragma unroll
            for (int n = 0; n < 2; ++n) { const f32x4 bv = bias ? *(const f32x4*)(bias + col0 + bj * HALF + n * 16) : (f32x4){0.f, 0.f, 0.f, 0.f};
#pragma unroll
                for (int ai = 0; ai < 2; ++ai)
#pragma unroll
                    for (int m = 0; m < 4; ++m) acc[ai][bj][m][n] += bv; }
        const bool bad = st.run(acc, u, wr, wc, fr, fq, lds, wid, lane) || poison != 0u;
        const float qnan = __builtin_nanf("");
#pragma unroll
        for (int ai = 0; ai < 2; ++ai)
#pragma unroll
            for (int m = 0; m < 4; ++m) { const int r = ai * HALF + wr * 64 + m * 16 + fr; const f32x2v sr = S[r]; const size_t off = (size_t)(u.pm * BM + r) * ldc + col0;
#pragma unroll
                for (int bj = 0; bj < 2; ++bj)
#pragma unroll
                    for (int n = 0; n < 2; ++n) { const f32x4 bs = *(const f32x4*)(base + off + bj * HALF + n * 16); f32x4 o = bs + (acc[ai][bj][m][n] - sr.x) * sr.y;
                        if (bad) o = (f32x4){qnan, qnan, qnan, qnan}; *(f32x4*)(out + off + bj * HALF + n * 16) = o; }
                asm volatile("" ::: "memory"); }
    }
};
struct EpiLnResLn {
    static constexpr bool PERM = false, AFTER_DRAIN = true;
    const float* base; float* out; bf16_t* xn; int ldc; const float* bias; PanelStats st1, st2; unsigned poison;
    __device__ __forceinline__ void refuse(size_t i0, size_t stride, int M, int N) const { const float q = __builtin_nanf(""); for (size_t i = i0; i < (size_t)M * N; i += stride) { const size_t o = (i / N) * ldc + i % N; out[o] = q; xn[o] = (bf16_t)0x7fc0u; }
        if (i0 == 0) { unsigned expect = 0u; __hip_atomic_compare_exchange_strong(st1.tmo + 1, &expect, 0x7f0u, __ATOMIC_RELAXED, __ATOMIC_RELAXED, __HIP_MEMORY_SCOPE_AGENT); __hip_atomic_store(st1.tmo, 1u, __ATOMIC_RELAXED, __HIP_MEMORY_SCOPE_AGENT); } }
    __device__ __forceinline__ void fused(f32x4 (&acc)[2][2][4][2], const Unit& u, int wr, int wc, int fr, int fq, PG8_LAS unsigned char* lds, int wid, int lane) const {
        typedef float f32x2v __attribute__((ext_vector_type(2))); typedef unsigned u32x2v __attribute__((ext_vector_type(2)));
        const PG8_LAS f32x2v* S = (const PG8_LAS f32x2v*)(lds + 8192);
        const int col0 = u.pn * BM + wc * 32 + 4 * fq;
#pragma unroll
        for (int bj = 0; bj < 2; ++bj)
#pragma unroll
            for (int n = 0; n < 2; ++n) { const f32x4 bv = bias ? *(const f32x4*)(bias + col0 + bj * HALF + n * 16) : (f32x4){0.f, 0.f, 0.f, 0.f};
#pragma unroll
                for (int ai = 0; ai < 2; ++ai)
#pragma unroll
                    for (int m = 0; m < 4; ++m) acc[ai][bj][m][n] += bv; }
        bool bad = st1.run(acc, u, wr, wc, fr, fq, lds, wid, lane) || poison != 0u;
        const float qnan = __builtin_nanf("");
#pragma unroll
        for (int ai = 0; ai < 2; ++ai)
#pragma unroll
            for (int m = 0; m < 4; ++m) { const int r = ai * HALF + wr * 64 + m * 16 + fr; const f32x2v sr = S[r]; const size_t off = (size_t)(u.pm * BM + r) * ldc + col0;
#pragma unroll
                for (int bj = 0; bj < 2; ++bj)
#pragma unroll
                    for (int n = 0; n < 2; ++n) { const f32x4 bs = *(const f32x4*)(base + off + bj * HALF + n * 16); acc[ai][bj][m][n] = bs + (acc[ai][bj][m][n] - sr.x) * sr.y; }
                asm volatile("" : "+v"(acc[ai][0][m][0]), "+v"(acc[ai][0][m][1]), "+v"(acc[ai][1][m][0]), "+v"(acc[ai][1][m][1]));
                if (m & 1) asm volatile("" ::: "memory"); }
        const bool bad1 = bad;
        bad = st2.run(acc, u, wr, wc, fr, fq, lds, wid, lane) || bad;
#pragma unroll
        for (int ai = 0; ai < 2; ++ai)
#pragma unroll
            for (int m = 0; m < 4; ++m) { const int r = ai * HALF + wr * 64 + m * 16 + fr; const f32x2v sr = S[r]; const size_t off = (size_t)(u.pm * BM + r) * ldc + col0;
#pragma unroll
                for (int bj = 0; bj < 2; ++bj)
#pragma unroll
                    for (int n = 0; n < 2; ++n) { const f32x4 x1 = acc[ai][bj][m][n]; *(f32x4*)(out + off + bj * HALF + n * 16) = bad1 ? (f32x4){qnan, qnan, qnan, qnan} : x1;
                        const f32x4 o = (x1 - sr.x) * sr.y; u32x2v w; w.x = cvt_pk_bf16(o[0], o[1]); w.y = cvt_pk_bf16(o[2], o[3]);
                        if (bad) { w.x = 0x7fc07fc0u; w.y = 0x7fc07fc0u; } *(u32x2v*)(xn + off + bj * HALF + n * 16) = w; }
                asm volatile("" ::: "memory"); }
    }
};

template <class Epi, class Sched, bool STAMP = false>
__device__ __forceinline__ void gemm_phase(PG8_LAS unsigned char* lds, const Gemm g, const Sched& S, const Epi& E, unsigned long long* stamps) {
    const int tid = threadIdx.x, wid = __builtin_amdgcn_readfirstlane(tid >> 6), lane = tid & 63, wr = wid >> 2, wc = wid & 3, fr = lane & 15, fq = lane >> 4;
    const int K = g.K, nt = K / BK;
    int ts_lo = 0, ts_hi = 0, nts = 0; const unsigned long long rt_entry = STAMP ? (unsigned long long)wall_clock64() : 0ull;
#define PG8_STAMP() do { if (STAMP && wid == 0 && nts < 64) { const unsigned long long _c = (unsigned long long)clock64(); \
        ts_lo = (lane == nts) ? (int)(unsigned)_c : ts_lo; ts_hi = (lane == nts) ? (int)(unsigned)(_c >> 32) : ts_hi; ++nts; } } while (0)
    PG8_STAMP();
    unsigned voffA[2], voffB[2];
#pragma unroll
    for (int i = 0; i < 2; ++i) { int R, C; stage_rc(tid * 16 + i * 8192, R, C); const int Rb = Epi::PERM ? ((R & ~31) + perm32(R & 31)) : R;
        voffA[i] = (unsigned)(R * K + C) * 2u; voffB[i] = (unsigned)(Rb * K + C) * 2u; }
    const size_t kstep = (size_t)(BK * 2);
    const size_t hstep = (size_t)HALF * K * 2;
    const size_t tstep = 2 * hstep;
    const unsigned ldsw = (unsigned)wid * 1024u;
    const int aoff = lds_byte(wr * 64 + fr, fq * 8), boff = lds_byte(wc * 32 + fr, fq * 8);
#define PG8_SA(b, h) (((b) * 2 + (h)) * HTB)
#define PG8_SB(b, h) ((4 + (b) * 2 + (h)) * HTB)
#define PG8_STAGE(bufoff, gbase, voff) do { _Pragma("unroll") for (int _i = 0; _i < 2; ++_i) \
        __builtin_amdgcn_global_load_lds((const unsigned*)((const char*)(gbase) + (voff)[_i]), (PG8_LAS unsigned*)(lds + (bufoff) + ldsw + _i * 8192), 16, 0, 0); } while (0)
#define PG8_LDA(dst, b, h) do { _Pragma("unroll") for (int m = 0; m < 4; ++m) _Pragma("unroll") for (int k = 0; k < 2; ++k) dst[m][k] = *(const PG8_LAS bf16x8*)(lds + PG8_SA(b, h) + aoff + m * 2048 + k * 1024); } while (0)
#define PG8_LDB(dst, b, h) do { _Pragma("unroll") for (int n = 0; n < 2; ++n) _Pragma("unroll") for (int k = 0; k < 2; ++k) dst[n][k] = *(const PG8_LAS bf16x8*)(lds + PG8_SB(b, h) + boff + n * 2048 + k * 1024); } while (0)
#define PG8_MMA(ai, bj, At, Bt) do { __builtin_amdgcn_s_setprio(1); _Pragma("unroll") for (int m = 0; m < 4; ++m) _Pragma("unroll") for (int n = 0; n < 2; ++n) _Pragma("unroll") for (int k = 0; k < 2; ++k) \
        acc[ai][bj][m][n] = __builtin_amdgcn_mfma_f32_16x16x32_bf16(Bt[n][k], At[m][k], acc[ai][bj][m][n], 0, 0, 0); __builtin_amdgcn_s_setprio(0); } while (0)
#define PG8_WAIT_V(n) asm volatile("s_waitcnt vmcnt(" #n ")" ::: "memory")
#define PG8_WAIT_L(n) asm volatile("s_waitcnt lgkmcnt(" #n ")" ::: "memory")
#define PG8_BAR __builtin_amdgcn_s_barrier()
#define PG8_SCHED __builtin_amdgcn_sched_barrier(0)
    Unit cur, nxt; int ui = 0;
    if (!S.next(0, cur)) return;
    f32x4 acc[2][2][4][2];
#pragma unroll
    for (int a = 0; a < 2; ++a)
#pragma unroll
        for (int b = 0; b < 2; ++b)
#pragma unroll
            for (int m = 0; m < 4; ++m)
#pragma unroll
                for (int n = 0; n < 2; ++n) acc[a][b][m][n] = (f32x4){0.f, 0.f, 0.f, 0.f};
    bf16x8 At[4][2], B0[2][2], B1[2][2];
    const char* cA = (const char*)g.A + (size_t)cur.pm * tstep; const char* cB = (const char*)g.Bt + (size_t)cur.pn * tstep;
    S.a_ready(cur);
    PG8_STAGE(PG8_SB(0, 0), cB, voffB); PG8_STAGE(PG8_SA(0, 0), cA, voffA); PG8_STAGE(PG8_SB(0, 1), cB + hstep, voffB); PG8_STAGE(PG8_SA(0, 1), cA + hstep, voffA);
    if (wr == 1) PG8_BAR;
    PG8_WAIT_V(4); PG8_BAR;
    PG8_STAGE(PG8_SB(1, 0), cB + kstep, voffB); PG8_STAGE(PG8_SA(1, 0), cA + kstep, voffA); PG8_STAGE(PG8_SB(1, 1), cB + hstep + kstep, voffB);
    PG8_WAIT_V(6); PG8_BAR;
    PG8_STAMP();
    for (;;) {
        const bool has_next = S.next(ui + 1, nxt);
        const char* nA = has_next ? (const char*)g.A + (size_t)nxt.pm * tstep : cA; const char* nB = has_next ? (const char*)g.Bt + (size_t)nxt.pn * tstep : cB;
        for (int t = 0; t < nt; t += 2) {
            const bool last = (t == nt - 2);
            const char* a1 = cA + (size_t)(t + 1) * kstep;
            const char* a2 = last ? nA : cA + (size_t)(t + 2) * kstep; const char* b2 = last ? nB : cB + (size_t)(t + 2) * kstep;
            const char* a3 = a2 + kstep; const char* b3 = b2 + kstep;
            if (last && has_next) S.a_ready(nxt);
            PG8_LDB(B0, 0, 0); PG8_SCHED; PG8_LDA(At, 0, 0); PG8_STAGE(PG8_SA(1, 1), a1 + hstep, voffA);
            PG8_WAIT_L(8); PG8_BAR; PG8_WAIT_L(0); PG8_MMA(0, 0, At, B0); PG8_BAR; PG8_SCHED;
            PG8_LDB(B1, 0, 1); PG8_STAGE(PG8_SB(0, 0), b2, voffB);
            PG8_BAR; PG8_WAIT_L(0); PG8_MMA(0, 1, At, B1); PG8_BAR;
            PG8_LDA(At, 0, 1); PG8_STAGE(PG8_SA(0, 0), a2, voffA);
            PG8_BAR; PG8_WAIT_L(0); PG8_MMA(1, 0, At, B0); PG8_BAR; PG8_SCHED;
            PG8_STAGE(PG8_SB(0, 1), b2 + hstep, voffB);
            PG8_WAIT_V(6); PG8_BAR; PG8_MMA(1, 1, At, B1); PG8_BAR;
            PG8_LDB(B0, 1, 0); PG8_SCHED; PG8_LDA(At, 1, 0); PG8_STAGE(PG8_SA(0, 1), a2 + hstep, voffA);
            PG8_WAIT_L(8); PG8_BAR; PG8_WAIT_L(0); PG8_MMA(0, 0, At, B0); PG8_BAR; PG8_SCHED;
            PG8_LDB(B1, 1, 1); PG8_STAGE(PG8_SB(1, 0), b3, voffB);
            PG8_BAR; PG8_WAIT_L(0); PG8_MMA(0, 1, At, B1); PG8_BAR;
            PG8_LDA(At, 1, 1); PG8_STAGE(PG8_SA(1, 0), a3, voffA);
            PG8_BAR; PG8_WAIT_L(0); PG8_MMA(1, 0, At, B0); PG8_BAR; PG8_SCHED;
            PG8_STAGE(PG8_SB(1, 1), b3 + hstep, voffB);
            PG8_WAIT_V(6); PG8_BAR; PG8_MMA(1, 1, At, B1); PG8_BAR;
        }
        PG8_STAMP();
        if constexpr (!Epi::AFTER_DRAIN) { E(acc, cur, wr, wc, fr, fq); S.done(cur); }
        PG8_STAMP();
        if (!has_next) break;
#pragma unroll
        for (int a = 0; a < 2; ++a)
#pragma unroll
            for (int b = 0; b < 2; ++b)
#pragma unroll
                for (int m = 0; m < 4; ++m)
#pragma unroll
                    for (int n = 0; n < 2; ++n) acc[a][b][m][n] = (f32x4){0.f, 0.f, 0.f, 0.f};
        cur = nxt; cA = nA; cB = nB; ++ui;
    }
    PG8_WAIT_V(0);
    if (wr == 0) PG8_BAR;
    PG8_BAR;
    if constexpr (Epi::AFTER_DRAIN) { E.fused(acc, cur, wr, wc, fr, fq, lds, wid, lane); S.done(cur); }
    PG8_STAMP();
    if (STAMP && wid == 0) { stamps[lane] = lane < nts ? (((unsigned long long)(unsigned)ts_hi << 32) | (unsigned)ts_lo) : 0ull;
        if (lane == 62) stamps[62] = rt_entry; if (lane == 63) stamps[63] = (unsigned long long)wall_clock64(); }
#undef PG8_STAMP
#undef PG8_SA
#undef PG8_SB
#undef PG8_STAGE
#undef PG8_LDA
#undef PG8_LDB
#undef PG8_MMA
#undef PG8_WAIT_V
#undef PG8_WAIT_L
#undef PG8_BAR
#undef PG8_SCHED
}
}

#include <hip/hip_cooperative_groups.h>
#include <cstdio>
namespace cg = cooperative_groups;
using pg8::bf16_t; using pg8::bf16x8; using pg8::f32x4; using pg8::Unit;
typedef float f32x16 __attribute__((ext_vector_type(16)));
typedef float f32x2 __attribute__((ext_vector_type(2)));
typedef unsigned u32x2 __attribute__((ext_vector_type(2)));
typedef unsigned u32x4v __attribute__((ext_vector_type(4)));
#define LAS __attribute__((address_space(3)))
#define XB_TMO      128
#define XB_XCNT(j)  (256  + 64 * (j))
#define XB_XSUB(j)  (1280 + 64 * (j))
#define XB_XGEN(j)  (2304 + 64 * (j))
#define XB_TOP      3328
#define XB_TOPGEN   3392
#define XCD_BAR_WORDS 3456
#define XB_SPIN_CAP (1u << 18)

__device__ __forceinline__ unsigned xb_ld(unsigned* p)              { return __hip_atomic_load(p, __ATOMIC_RELAXED, __HIP_MEMORY_SCOPE_AGENT); }
__device__ __forceinline__ unsigned xb_add(unsigned* p, unsigned v) { return __hip_atomic_fetch_add(p, v, __ATOMIC_RELAXED, __HIP_MEMORY_SCOPE_AGENT); }
__device__ __forceinline__ unsigned xb_xcc_id() { return (unsigned)__builtin_amdgcn_s_getreg((3 << 11) | 20) & 0xFu; }
#define XB_SPIN(cond, bar) do { unsigned _sp = 0; while (cond) { __builtin_amdgcn_s_sleep(1); \
    if ((++_sp & 255u) == 0u) { if (xb_ld(&(bar)[XB_TMO])) break; if (_sp > XB_SPIN_CAP) { atomicAdd(&(bar)[XB_TMO], 1u); break; } } } } while (0)

struct XcdBarrier {
    unsigned* bar; unsigned x;
    volatile LAS unsigned* st;
};

__device__ __forceinline__ XcdBarrier xcd_barrier_post(unsigned* bar, volatile LAS unsigned* st) {
    XcdBarrier b; b.bar = bar; b.x = xb_xcc_id(); b.st = st;
    if (threadIdx.x == 0) (void)xb_add(&bar[XB_XCNT(b.x)], 1u);
    return b;
}
__device__ __forceinline__ void xcd_barrier_complete(unsigned* bar, unsigned x, unsigned& nloc, unsigned& nx) {
    const unsigned G = gridDim.x * gridDim.y * gridDim.z;
    unsigned sum, cnt, mine, sp = 0u;
    for (;;) {
        sum = 0u; cnt = 0u; mine = 0u;
#pragma unroll
        for (unsigned j = 0; j < 16; ++j) { const unsigned c = xb_ld(&bar[XB_XCNT(j)]); sum += c; cnt += (c > 0u) ? 1u : 0u; mine = (j == x) ? c : mine; }
        if (sum == G) break;
        __builtin_amdgcn_s_sleep(1);
        if ((++sp & 255u) == 0u) { if (xb_ld(&bar[XB_TMO])) break; if (sp > XB_SPIN_CAP) { atomicAdd(&bar[XB_TMO], 1u); break; } }
    }
    nloc = mine > 0u ? mine : 1u; nx = cnt > 0u ? cnt : 1u;
}

__device__ __forceinline__ void xcd_barrier(const XcdBarrier& b) {
    asm volatile("s_waitcnt vmcnt(0)" ::: "memory");
    __syncthreads();
    if (threadIdx.x == 0) {
        unsigned* bar = b.bar;
        __builtin_amdgcn_s_waitcnt(0);
        unsigned nloc = b.st[0], nx = b.st[1];
        if (nloc == 0u) { xcd_barrier_complete(bar, b.x, nloc, nx); b.st[0] = nloc; b.st[1] = nx; }
        const unsigned old = xb_add(&bar[XB_XSUB(b.x)], 1u);
        const unsigned gen = old / nloc;
        if (old + 1u == (gen + 1u) * nloc) {
            __builtin_amdgcn_fence(__ATOMIC_RELEASE, "agent");
            asm volatile("s_waitcnt vmcnt(0)" ::: "memory");
            const unsigned og = xb_add(&bar[XB_TOP], 1u);
            const unsigned tg = og / nx;
            if (og + 1u == (tg + 1u) * nx) xb_add(&bar[XB_TOPGEN], 1u);
            else XB_SPIN(xb_ld(&bar[XB_TOPGEN]) == tg, bar);
            __builtin_amdgcn_fence(__ATOMIC_ACQUIRE, "agent");
            xb_add(&bar[XB_XGEN(b.x)], 1u);
            asm volatile("s_waitcnt vmcnt(0)" ::: "memory");
        } else {
            XB_SPIN(xb_ld(&bar[XB_XGEN(b.x)]) == gen, bar);
            __builtin_amdgcn_fence(__ATOMIC_ACQUIRE, "agent");
            asm volatile("s_waitcnt vmcnt(0)" ::: "memory");
        }
    }
    __syncthreads();
}

constexpr int MT = 16896, MPR = 16384, DM = 1024, NIN = 2816, DFF = 2816;
constexpr float EPS = 1e-6f;
constexpr int LDS_BYTES = 143360;
#ifndef N_LAUNCH_MODE
#define N_LAUNCH_MODE 1
#endif
constexpr int NPHASE = 13;
#ifndef EXTRA_LO
#define EXTRA_LO 0
#endif
#ifndef EXTRA_FLAGS
#define EXTRA_FLAGS 0
#endif
#ifndef EXTRA_HI
#define EXTRA_HI 0
#endif

constexpr size_t WS_WIN = 0;
constexpr size_t WS_WOUT = WS_WIN + (size_t)2816 * 1024 * 2;
constexpr size_t WS_WQ = WS_WOUT + (size_t)1024 * 1024 * 2;
constexpr size_t WS_WKV = WS_WQ + (size_t)1024 * 1024 * 2;
constexpr size_t WS_WO = WS_WKV + (size_t)2048 * 1024 * 2;
constexpr size_t WS_WGU = WS_WO + (size_t)1024 * 1024 * 2;
constexpr size_t WS_WD = WS_WGU + (size_t)5632 * 1024 * 2;
constexpr size_t WS_A = WS_WD + (size_t)1024 * 2816 * 2;
constexpr size_t WS_MN = WS_A + (size_t)MT * 1024 * 2;
constexpr size_t WS_MKB = WS_MN + (size_t)2048 * 1024 * 2;
constexpr size_t WS_MVT = WS_MKB + (size_t)2048 * 1024 * 2;
constexpr size_t WS_P = WS_MVT + (size_t)2048 * 1024 * 2;
constexpr size_t WS_U = WS_P + (size_t)MT * 2816 * 2;
constexpr size_t WS_DS = WS_U;
constexpr size_t WS_ST = WS_DS + (size_t)1024 * 8192 * 4;
constexpr size_t WS_AF = WS_ST + (size_t)1024 * 8192 * 2;
constexpr size_t WS_DEC = WS_AF + (size_t)MT * 16 * 4;
constexpr size_t WS_H = WS_U + (size_t)MT * 2816 * 2;
constexpr size_t WS_HB = WS_H + (size_t)MT * 1024 * 4;
constexpr size_t WS_SSQ = WS_HB + (size_t)MT * 1024 * 2;
constexpr size_t WS_SSQS = WS_SSQ + (size_t)3 * MT * 16 * 4;
constexpr size_t WS_BAR = WS_SSQS + (size_t)3 * 512 * 64 * 4;
constexpr size_t WS_GX = WS_BAR + (size_t)2 * XCD_BAR_WORDS * 4;
constexpr size_t WS_UX = WS_GX + (size_t)256 * 4 * 2816 * 4;
constexpr size_t WS_END = WS_UX + (size_t)256 * 2 * 2816 * 4;

constexpr size_t O_Y = 0;
constexpr size_t O_SGP = 17301504;
constexpr size_t O_SCP = 17563648;
constexpr size_t O_MK = 17608704;
constexpr size_t O_MV = 19705856;
constexpr size_t O_SGS = 21803008;
constexpr size_t O_SCS = 25997312;
constexpr size_t O_SV = 26718208;

struct Params { const float* in[29]; float* out; unsigned char* ws; int ph_lo, ph_hi, bar_region, pad; };

__device__ __forceinline__ unsigned pk2(float lo, float hi) { return pg8::cvt_pk_bf16(lo, hi); }
__device__ __forceinline__ bf16_t f2bf(float f) { return (bf16_t)(pk2(f, 0.f) & 0xffffu); }
__device__ __forceinline__ float bf2f(bf16_t b) { return __uint_as_float(((unsigned)b) << 16); }
__device__ __forceinline__ float bflo(unsigned w) { return __uint_as_float(w << 16); }
__device__ __forceinline__ float bfhi(unsigned w) { return __uint_as_float(w & 0xffff0000u); }
__device__ __forceinline__ float gelu_t(float x) { const float t = __builtin_fmaf(x * x, 0.044715f, 1.0f); const float e = __builtin_amdgcn_exp2f(x * t * -2.3022082f); return x * __builtin_amdgcn_rcpf(1.0f + e); }
__device__ __forceinline__ float silu_f(float x) { return x * __builtin_amdgcn_rcpf(1.0f + __builtin_amdgcn_exp2f(x * -1.44269504f)); }
__device__ __forceinline__ float logsig(float z) { return fminf(z, 0.f) - __logf(1.0f + __expf(-fabsf(z))); }
template <int CTRL> __device__ __forceinline__ float dppr(float x) { return __builtin_bit_cast(float, __builtin_amdgcn_update_dpp(0, __builtin_bit_cast(int, x), CTRL, 0xf, 0xf, true)); }
__device__ __forceinline__ float row_sum16(float s) { s += dppr<0x128>(s); s += dppr<0x124>(s); s += dppr<0x122>(s); s += dppr<0x121>(s); return s; }
__device__ __forceinline__ float wave_sum(float s) { s = row_sum16(s); s += __shfl_xor(s, 16); s += __shfl_xor(s, 32); return s; }
__device__ __forceinline__ float wave_max(float s) { for (int o = 32; o >= 1; o >>= 1) s = fmaxf(s, __shfl_xor(s, o)); return s; }
__device__ __forceinline__ f32x16 mma32(bf16x8 a, bf16x8 b, f32x16 c) { return __builtin_amdgcn_mfma_f32_32x32x16_bf16(a, b, c, 0, 0, 0); }
__device__ __forceinline__ f32x16 zero16() { f32x16 z; for (int i = 0; i < 16; ++i) z[i] = 0.f; return z; }
__device__ __forceinline__ float row_rs(const float* ssq, int row) {
    const f32x4* p = (const f32x4*)(ssq + (size_t)row * 16); f32x4 a = p[0], b = p[1], c = p[2], d = p[3];
    const float s = ((a[0] + a[1]) + (a[2] + a[3])) + ((b[0] + b[1]) + (b[2] + b[3])) + ((c[0] + c[1]) + (c[2] + c[3])) + ((d[0] + d[1]) + (d[2] + d[3]));
    return rsqrtf(s * (1.0f / 1024.0f) + EPS);
}

__device__ __forceinline__ float row_rs64(const float* ssq64, int r) {
    const f32x4* p = (const f32x4*)(ssq64 + (size_t)r * 64); float s = 0.f;
#pragma unroll
    for (int i = 0; i < 16; ++i) { const f32x4 a = p[i]; s += (a[0] + a[1]) + (a[2] + a[3]); }
    return rsqrtf(s * (1.0f / 1024.0f) + EPS);
}
__device__ __forceinline__ float row_rs2(const float* ssq16, const float* ssq64, int row) { return row < MPR ? row_rs(ssq16, row) : row_rs64(ssq64, row - MPR); }
template <int KC, class F>
__device__ __forceinline__ void gemm_small(const bf16_t* A, const bf16_t* Bt, int K, int ncb, LAS unsigned char* lds, F f) {
    constexpr int PITCH = KC * 2 + 16, PPR = KC / 8, NP = 96 * PPR, NPT = (NP + 511) / 512, BUF = 96 * PITCH; static_assert(KC % 32 == 0 && 2 * BUF <= 140000, "KC must be a multiple of the MFMA K; two buffers must fit");
    const int tid = threadIdx.x, lane = tid & 63, wave = tid >> 6, fr = lane & 15, fq = lane >> 4;
    for (int t = blockIdx.x; t < 16 * ncb; t += gridDim.x) { const int rb = t & 15, cb = t >> 4;
        f32x4 acc = (f32x4){0.f, 0.f, 0.f, 0.f};
        u32x4v v[NPT]; const bf16_t* src[NPT]; int dsto[NPT];
#pragma unroll
        for (int i = 0; i < NPT; ++i) { const int idx = tid + 512 * i, row = idx / PPR, pc = idx % PPR;
            src[i] = (row < 32 ? A + (size_t)(rb * 32 + row) * K : Bt + (size_t)(cb * 64 + row - 32) * K) + pc * 8; dsto[i] = row * PITCH + pc * 16;
            if (idx < NP) v[i] = *(const u32x4v*)(src[i]); }
        int buf = 0;
        for (int k0 = 0; k0 < K; k0 += KC) {
            LAS unsigned char* L = lds + buf * BUF;
#pragma unroll
            for (int i = 0; i < NPT; ++i) { const int idx = tid + 512 * i; if (idx < NP) *(LAS u32x4v*)(L + dsto[i]) = v[i]; }
            __syncthreads();
            if (k0 + KC < K) {
#pragma unroll
                for (int i = 0; i < NPT; ++i) { const int idx = tid + 512 * i; if (idx < NP) v[i] = *(const u32x4v*)(src[i] + k0 + KC); } }
            const LAS unsigned char* ap = L + ((wave & 1) * 16 + fr) * PITCH + fq * 16; const LAS unsigned char* bp = L + (32 + (wave >> 1) * 16 + fr) * PITCH + fq * 16;
#pragma unroll
            for (int k = 0; k < KC; k += 32) { const bf16x8 av = *(const LAS bf16x8*)(ap + k * 2); const bf16x8 bv = *(const LAS bf16x8*)(bp + k * 2);
                acc = __builtin_amdgcn_mfma_f32_16x16x32_bf16(bv, av, acc, 0, 0, 0); }
            buf ^= 1;
            __syncthreads();
        }
        __syncthreads();
        f(rb * 32 + (wave & 1) * 16 + fr, cb * 64 + (wave >> 1) * 16 + 4 * fq, cb * 4 + (wave >> 1), fq, acc);
    }
}
#define EPI_LOOP_ROWS for (int ai = 0; ai < 2; ++ai) _Pragma("unroll") for (int m = 0; m < 4; ++m)
__device__ __forceinline__ u32x4v pack8(const f32x4 a, const f32x4 c) { u32x4v w; w.x = pk2(a[0], a[1]); w.y = pk2(a[2], a[3]); w.z = pk2(c[0], c[1]); w.w = pk2(c[2], c[3]); return w; }
__device__ __forceinline__ float sq4(const f32x4 v) { return (v[0] * v[0] + v[1] * v[1]) + (v[2] * v[2] + v[3] * v[3]); }
template <int CTRL> __device__ __forceinline__ float dpp_f(float x) { return __builtin_bit_cast(float, __builtin_amdgcn_update_dpp(0, __builtin_bit_cast(int, x), CTRL, 0xf, 0xf, true)); }
template <int CTRL> __device__ __forceinline__ f32x4 dpp4(const f32x4 v) { return (f32x4){dpp_f<CTRL>(v[0]), dpp_f<CTRL>(v[1]), dpp_f<CTRL>(v[2]), dpp_f<CTRL>(v[3])}; }
__device__ __forceinline__ f32x4 gelu4(const f32x4 v) { return (f32x4){gelu_t(v[0]), gelu_t(v[1]), gelu_t(v[2]), gelu_t(v[3])}; }
__device__ __forceinline__ void rs_rows8(float (&rsv)[2][4], const float* ssq, int row0, int fq) {
    f32x4 q[2][4];
#pragma unroll
    for (int ai = 0; ai < 2; ++ai)
#pragma unroll
        for (int m = 0; m < 4; ++m) q[ai][m] = *(const f32x4*)(ssq + (size_t)(row0 + ai * 128 + m * 16) * 16 + 4 * fq);
#pragma unroll
    for (int ai = 0; ai < 2; ++ai)
#pragma unroll
        for (int m = 0; m < 4; ++m) { float t = (q[ai][m][0] + q[ai][m][1]) + (q[ai][m][2] + q[ai][m][3]); t += __shfl_xor(t, 16); t += __shfl_xor(t, 32); rsv[ai][m] = rsqrtf(t * (1.0f / 1024.0f) + EPS); }
}
__device__ __forceinline__ void rs_rows8_s(float (&rsv)[2][4], const float* ssq64, int r0, int fq) {
#pragma unroll
    for (int ai = 0; ai < 2; ++ai) { f32x4 q[4][4];
#pragma unroll
        for (int m = 0; m < 4; ++m) { const f32x4* pp = (const f32x4*)(ssq64 + (size_t)(r0 + ai * 128 + m * 16) * 64 + 16 * fq); q[m][0] = pp[0]; q[m][1] = pp[1]; q[m][2] = pp[2]; q[m][3] = pp[3]; }
#pragma unroll
        for (int m = 0; m < 4; ++m) { const f32x4 v = (q[m][0] + q[m][1]) + (q[m][2] + q[m][3]); float t = (v[0] + v[1]) + (v[2] + v[3]); t += __shfl_xor(t, 16); t += __shfl_xor(t, 32); rsv[ai][m] = rsqrtf(t * (1.0f / 1024.0f) + EPS); } }
}
struct EpiIn {
    static constexpr bool PERM = true, AFTER_DRAIN = false;
    bf16_t* P; float* af;
    __device__ __forceinline__ void operator()(const f32x4 (&acc)[2][2][4][2], const Unit& u, int wr, int wc, int fr, int fq) const {
        const int row0 = u.pm * 256 + wr * 64 + fr, col0 = u.pn * 256 + wc * 32 + 8 * fq;
#pragma unroll
        EPI_LOOP_ROWS { const int row = row0 + ai * 128 + m * 16;
#pragma unroll
            for (int bj = 0; bj < 2; ++bj) *(u32x4v*)(P + (size_t)row * NIN + col0 + bj * 128) = pack8(acc[ai][bj][m][0], acc[ai][bj][m][1]);
        }
    }
};
struct EpiKV {
    static constexpr bool PERM = true, AFTER_DRAIN = false;
    float* omk; float* omv; bf16_t* mkb; bf16_t* mvt;
    __device__ __forceinline__ void operator()(const f32x4 (&acc)[2][2][4][2], const Unit& u, int wr, int wc, int fr, int fq) const {
        const int row0 = u.pm * 256 + wr * 64 + fr, col0 = u.pn * 256 + wc * 32 + 8 * fq;
#pragma unroll
        EPI_LOOP_ROWS { const int row = row0 + ai * 128 + m * 16;
#pragma unroll
            for (int bj = 0; bj < 2; ++bj) { const f32x4 v0 = acc[ai][bj][m][0], v1 = acc[ai][bj][m][1]; const int col = col0 + bj * 128;
                if (col < 1024) { float* o = omk + (size_t)row * 1024 + col; *(f32x4*)o = v0; *(f32x4*)(o + 4) = v1; *(u32x4v*)(mkb + (size_t)row * 1024 + col) = pack8(v0, v1); }
                else { const int c2 = col - 1024; float* o = omv + (size_t)row * 1024 + c2; *(f32x4*)o = v0; *(f32x4*)(o + 4) = v1;
                    const int b = row >> 8, mt = row & 255, h = c2 >> 8, d = c2 & 255; bf16_t* t = mvt + ((size_t)(b * 4 + h) * 256 + d) * 256 + mt;
                    t[0] = f2bf(v0[0]); t[256] = f2bf(v0[1]); t[512] = f2bf(v0[2]); t[768] = f2bf(v0[3]); t[1024] = f2bf(v1[0]); t[1280] = f2bf(v1[1]); t[1536] = f2bf(v1[2]); t[1792] = f2bf(v1[3]); } }
        }
    }
};
__device__ __forceinline__ void unpack8(const u32x4v w, f32x4& a, f32x4& c) { a = (f32x4){bflo(w.x), bfhi(w.x), bflo(w.y), bfhi(w.y)}; c = (f32x4){bflo(w.z), bfhi(w.z), bflo(w.w), bfhi(w.w)}; }
struct EpiRes {
    static constexpr bool PERM = true, AFTER_DRAIN = false;
    const float* xf; bf16_t* hb; float* ssq;
    __device__ __forceinline__ void operator()(const f32x4 (&acc)[2][2][4][2], const Unit& u, int wr, int wc, int fr, int fq) const {
        const int row0 = u.pm * 256 + wr * 64 + fr, col0 = u.pn * 256 + wc * 32 + 8 * fq;
#pragma unroll
        for (int h2 = 0; h2 < 4; ++h2) { const int ai = h2 >> 1, mb = (h2 & 1) * 2;
            f32x4 bs[2][2][2];
            if (xf) {
#pragma unroll
                for (int mm = 0; mm < 2; ++mm)
#pragma unroll
                    for (int bj = 0; bj < 2; ++bj) { const float* pb = xf + (size_t)(row0 + ai * 128 + (mb + mm) * 16) * 1024 + col0 + bj * 128; bs[mm][bj][0] = *(const f32x4*)pb; bs[mm][bj][1] = *(const f32x4*)(pb + 4); }
            } else { u32x4v raw[2][2];
#pragma unroll
                for (int mm = 0; mm < 2; ++mm)
#pragma unroll
                    for (int bj = 0; bj < 2; ++bj) raw[mm][bj] = *(const u32x4v*)(hb + (size_t)(row0 + ai * 128 + (mb + mm) * 16) * 1024 + col0 + bj * 128);
#pragma unroll
                for (int mm = 0; mm < 2; ++mm)
#pragma unroll
                    for (int bj = 0; bj < 2; ++bj) unpack8(raw[mm][bj], bs[mm][bj][0], bs[mm][bj][1]); }
#pragma unroll
            for (int mm = 0; mm < 2; ++mm) { const int m = mb + mm, row = row0 + ai * 128 + m * 16; float s = 0.f;
#pragma unroll
                for (int bj = 0; bj < 2; ++bj) { const f32x4 v0 = acc[ai][bj][m][0] + bs[mm][bj][0], v1 = acc[ai][bj][m][1] + bs[mm][bj][1];
                    *(u32x4v*)(hb + (size_t)row * 1024 + col0 + bj * 128) = pack8(v0, v1); s += sq4(v0) + sq4(v1); }
                s += __shfl_xor(s, 16); s += __shfl_xor(s, 32);
                if (fq == 0) ssq[(size_t)row * 16 + u.pn * 4 + wc] = s; }
        }
    }
};
#define RLXA __ATOMIC_RELAXED, __HIP_MEMORY_SCOPE_AGENT
__device__ __forceinline__ void ld_coh16x4(f32x4& a, f32x4& b_, f32x4& c, f32x4& d, const float* pa, const float* pb, const float* pc, const float* pd) {
    asm volatile("global_load_dwordx4 %0, %4, off sc1\n\tglobal_load_dwordx4 %1, %5, off sc1\n\tglobal_load_dwordx4 %2, %6, off sc1\n\tglobal_load_dwordx4 %3, %7, off sc1\n\ts_waitcnt vmcnt(0)"
                 : "=&v"(a), "=&v"(b_), "=&v"(c), "=&v"(d) : "v"(pa), "v"(pb), "v"(pc), "v"(pd) : "memory");
}
__device__ __forceinline__ void spin_poll(unsigned* cnt, unsigned want) {
    unsigned sp = 0; while ((unsigned)__builtin_amdgcn_readfirstlane(__hip_atomic_load(cnt, RLXA)) < want) { __builtin_amdgcn_s_sleep(2); if (++sp > (1u << 22)) break; }
}
__device__ __forceinline__ void wg_wait2(unsigned* c1, unsigned w1, unsigned* c2, unsigned w2) {
    if (threadIdx.x < 64) { spin_poll(c1, w1); if (c2) spin_poll(c2, w2); __builtin_amdgcn_fence(__ATOMIC_ACQUIRE, "agent"); asm volatile("s_waitcnt vmcnt(0)" ::: "memory"); }
    __syncthreads();
}
struct EpiFin {
    static constexpr bool PERM = true, AFTER_DRAIN = true;
    const bf16_t* hb; float* ssq; unsigned* cnt; const float* gfin; float* out; int flags;
    const bf16_t* sA; const bf16_t* sBt; float* ssq64;
    __device__ __forceinline__ void fused(f32x4 (&acc)[2][2][4][2], const Unit& u, int wr, int wc, int fr, int fq, LAS unsigned char* lds_, int wid_, int lane_) const {
        const int row0 = u.pm * 256 + wr * 64 + fr, col0 = u.pn * 256 + wc * 32 + 8 * fq;
#pragma unroll
        for (int ai = 0; ai < 2; ++ai) { u32x4v raw[4][2];
#pragma unroll
            for (int m = 0; m < 4; ++m)
#pragma unroll
                for (int bj = 0; bj < 2; ++bj) raw[m][bj] = *(const u32x4v*)(hb + (size_t)(row0 + ai * 128 + m * 16) * 1024 + col0 + bj * 128);
#pragma unroll
            for (int m = 0; m < 4; ++m) { const int row = row0 + ai * 128 + m * 16; float s = 0.f;
#pragma unroll
                for (int bj = 0; bj < 2; ++bj) { f32x4 b0, b1; unpack8(raw[m][bj], b0, b1);
                    acc[ai][bj][m][0] += b0; acc[ai][bj][m][1] += b1; s += sq4(acc[ai][bj][m][0]) + sq4(acc[ai][bj][m][1]); }
                s += __shfl_xor(s, 16); s += __shfl_xor(s, 32);
                if (fq == 0) __hip_atomic_store((unsigned*)(ssq + (size_t)row * 16 + u.pn * 4 + wc), __float_as_uint(s), RLXA); }
        }
        asm volatile("s_waitcnt vmcnt(0)" ::: "memory");
        if ((threadIdx.x & 63) == 0) __hip_atomic_fetch_add(cnt + u.pm, 1u, RLXA);
        f32x4 sv = (f32x4){0.f, 0.f, 0.f, 0.f}; int sr = -1, sc = 0; unsigned* scw = cnt;
        { const bf16_t* hbs = hb + (size_t)MPR * 1024; float* sq = ssq64; unsigned* cnt2 = cnt + 64;
          gemm_small<256>(sA, sBt, 2816, 16, lds_, [&](int r, int c, int cb, int fq2, f32x4 a) {
              const size_t off = (size_t)r * 1024 + c; const u32x2 hw = *(const u32x2*)(hbs + off); const f32x4 v = a + (f32x4){bflo(hw.x), bfhi(hw.x), bflo(hw.y), bfhi(hw.y)};
              float s = sq4(v); s += __shfl_xor(s, 16); s += __shfl_xor(s, 32); if (fq2 == 0) __hip_atomic_store((unsigned*)(sq + (size_t)r * 64 + cb), __float_as_uint(s), RLXA);
              asm volatile("s_waitcnt vmcnt(0)" ::: "memory");
              scw = cnt2 + (r >> 5); if ((threadIdx.x & 63) == 0) __hip_atomic_fetch_add(scw, 1u, RLXA);
              sv = v; sr = r; sc = c; }); }
        wg_wait2(cnt + u.pm, 32u, sr >= 0 ? scw : nullptr, 128u);
        f32x4 g[2][2];
#pragma unroll
        for (int bj = 0; bj < 2; ++bj) { g[bj][0] = *(const f32x4*)(gfin + col0 + bj * 128); g[bj][1] = *(const f32x4*)(gfin + col0 + bj * 128 + 4); }
        f32x4 pq[2][4];
#pragma unroll
        for (int ai = 0; ai < 2; ++ai) { const float* b0 = ssq + (size_t)(row0 + ai * 128) * 16 + 4 * fq; ld_coh16x4(pq[ai][0], pq[ai][1], pq[ai][2], pq[ai][3], b0, b0 + 16 * 16, b0 + 32 * 16, b0 + 48 * 16); }
#pragma unroll
        EPI_LOOP_ROWS { const int row = row0 + ai * 128 + m * 16; const f32x4 q4 = pq[ai][m];
            float s = (q4[0] + q4[1]) + (q4[2] + q4[3]);
            s += __shfl_xor(s, 16); s += __shfl_xor(s, 32); const float rs = rsqrtf(s * (1.0f / 1024.0f) + EPS);
#pragma unroll
            for (int bj = 0; bj < 2; ++bj) { float* o = out + (size_t)row * 1024 + col0 + bj * 128; *(f32x4*)o = acc[ai][bj][m][0] * rs * g[bj][0]; *(f32x4*)(o + 4) = acc[ai][bj][m][1] * rs * g[bj][1]; }
        }
        if (sr >= 0) {

            const float* sp = ssq64 + (size_t)sr * 64 + 16 * fq; f32x4 q0, q1, q2, q3; ld_coh16x4(q0, q1, q2, q3, sp, sp + 4, sp + 8, sp + 12);
            const f32x4 qs = (q0 + q1) + (q2 + q3); float t = (qs[0] + qs[1]) + (qs[2] + qs[3]);
            t += __shfl_xor(t, 16); t += __shfl_xor(t, 32); const float rs = rsqrtf(t * (1.0f / 1024.0f) + EPS);
            *(f32x4*)(out + (size_t)(MPR + sr) * 1024 + sc) = sv * rs * *(const f32x4*)(gfin + sc);
        }
    }
};
struct EpiQ {
    static constexpr bool PERM = true, AFTER_DRAIN = false;
    bf16_t* Q; const float* ssq;
    __device__ __forceinline__ void operator()(const f32x4 (&acc)[2][2][4][2], const Unit& u, int wr, int wc, int fr, int fq) const {
        const int row0 = u.pm * 256 + wr * 64 + fr, col0 = u.pn * 256 + wc * 32 + 8 * fq;
        float rsv[2][4]; rs_rows8(rsv, ssq, row0, fq);
#pragma unroll
        EPI_LOOP_ROWS { const int row = row0 + ai * 128 + m * 16; const float rs = rsv[ai][m];
#pragma unroll
            for (int bj = 0; bj < 2; ++bj) *(u32x4v*)(Q + (size_t)row * 1024 + col0 + bj * 128) = pack8(acc[ai][bj][m][0] * rs, acc[ai][bj][m][1] * rs);
        }
    }
};
struct EpiGU {
    static constexpr bool PERM = true, AFTER_DRAIN = false;
    bf16_t* U; const float* ssq; const float* ssq64; float* scp; float* scs; const float* cw; const float* cbias; const float* sconv; float* GX; float* UX; int flags;
    __device__ __forceinline__ void operator()(const f32x4 (&acc)[2][2][4][2], const Unit& u, int wr, int wc, int fr, int fq) const {
        const int row0 = u.pm * 256 + wr * 64 + fr, ch0 = u.pn * 128 + wc * 32 + 8 * fq;
        if (flags & 48) {
            if (flags & 16) {
#pragma unroll
                EPI_LOOP_ROWS { const int row = row0 + ai * 128 + m * 16; *(u32x4v*)(U + (size_t)row * DFF + ch0) = pack8(acc[ai][0][m][0] * acc[ai][1][m][0], acc[ai][0][m][1] * acc[ai][1][m][1]); } }
            return; }
        float rsv[2][4]; if (u.pm < 64) rs_rows8(rsv, ssq, row0, fq); else rs_rows8_s(rsv, ssq64, row0 - MPR, fq);
        f32x4 w0[2], w1[2], w2[2], bb[2];
#pragma unroll
        for (int n = 0; n < 2; ++n) { w0[n] = *(const f32x4*)(cw + ch0 + 4 * n); w1[n] = *(const f32x4*)(cw + DFF + ch0 + 4 * n); w2[n] = *(const f32x4*)(cw + 2 * DFF + ch0 + 4 * n); bb[n] = *(const f32x4*)(cbias + ch0 + 4 * n); }
        if (u.pm < 64) {
#pragma unroll
            for (int ai = 0; ai < 2; ++ai) { f32x4 pr1[2], pr2[2];
#pragma unroll
                for (int n = 0; n < 2; ++n) { pr1[n] = (f32x4){0.f, 0.f, 0.f, 0.f}; pr2[n] = pr1[n]; }
#pragma unroll
                for (int m = 0; m < 4; ++m) { const int row = row0 + ai * 128 + m * 16; const float rs = rsv[ai][m]; const int t = row & 2047, t6 = row & 63;
                    f32x4 a[2];
#pragma unroll
                    for (int n = 0; n < 2; ++n) { const f32x4 g = acc[ai][0][m][n] * rs, up = acc[ai][1][m][n] * rs; const f32x4 r1 = dpp4<0x121>(g), r2 = dpp4<0x122>(g);
                        const f32x4 p1 = fr >= 1 ? r1 : pr1[n], p2 = fr >= 2 ? r2 : pr2[n]; pr1[n] = r1; pr2[n] = r2;
                        a[n] = gelu4(bb[n] + w0[n] * p2 + w1[n] * p1 + w2[n] * g) * up;
                        if (t >= 2046) *(f32x4*)(scp + (size_t)((row >> 11) * 2 + (t - 2046)) * DFF + ch0 + 4 * n) = g;
                        if (t6 < 2) { *(f32x4*)(GX + ((size_t)(row >> 6) * 4 + t6) * DFF + ch0 + 4 * n) = g; *(f32x4*)(UX + ((size_t)(row >> 6) * 2 + t6) * DFF + ch0 + 4 * n) = up; }
                        if (t6 >= 62) *(f32x4*)(GX + ((size_t)(row >> 6) * 4 + (t6 - 60)) * DFF + ch0 + 4 * n) = g; }
                    *(u32x4v*)(U + (size_t)row * DFF + ch0) = pack8(a[0], a[1]); } }
        } else {
            const int tt = fr & 3;
#pragma unroll
            EPI_LOOP_ROWS { const int row = row0 + ai * 128 + m * 16, r2i = row - MPR, bq = r2i >> 2; const float rs = rsv[ai][m];
                f32x4 a[2];
#pragma unroll
                for (int n = 0; n < 2; ++n) { const f32x4 g = acc[ai][0][m][n] * rs, up = acc[ai][1][m][n] * rs; const f32x4 r1 = dpp4<0x121>(g), r2 = dpp4<0x122>(g);
                    f32x4 p1 = r1, p2 = r2;
                    if (tt < 2) { const f32x4 s1 = *(const f32x4*)(sconv + (size_t)(bq * 2 + 1) * DFF + ch0 + 4 * n); if (tt == 0) { p1 = s1; p2 = *(const f32x4*)(sconv + (size_t)(bq * 2) * DFF + ch0 + 4 * n); } else p2 = s1; }
                    a[n] = gelu4(bb[n] + w0[n] * p2 + w1[n] * p1 + w2[n] * g) * up;
                    if (tt >= 2) *(f32x4*)(scs + (size_t)(bq * 2 + (tt - 2)) * DFF + ch0 + 4 * n) = g; }
                *(u32x4v*)(U + (size_t)row * DFF + ch0) = pack8(a[0], a[1]); }
        }
    }
};
__device__ __forceinline__ void act_fixup(const Params& p, int pm) {
    const float* GX = (const float*)(p.ws + WS_GX); const float* UX = (const float*)(p.ws + WS_UX); bf16_t* U = (bf16_t*)(p.ws + WS_U); const float* cw = p.in[25]; const float* cbias = p.in[26];
    for (int i0 = threadIdx.x; i0 < 4 * 704; i0 += 1024) {
        f32x4 w0[2], w1[2], w2[2], bb[2], g0[2], g1[2], u0[2], u1[2], gm2[2], gm1[2]; int t0v[2], chv[2]; bool ok[2];
#pragma unroll
        for (int k = 0; k < 2; ++k) { const int i = i0 + 512 * k; ok[k] = i < 4 * 704; const int ii = ok[k] ? i : i0; const int q = ii / 704, ch = (ii % 704) * 4, blk = pm * 4 + q, t0 = blk * 64; t0v[k] = t0; chv[k] = ch;
            w0[k] = *(const f32x4*)(cw + ch); w1[k] = *(const f32x4*)(cw + DFF + ch); w2[k] = *(const f32x4*)(cw + 2 * DFF + ch); bb[k] = *(const f32x4*)(cbias + ch);
            g0[k] = *(const f32x4*)(GX + ((size_t)blk * 4 + 0) * DFF + ch); g1[k] = *(const f32x4*)(GX + ((size_t)blk * 4 + 1) * DFF + ch);
            u0[k] = *(const f32x4*)(UX + ((size_t)blk * 2 + 0) * DFF + ch); u1[k] = *(const f32x4*)(UX + ((size_t)blk * 2 + 1) * DFF + ch);
            gm2[k] = (f32x4){0.f, 0.f, 0.f, 0.f}; gm1[k] = gm2[k];
            if ((t0 & 2047) != 0) { gm2[k] = *(const f32x4*)(GX + ((size_t)(blk - 1) * 4 + 2) * DFF + ch); gm1[k] = *(const f32x4*)(GX + ((size_t)(blk - 1) * 4 + 3) * DFF + ch); } }
#pragma unroll
        for (int k = 0; k < 2; ++k) if (ok[k]) {
            const f32x4 a0 = gelu4(bb[k] + w0[k] * gm2[k] + w1[k] * gm1[k] + w2[k] * g0[k]) * u0[k], a1 = gelu4(bb[k] + w0[k] * gm1[k] + w1[k] * g0[k] + w2[k] * g1[k]) * u1[k];
            u32x2 o0, o1; o0.x = pk2(a0[0], a0[1]); o0.y = pk2(a0[2], a0[3]); o1.x = pk2(a1[0], a1[1]); o1.y = pk2(a1[2], a1[3]);
            *(u32x2*)(U + (size_t)t0v[k] * DFF + chv[k]) = o0; *(u32x2*)(U + (size_t)(t0v[k] + 1) * DFF + chv[k]) = o1; }
    }
}

__device__ __forceinline__ int win_src_col(int n) { return n < 1536 ? n : (n < 2560 ? n + 16 : (n < 2576 ? n - 1024 : -1)); }
__device__ __forceinline__ void tr_strip(LAS float* T, const float* src, int ldn, bf16_t* dst, int K, int k0, int n0, const float* ksc, bool cmap, int rmode) {
    const int tid = threadIdx.x;
    f32x4 v[8];
    { const int n4 = (tid & 63) * 4; int sc = n0 + n4; if (cmap) sc = win_src_col(sc);
#pragma unroll
      for (int i = 0; i < 8; ++i) { const int kk = (tid >> 6) + 8 * i; v[i] = (f32x4){0.f, 0.f, 0.f, 0.f}; if (sc >= 0) v[i] = *(const f32x4*)(src + (size_t)(k0 + kk) * ldn + sc); }
#pragma unroll
      for (int i = 0; i < 8; ++i) { const int kk = (tid >> 6) + 8 * i; f32x4 w = v[i]; if (ksc) w = w * ksc[k0 + kk];
          T[kk * 257 + n4] = w[0]; T[kk * 257 + n4 + 1] = w[1]; T[kk * 257 + n4 + 2] = w[2]; T[kk * 257 + n4 + 3] = w[3]; } }
    __syncthreads();
    { const int n = tid >> 1, kh = (tid & 1) * 32;
#pragma unroll
      for (int q = 0; q < 4; ++q) { const int kb = kh + q * 8; u32x4v w;
          w.x = pk2(T[(kb + 0) * 257 + n], T[(kb + 1) * 257 + n]); w.y = pk2(T[(kb + 2) * 257 + n], T[(kb + 3) * 257 + n]);
          w.z = pk2(T[(kb + 4) * 257 + n], T[(kb + 5) * 257 + n]); w.w = pk2(T[(kb + 6) * 257 + n], T[(kb + 7) * 257 + n]);
          const int nn = n0 + n, drow = rmode ? ((nn >> 7) * 256 + (rmode == 2 ? 128 : 0) + (nn & 127)) : nn;
          *(u32x4v*)(dst + (size_t)drow * K + k0 + kb) = w; } }
    __syncthreads();
}
struct NormRow { f32x4 v[4]; };
__device__ __forceinline__ void norm_load(NormRow& R, const float* x, int lane) {
#pragma unroll
    for (int i = 0; i < 4; ++i) R.v[i] = __builtin_nontemporal_load((const f32x4*)(x + i * 256 + lane * 4));
}
constexpr int PREP_TA = 66048;
__device__ __forceinline__ void norm_a(const NormRow& R, float rs, const LAS float* Ta, float* af_row, int lane) {
    float acc[16];
#pragma unroll
    for (int c = 0; c < 16; ++c) { float s = 0.f;
#pragma unroll
        for (int i = 0; i < 4; ++i) { const f32x4 w = *(const LAS f32x4*)(Ta + c * 1024 + i * 256 + lane * 4); s += (R.v[i][0] * w[0] + R.v[i][1] * w[1]) + (R.v[i][2] * w[2] + R.v[i][3] * w[3]); }
        acc[c] = s; }
    const bool b5 = lane & 32, b4 = lane & 16, b3 = lane & 8, b2 = lane & 4;
    float a8[8], a4[4], a2[2], a1;
#pragma unroll
    for (int j = 0; j < 8; ++j) { const float send = b5 ? acc[j] : acc[j + 8]; const float keep = b5 ? acc[j + 8] : acc[j]; a8[j] = keep + __shfl_xor(send, 32); }
#pragma unroll
    for (int j = 0; j < 4; ++j) { const float send = b4 ? a8[j] : a8[j + 4]; const float keep = b4 ? a8[j + 4] : a8[j]; a4[j] = keep + __shfl_xor(send, 16); }
#pragma unroll
    for (int j = 0; j < 2; ++j) { const float send = b3 ? a4[j] : a4[j + 2]; const float keep = b3 ? a4[j + 2] : a4[j]; a2[j] = keep + __shfl_xor(send, 8); }
    { const float send = b2 ? a2[0] : a2[1]; const float keep = b2 ? a2[1] : a2[0]; a1 = keep + __shfl_xor(send, 4); }
    a1 += __shfl_xor(a1, 2); a1 += __shfl_xor(a1, 1);
    if ((lane & 3) == 0) af_row[(lane >> 2) & 15] = a1 * rs;
}
__device__ __forceinline__ void norm_fin(const NormRow& R, const float* g, bf16_t* o, int lane, const LAS float* Ta = nullptr, float* af_row = nullptr) {
    float s = 0.f;
#pragma unroll
    for (int i = 0; i < 4; ++i) s += (R.v[i][0] * R.v[i][0] + R.v[i][1] * R.v[i][1]) + (R.v[i][2] * R.v[i][2] + R.v[i][3] * R.v[i][3]);
    s = wave_sum(s); const float rs = rsqrtf(s * (1.0f / 1024.0f) + EPS);
#pragma unroll
    for (int i = 0; i < 4; ++i) { const f32x4 gg = *(const f32x4*)(g + i * 256 + lane * 4); const f32x4 y = R.v[i] * rs * gg; u32x2 w; w.x = pk2(y[0], y[1]); w.y = pk2(y[2], y[3]);
        *(u32x2*)(o + i * 256 + lane * 4) = w; }
    if (af_row) norm_a(R, rs, Ta, af_row, lane);
}
__device__ __forceinline__ void norm_addr(const Params& p, int r, const float*& x, const float*& g, bf16_t*& o) {
    if (r < MPR) { x = p.in[0] + (size_t)r * 1024; g = p.in[7]; o = (bf16_t*)(p.ws + WS_A) + (size_t)r * 1024; }
    else if (r < MT) { x = p.in[1] + (size_t)(r - MPR) * 1024; g = p.in[7]; o = (bf16_t*)(p.ws + WS_A) + (size_t)r * 1024; }
    else { x = p.in[2] + (size_t)(r - MT) * 1024; g = p.in[17]; o = (bf16_t*)(p.ws + WS_MN) + (size_t)(r - MT) * 1024; }
}
__device__ __forceinline__ void phase_prep(const Params& p, LAS unsigned char* lds) {
    unsigned char* ws = p.ws; LAS float* T = (LAS float*)lds;
    const int tid = threadIdx.x, lane = tid & 63, wave = tid >> 6;
    LAS float* Ta = (LAS float*)(lds + PREP_TA);
#pragma unroll
    for (int i = 0; i < 8; ++i) { const int idx = tid + 512 * i, k = idx >> 2, c4 = (idx & 3) * 4; const f32x4 w = *(const f32x4*)(p.in[8] + (size_t)k * 2576 + 1536 + c4) * p.in[7][k];
        Ta[(c4 + 0) * 1024 + k] = w[0]; Ta[(c4 + 1) * 1024 + k] = w[1]; Ta[(c4 + 2) * 1024 + k] = w[2]; Ta[(c4 + 3) * 1024 + k] = w[3]; }
    __syncthreads();
    for (int j = blockIdx.x; j < 1008; j += gridDim.x) {
        const float* src; int ldn, K, nt; bf16_t* dst; const float* ksc = nullptr; bool cmap = false; int jj = j, rmode = 0;
        if (jj < 160) { src = p.in[8]; ldn = 2576; K = 1024; nt = 10; dst = (bf16_t*)(ws + WS_WIN); cmap = true; }
        else if ((jj -= 160) < 64) { src = p.in[15]; ldn = 1024; K = 1024; nt = 4; dst = (bf16_t*)(ws + WS_WOUT); }
        else if ((jj -= 64) < 64) { src = p.in[18]; ldn = 1024; K = 1024; nt = 4; dst = (bf16_t*)(ws + WS_WQ); ksc = p.in[16]; }
        else if ((jj -= 64) < 64) { src = p.in[19]; ldn = 1024; K = 1024; nt = 4; dst = (bf16_t*)(ws + WS_WKV); }
        else if ((jj -= 64) < 64) { src = p.in[20]; ldn = 1024; K = 1024; nt = 4; dst = (bf16_t*)(ws + WS_WKV) + (size_t)1024 * 1024; }
        else if ((jj -= 64) < 64) { src = p.in[21]; ldn = 1024; K = 1024; nt = 4; dst = (bf16_t*)(ws + WS_WO); }
        else if ((jj -= 64) < 176) { src = p.in[23]; ldn = 2816; K = 1024; nt = 11; dst = (bf16_t*)(ws + WS_WGU); ksc = p.in[22]; rmode = 1; }
        else if ((jj -= 176) < 176) { src = p.in[24]; ldn = 2816; K = 1024; nt = 11; dst = (bf16_t*)(ws + WS_WGU); ksc = p.in[22]; rmode = 2; }
        else { jj -= 176; src = p.in[27]; ldn = 1024; K = 2816; nt = 4; dst = (bf16_t*)(ws + WS_WD); }
        const int kt = jj / nt, ntile = jj % nt;
        tr_strip(T, src, ldn, dst, K, kt * 64, ntile * 256, ksc, cmap, rmode);
    }
    const int stride = gridDim.x * 8;
    for (int r = blockIdx.x * 8 + wave; r < MT + 2048; r += 2 * stride) {
        const int r2 = r + stride; const bool has2 = r2 < MT + 2048;
        const float *x1, *g1, *x2 = nullptr, *g2 = nullptr; bf16_t *o1, *o2 = nullptr; NormRow A, B;
        norm_addr(p, r, x1, g1, o1); norm_load(A, x1, lane);
        if (has2) { norm_addr(p, r2, x2, g2, o2); norm_load(B, x2, lane); }
        float* af = (float*)(ws + WS_AF);
        norm_fin(A, g1, o1, lane, Ta, r < MT ? af + (size_t)r * 16 : nullptr);
        if (has2) norm_fin(B, g2, o2, lane, Ta, r2 < MT ? af + (size_t)r2 * 16 : nullptr);
    }
}

constexpr int G_Q = 0, G_K = 9216, G_B = 18432, G_A = 35072, G_WA = 39168, G_BA = 43264, G_VT = 43520, G_X = 61952  , G_ST = 71168, G_RED = 89600, G_SEG = 90624, G_R = 92672, G_END = 110080;
struct GlaPre { u32x4v q, k, v0, v1, s0, s1, r0, r1; f32x4 aw; float ba; };
template <bool OUT>
__device__ __forceinline__ void gla_issue(GlaPre& R, const Params& p, int item) {
    const int b = item >> 7, h = (item >> 5) & 3, c = item & 31; const int tid = threadIdx.x; const int row0 = b * 2048 + c * 64;
    const bf16_t* P = (const bf16_t*)(p.ws + WS_P); const float* af = (const float*)(p.ws + WS_AF);
    { const int i = tid >> 3, d8 = (tid & 7) * 8; const bf16_t* src = P + (size_t)(row0 + i) * NIN + h * 64 + d8; R.q = *(const u32x4v*)src; R.k = *(const u32x4v*)(src + 256); }
    if (tid < 256) { const int i = tid >> 2, r4 = (tid & 3) * 4; R.aw = *(const f32x4*)(af + (size_t)(row0 + i) * 16 + r4); }
    else { const int t2 = tid - 256, r = t2 >> 4, d4 = (t2 & 15) * 4; R.aw = *(const f32x4*)(p.in[9] + r * 256 + h * 64 + d4); }
    R.ba = p.in[10][h * 64 + (tid & 63)];
    { const int j = tid >> 4, v8 = (tid & 15) * 8; R.v0 = *(const u32x4v*)(P + (size_t)(row0 + j) * NIN + 512 + h * 128 + v8); R.v1 = *(const u32x4v*)(P + (size_t)(row0 + j + 32) * NIN + 512 + h * 128 + v8); }
    if (OUT) { const bf16_t* St = (const bf16_t*)(p.ws + WS_ST) + (size_t)item * 8192; const int v = tid >> 3, d8 = (tid & 7) * 8;
        R.s0 = *(const u32x4v*)(St + v * 64 + d8); R.s1 = *(const u32x4v*)(St + (v + 64) * 64 + d8);
        const int j = tid >> 4, v8 = (tid & 15) * 8; R.r0 = *(const u32x4v*)(P + (size_t)(row0 + j) * NIN + 1024 + h * 128 + v8); R.r1 = *(const u32x4v*)(P + (size_t)(row0 + j + 32) * NIN + 1024 + h * 128 + v8); }
}
__device__ __forceinline__ void vt_scatter(LAS bf16_t* LVt, const u32x4v w, int v8, int j) {
    LVt[(v8 + 0) * 72 + j] = (bf16_t)(w.x & 0xffff); LVt[(v8 + 1) * 72 + j] = (bf16_t)(w.x >> 16); LVt[(v8 + 2) * 72 + j] = (bf16_t)(w.y & 0xffff); LVt[(v8 + 3) * 72 + j] = (bf16_t)(w.y >> 16);
    LVt[(v8 + 4) * 72 + j] = (bf16_t)(w.z & 0xffff); LVt[(v8 + 5) * 72 + j] = (bf16_t)(w.z >> 16); LVt[(v8 + 6) * 72 + j] = (bf16_t)(w.w & 0xffff); LVt[(v8 + 7) * 72 + j] = (bf16_t)(w.w >> 16);
}
template <bool OUT>
__device__ __forceinline__ void gla_fill(const GlaPre& R, LAS unsigned char* lds) {
    const int tid = threadIdx.x;
    LAS bf16_t* Lq = (LAS bf16_t*)(lds + G_Q); LAS bf16_t* Lk = (LAS bf16_t*)(lds + G_K); LAS float* Lb = (LAS float*)(lds + G_B);
    LAS float* La = (LAS float*)(lds + G_A); LAS float* Lwa = (LAS float*)(lds + G_WA); LAS float* Lba = (LAS float*)(lds + G_BA);
    LAS bf16_t* LVt = (LAS bf16_t*)(lds + G_VT); LAS float* Lseg = (LAS float*)(lds + G_SEG);
    { const int i = tid >> 3, d8 = (tid & 7) * 8; *(LAS u32x4v*)(Lq + i * 72 + d8) = R.q; *(LAS u32x4v*)(Lk + i * 72 + d8) = R.k; }
    if (tid < 256) { const int i = tid >> 2, r4 = (tid & 3) * 4; *(LAS f32x4*)(La + i * 16 + r4) = R.aw; }
    else { const int t2 = tid - 256, r = t2 >> 4, d4 = (t2 & 15) * 4; *(LAS f32x4*)(Lwa + r * 64 + d4) = R.aw; }
    if (tid < 64) Lba[tid] = R.ba;
    { const int j = tid >> 4, v8 = (tid & 15) * 8; vt_scatter(LVt, R.v0, v8, j); vt_scatter(LVt, R.v1, v8, j + 32); }
    if (OUT) { LAS bf16_t* LSt = (LAS bf16_t*)(lds + G_ST); LAS bf16_t* Lr = (LAS bf16_t*)(lds + G_R); const int v = tid >> 3, d8 = (tid & 7) * 8;
        *(LAS u32x4v*)(LSt + v * 72 + d8) = R.s0; *(LAS u32x4v*)(LSt + (v + 64) * 72 + d8) = R.s1;
        const int j = tid >> 4, v8 = (tid & 15) * 8; *(LAS u32x4v*)(Lr + j * 136 + v8) = R.r0; *(LAS u32x4v*)(Lr + (j + 32) * 136 + v8) = R.r1; }
    __syncthreads();
}
__device__ __forceinline__ void gla_gates(LAS unsigned char* lds) {
    const int tid = threadIdx.x;
    LAS float* Lb = (LAS float*)(lds + G_B); LAS float* La = (LAS float*)(lds + G_A); LAS float* Lwa = (LAS float*)(lds + G_WA); LAS float* Lba = (LAS float*)(lds + G_BA); LAS float* Lseg = (LAS float*)(lds + G_SEG);
    const int d = tid & 63, seg = tid >> 6; float acc = 0.f; float pre[8];
#pragma unroll
    for (int ii = 0; ii < 8; ++ii) { const int i = seg * 8 + ii; float z = Lba[d];
#pragma unroll
        for (int r = 0; r < 16; ++r) z += La[i * 16 + r] * Lwa[r * 64 + d];
        acc += logsig(z) * (1.0f / 16.0f); pre[ii] = acc; }
    Lseg[seg * 64 + d] = acc;
    __syncthreads();
    float off = 0.f;
#pragma unroll
    for (int s = 0; s < 8; ++s) if (s < seg) off += Lseg[s * 64 + d];
#pragma unroll
    for (int ii = 0; ii < 8; ++ii) Lb[(seg * 8 + ii) * 65 + d] = pre[ii] + off;
    __syncthreads();
}
__device__ __forceinline__ void gla_local_loop(const Params& p, LAS unsigned char* lds, int first, int stride, int nitems) {
    const int tid = threadIdx.x, lane = tid & 63, wave = tid >> 6;
    GlaPre R; if (first < nitems) gla_issue<false>(R, p, first);
    for (int item = first; item < nitems; item += stride) {
        gla_fill<false>(R, lds);
        if (item + stride < nitems) gla_issue<false>(R, p, item + stride);
        gla_gates(lds);
        LAS bf16_t* Lk = (LAS bf16_t*)(lds + G_K); LAS float* Lb = (LAS float*)(lds + G_B); LAS bf16_t* LVt = (LAS bf16_t*)(lds + G_VT); LAS bf16_t* LKt = (LAS bf16_t*)(lds + G_X);
        float* dS = (float*)(p.ws + WS_DS) + (size_t)item * 8192; float* dec = (float*)(p.ws + WS_DEC) + (size_t)item * 64;
        { const int j = tid >> 3, d8 = (tid & 7) * 8;
#pragma unroll
          for (int e = 0; e < 8; ++e) { const float kv = bf2f(Lk[j * 72 + d8 + e]); LKt[(d8 + e) * 72 + j] = f2bf(kv * __expf(Lb[63 * 65 + d8 + e] - Lb[j * 65 + d8 + e])); } }
        if (tid < 64) dec[tid] = __expf(Lb[63 * 65 + tid]);
        __syncthreads();
        const int db = wave & 1, vb = wave >> 1, r = lane & 31, hh = lane >> 5;
        f32x16 acc = zero16();
#pragma unroll
        for (int ks = 0; ks < 4; ++ks) { const bf16x8 a = *(const LAS bf16x8*)(LKt + (db * 32 + r) * 72 + ks * 16 + 8 * hh); const bf16x8 bb = *(const LAS bf16x8*)(LVt + (vb * 32 + r) * 72 + ks * 16 + 8 * hh); acc = mma32(a, bb, acc); }
#pragma unroll
        for (int i = 0; i < 16; ++i) { const int d = db * 32 + (i & 3) + 8 * (i >> 2) + 4 * hh; dS[d * 128 + vb * 32 + r] = acc[i]; }
        __syncthreads();
    }
}
__device__ __forceinline__ void gla_out_loop(const Params& p, LAS unsigned char* lds, int first, int stride, int nitems) {
    const int tid = threadIdx.x, lane = tid & 63, wave = tid >> 6;
    GlaPre R; if (first < nitems) gla_issue<true>(R, p, first);
    for (int item = first; item < nitems; item += stride) {
        const int b = item >> 7, h = (item >> 5) & 3, c = item & 31; const int row0 = b * 2048 + c * 64;
        gla_fill<true>(R, lds);
        if (item + stride < nitems) gla_issue<true>(R, p, item + stride);
        gla_gates(lds);
        LAS bf16_t* Lq = (LAS bf16_t*)(lds + G_Q); LAS bf16_t* Lk = (LAS bf16_t*)(lds + G_K); LAS float* Lb = (LAS float*)(lds + G_B); LAS bf16_t* LVt = (LAS bf16_t*)(lds + G_VT);
        LAS bf16_t* Lsc = (LAS bf16_t*)(lds + G_X); LAS bf16_t* LSt = (LAS bf16_t*)(lds + G_ST); LAS float* Lred = (LAS float*)(lds + G_RED); LAS bf16_t* Lr = (LAS bf16_t*)(lds + G_R);
        bf16_t* mix = (bf16_t*)(p.ws + WS_A);
        { const int i = tid >> 3, d8 = (tid & 7) * 8;
#pragma unroll
          for (int e = 0; e < 8; e += 2) { const float b0 = Lb[i * 65 + d8 + e], b1 = Lb[i * 65 + d8 + e + 1];
              const float q0 = bf2f(Lq[i * 72 + d8 + e]) * __expf(b0) * 0.125f, q1 = bf2f(Lq[i * 72 + d8 + e + 1]) * __expf(b1) * 0.125f;
              const float k0 = bf2f(Lk[i * 72 + d8 + e]) * __expf(-b0), k1 = bf2f(Lk[i * 72 + d8 + e + 1]) * __expf(-b1);
              *(LAS unsigned*)(Lq + i * 72 + d8 + e) = pk2(q0, q1); *(LAS unsigned*)(Lk + i * 72 + d8 + e) = pk2(k0, k1); } }
        __syncthreads();
        const int r = lane & 31, hh = lane >> 5;
        if (wave < 4) { const int ib = wave & 1, jb = wave >> 1;
            f32x16 acc = zero16();
            if (jb <= ib) {
#pragma unroll
                for (int ks = 0; ks < 4; ++ks) { const bf16x8 a = *(const LAS bf16x8*)(Lq + (ib * 32 + r) * 72 + ks * 16 + 8 * hh); const bf16x8 bb = *(const LAS bf16x8*)(Lk + (jb * 32 + r) * 72 + ks * 16 + 8 * hh); acc = mma32(a, bb, acc); } }
#pragma unroll
            for (int i = 0; i < 16; ++i) { const int ii = ib * 32 + (i & 3) + 8 * (i >> 2) + 4 * hh, jj = jb * 32 + r; Lsc[ii * 72 + jj] = f2bf(jj <= ii ? acc[i] : 0.f); } }
        __syncthreads();
        const int ib = wave & 1, vb = wave >> 1;
        f32x16 acc = zero16();
#pragma unroll
        for (int ks = 0; ks < 4; ++ks) { const bf16x8 a = *(const LAS bf16x8*)(Lsc + (ib * 32 + r) * 72 + ks * 16 + 8 * hh); const bf16x8 bb = *(const LAS bf16x8*)(LVt + (vb * 32 + r) * 72 + ks * 16 + 8 * hh); acc = mma32(a, bb, acc); }
#pragma unroll
        for (int ks = 0; ks < 4; ++ks) { const bf16x8 a = *(const LAS bf16x8*)(Lq + (ib * 32 + r) * 72 + ks * 16 + 8 * hh); const bf16x8 bb = *(const LAS bf16x8*)(LSt + (vb * 32 + r) * 72 + ks * 16 + 8 * hh); acc = mma32(a, bb, acc); }
#pragma unroll
        for (int i = 0; i < 16; ++i) { float s = row_sum16(acc[i] * acc[i]); s += __shfl_xor(s, 16);
            if (r == 0) Lred[(ib * 32 + (i & 3) + 8 * (i >> 2) + 4 * hh) * 4 + vb] = s; }
        __syncthreads();
        const float gg = p.in[11][h * 128 + vb * 32 + r];
#pragma unroll
        for (int i = 0; i < 16; ++i) { const int ii = ib * 32 + (i & 3) + 8 * (i >> 2) + 4 * hh; const f32x4 q = *(const LAS f32x4*)(Lred + ii * 4);
            const float rs = rsqrtf(((q[0] + q[1]) + (q[2] + q[3])) * (1.0f / 128.0f) + EPS);
            const float rg = bf2f(Lr[ii * 136 + vb * 32 + r]);
            mix[(size_t)(row0 + ii) * 1024 + h * 128 + vb * 32 + r] = f2bf(acc[i] * rs * gg * silu_f(rg)); }
        __syncthreads();
    }
}
__device__ __forceinline__ void gla_scan(const Params& p) {
    for (int gt = blockIdx.x * 512 + threadIdx.x; gt < 131072; gt += gridDim.x * 512) {
    const int bh = gt >> 12, rem = gt & 4095, v = rem & 127, d = (rem >> 7) * 2;
    const float* dS = (const float*)(p.ws + WS_DS); const float* dec = (const float*)(p.ws + WS_DEC); bf16_t* St = (bf16_t*)(p.ws + WS_ST);
    float s0 = 0.f, s1 = 0.f;
#pragma unroll 8
    for (int c = 0; c < 32; ++c) { const size_t item = (size_t)bh * 32 + c;
        *(unsigned*)(St + item * 8192 + v * 64 + d) = pk2(s0, s1);
        const float a0 = dec[item * 64 + d], a1 = dec[item * 64 + d + 1];
        s0 = a0 * s0 + dS[item * 8192 + d * 128 + v]; s1 = a1 * s1 + dS[item * 8192 + (d + 1) * 128 + v]; }
    float* o = p.out + O_SGP + (size_t)bh * 8192; o[d * 128 + v] = s0; o[(d + 1) * 128 + v] = s1; }
}

__device__ __forceinline__ void sgu_item(const Params& p, LAS unsigned char* lds, int item) {
    const int b = item >> 6, nck = (item >> 2) & 15, h = item & 3; const int tid = threadIdx.x, lane = tid & 63, wave = tid >> 6;
    LAS bf16_t* LW = (LAS bf16_t*)lds; LAS bf16_t* LsvT = (LAS bf16_t*)(lds + 34816);
    const bf16_t* P = (const bf16_t*)(p.ws + WS_P); bf16_t* mix = (bf16_t*)(p.ws + WS_A); const int row0 = b * 2048 + nck * 128;
    const float* Wsrc = p.in[13] + (size_t)h * 16384;
#pragma unroll
    for (int k = 0; k < 8; ++k) { const int idx = tid + 512 * k, i = idx >> 5, j4 = (idx & 31) * 4; const f32x4 w = *(const f32x4*)(Wsrc + i * 128 + j4);
        u32x2 o; o.x = pk2(j4 <= i ? w[0] : 0.f, j4 + 1 <= i ? w[1] : 0.f); o.y = pk2(j4 + 2 <= i ? w[2] : 0.f, j4 + 3 <= i ? w[3] : 0.f); *(LAS u32x2*)(LW + i * 136 + j4) = o; }
    { const int j = tid >> 2, q4 = tid & 3; const bf16_t* src = P + (size_t)(row0 + j) * NIN + 2048 + h * 128 + q4 * 32; float g[32]; float ss = 0.f;
#pragma unroll
      for (int k = 0; k < 4; ++k) { const u32x4v w = *(const u32x4v*)(src + k * 8); const unsigned ww[4] = {w.x, w.y, w.z, w.w};
#pragma unroll
          for (int e = 0; e < 4; ++e) { const float a = gelu_t(bflo(ww[e])), c = gelu_t(bfhi(ww[e])); g[k * 8 + e * 2] = a; g[k * 8 + e * 2 + 1] = c; ss += a * a + c * c; } }
      ss += __shfl_xor(ss, 1); ss += __shfl_xor(ss, 2); const float rs = rsqrtf(ss * (1.0f / 128.0f) + EPS);
#pragma unroll
      for (int e = 0; e < 32; ++e) { const int d = q4 * 32 + e; LsvT[d * 136 + j] = f2bf(g[e] * rs * p.in[12][h * 128 + d]); } }
    __syncthreads();
    const int r = lane & 31, hh = lane >> 5, ib = wave & 3;
#pragma unroll
    for (int t = 0; t < 2; ++t) { const int db = (wave >> 2) * 2 + t; f32x16 acc = zero16();
        for (int ks = 0; ks <= ib * 2 + 1; ++ks) { const bf16x8 a = *(const LAS bf16x8*)(LW + (ib * 32 + r) * 136 + ks * 16 + 8 * hh); const bf16x8 bb = *(const LAS bf16x8*)(LsvT + (db * 32 + r) * 136 + ks * 16 + 8 * hh); acc = mma32(a, bb, acc); }
        bf16_t uraw[16]; float bsv[16];
#pragma unroll
        for (int i = 0; i < 16; ++i) { const int ii = ib * 32 + (i & 3) + 8 * (i >> 2) + 4 * hh, d = db * 32 + r; uraw[i] = P[(size_t)(row0 + ii) * NIN + 1536 + h * 128 + d]; bsv[i] = p.in[14][h * 128 + ii]; }
#pragma unroll
        for (int i = 0; i < 16; ++i) { const int ii = ib * 32 + (i & 3) + 8 * (i >> 2) + 4 * hh, d = db * 32 + r; const float z = acc[i] + bsv[i];
            const float u = gelu_t(bf2f(uraw[i])); mix[(size_t)(row0 + ii) * 1024 + 512 + h * 128 + d] = f2bf(u * z); } }
    __syncthreads();
}

constexpr int SM_Q = 0, SM_K = 4096, SM_B = 8192, SM_V = 12288, SM_A = 20480, SM_RED = 21504, SM_O = 22016, SM_END = 30208;
__device__ __forceinline__ void sample_mixer(const Params& p, LAS unsigned char* lds, int b, int hp) {
    const int tid = threadIdx.x, lane = tid & 63, wave = tid >> 6; const int rowb = MPR + b * 4;
    const bf16_t* P = (const bf16_t*)(p.ws + WS_P); const float* af = (const float*)(p.ws + WS_AF); bf16_t* mix = (bf16_t*)(p.ws + WS_A);
    LAS float* Lq = (LAS float*)(lds + SM_Q); LAS float* Lk = (LAS float*)(lds + SM_K); LAS float* Lb = (LAS float*)(lds + SM_B); LAS float* Lv = (LAS float*)(lds + SM_V);
    LAS float* LA = (LAS float*)(lds + SM_A); LAS float* Lred = (LAS float*)(lds + SM_RED); LAS float* Lo = (LAS float*)(lds + SM_O);
    if (hp == 0) { const int ch = tid, h = tid >> 7; float g[4], u[4];
#pragma unroll
      for (int t = 0; t < 4; ++t) { g[t] = gelu_t(bf2f(P[(size_t)(rowb + t) * NIN + 2048 + ch])); u[t] = gelu_t(bf2f(P[(size_t)(rowb + t) * NIN + 1536 + ch])); const float s = wave_sum(g[t] * g[t]); if (lane == 0) Lred[wave * 4 + t] = s; }
      __syncthreads();
      const float gs = p.in[12][ch]; float sv[4];
#pragma unroll
      for (int t = 0; t < 4; ++t) { const float tot = Lred[(2 * h) * 4 + t] + Lred[(2 * h + 1) * 4 + t]; sv[t] = g[t] * rsqrtf(tot * (1.0f / 128.0f) + EPS) * gs; p.out[O_SV + (size_t)(b * 4 + t) * 512 + ch] = sv[t]; }
#pragma unroll
      for (int i = 0; i < 4; ++i) { float z = p.in[14][h * 128 + i];
#pragma unroll
          for (int j = 0; j < 4; ++j) if (j <= i) z += p.in[13][(size_t)h * 16384 + i * 128 + j] * sv[j];
          mix[(size_t)(rowb + i) * 1024 + 512 + ch] = f2bf(u[i] * z); }
      __syncthreads();
    }
#pragma unroll
    for (int k = 0; k < 2; ++k) { const int idx = tid + 512 * k, t = idx >> 8, c = idx & 255;
        Lq[t * 256 + c] = bf2f(P[(size_t)(rowb + t) * NIN + c]); Lk[t * 256 + c] = bf2f(P[(size_t)(rowb + t) * NIN + 256 + c]);
        float z = p.in[10][c];
#pragma unroll
        for (int r = 0; r < 16; ++r) z += af[(size_t)(rowb + t) * 16 + r] * p.in[9][r * 256 + c];
        Lb[t * 256 + c] = logsig(z) * (1.0f / 16.0f); }
#pragma unroll
    for (int t = 0; t < 4; ++t) Lv[t * 512 + tid] = bf2f(P[(size_t)(rowb + t) * NIN + 512 + tid]);
    __syncthreads();
    if (tid < 256) { float a = 0.f;
#pragma unroll
        for (int t = 0; t < 4; ++t) { a += Lb[t * 256 + tid]; Lb[t * 256 + tid] = a; } }
    __syncthreads();
    { const int h = tid >> 7, pr = (tid >> 3) & 15, i = pr >> 2, j = pr & 3, part = tid & 7; float s = 0.f;
      if (j <= i) {
#pragma unroll
          for (int e = 0; e < 8; ++e) { const int c = h * 64 + part * 8 + e; s += Lq[i * 256 + c] * Lk[j * 256 + c] * __expf(Lb[i * 256 + c] - Lb[j * 256 + c]); } }
      s += __shfl_xor(s, 1); s += __shfl_xor(s, 2); s += __shfl_xor(s, 4);
      if (part == 0) LA[h * 16 + pr] = s * 0.125f; }
    __syncthreads();
    LAS float* Le3 = (LAS float*)(lds + SM_END);
    { float qn[2], kn[2];
#pragma unroll
      for (int k = 0; k < 2; ++k) { const int idx = tid + 512 * k, t = idx >> 8, c = idx & 255; const float bt = Lb[t * 256 + c], b3 = Lb[3 * 256 + c];
          qn[k] = Lq[t * 256 + c] * __expf(bt) * 0.125f; kn[k] = Lk[t * 256 + c] * __expf(b3 - bt); }
      const float e3 = tid < 256 ? __expf(Lb[3 * 256 + tid]) : 0.f;
      __syncthreads();
#pragma unroll
      for (int k = 0; k < 2; ++k) { const int idx = tid + 512 * k; Lq[idx] = qn[k]; Lk[idx] = kn[k]; }
      if (tid < 256) Le3[tid] = e3; }
    __syncthreads();
    const int v = tid & 127, dq = tid >> 7;
    for (int h = 2 * hp; h < 2 * hp + 2; ++h) {
        const float* S0 = p.in[3] + (size_t)(b * 4 + h) * 8192; float* So = p.out + O_SGS + (size_t)(b * 4 + h) * 8192;
        float op[4] = {0.f, 0.f, 0.f, 0.f}; float vv[4];
#pragma unroll
        for (int t = 0; t < 4; ++t) vv[t] = Lv[t * 512 + h * 128 + v];
        float s0v[16];
#pragma unroll
        for (int dd = 0; dd < 16; ++dd) s0v[dd] = __builtin_nontemporal_load(S0 + (dq * 16 + dd) * 128 + v);
#pragma unroll
        for (int dd = 0; dd < 16; ++dd) { const int d = dq * 16 + dd, c = h * 64 + d; const float s0 = s0v[dd];
            float sn = Le3[c] * s0;
#pragma unroll
            for (int t = 0; t < 4; ++t) { op[t] += Lq[t * 256 + c] * s0; sn += Lk[t * 256 + c] * vv[t]; }
            So[d * 128 + v] = sn; }
#pragma unroll
        for (int t = 0; t < 4; ++t) Lo[(dq * 4 + t) * 128 + v] = op[t];
        __syncthreads();
        { const int i = tid >> 7; float o = Lo[(0 * 4 + i) * 128 + v] + Lo[(1 * 4 + i) * 128 + v] + Lo[(2 * 4 + i) * 128 + v] + Lo[(3 * 4 + i) * 128 + v];
#pragma unroll
          for (int j = 0; j < 4; ++j) if (j <= i) o += LA[h * 16 + i * 4 + j] * Lv[j * 512 + h * 128 + v];
          const float s = wave_sum(o * o); if (lane == 0) Lred[wave] = s;
          __syncthreads();
          const float tot = Lred[2 * i] + Lred[2 * i + 1]; const float rg = bf2f(P[(size_t)(rowb + i) * NIN + 1024 + h * 128 + v]);
          mix[(size_t)(rowb + i) * 1024 + h * 128 + v] = f2bf(o * rsqrtf(tot * (1.0f / 128.0f) + EPS) * p.in[11][h * 128 + v] * silu_f(rg)); }
        __syncthreads();
    }
}

__device__ __forceinline__ void attn_prompt(const Params& p, LAS unsigned char* lds, int item) {
    const int b = item >> 5, h = (item >> 3) & 3, rt = item & 7; const int tid = threadIdx.x, lane = tid & 63, wave = tid >> 6, r = lane & 31, hh = lane >> 5;
    LAS bf16_t* LK = (LAS bf16_t*)lds; bf16_t* qx = (bf16_t*)(p.ws + WS_A);
    const bf16_t* mkb = (const bf16_t*)(p.ws + WS_MKB) + (size_t)b * 256 * 1024 + h * 256; const bf16_t* mvt = (const bf16_t*)(p.ws + WS_MVT) + (size_t)(b * 4 + h) * 65536;
    const int r0 = b * 2048 + rt * 256 + wave * 32; const bf16_t* qrow = qx + (size_t)(r0 + r) * 1024 + h * 256 + 8 * hh;
    bf16x8 qf[16];
#pragma unroll
    for (int ks = 0; ks < 16; ++ks) qf[ks] = *(const bf16x8*)(qrow + ks * 16);
#pragma unroll 4
    for (int k = 0; k < 16; ++k) { const int idx = tid + 512 * k, m = idx >> 5, d8 = (idx & 31) * 8; *(LAS u32x4v*)(LK + m * 264 + d8) = *(const u32x4v*)(mkb + (size_t)m * 1024 + d8); }
    __syncthreads();
    f32x16 s[8];
#pragma unroll
    for (int mb = 0; mb < 8; ++mb) s[mb] = zero16();
#pragma unroll
    for (int ks = 0; ks < 16; ++ks) {
#pragma unroll
        for (int mb = 0; mb < 8; ++mb) { const bf16x8 kf = *(const LAS bf16x8*)(LK + (mb * 32 + r) * 264 + ks * 16 + 8 * hh); s[mb] = mma32(kf, qf[ks], s[mb]); } }
    float mx = -3.0e38f;
#pragma unroll
    for (int mb = 0; mb < 8; ++mb)
#pragma unroll
        for (int i = 0; i < 16; ++i) mx = fmaxf(mx, s[mb][i]);
    mx = fmaxf(mx, __shfl_xor(mx, 32)); float sum = 0.f;
#pragma unroll
    for (int mb = 0; mb < 8; ++mb)
#pragma unroll
        for (int i = 0; i < 16; ++i) { const float e = __expf((s[mb][i] - mx) * 0.0625f); s[mb][i] = e; sum += e; }
    sum += __shfl_xor(sum, 32); const float inv = __builtin_amdgcn_rcpf(sum);
    bf16x8 pf[8][2];
#pragma unroll
    for (int mb = 0; mb < 8; ++mb)
#pragma unroll
        for (int sI = 0; sI < 2; ++sI) { u32x4v w; w.x = pk2(s[mb][8 * sI + 0] * inv, s[mb][8 * sI + 1] * inv); w.y = pk2(s[mb][8 * sI + 2] * inv, s[mb][8 * sI + 3] * inv);
            w.z = pk2(s[mb][8 * sI + 4] * inv, s[mb][8 * sI + 5] * inv); w.w = pk2(s[mb][8 * sI + 6] * inv, s[mb][8 * sI + 7] * inv); pf[mb][sI] = __builtin_bit_cast(bf16x8, w); }
    __syncthreads();
#pragma unroll 4
    for (int k = 0; k < 16; ++k) { const int idx = tid + 512 * k, d = idx >> 5, m8 = (idx & 31) * 8; *(LAS u32x4v*)(LK + d * 264 + m8) = *(const u32x4v*)(mvt + (size_t)d * 256 + m8); }
    __syncthreads();
    for (int dh = 0; dh < 2; ++dh) {
        f32x16 o[4];
#pragma unroll
        for (int q = 0; q < 4; ++q) o[q] = zero16();
#pragma unroll
        for (int mb = 0; mb < 8; ++mb)
#pragma unroll
            for (int sI = 0; sI < 2; ++sI)
#pragma unroll
                for (int q = 0; q < 4; ++q) { const LAS bf16_t* vp = LK + ((dh * 4 + q) * 32 + r) * 264 + mb * 32 + 16 * sI + 4 * hh;
                    const u32x2 lo = *(const LAS u32x2*)vp, hi = *(const LAS u32x2*)(vp + 8); u32x4v w; w.x = lo.x; w.y = lo.y; w.z = hi.x; w.w = hi.y;
                    o[q] = mma32(pf[mb][sI], __builtin_bit_cast(bf16x8, w), o[q]); }
#pragma unroll
        for (int q = 0; q < 4; ++q)
#pragma unroll
            for (int i = 0; i < 16; ++i) { const int ii = (i & 3) + 8 * (i >> 2) + 4 * hh; qx[(size_t)(r0 + ii) * 1024 + h * 256 + (dh * 4 + q) * 32 + r] = f2bf(o[q][i]); }
    }
    __syncthreads();
}
__device__ __forceinline__ void attn_sample(const Params& p, LAS unsigned char* lds, int item) {
    const int b = item >> 2, h = item & 3; const int tid = threadIdx.x, lane = tid & 63, wave = tid >> 6; const int rowb = MPR + b * 4;
    bf16_t* qx = (bf16_t*)(p.ws + WS_A); LAS float* Ls = (LAS float*)lds;   LAS float* Lred = (LAS float*)(lds + 4096); LAS float* Lo = (LAS float*)(lds + 8192);
    const float* Kc = p.in[5] + ((size_t)b * 256 * 4 + h) * 256; const float* Vc = p.in[6] + ((size_t)b * 256 * 4 + h) * 256;
    f32x4 q[4];
#pragma unroll
    for (int t = 0; t < 4; ++t) { const u32x2 w = *(const u32x2*)(qx + (size_t)(rowb + t) * 1024 + h * 256 + lane * 4); q[t] = (f32x4){bflo(w.x), bfhi(w.x), bflo(w.y), bfhi(w.y)}; }
    const bool b5 = lane & 32, b4 = lane & 16, b3 = lane & 8, b2 = lane & 4, b1 = lane & 2;
    for (int mb = 0; mb < 4; ++mb) {
        f32x4 kv[8];
#pragma unroll
        for (int rr = 0; rr < 8; ++rr) kv[rr] = __builtin_nontemporal_load((const f32x4*)(Kc + (size_t)(wave * 32 + mb * 8 + rr) * 1024 + lane * 4));
        float a[32];
#pragma unroll
        for (int rr = 0; rr < 8; ++rr)
#pragma unroll
            for (int t = 0; t < 4; ++t) a[rr * 4 + t] = (kv[rr][0] * q[t][0] + kv[rr][1] * q[t][1]) + (kv[rr][2] * q[t][2] + kv[rr][3] * q[t][3]);
        float c16[16], c8[8], c4[4], c2[2], c1;
#pragma unroll
        for (int j = 0; j < 16; ++j) { const float send = b5 ? a[j] : a[j + 16]; const float keep = b5 ? a[j + 16] : a[j]; c16[j] = keep + __shfl_xor(send, 32); }
#pragma unroll
        for (int j = 0; j < 8; ++j) { const float send = b4 ? c16[j] : c16[j + 8]; const float keep = b4 ? c16[j + 8] : c16[j]; c8[j] = keep + __shfl_xor(send, 16); }
#pragma unroll
        for (int j = 0; j < 4; ++j) { const float send = b3 ? c8[j] : c8[j + 4]; const float keep = b3 ? c8[j + 4] : c8[j]; c4[j] = keep + __shfl_xor(send, 8); }
#pragma unroll
        for (int j = 0; j < 2; ++j) { const float send = b2 ? c4[j] : c4[j + 2]; const float keep = b2 ? c4[j + 2] : c4[j]; c2[j] = keep + __shfl_xor(send, 4); }
        { const float send = b1 ? c2[0] : c2[1]; const float keep = b1 ? c2[1] : c2[0]; c1 = keep + __shfl_xor(send, 2); }
        c1 += __shfl_xor(c1, 1);
        if ((lane & 1) == 0) { const int j = (lane >> 1) & 31; Ls[(j & 3) * 256 + wave * 32 + mb * 8 + (j >> 2)] = c1 * 0.0625f; }
    }
    __syncthreads();
    { const int t = tid >> 7, m0 = tid & 127; const float a = Ls[t * 256 + m0], c = Ls[t * 256 + m0 + 128]; const float mx = wave_max(fmaxf(a, c)); if (lane == 0) Lred[wave] = mx;
      __syncthreads();
      const float mxx = fmaxf(Lred[2 * t], Lred[2 * t + 1]); const float ea = __expf(a - mxx), ec = __expf(c - mxx); const float sm = wave_sum(ea + ec); if (lane == 0) Lred[16 + wave] = sm;
      __syncthreads();
      const float inv = __builtin_amdgcn_rcpf(Lred[16 + 2 * t] + Lred[16 + 2 * t + 1]); Ls[t * 256 + m0] = ea * inv; Ls[t * 256 + m0 + 128] = ec * inv; }
    __syncthreads();
    f32x4 o[4];
#pragma unroll
    for (int t = 0; t < 4; ++t) o[t] = (f32x4){0.f, 0.f, 0.f, 0.f};
#pragma unroll 2
    for (int mm = 0; mm < 32; mm += 4) { const int m = wave * 32 + mm; f32x4 vv[4], pp[4];
#pragma unroll
        for (int rr = 0; rr < 4; ++rr) vv[rr] = __builtin_nontemporal_load((const f32x4*)(Vc + (size_t)(m + rr) * 1024 + lane * 4));
#pragma unroll
        for (int t = 0; t < 4; ++t) pp[t] = *(const LAS f32x4*)(Ls + t * 256 + m);
#pragma unroll
        for (int rr = 0; rr < 4; ++rr)
#pragma unroll
            for (int t = 0; t < 4; ++t) o[t] += vv[rr] * pp[t][rr]; }
#pragma unroll
    for (int t = 0; t < 4; ++t) *(LAS f32x4*)(Lo + (wave * 4 + t) * 256 + lane * 4) = o[t];
    __syncthreads();
#pragma unroll
    for (int k = 0; k < 2; ++k) { const int idx = tid + 512 * k, t = idx >> 8, d = idx & 255; float s = 0.f;
#pragma unroll
        for (int w = 0; w < 8; ++w) s += Lo[(w * 4 + t) * 256 + d];
        qx[(size_t)(rowb + t) * 1024 + h * 256 + d] = f2bf(s); }
    __syncthreads();
}

__device__ __forceinline__ void phase_act(const Params& p) {
    const bf16_t* G = (const bf16_t*)(p.ws + WS_P); bf16_t* U = (bf16_t*)(p.ws + WS_U);
    const float* cw = p.in[25]; const float* cb = p.in[26];
    const int nthr = gridDim.x * 512, gt = blockIdx.x * 512 + threadIdx.x;
    for (int it = gt; it < 1024 * 352; it += nthr) { const int run = it / 352, cc = (it % 352) * 8; const int row0 = run * 16; const bool first = (row0 & 2047) == 0;
        float w0[8], w1[8], w2[8], bb[8], g2[8], g1[8];
#pragma unroll
        for (int e = 0; e < 8; ++e) { w0[e] = cw[cc + e]; w1[e] = cw[DFF + cc + e]; w2[e] = cw[2 * DFF + cc + e]; bb[e] = cb[cc + e]; g2[e] = 0.f; g1[e] = 0.f; }
        if (!first) { const u32x4v a = *(const u32x4v*)(G + (size_t)(row0 - 2) * DFF + cc), c = *(const u32x4v*)(G + (size_t)(row0 - 1) * DFF + cc);
            g2[0] = bflo(a.x); g2[1] = bfhi(a.x); g2[2] = bflo(a.y); g2[3] = bfhi(a.y); g2[4] = bflo(a.z); g2[5] = bfhi(a.z); g2[6] = bflo(a.w); g2[7] = bfhi(a.w);
            g1[0] = bflo(c.x); g1[1] = bfhi(c.x); g1[2] = bflo(c.y); g1[3] = bfhi(c.y); g1[4] = bflo(c.z); g1[5] = bfhi(c.z); g1[6] = bflo(c.w); g1[7] = bfhi(c.w); }
#pragma unroll 4
        for (int t = 0; t < 16; ++t) { const size_t off = (size_t)(row0 + t) * DFF + cc; const u32x4v a = *(const u32x4v*)(G + off), uu = *(const u32x4v*)(U + off);
            float g0[8] = {bflo(a.x), bfhi(a.x), bflo(a.y), bfhi(a.y), bflo(a.z), bfhi(a.z), bflo(a.w), bfhi(a.w)};
            const float uf[8] = {bflo(uu.x), bfhi(uu.x), bflo(uu.y), bfhi(uu.y), bflo(uu.z), bfhi(uu.z), bflo(uu.w), bfhi(uu.w)}; float r[8];
#pragma unroll
            for (int e = 0; e < 8; ++e) { r[e] = gelu_t(bb[e] + w0[e] * g2[e] + w1[e] * g1[e] + w2[e] * g0[e]) * uf[e]; g2[e] = g1[e]; g1[e] = g0[e]; }
            u32x4v o; o.x = pk2(r[0], r[1]); o.y = pk2(r[2], r[3]); o.z = pk2(r[4], r[5]); o.w = pk2(r[6], r[7]); *(u32x4v*)(U + off) = o; }
    }
    for (int it = gt; it < 128 * 352; it += nthr) { const int b = it / 352, cc = (it % 352) * 8; const int row0 = MPR + b * 4;
        float w0[8], w1[8], w2[8], bb[8], g2[8], g1[8];
#pragma unroll
        for (int e = 0; e < 8; ++e) { w0[e] = cw[cc + e]; w1[e] = cw[DFF + cc + e]; w2[e] = cw[2 * DFF + cc + e]; bb[e] = cb[cc + e]; g2[e] = p.in[4][(size_t)(b * 2) * DFF + cc + e]; g1[e] = p.in[4][(size_t)(b * 2 + 1) * DFF + cc + e]; }
#pragma unroll
        for (int t = 0; t < 4; ++t) { const size_t off = (size_t)(row0 + t) * DFF + cc; const u32x4v a = *(const u32x4v*)(G + off), uu = *(const u32x4v*)(U + off);
            float g0[8] = {bflo(a.x), bfhi(a.x), bflo(a.y), bfhi(a.y), bflo(a.z), bfhi(a.z), bflo(a.w), bfhi(a.w)};
            const float uf[8] = {bflo(uu.x), bfhi(uu.x), bflo(uu.y), bfhi(uu.y), bflo(uu.z), bfhi(uu.z), bflo(uu.w), bfhi(uu.w)}; float r[8];
#pragma unroll
            for (int e = 0; e < 8; ++e) { r[e] = gelu_t(bb[e] + w0[e] * g2[e] + w1[e] * g1[e] + w2[e] * g0[e]) * uf[e]; g2[e] = g1[e]; g1[e] = g0[e]; }
            u32x4v o; o.x = pk2(r[0], r[1]); o.y = pk2(r[2], r[3]); o.z = pk2(r[4], r[5]); o.w = pk2(r[6], r[7]); *(u32x4v*)(U + off) = o; }
    }
}
__device__ __forceinline__ void phase_final(const Params& p) {
    const float* h32 = (const float*)(p.ws + WS_H); const float* ssq = (const float*)(p.ws + WS_SSQ) + (size_t)2 * MT * 16; const float* g = p.in[28];
    const int lane = threadIdx.x & 63, wave = threadIdx.x >> 6;
    const float* ssq64 = (const float*)(p.ws + WS_SSQS) + (size_t)2 * 512 * 64;
    for (int r = blockIdx.x * 8 + wave; r < MT; r += gridDim.x * 8) { const float rs = row_rs2(ssq, ssq64, r);
#pragma unroll
        for (int i = 0; i < 4; ++i) { const size_t off = (size_t)r * 1024 + i * 256 + lane * 4; *(f32x4*)(p.out + O_Y + off) = *(const f32x4*)(h32 + off) * rs * *(const f32x4*)(g + i * 256 + lane * 4); } }
}

template <int DUMMY>
__device__ __forceinline__ void run_phases(const Params& p, LAS unsigned char* lds, const int lo, const int hi) {
    unsigned char* ws = p.ws; const int G = gridDim.x, bx = blockIdx.x;
#define IN(k) (lo <= (k) && (k) < hi)
#define MKBAR() XcdBarrier bar; bar.bar = (unsigned*)(p.ws + WS_BAR) + (size_t)p.bar_region * XCD_BAR_WORDS; bar.x = xb_xcc_id(); bar.st = (volatile LAS unsigned*)(lds + LDS_BYTES - 16)
#define SEAM(k) do { if (IN(k) && IN((k) + 1)) { MKBAR(); xcd_barrier(bar); } } while (0)
    if (IN(0)) { phase_prep(p, lds); } SEAM(0);
    if (IN(0) && IN(1)) {
        volatile LAS unsigned* stw = (volatile LAS unsigned*)(lds + LDS_BYTES - 16);
        if (threadIdx.x == 0 && (G % 8) == 0) { unsigned* barw = (unsigned*)(p.ws + WS_BAR) + (size_t)p.bar_region * XCD_BAR_WORDS; const unsigned x = xb_xcc_id(); unsigned pre = 0;
            for (unsigned j = 0; j < 16; ++j) { const unsigned cj = xb_ld(&barw[XB_XCNT(j)]); if (j < x) pre += cj; }
            const unsigned clin = pre + stw[2], per = (unsigned)G / 8u; stw[3] = (clin % per) * 8u + clin / per; }
        __syncthreads();
    }
#define CX ((int)((volatile LAS unsigned*)(lds + LDS_BYTES - 16))[3])
    if (IN(1)) {
        { pg8::Gemm g{(const bf16_t*)(ws + WS_A), (const bf16_t*)(ws + WS_WIN), MT, 2560, 1024}; pg8::StaticOrder S; S.init(MT, 2560, G, CX);
          EpiIn E{(bf16_t*)(ws + WS_P), (float*)(ws + WS_AF)}; pg8::gemm_phase<EpiIn, pg8::StaticOrder>(lds, g, S, E, nullptr); }
        __syncthreads();
        { pg8::Gemm g{(const bf16_t*)(ws + WS_MN), (const bf16_t*)(ws + WS_WKV), 2048, 2048, 1024}; pg8::StaticOrder S; S.init(2048, 2048, G, (CX + 104) % G);
          EpiKV E{p.out + O_MK, p.out + O_MV, (bf16_t*)(ws + WS_MKB), (bf16_t*)(ws + WS_MVT)}; pg8::gemm_phase<EpiKV, pg8::StaticOrder>(lds, g, S, E, nullptr); }
        __syncthreads();
    } SEAM(1);
    if (IN(2)) {
        gla_local_loop(p, lds, bx, G, 1024);
        for (int it = bx; it < 512; it += G) sgu_item(p, lds, it);
        for (int it = G - 1 - bx; it < 256; it += G) sample_mixer(p, lds, it >> 1, it & 1);
    } SEAM(2);
    if (IN(3)) { gla_scan(p); } SEAM(3);
    if (IN(4)) { gla_out_loop(p, lds, bx, G, 1024); } SEAM(4);
    if (IN(5)) {
        pg8::Gemm g{(const bf16_t*)(ws + WS_A), (const bf16_t*)(ws + WS_WOUT), MPR, 1024, 1024}; pg8::StaticOrder S; S.init(MPR, 1024, G, CX);
        EpiRes E{p.in[0], (bf16_t*)(ws + WS_HB), (float*)(ws + WS_SSQ)}; pg8::gemm_phase<EpiRes, pg8::StaticOrder>(lds, g, S, E, nullptr);
        __syncthreads();
        { const float* xs = p.in[1]; bf16_t* hb = (bf16_t*)(ws + WS_HB) + (size_t)MPR * 1024; float* sq = (float*)(ws + WS_SSQS);
          gemm_small<256>((const bf16_t*)(ws + WS_A) + (size_t)MPR * 1024, (const bf16_t*)(ws + WS_WOUT), 1024, 16, lds, [=](int r, int c, int cb, int fq, f32x4 a) {
              const size_t off = (size_t)r * 1024 + c; const f32x4 v = a + *(const f32x4*)(xs + off); u32x2 w; w.x = pk2(v[0], v[1]); w.y = pk2(v[2], v[3]); *(u32x2*)(hb + off) = w;
              float s = sq4(v); s += __shfl_xor(s, 16); s += __shfl_xor(s, 32); if (fq == 0) sq[(size_t)r * 64 + cb] = s; }); }
    } SEAM(5);
    if (IN(6)) {
        pg8::Gemm g{(const bf16_t*)(ws + WS_HB), (const bf16_t*)(ws + WS_WQ), MPR, 1024, 1024}; pg8::StaticOrder S; S.init(MPR, 1024, G, CX);
        EpiQ E{(bf16_t*)(ws + WS_A), (const float*)(ws + WS_SSQ)}; pg8::gemm_phase<EpiQ, pg8::StaticOrder>(lds, g, S, E, nullptr);
        __syncthreads();
        { bf16_t* Q = (bf16_t*)(ws + WS_A) + (size_t)MPR * 1024; const float* sq = (const float*)(ws + WS_SSQS);
          gemm_small<256>((const bf16_t*)(ws + WS_HB) + (size_t)MPR * 1024, (const bf16_t*)(ws + WS_WQ), 1024, 16, lds, [=](int r, int c, int cb, int fq, f32x4 a) {
              const f32x4 v = a * row_rs64(sq, r); u32x2 w; w.x = pk2(v[0], v[1]); w.y = pk2(v[2], v[3]); *(u32x2*)(Q + (size_t)r * 1024 + c) = w; }); }
    } SEAM(6);
    if (IN(7)) {
        if ((bx >> 3) & 1) { for (int it = bx; it < 512; it += G) attn_sample(p, lds, it); for (int it = bx; it < 256; it += G) attn_prompt(p, lds, it); }
        else { for (int it = bx; it < 256; it += G) attn_prompt(p, lds, it); for (int it = bx; it < 512; it += G) attn_sample(p, lds, it); }
    } SEAM(7);
    if (IN(8)) {
        pg8::Gemm g{(const bf16_t*)(ws + WS_A), (const bf16_t*)(ws + WS_WO), MPR, 1024, 1024}; pg8::StaticOrder S; S.init(MPR, 1024, G, CX);
        EpiRes E{nullptr, (bf16_t*)(ws + WS_HB), (float*)(ws + WS_SSQ) + (size_t)MT * 16};
        pg8::gemm_phase<EpiRes, pg8::StaticOrder>(lds, g, S, E, nullptr);
        __syncthreads();
        { bf16_t* hb = (bf16_t*)(ws + WS_HB) + (size_t)MPR * 1024; float* sq = (float*)(ws + WS_SSQS) + (size_t)512 * 64;
          gemm_small<256>((const bf16_t*)(ws + WS_A) + (size_t)MPR * 1024, (const bf16_t*)(ws + WS_WO), 1024, 16, lds, [=](int r, int c, int cb, int fq, f32x4 a) {
              const size_t off = (size_t)r * 1024 + c; const u32x2 hw = *(const u32x2*)(hb + off); const f32x4 v = a + (f32x4){bflo(hw.x), bfhi(hw.x), bflo(hw.y), bfhi(hw.y)};
              u32x2 w; w.x = pk2(v[0], v[1]); w.y = pk2(v[2], v[3]); *(u32x2*)(hb + off) = w;
              float s = sq4(v); s += __shfl_xor(s, 16); s += __shfl_xor(s, 32); if (fq == 0) sq[(size_t)r * 64 + cb] = s; }); }
    } SEAM(8);
    if (IN(9)) {
        pg8::Gemm g{(const bf16_t*)(ws + WS_HB), (const bf16_t*)(ws + WS_WGU), MT, 5632, 1024}; pg8::StaticOrder S; S.init(MT, 5632, G, CX);
        EpiGU E{(bf16_t*)(ws + WS_U), (const float*)(ws + WS_SSQ) + (size_t)MT * 16, (const float*)(ws + WS_SSQS) + (size_t)512 * 64, p.out + O_SCP, p.out + O_SCS, p.in[25], p.in[26], p.in[4], (float*)(ws + WS_GX), (float*)(ws + WS_UX), p.pad}; pg8::gemm_phase<EpiGU, pg8::StaticOrder>(lds, g, S, E, nullptr);
        __syncthreads();
    } if (IN(9) && IN(11)) { MKBAR(); xcd_barrier(bar); }
    if (IN(11)) {
        pg8::Gemm g{(const bf16_t*)(ws + WS_U), (const bf16_t*)(ws + WS_WD), MPR, 1024, 2816}; pg8::StaticOrder S; S.init(MPR, 1024, G, CX);
        if (!(p.pad & 2)) { Unit fu; for (int i = 0; S.next(i, fu); ++i) act_fixup(p, fu.pm); asm volatile("s_waitcnt vmcnt(0)" ::: "memory"); __syncthreads(); }
        EpiFin E{(const bf16_t*)(ws + WS_HB), (float*)(ws + WS_SSQ) + (size_t)2 * MT * 16, (unsigned*)(ws + WS_BAR) + (size_t)p.bar_region * XCD_BAR_WORDS, p.in[28], p.out + O_Y, p.pad,
                 (const bf16_t*)(ws + WS_U) + (size_t)MPR * 2816, (const bf16_t*)(ws + WS_WD), (float*)(ws + WS_SSQS) + (size_t)2 * 512 * 64};
        pg8::gemm_phase<EpiFin, pg8::StaticOrder>(lds, g, S, E, nullptr);
        __syncthreads();
    }
#undef IN
#undef SEAM
#undef CX
}
__global__ void __launch_bounds__(512) mega(Params p) {
    extern __shared__ __attribute__((aligned(16))) unsigned char lds_raw[];
    LAS unsigned char* lds = (LAS unsigned char*)lds_raw;
    if (p.ph_lo < 0) { cg::grid_group grid = cg::this_grid(); grid.sync(); }
    volatile LAS unsigned* st = (volatile LAS unsigned*)(lds + LDS_BYTES - 16);
    if (threadIdx.x < 4) st[threadIdx.x] = 0u;
    __syncthreads();
    if (threadIdx.x == 0) { unsigned* barw = (unsigned*)(p.ws + WS_BAR) + (size_t)p.bar_region * XCD_BAR_WORDS;
        st[2] = xb_add(&barw[XB_XCNT(xb_xcc_id())], 1u);
        st[3] = blockIdx.x; }
    __syncthreads();
    run_phases<0>(p, lds, p.ph_lo, p.ph_hi);
#ifdef EXTRA_SYNC
    for (int i = 0; i < EXTRA_SYNC; ++i) { MKBAR(); xcd_barrier(bar); }
#endif
}

extern "C" void kernel_launch(void* const* d_in, const int* in_sizes, int n_in, void* d_out, int out_size, void* d_ws, size_t ws_size, hipStream_t stream) {
    static int grid = 0;
    if (grid == 0) {
        if (n_in != 29 || ws_size < WS_END) { fprintf(stderr, "kernel_launch: unexpected n_in %d / ws %zu (need %zu)\n", n_in, ws_size, (size_t)WS_END); grid = -1; return; }
        int dev = 0, cus = 0, per_cu = 0;
        hipGetDevice(&dev); hipDeviceGetAttribute(&cus, hipDeviceAttributeMultiprocessorCount, dev);
        if (hipFuncSetAttribute((const void*)mega, hipFuncAttributeMaxDynamicSharedMemorySize, LDS_BYTES) != hipSuccess) { fprintf(stderr, "kernel_launch: hipFuncSetAttribute failed\n"); grid = -1; return; }
        if (hipOccupancyMaxActiveBlocksPerMultiprocessor(&per_cu, (const void*)mega, 512, LDS_BYTES) != hipSuccess || per_cu < 1) { fprintf(stderr, "kernel_launch: occupancy query gives %d\n", per_cu); (void)hipGetLastError(); per_cu = 1; }
        grid = cus;
    }
    if (grid < 0) return;
    Params p{};
    for (int i = 0; i < 29; ++i) p.in[i] = (const float*)d_in[i];
    p.out = (float*)d_out; p.ws = (unsigned char*)d_ws;
    (void)hipMemsetAsync((unsigned char*)d_ws + WS_BAR, 0, (size_t)2 * XCD_BAR_WORDS * 4, stream);
#if N_LAUNCH_MODE == 1
    p.ph_lo = 0; p.ph_hi = NPHASE;
    void* args[] = {&p};
    hipError_t e = hipLaunchCooperativeKernel((const void*)mega, dim3(grid), dim3(512), args, LDS_BYTES, stream);
    if (e != hipSuccess) fprintf(stderr, "cooperative launch failed: %s (grid %d)\n", hipGetErrorString(e), grid);
#if EXTRA_HI > 0
    Params p2 = p; p2.ph_lo = EXTRA_LO; p2.ph_hi = EXTRA_HI; p2.bar_region = 1; p2.pad = EXTRA_FLAGS; void* args2[] = {&p2};
    (void)hipLaunchCooperativeKernel((const void*)mega, dim3(grid), dim3(512), args2, LDS_BYTES, stream);
#endif
#else
    for (int ph = 0; ph < NPHASE; ++ph) { p.ph_lo = ph; p.ph_hi = ph + 1; hipLaunchKernelGGL(mega, dim3(grid), dim3(512), LDS_BYTES, stream, p); }
#endif
}
```

```cpp
#include <hip/hip_runtime.h>
namespace pg8 {
#define PG8_LAS __attribute__((address_space(3)))
typedef unsigned short bf16_t;
typedef short bf16x8 __attribute__((ext_vector_type(8)));
typedef float f32x4 __attribute__((ext_vector_type(4)));
typedef unsigned u32x4 __attribute__((ext_vector_type(4)));
constexpr int BM = 256, BK = 64, HALF = 128, HTB = HALF * BK * 2  , STAGE_BYTES = 8 * HTB, NXCD = 8, WGM = 8;

__host__ __device__ __forceinline__ int lds_byte(int r, int c) { const int st = (r >> 4) * 2 + (c >> 5), rr = r & 15, cc = c & 31, ob = rr * 64 + cc * 2; return st * 1024 + (ob ^ (((ob >> 9) & 1) << 5)); }
__host__ __device__ __forceinline__ void stage_rc(int b, int& R, int& C) { const int st = b / 1024, sb = b % 1024, swz = sb ^ (((sb >> 9) & 1) << 5); R = (st >> 1) * 16 + swz / 64; C = (st & 1) * 32 + (swz % 64) / 2; }
__host__ __device__ __forceinline__ int perm32(int rho) { const int n = rho >> 4, i = rho & 15; return 8 * (i >> 2) + 4 * n + (i & 3); }

struct Unit { int pm, pn; };
struct Gemm { const bf16_t* A; const bf16_t* Bt; int M, N, K; };

struct StaticOrder {
    int nM, nN, nwg, G, c;
    __host__ __device__ void init(int M, int N, int G_, int c_) { nM = M / BM; nN = N / BM; nwg = nM * nN; G = G_; c = c_; }
    __host__ __device__ __forceinline__ bool next(int i, Unit& u) const {
        const long L = (long)i * G + c; if (L >= nwg) return false;
        int wgid = (int)L; { const int q = nwg / NXCD, r = nwg % NXCD, xcd = wgid % NXCD, off = wgid / NXCD; wgid = (xcd < r ? xcd * (q + 1) : r * (q + 1) + (xcd - r) * q) + off; }
        const int nig = WGM * nN, gid = wgid / nig, fm = gid * WGM, gsz = (nM - fm) < WGM ? (nM - fm) : WGM;
        u.pm = fm + ((wgid % nig) % gsz); u.pn = (wgid % nig) / gsz; return true;
    }
    __device__ __forceinline__ void a_ready(const Unit&) const {}
    __device__ __forceinline__ void done(const Unit&) const {}
};
struct CountedOrder : StaticOrder {
    const unsigned* ready; unsigned need; unsigned* tmo;
    __device__ __forceinline__ void a_ready(const Unit& u) const {
        if (threadIdx.x < 64) {
            const unsigned long long t0 = __builtin_amdgcn_s_memrealtime(); unsigned polls = 0;
            while ((unsigned)__builtin_amdgcn_readfirstlane(__hip_atomic_load(ready + 64 * u.pm, __ATOMIC_RELAXED, __HIP_MEMORY_SCOPE_AGENT)) < need) {
                if ((++polls & 255u) == 0u && __builtin_amdgcn_readfirstlane(__hip_atomic_load(tmo, __ATOMIC_RELAXED, __HIP_MEMORY_SCOPE_AGENT)) != 0u) break;
                if (__builtin_amdgcn_s_memrealtime() - t0 > 2000000ull) {
                    if (threadIdx.x == 0) { unsigned expect = 0u; __hip_atomic_compare_exchange_strong(tmo + 1, &expect, 0x600u | (unsigned)(u.pm & 0xff), __ATOMIC_RELAXED, __ATOMIC_RELAXED, __HIP_MEMORY_SCOPE_AGENT); __hip_atomic_store(tmo, 1u, __ATOMIC_RELAXED, __HIP_MEMORY_SCOPE_AGENT); }
                    break; }
                __builtin_amdgcn_s_sleep(2); }
            __builtin_amdgcn_fence(__ATOMIC_ACQUIRE, "agent");
            asm volatile("s_waitcnt vmcnt(0)" ::: "memory");
        }
#if !defined(BROKEN_HOOK_NO_BARRIER)
        asm volatile("" ::: "memory"); __builtin_amdgcn_s_barrier(); asm volatile("" ::: "memory");
#endif
    }
};

__device__ __forceinline__ unsigned cvt_pk_bf16(float lo, float hi) { unsigned r; asm volatile("v_cvt_pk_bf16_f32 %0, %1, %2" : "=v"(r) : "v"(lo), "v"(hi)); return r; }
typedef float f32x2 __attribute__((ext_vector_type(2)));
__device__ __forceinline__ f32x2 gelu_pk(f32x2 v) {
    const f32x2 av = __builtin_elementwise_abs(v), d = av * 0.2316418882f + 1.0f;
    f32x2 t; t.x = __builtin_amdgcn_rcpf(d.x); t.y = __builtin_amdgcn_rcpf(d.y);
    f32x2 q = t * 0.5307027145f + (-0.7265760135f); q = q * t + 0.7107068705f; q = q * t + (-0.142248368f); q = q * t + 0.127414796f; q = q * t;
    const f32x2 s = (v * v) * (-0.72134752044f);
    f32x2 e; e.x = __builtin_amdgcn_exp2f(s.x); e.y = __builtin_amdgcn_exp2f(s.y);
    const f32x2 m = v * (q * e), r = v - m;
    f32x2 o; o.x = v.x < 0.f ? m.x : r.x; o.y = v.y < 0.f ? m.y : r.y; return o;
}

struct EpiF32 {
    static constexpr bool PERM = false, AFTER_DRAIN = false;
    float* C; int ldc; const float* bias;
    __device__ __forceinline__ void operator()(const f32x4 (&acc)[2][2][4][2], const Unit& u, int wr, int wc, int fr, int fq) const {
        const int row0 = u.pm * BM + wr * 64 + fr, col0 = u.pn * BM + wc * 32 + 4 * fq;
        f32x4 bv[2][2];
#pragma unroll
        for (int bj = 0; bj < 2; ++bj)
#pragma unroll
            for (int n = 0; n < 2; ++n) bv[bj][n] = bias ? *(const f32x4*)(bias + col0 + bj * HALF + n * 16) : (f32x4){0.f, 0.f, 0.f, 0.f};
#pragma unroll
        for (int ai = 0; ai < 2; ++ai)
#pragma unroll
            for (int m = 0; m < 4; ++m) { float* rowp = C + (size_t)(row0 + ai * HALF + m * 16) * ldc + col0;
#pragma unroll
                for (int bj = 0; bj < 2; ++bj)
#pragma unroll
                    for (int n = 0; n < 2; ++n) *(f32x4*)(rowp + bj * HALF + n * 16) = acc[ai][bj][m][n] + bv[bj][n]; }
    }
};
template <int ACT  > struct EpiBf16 {
    static constexpr bool PERM = true, AFTER_DRAIN = false;
    bf16_t* O; int ldc; const float* bias; int split_cols; size_t split_stride;
    __device__ __forceinline__ void operator()(const f32x4 (&acc)[2][2][4][2], const Unit& u, int wr, int wc, int fr, int fq) const {
        const int row0 = u.pm * BM + wr * 64 + fr; int colt = u.pn * BM; bf16_t* base = O;
        if (split_cols) { const int t = colt / split_cols; base += (size_t)t * split_stride; colt -= t * split_cols; }
        const int col0 = colt + wc * 32 + 8 * fq, bcol0 = u.pn * BM + wc * 32 + 8 * fq;
        f32x4 bv[2][2];
#pragma unroll
        for (int bj = 0; bj < 2; ++bj)
#pragma unroll
            for (int n = 0; n < 2; ++n) bv[bj][n] = bias ? *(const f32x4*)(bias + bcol0 + bj * HALF + 4 * n) : (f32x4){0.f, 0.f, 0.f, 0.f};
#pragma unroll
        for (int ai = 0; ai < 2; ++ai)
#pragma unroll
            for (int m = 0; m < 4; ++m) { bf16_t* rowp = base + (size_t)(row0 + ai * HALF + m * 16) * ldc + col0;
#pragma unroll
                for (int bj = 0; bj < 2; ++bj) { f32x4 v0 = acc[ai][bj][m][0] + bv[bj][0], v1 = acc[ai][bj][m][1] + bv[bj][1];
                    if (ACT == 1) { f32x2 a = gelu_pk((f32x2){v0[0], v0[1]}), b = gelu_pk((f32x2){v0[2], v0[3]}), c = gelu_pk((f32x2){v1[0], v1[1]}), d = gelu_pk((f32x2){v1[2], v1[3]});
                        v0 = (f32x4){a.x, a.y, b.x, b.y}; v1 = (f32x4){c.x, c.y, d.x, d.y}; }
                    if (ACT == 2) {
#pragma unroll
                        for (int j = 0; j < 4; ++j) { v0[j] = 0.5f * v0[j] * (1.0f + erff(v0[j] * 0.70710678f)); v1[j] = 0.5f * v1[j] * (1.0f + erff(v1[j] * 0.70710678f)); } }
                    u32x4 w; w.x = cvt_pk_bf16(v0[0], v0[1]); w.y = cvt_pk_bf16(v0[2], v0[3]); w.z = cvt_pk_bf16(v1[0], v1[1]); w.w = cvt_pk_bf16(v1[2], v1[3]);
                    *(u32x4*)(rowp + bj * HALF) = w; } }
    }
};

struct PanelStats {
    unsigned* xbuf;
    unsigned* cnt;
    unsigned* tmo;
    int ntn; float eps;
    unsigned code;
    __device__ __forceinline__ bool run(const f32x4 (&v)[2][2][4][2], const Unit& u, int wr, int wc, int fr, int fq, PG8_LAS unsigned char* lds, int wid, int lane) const {
        typedef float f32x2v __attribute__((ext_vector_type(2)));
        PG8_LAS f32x2v* P = (PG8_LAS f32x2v*)lds;
        PG8_LAS f32x2v* S = (PG8_LAS f32x2v*)(lds + 8192);
        PG8_LAS unsigned* flag = (PG8_LAS unsigned*)(lds + 8192 + 2048);
#pragma unroll
        for (int ai = 0; ai < 2; ++ai)
#pragma unroll
            for (int m = 0; m < 4; ++m) {
                float s = 0.f;
#pragma unroll
                for (int bj = 0; bj < 2; ++bj)
#pragma unroll
                    for (int n = 0; n < 2; ++n) { const f32x4 x = v[ai][bj][m][n]; s += (x[0] + x[1]) + (x[2] + x[3]); }
                s += __shfl_xor(s, 16); s += __shfl_xor(s, 32);
                const float mw = s * (1.0f / 64.0f); float q = 0.f;
#pragma unroll
                for (int bj = 0; bj < 2; ++bj)
#pragma unroll
                    for (int n = 0; n < 2; ++n) { const f32x4 d = v[ai][bj][m][n] - mw; q += (d[0] * d[0] + d[1] * d[1]) + (d[2] * d[2] + d[3] * d[3]); }
                q += __shfl_xor(q, 16); q += __shfl_xor(q, 32);
                if (fq == 0) P[(ai * HALF + wr * 64 + m * 16 + fr) * 4 + wc] = (f32x2v){mw, q};
            }
        asm volatile("s_waitcnt lgkmcnt(0)" ::: "memory"); __builtin_amdgcn_s_barrier(); asm volatile("" ::: "memory");
#if defined(BROKEN_NO_WAIT)
        if (blockIdx.x >= 64) { const long long t0 = clock64(); while (clock64() - t0 < 60000) __builtin_amdgcn_s_sleep(8); }
#endif
        const int row = wid * 32 + (lane & 31);
        if (lane < 32) {
            const f32x2v a = P[row * 4 + 0], b = P[row * 4 + 1], c = P[row * 4 + 2], d = P[row * 4 + 3];
            const float mt = (a.x + b.x + c.x + d.x) * 0.25f;
            const float da = a.x - mt, db = b.x - mt, dc = c.x - mt, dd = d.x - mt;
            const float m2 = (a.y + b.y) + (c.y + d.y) + 64.0f * ((da * da + db * db) + (dc * dc + dd * dd));
            unsigned long long* slot = (unsigned long long*)xbuf + ((size_t)(u.pm * BM + row) * 4 + u.pn);
            __hip_atomic_store(slot, ((unsigned long long)__float_as_uint(m2) << 32) | __float_as_uint(mt), __ATOMIC_RELAXED, __HIP_MEMORY_SCOPE_AGENT);
        }
        asm volatile("s_waitcnt vmcnt(0)" ::: "memory");
        if (lane == 0) __hip_atomic_fetch_add(cnt + 64 * u.pm, 1u, __ATOMIC_RELAXED, __HIP_MEMORY_SCOPE_AGENT);
        if (wid == 0) {
            bool dead = false; const unsigned long long t0 = __builtin_amdgcn_s_memrealtime(); const unsigned want = 8u * (unsigned)ntn;
            for (;;) {
#if defined(BROKEN_NO_WAIT)
                break;
#endif
                if ((unsigned)__builtin_amdgcn_readfirstlane(__hip_atomic_load(cnt + 64 * u.pm, __ATOMIC_RELAXED, __HIP_MEMORY_SCOPE_AGENT)) >= want) break;
                if (__builtin_amdgcn_s_memrealtime() - t0 > 2000000ull) {
                    if (lane == 0) { unsigned expect = 0u; __hip_atomic_compare_exchange_strong(tmo + 1, &expect, code | (unsigned)(u.pm & 0xff), __ATOMIC_RELAXED, __ATOMIC_RELAXED, __HIP_MEMORY_SCOPE_AGENT);
                                     __hip_atomic_store(tmo, 1u, __ATOMIC_RELAXED, __HIP_MEMORY_SCOPE_AGENT); }
                    dead = true; break; }
                __builtin_amdgcn_s_sleep(2);
            }
            __builtin_amdgcn_fence(__ATOMIC_ACQUIRE, "agent");
            if (lane == 0) flag[0] = dead ? 1u : 0u;
        }
        asm volatile("s_waitcnt vmcnt(0) lgkmcnt(0)" ::: "memory"); __builtin_amdgcn_s_barrier(); asm volatile("" ::: "memory");
        const bool bad = flag[0] != 0u;
        if (lane < 32) {
            const unsigned long long* slot = (const unsigned long long*)xbuf + (size_t)(u.pm * BM + row) * 4; float mt[4], m2[4]; float ms = 0.f;
#pragma unroll
            for (int t = 0; t < 4; ++t) { if (t < ntn) { const unsigned long long w = __hip_atomic_load(slot + t, __ATOMIC_RELAXED, __HIP_MEMORY_SCOPE_AGENT); mt[t] = __uint_as_float((unsigned)w); m2[t] = __uint_as_float((unsigned)(w >> 32)); } else { mt[t] = 0.f; m2[t] = 0.f; } ms += mt[t]; }
            const float mean = ms / (float)ntn; float q = 0.f;
#pragma unroll
            for (int t = 0; t < 4; ++t) if (t < ntn) { const float dm = mt[t] - mean; q += m2[t] + 256.0f * dm * dm; }
            S[row] = (f32x2v){mean, 1.0f / sqrtf(q / (256.0f * (float)ntn) + eps)};
        }
        asm volatile("s_waitcnt lgkmcnt(0)" ::: "memory"); __builtin_amdgcn_s_barrier(); asm volatile("" ::: "memory");
        return bad;
    }
};
struct EpiLnRes {
    static constexpr bool PERM = false, AFTER_DRAIN = true;
    const float* base; float* out; int ldc; const float* bias; PanelStats st; unsigned poison;
    __device__ __forceinline__ void refuse(size_t i0, size_t stride, int M, int N) const { const float q = __builtin_nanf(""); for (size_t i = i0; i < (size_t)M * N; i += stride) out[(i / N) * ldc + i % N] = q;
        if (i0 == 0) { unsigned expect = 0u; __hip_atomic_compare_exchange_strong(st.tmo + 1, &expect, 0x7f0u, __ATOMIC_RELAXED, __ATOMIC_RELAXED, __HIP_MEMORY_SCOPE_AGENT); __hip_atomic_store(st.tmo, 1u, __ATOMIC_RELAXED, __HIP_MEMORY_SCOPE_AGENT); } }
    __device__ __forceinline__ void fused(f32x4 (&acc)[2][2][4][2], const Unit& u, int wr, int wc, int fr, int fq, PG8_LAS unsigned char* lds, int wid, int lane) const {
        typedef float f32x2v __attribute__((ext_vector_type(2)));
        const PG8_LAS f32x2v* S = (const PG8_LAS f32x2v*)(lds + 8192);
        const int col0 = u.pn * BM + wc * 32 + 4 * fq;
#pragma unroll
        for (int bj = 0; bj < 2; ++bj)
#pragma unroll
            for (int n = 0; n < 2; ++n) { const f32x4 bv = bias ? *(const f32x4*)(bias + col0 + bj * HALF + n * 16) : (f32x4){0.f, 0.f, 0.f, 0.f};
#pragma unroll
                for (int ai = 0; ai < 2; ++ai)
#pragma unroll
                    for (int m = 0; m < 4; ++m) acc[ai][bj][m][n] += bv; }
        const bool bad = st.run(acc, u, wr, wc, fr, fq, lds, wid, lane) || poison != 0u;
        const float qnan = __builtin_nanf("");
#pragma unroll
        for (int ai = 0; ai < 2; ++ai)
#pragma unroll
            for (int m = 0; m < 4; ++m) { const int r = ai * HALF + wr * 64 + m * 16 + fr; const f32x2v sr = S[r]; const size_t off = (size_t)(u.pm * BM + r) * ldc + col0;
#pragma unroll
                for (int bj = 0; bj < 2; ++bj)
#pragma unroll
                    for (int n = 0; n < 2; ++n) { const f32x4 bs = *(const f32x4*)(base + off + bj * HALF + n * 16); f32x4 o = bs + (acc[ai][bj][m][n] - sr.x) * sr.y;
                        if (bad) o = (f32x4){qnan, qnan, qnan, qnan}; *(f32x4*)(out + off + bj * HALF + n * 16) = o; }
                asm volatile("" ::: "memory"); }
    }
};
struct EpiLnResLn {
    static constexpr bool PERM = false, AFTER_DRAIN = true;
    const float* base; float* out; bf16_t* xn; int ldc; const float* bias; PanelStats st1, st2; unsigned poison;
    __device__ __forceinline__ void refuse(size_t i0, size_t stride, int M, int N) const { const float q = __builtin_nanf(""); for (size_t i = i0; i < (size_t)M * N; i += stride) { const size_t o = (i / N) * ldc + i % N; out[o] = q; xn[o] = (bf16_t)0x7fc0u; }
        if (i0 == 0) { unsigned expect = 0u; __hip_atomic_compare_exchange_strong(st1.tmo + 1, &expect, 0x7f0u, __ATOMIC_RELAXED, __ATOMIC_RELAXED, __HIP_MEMORY_SCOPE_AGENT); __hip_atomic_store(st1.tmo, 1u, __ATOMIC_RELAXED, __HIP_MEMORY_SCOPE_AGENT); } }
    __device__ __forceinline__ void fused(f32x4 (&acc)[2][2][4][2], const Unit& u, int wr, int wc, int fr, int fq, PG8_LAS unsigned char* lds, int wid, int lane) const {
        typedef float f32x2v __attribute__((ext_vector_type(2))); typedef unsigned u32x2v __attribute__((ext_vector_type(2)));
        const PG8_LAS f32x2v* S = (const PG8_LAS f32x2v*)(lds + 8192);
        const int col0 = u.pn * BM + wc * 32 + 4 * fq;
#pragma unroll
        for (int bj = 0; bj < 2; ++bj)
#pragma unroll
            for (int n = 0; n < 2; ++n) { const f32x4 bv = bias ? *(const f32x4*)(bias + col0 + bj * HALF + n * 16) : (f32x4){0.f, 0.f, 0.f, 0.f};
#pragma unroll
                for (int ai = 0; ai < 2; ++ai)
#pragma unroll
                    for (int m = 0; m < 4; ++m) acc[ai][bj][m][n] += bv; }
        bool bad = st1.run(acc, u, wr, wc, fr, fq, lds, wid, lane) || poison != 0u;
        const float qnan = __builtin_nanf("");
#pragma unroll
        for (int ai = 0; ai < 2; ++ai)
#pragma unroll
            for (int m = 0; m < 4; ++m) { const int r = ai * HALF + wr * 64 + m * 16 + fr; const f32x2v sr = S[r]; const size_t off = (size_t)(u.pm * BM + r) * ldc + col0;
#pragma unroll
                for (int bj = 0; bj < 2; ++bj)
#pragma unroll
                    for (int n = 0; n < 2; ++n) { const f32x4 bs = *(const f32x4*)(base + off + bj * HALF + n * 16); acc[ai][bj][m][n] = bs + (acc[ai][bj][m][n] - sr.x) * sr.y; }
                asm volatile("" : "+v"(acc[ai][0][m][0]), "+v"(acc[ai][0][m][1]), "+v"(acc[ai][1][m][0]), "+v"(acc[ai][1][m][1]));
                if (m & 1) asm volatile("" ::: "memory"); }
        const bool bad1 = bad;
        bad = st2.run(acc, u, wr, wc, fr, fq, lds, wid, lane) || bad;
#pragma unroll
        for (int ai = 0; ai < 2; ++ai)
#pragma unroll
            for (int m = 0; m < 4; ++m) { const int r = ai * HALF + wr * 64 + m * 16 + fr; const f32x2v sr = S[r]; const size_t off = (size_t)(u.pm * BM + r) * ldc + col0;
#pragma unroll
                for (int bj = 0; bj < 2; ++bj)
#pragma unroll
                    for (int n = 0; n < 2; ++n) { const f32x4 x1 = acc[ai][bj][m][n]; *(f32x4*)(out + off + bj * HALF + n * 16) = bad1 ? (f32x4){qnan, qnan, qnan, qnan} : x1;
                        const f32x4 o = (x1 - sr.x) * sr.y; u32x2v w; w.x = cvt_pk_bf16(o[0], o[1]); w.y = cvt_pk_bf16(o[2], o[3]);
                        if (bad) { w.x = 0x7fc07fc0u; w.y = 0x7fc07fc0u; } *(u32x2v*)(xn + off + bj * HALF + n * 16) = w; }
                asm volatile("" ::: "memory"); }
    }
};

template <class Epi, class Sched, bool STAMP = false>
__device__ __forceinline__ void gemm_phase(PG8_LAS unsigned char* lds, const Gemm g, const Sched& S, const Epi& E, unsigned long long* stamps) {
    const int tid = threadIdx.x, wid = __builtin_amdgcn_readfirstlane(tid >> 6), lane = tid & 63, wr = wid >> 2, wc = wid & 3, fr = lane & 15, fq = lane >> 4;
    const int K = g.K, nt = K / BK;
    int ts_lo = 0, ts_hi = 0, nts = 0; const unsigned long long rt_entry = STAMP ? (unsigned long long)wall_clock64() : 0ull;
#define PG8_STAMP() do { if (STAMP && wid == 0 && nts < 64) { const unsigned long long _c = (unsigned long long)clock64(); \
        ts_lo = (lane == nts) ? (int)(unsigned)_c : ts_lo; ts_hi = (lane == nts) ? (int)(unsigned)(_c >> 32) : ts_hi; ++nts; } } while (0)
    PG8_STAMP();
    unsigned voffA[2], voffB[2];
#pragma unroll
    for (int i = 0; i < 2; ++i) { int R, C; stage_rc(tid * 16 + i * 8192, R, C); const int Rb = Epi::PERM ? ((R & ~31) + perm32(R & 31)) : R;
        voffA[i] = (unsigned)(R * K + C) * 2u; voffB[i] = (unsigned)(Rb * K + C) * 2u; }
    const size_t kstep = (size_t)(BK * 2);
    const size_t hstep = (size_t)HALF * K * 2;
    const size_t tstep = 2 * hstep;
    const unsigned ldsw = (unsigned)wid * 1024u;
    const int aoff = lds_byte(wr * 64 + fr, fq * 8), boff = lds_byte(wc * 32 + fr, fq * 8);
#define PG8_SA(b, h) (((b) * 2 + (h)) * HTB)
#define PG8_SB(b, h) ((4 + (b) * 2 + (h)) * HTB)
#define PG8_STAGE(bufoff, gbase, voff) do { _Pragma("unroll") for (int _i = 0; _i < 2; ++_i) \
        __builtin_amdgcn_global_load_lds((const unsigned*)((const char*)(gbase) + (voff)[_i]), (PG8_LAS unsigned*)(lds + (bufoff) + ldsw + _i * 8192), 16, 0, 0); } while (0)
#define PG8_LDA(dst, b, h) do { _Pragma("unroll") for (int m = 0; m < 4; ++m) _Pragma("unroll") for (int k = 0; k < 2; ++k) dst[m][k] = *(const PG8_LAS bf16x8*)(lds + PG8_SA(b, h) + aoff + m * 2048 + k * 1024); } while (0)
#define PG8_LDB(dst, b, h) do { _Pragma("unroll") for (int n = 0; n < 2; ++n) _Pragma("unroll") for (int k = 0; k < 2; ++k) dst[n][k] = *(const PG8_LAS bf16x8*)(lds + PG8_SB(b, h) + boff + n * 2048 + k * 1024); } while (0)
#define PG8_MMA(ai, bj, At, Bt) do { __builtin_amdgcn_s_setprio(1); _Pragma("unroll") for (int m = 0; m < 4; ++m) _Pragma("unroll") for (int n = 0; n < 2; ++n) _Pragma("unroll") for (int k = 0; k < 2; ++k) \
        acc[ai][bj][m][n] = __builtin_amdgcn_mfma_f32_16x16x32_bf16(Bt[n][k], At[m][k], acc[ai][bj][m][n], 0, 0, 0); __builtin_amdgcn_s_setprio(0); } while (0)
#define PG8_WAIT_V(n) asm volatile("s_waitcnt vmcnt(" #n ")" ::: "memory")
#define PG8_WAIT_L(n) asm volatile("s_waitcnt lgkmcnt(" #n ")" ::: "memory")
#define PG8_BAR __builtin_amdgcn_s_barrier()
#define PG8_SCHED __builtin_amdgcn_sched_barrier(0)
    Unit cur, nxt; int ui = 0;
    if (!S.next(0, cur)) return;
    f32x4 acc[2][2][4][2];
#pragma unroll
    for (int a = 0; a < 2; ++a)
#pragma unroll
        for (int b = 0; b < 2; ++b)
#pragma unroll
            for (int m = 0; m < 4; ++m)
#pragma unroll
                for (int n = 0; n < 2; ++n) acc[a][b][m][n] = (f32x4){0.f, 0.f, 0.f, 0.f};
    bf16x8 At[4][2], B0[2][2], B1[2][2];
    const char* cA = (const char*)g.A + (size_t)cur.pm * tstep; const char* cB = (const char*)g.Bt + (size_t)cur.pn * tstep;
    S.a_ready(cur);
    PG8_STAGE(PG8_SB(0, 0), cB, voffB); PG8_STAGE(PG8_SA(0, 0), cA, voffA); PG8_STAGE(PG8_SB(0, 1), cB + hstep, voffB); PG8_STAGE(PG8_SA(0, 1), cA + hstep, voffA);
    if (wr == 1) PG8_BAR;
    PG8_WAIT_V(4); PG8_BAR;
    PG8_STAGE(PG8_SB(1, 0), cB + kstep, voffB); PG8_STAGE(PG8_SA(1, 0), cA + kstep, voffA); PG8_STAGE(PG8_SB(1, 1), cB + hstep + kstep, voffB);
    PG8_WAIT_V(6); PG8_BAR;
    PG8_STAMP();
    for (;;) {
        const bool has_next = S.next(ui + 1, nxt);
        const char* nA = has_next ? (const char*)g.A + (size_t)nxt.pm * tstep : cA; const char* nB = has_next ? (const char*)g.Bt + (size_t)nxt.pn * tstep : cB;
        for (int t = 0; t < nt; t += 2) {
            const bool last = (t == nt - 2);
            const char* a1 = cA + (size_t)(t + 1) * kstep;
            const char* a2 = last ? nA : cA + (size_t)(t + 2) * kstep; const char* b2 = last ? nB : cB + (size_t)(t + 2) * kstep;
            const char* a3 = a2 + kstep; const char* b3 = b2 + kstep;
            if (last && has_next) S.a_ready(nxt);
            PG8_LDB(B0, 0, 0); PG8_SCHED; PG8_LDA(At, 0, 0); PG8_STAGE(PG8_SA(1, 1), a1 + hstep, voffA);
            PG8_WAIT_L(8); PG8_BAR; PG8_WAIT_L(0); PG8_MMA(0, 0, At, B0); PG8_BAR; PG8_SCHED;
            PG8_LDB(B1, 0, 1); PG8_STAGE(PG8_SB(0, 0), b2, voffB);
            PG8_BAR; PG8_WAIT_L(0); PG8_MMA(0, 1, At, B1); PG8_BAR;
            PG8_LDA(At, 0, 1); PG8_STAGE(PG8_SA(0, 0), a2, voffA);
            PG8_BAR; PG8_WAIT_L(0); PG8_MMA(1, 0, At, B0); PG8_BAR; PG8_SCHED;
            PG8_STAGE(PG8_SB(0, 1), b2 + hstep, voffB);
            PG8_WAIT_V(6); PG8_BAR; PG8_MMA(1, 1, At, B1); PG8_BAR;
            PG8_LDB(B0, 1, 0); PG8_SCHED; PG8_LDA(At, 1, 0); PG8_STAGE(PG8_SA(0, 1), a2 + hstep, voffA);
            PG8_WAIT_L(8); PG8_BAR; PG8_WAIT_L(0); PG8_MMA(0, 0, At, B0); PG8_BAR; PG8_SCHED;
            PG8_LDB(B1, 1, 1); PG8_STAGE(PG8_SB(1, 0), b3, voffB);
            PG8_BAR; PG8_WAIT_L(0); PG8_MMA(0, 1, At, B1); PG8_BAR;
            PG8_LDA(At, 1, 1); PG8_STAGE(PG8_SA(1, 0), a3, voffA);
            PG8_BAR; PG8_WAIT_L(0); PG8_MMA(1, 0, At, B0); PG8_BAR; PG8_SCHED;
            PG8_STAGE(PG8_SB(1, 1), b3 + hstep, voffB);
            PG8_WAIT_V(6); PG8_BAR; PG8_MMA(1, 1, At, B1); PG8_BAR;
        }
        PG8_STAMP();
        if constexpr (!Epi::AFTER_DRAIN) { E(acc, cur, wr, wc, fr, fq); S.done(cur); }
        PG8_STAMP();
        if (!has_next) break;
#pragma unroll
        for (int a = 0; a < 2; ++a)
#pragma unroll
            for (int b = 0; b < 2; ++b)
#pragma unroll
                for (int m = 0; m < 4; ++m)
#pragma unroll
                    for (int n = 0; n < 2; ++n) acc[a][b][m][n] = (f32x4){0.f, 0.f, 0.f, 0.f};
        cur = nxt; cA = nA; cB = nB; ++ui;
    }
    PG8_WAIT_V(0);
    if (wr == 0) PG8_BAR;
    PG8_BAR;
    if constexpr (Epi::AFTER_DRAIN) { E.fused(acc, cur, wr, wc, fr, fq, lds, wid, lane); S.done(cur); }
    PG8_STAMP();
    if (STAMP && wid == 0) { stamps[lane] = lane < nts ? (((unsigned long long)(unsigned)ts_hi << 32) | (unsigned)ts_lo) : 0ull;
        if (lane == 62) stamps[62] = rt_entry; if (lane == 63) stamps[63] = (unsigned long long)wall_clock64(); }
#undef PG8_STAMP
#undef PG8_SA
#undef PG8_SB
#undef PG8_STAGE
#undef PG8_LDA
#undef PG8_LDB
#undef PG8_MMA
#undef PG8_WAIT_V
#undef PG8_WAIT_L
#undef PG8_BAR
#undef PG8_SCHED
}
}

#include <hip/hip_cooperative_groups.h>
#include <cstdio>
namespace cg = cooperative_groups;
using pg8::bf16_t; using pg8::bf16x8; using pg8::f32x4; using pg8::Unit;
typedef float f32x16 __attribute__((ext_vector_type(16)));
typedef float f32x2 __attribute__((ext_vector_type(2)));
typedef unsigned u32x2 __attribute__((ext_vector_type(2)));
typedef unsigned u32x4v __attribute__((ext_vector_type(4)));
#define LAS __attribute__((address_space(3)))
#define XB_TMO      128
#define XB_XCNT(j)  (256  + 64 * (j))
#define XB_XSUB(j)  (1280 + 64 * (j))
#define XB_XGEN(j)  (2304 + 64 * (j))
#define XB_TOP      3328
#define XB_TOPGEN   3392
#define XCD_BAR_WORDS 3456
#define XB_SPIN_CAP (1u << 18)

__device__ __forceinline__ unsigned xb_ld(unsigned* p)              { return __hip_atomic_load(p, __ATOMIC_RELAXED, __HIP_MEMORY_SCOPE_AGENT); }
__device__ __forceinline__ unsigned xb_add(unsigned* p, unsigned v) { return __hip_atomic_fetch_add(p, v, __ATOMIC_RELAXED, __HIP_MEMORY_SCOPE_AGENT); }
__device__ __forceinline__ unsigned xb_xcc_id() { return (unsigned)__builtin_amdgcn_s_getreg((3 << 11) | 20) & 0xFu; }
#define XB_SPIN(cond, bar) do { unsigned _sp = 0; while (cond) { __builtin_amdgcn_s_sleep(1); \
    if ((++_sp & 255u) == 0u) { if (xb_ld(&(bar)[XB_TMO])) break; if (_sp > XB_SPIN_CAP) { atomicAdd(&(bar)[XB_TMO], 1u); break; } } } } while (0)

struct XcdBarrier {
    unsigned* bar; unsigned x;
    volatile LAS unsigned* st;
};

__device__ __forceinline__ XcdBarrier xcd_barrier_post(unsigned* bar, volatile LAS unsigned* st) {
    XcdBarrier b; b.bar = bar; b.x = xb_xcc_id(); b.st = st;
    if (threadIdx.x == 0) (void)xb_add(&bar[XB_XCNT(b.x)], 1u);
    return b;
}
__device__ __forceinline__ void xcd_barrier_complete(unsigned* bar, unsigned x, unsigned& nloc, unsigned& nx) {
    const unsigned G = gridDim.x * gridDim.y * gridDim.z;
    unsigned sum, cnt, mine, sp = 0u;
    for (;;) {
        sum = 0u; cnt = 0u; mine = 0u;
#pragma unroll
        for (unsigned j = 0; j < 16; ++j) { const unsigned c = xb_ld(&bar[XB_XCNT(j)]); sum += c; cnt += (c > 0u) ? 1u : 0u; mine = (j == x) ? c : mine; }
        if (sum == G) break;
        __builtin_amdgcn_s_sleep(1);
        if ((++sp & 255u) == 0u) { if (xb_ld(&bar[XB_TMO])) break; if (sp > XB_SPIN_CAP) { atomicAdd(&bar[XB_TMO], 1u); break; } }
    }
    nloc = mine > 0u ? mine : 1u; nx = cnt > 0u ? cnt : 1u;
}

__device__ __forceinline__ void xcd_barrier(const XcdBarrier& b) {
    asm volatile("s_waitcnt vmcnt(0)" ::: "memory");
    __syncthreads();
    if (threadIdx.x == 0) {
        unsigned* bar = b.bar;
        __builtin_amdgcn_s_waitcnt(0);
        unsigned nloc = b.st[0], nx = b.st[1];
        if (nloc == 0u) { xcd_barrier_complete(bar, b.x, nloc, nx); b.st[0] = nloc; b.st[1] = nx; }
        const unsigned old = xb_add(&bar[XB_XSUB(b.x)], 1u);
        const unsigned gen = old / nloc;
        if (old + 1u == (gen + 1u) * nloc) {
            __builtin_amdgcn_fence(__ATOMIC_RELEASE, "agent");
            asm volatile("s_waitcnt vmcnt(0)" ::: "memory");
            const unsigned og = xb_add(&bar[XB_TOP], 1u);
            const unsigned tg = og / nx;
            if (og + 1u == (tg + 1u) * nx) xb_add(&bar[XB_TOPGEN], 1u);
            else XB_SPIN(xb_ld(&bar[XB_TOPGEN]) == tg, bar);
            __builtin_amdgcn_fence(__ATOMIC_ACQUIRE, "agent");
            xb_add(&bar[XB_XGEN(b.x)], 1u);
            asm volatile("s_waitcnt vmcnt(0)" ::: "memory");
        } else {
            XB_SPIN(xb_ld(&bar[XB_XGEN(b.x)]) == gen, bar);
            __builtin_amdgcn_fence(__ATOMIC_ACQUIRE, "agent");
            asm volatile("s_waitcnt vmcnt(0)" ::: "memory");
        }
    }
    __syncthreads();
}

constexpr int MT = 16896, MPR = 16384, DM = 1024, NIN = 2816, DFF = 2816;
constexpr float EPS = 1e-6f;
constexpr int LDS_BYTES = 143360;
#ifndef N_LAUNCH_MODE
#define N_LAUNCH_MODE 1
#endif
constexpr int NPHASE = 13;
#ifndef EXTRA_LO
#define EXTRA_LO 0
#endif
#ifndef EXTRA_FLAGS
#define EXTRA_FLAGS 0
#endif
#ifndef EXTRA_HI
#define EXTRA_HI 0
#endif

constexpr size_t WS_WIN = 0;
constexpr size_t WS_WOUT = WS_WIN + (size_t)2816 * 1024 * 2;
constexpr size_t WS_WQ = WS_WOUT + (size_t)1024 * 1024 * 2;
constexpr size_t WS_WKV = WS_WQ + (size_t)1024 * 1024 * 2;
constexpr size_t WS_WO = WS_WKV + (size_t)2048 * 1024 * 2;
constexpr size_t WS_WGU = WS_WO + (size_t)1024 * 1024 * 2;
constexpr size_t WS_WD = WS_WGU + (size_t)5632 * 1024 * 2;
constexpr size_t WS_A = WS_WD + (size_t)1024 * 2816 * 2;
constexpr size_t WS_MN = WS_A + (size_t)MT * 1024 * 2;
constexpr size_t WS_MKB = WS_MN + (size_t)2048 * 1024 * 2;
constexpr size_t WS_MVT = WS_MKB + (size_t)2048 * 1024 * 2;
constexpr size_t WS_P = WS_MVT + (size_t)2048 * 1024 * 2;
constexpr size_t WS_U = WS_P + (size_t)MT * 2816 * 2;
constexpr size_t WS_DS = WS_U;
constexpr size_t WS_ST = WS_DS + (size_t)1024 * 8192 * 4;
constexpr size_t WS_AF = WS_ST + (size_t)1024 * 8192 * 2;
constexpr size_t WS_DEC = WS_AF + (size_t)MT * 16 * 4;
constexpr size_t WS_H = WS_U + (size_t)MT * 2816 * 2;
constexpr size_t WS_HB = WS_H + (size_t)MT * 1024 * 4;
constexpr size_t WS_SSQ = WS_HB + (size_t)MT * 1024 * 2;
constexpr size_t WS_SSQS = WS_SSQ + (size_t)3 * MT * 16 * 4;
constexpr size_t WS_BAR = WS_SSQS + (size_t)3 * 512 * 64 * 4;
constexpr size_t WS_GX = WS_BAR + (size_t)2 * XCD_BAR_WORDS * 4;
constexpr size_t WS_UX = WS_GX + (size_t)256 * 4 * 2816 * 4;
constexpr size_t WS_END = WS_UX + (size_t)256 * 2 * 2816 * 4;

constexpr size_t O_Y = 0;
constexpr size_t O_SGP = 17301504;
constexpr size_t O_SCP = 17563648;
constexpr size_t O_MK = 17608704;
constexpr size_t O_MV = 19705856;
constexpr size_t O_SGS = 21803008;
constexpr size_t O_SCS = 25997312;
constexpr size_t O_SV = 26718208;

struct Params { const float* in[29]; float* out; unsigned char* ws; int ph_lo, ph_hi, bar_region, pad; };

__device__ __forceinline__ unsigned pk2(float lo, float hi) { return pg8::cvt_pk_bf16(lo, hi); }
__device__ __forceinline__ bf16_t f2bf(float f) { return (bf16_t)(pk2(f, 0.f) & 0xffffu); }
__device__ __forceinline__ float bf2f(bf16_t b) { return __uint_as_float(((unsigned)b) << 16); }
__device__ __forceinline__ float bflo(unsigned w) { return __uint_as_float(w << 16); }
__device__ __forceinline__ float bfhi(unsigned w) { return __uint_as_float(w & 0xffff0000u); }
__device__ __forceinline__ float gelu_t(float x) { const float t = __builtin_fmaf(x * x, 0.044715f, 1.0f); const float e = __builtin_amdgcn_exp2f(x * t * -2.3022082f); return x * __builtin_amdgcn_rcpf(1.0f + e); }
__device__ __forceinline__ float silu_f(float x) { return x * __builtin_amdgcn_rcpf(1.0f + __builtin_amdgcn_exp2f(x * -1.44269504f)); }
__device__ __forceinline__ float logsig(float z) { return fminf(z, 0.f) - __logf(1.0f + __expf(-fabsf(z))); }
template <int CTRL> __device__ __forceinline__ float dppr(float x) { return __builtin_bit_cast(float, __builtin_amdgcn_update_dpp(0, __builtin_bit_cast(int, x), CTRL, 0xf, 0xf, true)); }
__device__ __forceinline__ float row_sum16(float s) { s += dppr<0x128>(s); s += dppr<0x124>(s); s += dppr<0x122>(s); s += dppr<0x121>(s); return s; }
__device__ __forceinline__ float wave_sum(float s) { s = row_sum16(s); s += __shfl_xor(s, 16); s += __shfl_xor(s, 32); return s; }
__device__ __forceinline__ float wave_max(float s) { for (int o = 32; o >= 1; o >>= 1) s = fmaxf(s, __shfl_xor(s, o)); return s; }
__device__ __forceinline__ f32x16 mma32(bf16x8 a, bf16x8 b, f32x16 c) { return __builtin_amdgcn_mfma_f32_32x32x16_bf16(a, b, c, 0, 0, 0); }
__device__ __forceinline__ f32x16 zero16() { f32x16 z; for (int i = 0; i < 16; ++i) z[i] = 0.f; return z; }
__device__ __forceinline__ float row_rs(const float* ssq, int row) {
    const f32x4* p = (const f32x4*)(ssq + (size_t)row * 16); f32x4 a = p[0], b = p[1], c = p[2], d = p[3];
    const float s = ((a[0] + a[1]) + (a[2] + a[3])) + ((b[0] + b[1]) + (b[2] + b[3])) + ((c[0] + c[1]) + (c[2] + c[3])) + ((d[0] + d[1]) + (d[2] + d[3]));
    return rsqrtf(s * (1.0f / 1024.0f) + EPS);
}

__device__ __forceinline__ float row_rs64(const float* ssq64, int r) {
    const f32x4* p = (const f32x4*)(ssq64 + (size_t)r * 64); float s = 0.f;
#pragma unroll
    for (int i = 0; i < 16; ++i) { const f32x4 a = p[i]; s += (a[0] + a[1]) + (a[2] + a[3]); }
    return rsqrtf(s * (1.0f / 1024.0f) + EPS);
}
__device__ __forceinline__ float row_rs2(const float* ssq16, const float* ssq64, int row) { return row < MPR ? row_rs(ssq16, row) : row_rs64(ssq64, row - MPR); }
template <int KC, class F>
__device__ __forceinline__ void gemm_small(const bf16_t* A, const bf16_t* Bt, int K, int ncb, LAS unsigned char* lds, F f) {
    constexpr int PITCH = KC * 2 + 16, PPR = KC / 8, NP = 96 * PPR, NPT = (NP + 511) / 512, BUF = 96 * PITCH; static_assert(KC % 32 == 0 && 2 * BUF <= 140000, "KC must be a multiple of the MFMA K; two buffers must fit");
    const int tid = threadIdx.x, lane = tid & 63, wave = tid >> 6, fr = lane & 15, fq = lane >> 4;
    for (int t = blockIdx.x; t < 16 * ncb; t += gridDim.x) { const int rb = t & 15, cb = t >> 4;
        f32x4 acc = (f32x4){0.f, 0.f, 0.f, 0.f};
        u32x4v v[NPT]; const bf16_t* src[NPT]; int dsto[NPT];
#pragma unroll
        for (int i = 0; i < NPT; ++i) { const int idx = tid + 512 * i, row = idx / PPR, pc = idx % PPR;
            src[i] = (row < 32 ? A + (size_t)(rb * 32 + row) * K : Bt + (size_t)(cb * 64 + row - 32) * K) + pc * 8; dsto[i] = row * PITCH + pc * 16;
            if (idx < NP) v[i] = *(const u32x4v*)(src[i]); }
        int buf = 0;
        for (int k0 = 0; k0 < K; k0 += KC) {
            LAS unsigned char* L = lds + buf * BUF;
#pragma unroll
            for (int i = 0; i < NPT; ++i) { const int idx = tid + 512 * i; if (idx < NP) *(LAS u32x4v*)(L + dsto[i]) = v[i]; }
            __syncthreads();
            if (k0 + KC < K) {
#pragma unroll
                for (int i = 0; i < NPT; ++i) { const int idx = tid + 512 * i; if (idx < NP) v[i] = *(const u32x4v*)(src[i] + k0 + KC); } }
            const LAS unsigned char* ap = L + ((wave & 1) * 16 + fr) * PITCH + fq * 16; const LAS unsigned char* bp = L + (32 + (wave >> 1) * 16 + fr) * PITCH + fq * 16;
#pragma unroll
            for (int k = 0; k < KC; k += 32) { const bf16x8 av = *(const LAS bf16x8*)(ap + k * 2); const bf16x8 bv = *(const LAS bf16x8*)(bp + k * 2);
                acc = __builtin_amdgcn_mfma_f32_16x16x32_bf16(bv, av, acc, 0, 0, 0); }
            buf ^= 1;
            __syncthreads();
        }
        __syncthreads();
        f(rb * 32 + (wave & 1) * 16 + fr, cb * 64 + (wave >> 1) * 16 + 4 * fq, cb * 4 + (wave >> 1), fq, acc);
    }
}
#define EPI_LOOP_ROWS for (int ai = 0; ai < 2; ++ai) _Pragma("unroll") for (int m = 0; m < 4; ++m)
__device__ __forceinline__ u32x4v pack8(const f32x4 a, const f32x4 c) { u32x4v w; w.x = pk2(a[0], a[1]); w.y = pk2(a[2], a[3]); w.z = pk2(c[0], c[1]); w.w = pk2(c[2], c[3]); return w; }
__device__ __forceinline__ float sq4(const f32x4 v) { return (v[0] * v[0] + v[1] * v[1]) + (v[2] * v[2] + v[3] * v[3]); }
template <int CTRL> __device__ __forceinline__ float dpp_f(float x) { return __builtin_bit_cast(float, __builtin_amdgcn_update_dpp(0, __builtin_bit_cast(int, x), CTRL, 0xf, 0xf, true)); }
template <int CTRL> __device__ __forceinline__ f32x4 dpp4(const f32x4 v) { return (f32x4){dpp_f<CTRL>(v[0]), dpp_f<CTRL>(v[1]), dpp_f<CTRL>(v[2]), dpp_f<CTRL>(v[3])}; }
__device__ __forceinline__ f32x4 gelu4(const f32x4 v) { return (f32x4){gelu_t(v[0]), gelu_t(v[1]), gelu_t(v[2]), gelu_t(v[3])}; }
__device__ __forceinline__ void rs_rows8(float (&rsv)[2][4], const float* ssq, int row0, int fq) {
    f32x4 q[2][4];
#pragma unroll
    for (int ai = 0; ai < 2; ++ai)
#pragma unroll
        for (int m = 0; m < 4; ++m) q[ai][m] = *(const f32x4*)(ssq + (size_t)(row0 + ai * 128 + m * 16) * 16 + 4 * fq);
#pragma unroll
    for (int ai = 0; ai < 2; ++ai)
#pragma unroll
        for (int m = 0; m < 4; ++m) { float t = (q[ai][m][0] + q[ai][m][1]) + (q[ai][m][2] + q[ai][m][3]); t += __shfl_xor(t, 16); t += __shfl_xor(t, 32); rsv[ai][m] = rsqrtf(t * (1.0f / 1024.0f) + EPS); }
}
__device__ __forceinline__ void rs_rows8_s(float (&rsv)[2][4], const float* ssq64, int r0, int fq) {
#pragma unroll
    for (int ai = 0; ai < 2; ++ai) { f32x4 q[4][4];
#pragma unroll
        for (int m = 0; m < 4; ++m) { const f32x4* pp = (const f32x4*)(ssq64 + (size_t)(r0 + ai * 128 + m * 16) * 64 + 16 * fq); q[m][0] = pp[0]; q[m][1] = pp[1]; q[m][2] = pp[2]; q[m][3] = pp[3]; }
#pragma unroll
        for (int m = 0; m < 4; ++m) { const f32x4 v = (q[m][0] + q[m][1]) + (q[m][2] + q[m][3]); float t = (v[0] + v[1]) + (v[2] + v[3]); t += __shfl_xor(t, 16); t += __shfl_xor(t, 32); rsv[ai][m] = rsqrtf(t * (1.0f / 1024.0f) + EPS); } }
}
struct EpiIn {
    static constexpr bool PERM = true, AFTER_DRAIN = false;
    bf16_t* P; float* af;
    __device__ __forceinline__ void operator()(const f32x4 (&acc)[2][2][4][2], const Unit& u, int wr, int wc, int fr, int fq) const {
        const int row0 = u.pm * 256 + wr * 64 + fr, col0 = u.pn * 256 + wc * 32 + 8 * fq;
#pragma unroll
        EPI_LOOP_ROWS { const int row = row0 + ai * 128 + m * 16;
#pragma unroll
            for (int bj = 0; bj < 2; ++bj) *(u32x4v*)(P + (size_t)row * NIN + col0 + bj * 128) = pack8(acc[ai][bj][m][0], acc[ai][bj][m][1]);
        }
    }
};
struct EpiKV {
    static constexpr bool PERM = true, AFTER_DRAIN = false;
    float* omk; float* omv; bf16_t* mkb; bf16_t* mvt;
    __device__ __forceinline__ void operator()(const f32x4 (&acc)[2][2][4][2], const Unit& u, int wr, int wc, int fr, int fq) const {
        const int row0 = u.pm * 256 + wr * 64 + fr, col0 = u.pn * 256 + wc * 32 + 8 * fq;
#pragma unroll
        EPI_LOOP_ROWS { const int row = row0 + ai * 128 + m * 16;
#pragma unroll
            for (int bj = 0; bj < 2; ++bj) { const f32x4 v0 = acc[ai][bj][m][0], v1 = acc[ai][bj][m][1]; const int col = col0 + bj * 128;
                if (col < 1024) { float* o = omk + (size_t)row * 1024 + col; *(f32x4*)o = v0; *(f32x4*)(o + 4) = v1; *(u32x4v*)(mkb + (size_t)row * 1024 + col) = pack8(v0, v1); }
                else { const int c2 = col - 1024; float* o = omv + (size_t)row * 1024 + c2; *(f32x4*)o = v0; *(f32x4*)(o + 4) = v1;
                    const int b = row >> 8, mt = row & 255, h = c2 >> 8, d = c2 & 255; bf16_t* t = mvt + ((size_t)(b * 4 + h) * 256 + d) * 256 + mt;
                    t[0] = f2bf(v0[0]); t[256] = f2bf(v0[1]); t[512] = f2bf(v0[2]); t[768] = f2bf(v0[3]); t[1024] = f2bf(v1[0]); t[1280] = f2bf(v1[1]); t[1536] = f2bf(v1[2]); t[1792] = f2bf(v1[3]); } }
        }
    }
};
__device__ __forceinline__ void unpack8(const u32x4v w, f32x4& a, f32x4& c) { a = (f32x4){bflo(w.x), bfhi(w.x), bflo(w.y), bfhi(w.y)}; c = (f32x4){bflo(w.z), bfhi(w.z), bflo(w.w), bfhi(w.w)}; }
struct EpiRes {
    static constexpr bool PERM = true, AFTER_DRAIN = false;
    const float* xf; bf16_t* hb; float* ssq;
    __device__ __forceinline__ void operator()(const f32x4 (&acc)[2][2][4][2], const Unit& u, int wr, int wc, int fr, int fq) const {
        const int row0 = u.pm * 256 + wr * 64 + fr, col0 = u.pn * 256 + wc * 32 + 8 * fq;
#pragma unroll
        for (int h2 = 0; h2 < 4; ++h2) { const int ai = h2 >> 1, mb = (h2 & 1) * 2;
            f32x4 bs[2][2][2];
            if (xf) {
#pragma unroll
                for (int mm = 0; mm < 2; ++mm)
#pragma unroll
                    for (int bj = 0; bj < 2; ++bj) { const float* pb = xf + (size_t)(row0 + ai * 128 + (mb + mm) * 16) * 1024 + col0 + bj * 128; bs[mm][bj][0] = *(const f32x4*)pb; bs[mm][bj][1] = *(const f32x4*)(pb + 4); }
            } else { u32x4v raw[2][2];
#pragma unroll
                for (int mm = 0; mm < 2; ++mm)
#pragma unroll
                    for (int bj = 0; bj < 2; ++bj) raw[mm][bj] = *(const u32x4v*)(hb + (size_t)(row0 + ai * 128 + (mb + mm) * 16) * 1024 + col0 + bj * 128);
#pragma unroll
                for (int mm = 0; mm < 2; ++mm)
#pragma unroll
                    for (int bj = 0; bj < 2; ++bj) unpack8(raw[mm][bj], bs[mm][bj][0], bs[mm][bj][1]); }
#pragma unroll
            for (int mm = 0; mm < 2; ++mm) { const int m = mb + mm, row = row0 + ai * 128 + m * 16; float s = 0.f;
#pragma unroll
                for (int bj = 0; bj < 2; ++bj) { const f32x4 v0 = acc[ai][bj][m][0] + bs[mm][bj][0], v1 = acc[ai][bj][m][1] + bs[mm][bj][1];
                    *(u32x4v*)(hb + (size_t)row * 1024 + col0 + bj * 128) = pack8(v0, v1); s += sq4(v0) + sq4(v1); }
                s += __shfl_xor(s, 16); s += __shfl_xor(s, 32);
                if (fq == 0) ssq[(size_t)row * 16 + u.pn * 4 + wc] = s; }
        }
    }
};
#define RLXA __ATOMIC_RELAXED, __HIP_MEMORY_SCOPE_AGENT
__device__ __forceinline__ void ld_coh16x4(f32x4& a, f32x4& b_, f32x4& c, f32x4& d, const float* pa, const float* pb, const float* pc, const float* pd) {
    asm volatile("global_load_dwordx4 %0, %4, off sc1\n\tglobal_load_dwordx4 %1, %5, off sc1\n\tglobal_load_dwordx4 %2, %6, off sc1\n\tglobal_load_dwordx4 %3, %7, off sc1\n\ts_waitcnt vmcnt(0)"
                 : "=&v"(a), "=&v"(b_), "=&v"(c), "=&v"(d) : "v"(pa), "v"(pb), "v"(pc), "v"(pd) : "memory");
}
__device__ __forceinline__ void spin_poll(unsigned* cnt, unsigned want) {
    unsigned sp = 0; while ((unsigned)__builtin_amdgcn_readfirstlane(__hip_atomic_load(cnt, RLXA)) < want) { __builtin_amdgcn_s_sleep(2); if (++sp > (1u << 22)) break; }
}
__device__ __forceinline__ void wg_wait2(unsigned* c1, unsigned w1, unsigned* c2, unsigned w2) {
    if (threadIdx.x < 64) { spin_poll(c1, w1); if (c2) spin_poll(c2, w2); __builtin_amdgcn_fence(__ATOMIC_ACQUIRE, "agent"); asm volatile("s_waitcnt vmcnt(0)" ::: "memory"); }
    __syncthreads();
}
struct EpiFin {
    static constexpr bool PERM = true, AFTER_DRAIN = true;
    const bf16_t* hb; float* ssq; unsigned* cnt; const float* gfin; float* out; int flags;
    const bf16_t* sA; const bf16_t* sBt; float* ssq64;
    __device__ __forceinline__ void fused(f32x4 (&acc)[2][2][4][2], const Unit& u, int wr, int wc, int fr, int fq, LAS unsigned char* lds_, int wid_, int lane_) const {
        const int row0 = u.pm * 256 + wr * 64 + fr, col0 = u.pn * 256 + wc * 32 + 8 * fq;
#pragma unroll
        for (int ai = 0; ai < 2; ++ai) { u32x4v raw[4][2];
#pragma unroll
            for (int m = 0; m < 4; ++m)
#pragma unroll
                for (int bj = 0; bj < 2; ++bj) raw[m][bj] = *(const u32x4v*)(hb + (size_t)(row0 + ai * 128 + m * 16) * 1024 + col0 + bj * 128);
#pragma unroll
            for (int m = 0; m < 4; ++m) { const int row = row0 + ai * 128 + m * 16; float s = 0.f;
#pragma unroll
                for (int bj = 0; bj < 2; ++bj) { f32x4 b0, b1; unpack8(raw[m][bj], b0, b1);
                    acc[ai][bj][m][0] += b0; acc[ai][bj][m][1] += b1; s += sq4(acc[ai][bj][m][0]) + sq4(acc[ai][bj][m][1]); }
                s += __shfl_xor(s, 16); s += __shfl_xor(s, 32);
                if (fq == 0) __hip_atomic_store((unsigned*)(ssq + (size_t)row * 16 + u.pn * 4 + wc), __float_as_uint(s), RLXA); }
        }
        asm volatile("s_waitcnt vmcnt(0)" ::: "memory");
        if ((threadIdx.x & 63) == 0) __hip_atomic_fetch_add(cnt + u.pm, 1u, RLXA);
        f32x4 sv = (f32x4){0.f, 0.f, 0.f, 0.f}; int sr = -1, sc = 0; unsigned* scw = cnt;
        { const bf16_t* hbs = hb + (size_t)MPR * 1024; float* sq = ssq64; unsigned* cnt2 = cnt + 64;
          gemm_small<256>(sA, sBt, 2816, 16, lds_, [&](int r, int c, int cb, int fq2, f32x4 a) {
              const size_t off = (size_t)r * 1024 + c; const u32x2 hw = *(const u32x2*)(hbs + off); const f32x4 v = a + (f32x4){bflo(hw.x), bfhi(hw.x), bflo(hw.y), bfhi(hw.y)};
              float s = sq4(v); s += __shfl_xor(s, 16); s += __shfl_xor(s, 32); if (fq2 == 0) __hip_atomic_store((unsigned*)(sq + (size_t)r * 64 + cb), __float_as_uint(s), RLXA);
              asm volatile("s_waitcnt vmcnt(0)" ::: "memory");
              scw = cnt2 + (r >> 5); if ((threadIdx.x & 63) == 0) __hip_atomic_fetch_add(scw, 1u, RLXA);
              sv = v; sr = r; sc = c; }); }
        wg_wait2(cnt + u.pm, 32u, sr >= 0 ? scw : nullptr, 128u);
        f32x4 g[2][2];
#pragma unroll
        for (int bj = 0; bj < 2; ++bj) { g[bj][0] = *(const f32x4*)(gfin + col0 + bj * 128); g[bj][1] = *(const f32x4*)(gfin + col0 + bj * 128 + 4); }
        f32x4 pq[2][4];
#pragma unroll
        for (int ai = 0; ai < 2; ++ai) { const float* b0 = ssq + (size_t)(row0 + ai * 128) * 16 + 4 * fq; ld_coh16x4(pq[ai][0], pq[ai][1], pq[ai][2], pq[ai][3], b0, b0 + 16 * 16, b0 + 32 * 16, b0 + 48 * 16); }
#pragma unroll
        EPI_LOOP_ROWS { const int row = row0 + ai * 128 + m * 16; const f32x4 q4 = pq[ai][m];
            float s = (q4[0] + q4[1]) + (q4[2] + q4[3]);
            s += __shfl_xor(s, 16); s += __shfl_xor(s, 32); const float rs = rsqrtf(s * (1.0f / 1024.0f) + EPS);
#pragma unroll
            for (int bj = 0; bj < 2; ++bj) { float* o = out + (size_t)row * 1024 + col0 + bj * 128; *(f32x4*)o = acc[ai][bj][m][0] * rs * g[bj][0]; *(f32x4*)(o + 4) = acc[ai][bj][m][1] * rs * g[bj][1]; }
        }
        if (sr >= 0) {

            const float* sp = ssq64 + (size_t)sr * 64 + 16 * fq; f32x4 q0, q1, q2, q3; ld_coh16x4(q0, q1, q2, q3, sp, sp + 4, sp + 8, sp + 12);
            const f32x4 qs = (q0 + q1) + (q2 + q3); float t = (qs[0] + qs[1]) + (qs[2] + qs[3]);
            t += __shfl_xor(t, 16); t += __shfl_xor(t, 32); const float rs = rsqrtf(t * (1.0f / 1024.0f) + EPS);
            *(f32x4*)(out + (size_t)(MPR + sr) * 1024 + sc) = sv * rs * *(const f32x4*)(gfin + sc);
        }
    }
};
struct EpiQ {
    static constexpr bool PERM = true, AFTER_DRAIN = false;
    bf16_t* Q; const float* ssq;
    __device__ __forceinline__ void operator()(const f32x4 (&acc)[2][2][4][2], const Unit& u, int wr, int wc, int fr, int fq) const {
        const int row0 = u.pm * 256 + wr * 64 + fr, col0 = u.pn * 256 + wc * 32 + 8 * fq;
        float rsv[2][4]; rs_rows8(rsv, ssq, row0, fq);
#pragma unroll
        EPI_LOOP_ROWS { const int row = row0 + ai * 128 + m * 16; const float rs = rsv[ai][m];
#pragma unroll
            for (int bj = 0; bj < 2; ++bj) *(u32x4v*)(Q + (size_t)row * 1024 + col0 + bj * 128) = pack8(acc[ai][bj][m][0] * rs, acc[ai][bj][m][1] * rs);
        }
    }
};
struct EpiGU {
    static constexpr bool PERM = true, AFTER_DRAIN = false;
    bf16_t* U; const float* ssq; const float* ssq64; float* scp; float* scs; const float* cw; const float* cbias; const float* sconv; float* GX; float* UX; int flags;
    __device__ __forceinline__ void operator()(const f32x4 (&acc)[2][2][4][2], const Unit& u, int wr, int wc, int fr, int fq) const {
        const int row0 = u.pm * 256 + wr * 64 + fr, ch0 = u.pn * 128 + wc * 32 + 8 * fq;
        if (flags & 48) {
            if (flags & 16) {
#pragma unroll
                EPI_LOOP_ROWS { const int row = row0 + ai * 128 + m * 16; *(u32x4v*)(U + (size_t)row * DFF + ch0) = pack8(acc[ai][0][m][0] * acc[ai][1][m][0], acc[ai][0][m][1] * acc[ai][1][m][1]); } }
            return; }
        float rsv[2][4]; if (u.pm < 64) rs_rows8(rsv, ssq, row0, fq); else rs_rows8_s(rsv, ssq64, row0 - MPR, fq);
        f32x4 w0[2], w1[2], w2[2], bb[2];
#pragma unroll
        for (int n = 0; n < 2; ++n) { w0[n] = *(const f32x4*)(cw + ch0 + 4 * n); w1[n] = *(const f32x4*)(cw + DFF + ch0 + 4 * n); w2[n] = *(const f32x4*)(cw + 2 * DFF + ch0 + 4 * n); bb[n] = *(const f32x4*)(cbias + ch0 + 4 * n); }
        if (u.pm < 64) {
#pragma unroll
            for (int ai = 0; ai < 2; ++ai) { f32x4 pr1[2], pr2[2];
#pragma unroll
                for (int n = 0; n < 2; ++n) { pr1[n] = (f32x4){0.f, 0.f, 0.f, 0.f}; pr2[n] = pr1[n]; }
#pragma unroll
                for (int m = 0; m < 4; ++m) { const int row = row0 + ai * 128 + m * 16; const float rs = rsv[ai][m]; const int t = row & 2047, t6 = row & 63;
                    f32x4 a[2];
#pragma unroll
                    for (int n = 0; n < 2; ++n) { const f32x4 g = acc[ai][0][m][n] * rs, up = acc[ai][1][m][n] * rs; const f32x4 r1 = dpp4<0x121>(g), r2 = dpp4<0x122>(g);
                        const f32x4 p1 = fr >= 1 ? r1 : pr1[n], p2 = fr >= 2 ? r2 : pr2[n]; pr1[n] = r1; pr2[n] = r2;
                        a[n] = gelu4(bb[n] + w0[n] * p2 + w1[n] * p1 + w2[n] * g) * up;
                        if (t >= 2046) *(f32x4*)(scp + (size_t)((row >> 11) * 2 + (t - 2046)) * DFF + ch0 + 4 * n) = g;
                        if (t6 < 2) { *(f32x4*)(GX + ((size_t)(row >> 6) * 4 + t6) * DFF + ch0 + 4 * n) = g; *(f32x4*)(UX + ((size_t)(row >> 6) * 2 + t6) * DFF + ch0 + 4 * n) = up; }
                        if (t6 >= 62) *(f32x4*)(GX + ((size_t)(row >> 6) * 4 + (t6 - 60)) * DFF + ch0 + 4 * n) = g; }
                    *(u32x4v*)(U + (size_t)row * DFF + ch0) = pack8(a[0], a[1]); } }
        } else {
            const int tt = fr & 3;
#pragma unroll
            EPI_LOOP_ROWS { const int row = row0 + ai * 128 + m * 16, r2i = row - MPR, bq = r2i >> 2; const float rs = rsv[ai][m];
                f32x4 a[2];
#pragma unroll
                for (int n = 0; n < 2; ++n) { const f32x4 g = acc[ai][0][m][n] * rs, up = acc[ai][1][m][n] * rs; const f32x4 r1 = dpp4<0x121>(g), r2 = dpp4<0x122>(g);
                    f32x4 p1 = r1, p2 = r2;
                    if (tt < 2) { const f32x4 s1 = *(const f32x4*)(sconv + (size_t)(bq * 2 + 1) * DFF + ch0 + 4 * n); if (tt == 0) { p1 = s1; p2 = *(const f32x4*)(sconv + (size_t)(bq * 2) * DFF + ch0 + 4 * n); } else p2 = s1; }
                    a[n] = gelu4(bb[n] + w0[n] * p2 + w1[n] * p1 + w2[n] * g) * up;
                    if (tt >= 2) *(f32x4*)(scs + (size_t)(bq * 2 + (tt - 2)) * DFF + ch0 + 4 * n) = g; }
                *(u32x4v*)(U + (size_t)row * DFF + ch0) = pack8(a[0], a[1]); }
        }
    }
};
__device__ __forceinline__ void act_fixup(const Params& p, int pm) {
    const float* GX = (const float*)(p.ws + WS_GX); const float* UX = (const float*)(p.ws + WS_UX); bf16_t* U = (bf16_t*)(p.ws + WS_U); const float* cw = p.in[25]; const float* cbias = p.in[26];
    for (int i0 = threadIdx.x; i0 < 4 * 704; i0 += 1024) {
        f32x4 w0[2], w1[2], w2[2], bb[2], g0[2], g1[2], u0[2], u1[2], gm2[2], gm1[2]; int t0v[2], chv[2]; bool ok[2];
#pragma unroll
        for (int k = 0; k < 2; ++k) { const int i = i0 + 512 * k; ok[k] = i < 4 * 704; const int ii = ok[k] ? i : i0; const int q = ii / 704, ch = (ii % 704) * 4, blk = pm * 4 + q, t0 = blk * 64; t0v[k] = t0; chv[k] = ch;
            w0[k] = *(const f32x4*)(cw + ch); w1[k] = *(const f32x4*)(cw + DFF + ch); w2[k] = *(const f32x4*)(cw + 2 * DFF + ch); bb[k] = *(const f32x4*)(cbias + ch);
            g0[k] = *(const f32x4*)(GX + ((size_t)blk * 4 + 0) * DFF + ch); g1[k] = *(const f32x4*)(GX + ((size_t)blk * 4 + 1) * DFF + ch);
            u0[k] = *(const f32x4*)(UX + ((size_t)blk * 2 + 0) * DFF + ch); u1[k] = *(const f32x4*)(UX + ((size_t)blk * 2 + 1) * DFF + ch);
            gm2[k] = (f32x4){0.f, 0.f, 0.f, 0.f}; gm1[k] = gm2[k];
            if ((t0 & 2047) != 0) { gm2[k] = *(const f32x4*)(GX + ((size_t)(blk - 1) * 4 + 2) * DFF + ch); gm1[k] = *(const f32x4*)(GX + ((size_t)(blk - 1) * 4 + 3) * DFF + ch); } }
#pragma unroll
        for (int k = 0; k < 2; ++k) if (ok[k]) {
            const f32x4 a0 = gelu4(bb[k] + w0[k] * gm2[k] + w1[k] * gm1[k] + w2[k] * g0[k]) * u0[k], a1 = gelu4(bb[k] + w0[k] * gm1[k] + w1[k] * g0[k] + w2[k] * g1[k]) * u1[k];
            u32x2 o0, o1; o0.x = pk2(a0[0], a0[1]); o0.y = pk2(a0[2], a0[3]); o1.x = pk2(a1[0], a1[1]); o1.y = pk2(a1[2], a1[3]);
            *(u32x2*)(U + (size_t)t0v[k] * DFF + chv[k]) = o0; *(u32x2*)(U + (size_t)(t0v[k] + 1) * DFF + chv[k]) = o1; }
    }
}

__device__ __forceinline__ int win_src_col(int n) { return n < 1536 ? n : (n < 2560 ? n + 16 : (n < 2576 ? n - 1024 : -1)); }
__device__ __forceinline__ void tr_strip(LAS float* T, const float* src, int ldn, bf16_t* dst, int K, int k0, int n0, const float* ksc, bool cmap, int rmode) {
    const int tid = threadIdx.x;
    f32x4 v[8];
    { const int n4 = (tid & 63) * 4; int sc = n0 + n4; if (cmap) sc = win_src_col(sc);
#pragma unroll
      for (int i = 0; i < 8; ++i) { const int kk = (tid >> 6) + 8 * i; v[i] = (f32x4){0.f, 0.f, 0.f, 0.f}; if (sc >= 0) v[i] = *(const f32x4*)(src + (size_t)(k0 + kk) * ldn + sc); }
#pragma unroll
      for (int i = 0; i < 8; ++i) { const int kk = (tid >> 6) + 8 * i; f32x4 w = v[i]; if (ksc) w = w * ksc[k0 + kk];
          T[kk * 257 + n4] = w[0]; T[kk * 257 + n4 + 1] = w[1]; T[kk * 257 + n4 + 2] = w[2]; T[kk * 257 + n4 + 3] = w[3]; } }
    __syncthreads();
    { const int n = tid >> 1, kh = (tid & 1) * 32;
#pragma unroll
      for (int q = 0; q < 4; ++q) { const int kb = kh + q * 8; u32x4v w;
          w.x = pk2(T[(kb + 0) * 257 + n], T[(kb + 1) * 257 + n]); w.y = pk2(T[(kb + 2) * 257 + n], T[(kb + 3) * 257 + n]);
          w.z = pk2(T[(kb + 4) * 257 + n], T[(kb + 5) * 257 + n]); w.w = pk2(T[(kb + 6) * 257 + n], T[(kb + 7) * 257 + n]);
          const int nn = n0 + n, drow = rmode ? ((nn >> 7) * 256 + (rmode == 2 ? 128 : 0) + (nn & 127)) : nn;
          *(u32x4v*)(dst + (size_t)drow * K + k0 + kb) = w; } }
    __syncthreads();
}
struct NormRow { f32x4 v[4]; };
__device__ __forceinline__ void norm_load(NormRow& R, const float* x, int lane) {
#pragma unroll
    for (int i = 0; i < 4; ++i) R.v[i] = __builtin_nontemporal_load((const f32x4*)(x + i * 256 + lane * 4));
}
constexpr int PREP_TA = 66048;
__device__ __forceinline__ void norm_a(const NormRow& R, float rs, const LAS float* Ta, float* af_row, int lane) {
    float acc[16];
#pragma unroll
    for (int c = 0; c < 16; ++c) { float s = 0.f;
#pragma unroll
        for (int i = 0; i < 4; ++i) { const f32x4 w = *(const LAS f32x4*)(Ta + c * 1024 + i * 256 + lane * 4); s += (R.v[i][0] * w[0] + R.v[i][1] * w[1]) + (R.v[i][2] * w[2] + R.v[i][3] * w[3]); }
        acc[c] = s; }
    const bool b5 = lane & 32, b4 = lane & 16, b3 = lane & 8, b2 = lane & 4;
    float a8[8], a4[4], a2[2], a1;
#pragma unroll
    for (int j = 0; j < 8; ++j) { const float send = b5 ? acc[j] : acc[j + 8]; const float keep = b5 ? acc[j + 8] : acc[j]; a8[j] = keep + __shfl_xor(send, 32); }
#pragma unroll
    for (int j = 0; j < 4; ++j) { const float send = b4 ? a8[j] : a8[j + 4]; const float keep = b4 ? a8[j + 4] : a8[j]; a4[j] = keep + __shfl_xor(send, 16); }
#pragma unroll
    for (int j = 0; j < 2; ++j) { const float send = b3 ? a4[j] : a4[j + 2]; const float keep = b3 ? a4[j + 2] : a4[j]; a2[j] = keep + __shfl_xor(send, 8); }
    { const float send = b2 ? a2[0] : a2[1]; const float keep = b2 ? a2[1] : a2[0]; a1 = keep + __shfl_xor(send, 4); }
    a1 += __shfl_xor(a1, 2); a1 += __shfl_xor(a1, 1);
    if ((lane & 3) == 0) af_row[(lane >> 2) & 15] = a1 * rs;
}
__device__ __forceinline__ void norm_fin(const NormRow& R, const float* g, bf16_t* o, int lane, const LAS float* Ta = nullptr, float* af_row = nullptr) {
    float s = 0.f;
#pragma unroll
    for (int i = 0; i < 4; ++i) s += (R.v[i][0] * R.v[i][0] + R.v[i][1] * R.v[i][1]) + (R.v[i][2] * R.v[i][2] + R.v[i][3] * R.v[i][3]);
    s = wave_sum(s); const float rs = rsqrtf(s * (1.0f / 1024.0f) + EPS);
#pragma unroll
    for (int i = 0; i < 4; ++i) { const f32x4 gg = *(const f32x4*)(g + i * 256 + lane * 4); const f32x4 y = R.v[i] * rs * gg; u32x2 w; w.x = pk2(y[0], y[1]); w.y = pk2(y[2], y[3]);
        *(u32x2*)(o + i * 256 + lane * 4) = w; }
    if (af_row) norm_a(R, rs, Ta, af_row, lane);
}
__device__ __forceinline__ void norm_addr(const Params& p, int r, const float*& x, const float*& g, bf16_t*& o) {
    if (r < MPR) { x = p.in[0] + (size_t)r * 1024; g = p.in[7]; o = (bf16_t*)(p.ws + WS_A) + (size_t)r * 1024; }
    else if (r < MT) { x = p.in[1] + (size_t)(r - MPR) * 1024; g = p.in[7]; o = (bf16_t*)(p.ws + WS_A) + (size_t)r * 1024; }
    else { x = p.in[2] + (size_t)(r - MT) * 1024; g = p.in[17]; o = (bf16_t*)(p.ws + WS_MN) + (size_t)(r - MT) * 1024; }
}
__device__ __forceinline__ void phase_prep(const Params& p, LAS unsigned char* lds) {
    unsigned char* ws = p.ws; LAS float* T = (LAS float*)lds;
    const int tid = threadIdx.x, lane = tid & 63, wave = tid >> 6;
    LAS float* Ta = (LAS float*)(lds + PREP_TA);
#pragma unroll
    for (int i = 0; i < 8; ++i) { const int idx = tid + 512 * i, k = idx >> 2, c4 = (idx & 3) * 4; const f32x4 w = *(const f32x4*)(p.in[8] + (size_t)k * 2576 + 1536 + c4) * p.in[7][k];
        Ta[(c4 + 0) * 1024 + k] = w[0]; Ta[(c4 + 1) * 1024 + k] = w[1]; Ta[(c4 + 2) * 1024 + k] = w[2]; Ta[(c4 + 3) * 1024 + k] = w[3]; }
    __syncthreads();
    for (int j = blockIdx.x; j < 1008; j += gridDim.x) {
        const float* src; int ldn, K, nt; bf16_t* dst; const float* ksc = nullptr; bool cmap = false; int jj = j, rmode = 0;
        if (jj < 160) { src = p.in[8]; ldn = 2576; K = 1024; nt = 10; dst = (bf16_t*)(ws + WS_WIN); cmap = true; }
        else if ((jj -= 160) < 64) { src = p.in[15]; ldn = 1024; K = 1024; nt = 4; dst = (bf16_t*)(ws + WS_WOUT); }
        else if ((jj -= 64) < 64) { src = p.in[18]; ldn = 1024; K = 1024; nt = 4; dst = (bf16_t*)(ws + WS_WQ); ksc = p.in[16]; }
        else if ((jj -= 64) < 64) { src = p.in[19]; ldn = 1024; K = 1024; nt = 4; dst = (bf16_t*)(ws + WS_WKV); }
        else if ((jj -= 64) < 64) { src = p.in[20]; ldn = 1024; K = 1024; nt = 4; dst = (bf16_t*)(ws + WS_WKV) + (size_t)1024 * 1024; }
        else if ((jj -= 64) < 64) { src = p.in[21]; ldn = 1024; K = 1024; nt = 4; dst = (bf16_t*)(ws + WS_WO); }
        else if ((jj -= 64) < 176) { src = p.in[23]; ldn = 2816; K = 1024; nt = 11; dst = (bf16_t*)(ws + WS_WGU); ksc = p.in[22]; rmode = 1; }
        else if ((jj -= 176) < 176) { src = p.in[24]; ldn = 2816; K = 1024; nt = 11; dst = (bf16_t*)(ws + WS_WGU); ksc = p.in[22]; rmode = 2; }
        else { jj -= 176; src = p.in[27]; ldn = 1024; K = 2816; nt = 4; dst = (bf16_t*)(ws + WS_WD); }
        const int kt = jj / nt, ntile = jj % nt;
        tr_strip(T, src, ldn, dst, K, kt * 64, ntile * 256, ksc, cmap, rmode);
    }
    const int stride = gridDim.x * 8;
    for (int r = blockIdx.x * 8 + wave; r < MT + 2048; r += 2 * stride) {
        const int r2 = r + stride; const bool has2 = r2 < MT + 2048;
        const float *x1, *g1, *x2 = nullptr, *g2 = nullptr; bf16_t *o1, *o2 = nullptr; NormRow A, B;
        norm_addr(p, r, x1, g1, o1); norm_load(A, x1, lane);
        if (has2) { norm_addr(p, r2, x2, g2, o2); norm_load(B, x2, lane); }
        float* af = (float*)(ws + WS_AF);
        norm_fin(A, g1, o1, lane, Ta, r < MT ? af + (size_t)r * 16 : nullptr);
        if (has2) norm_fin(B, g2, o2, lane, Ta, r2 < MT ? af + (size_t)r2 * 16 : nullptr);
    }
}

constexpr int G_Q = 0, G_K = 9216, G_B = 18432, G_A = 35072, G_WA = 39168, G_BA = 43264, G_VT = 43520, G_X = 61952  , G_ST = 71168, G_RED = 89600, G_SEG = 90624, G_R = 92672, G_END = 110080;
struct GlaPre { u32x4v q, k, v0, v1, s0, s1, r0, r1; f32x4 aw; float ba; };
template <bool OUT>
__device__ __forceinline__ void gla_issue(GlaPre& R, const Params& p, int item) {
    const int b = item >> 7, h = (item >> 5) & 3, c = item & 31; const int tid = threadIdx.x; const int row0 = b * 2048 + c * 64;
    const bf16_t* P = (const bf16_t*)(p.ws + WS_P); const float* af = (const float*)(p.ws + WS_AF);
    { const int i = tid >> 3, d8 = (tid & 7) * 8; const bf16_t* src = P + (size_t)(row0 + i) * NIN + h * 64 + d8; R.q = *(const u32x4v*)src; R.k = *(const u32x4v*)(src + 256); }
    if (tid < 256) { const int i = tid >> 2, r4 = (tid & 3) * 4; R.aw = *(const f32x4*)(af + (size_t)(row0 + i) * 16 + r4); }
    else { const int t2 = tid - 256, r = t2 >> 4, d4 = (t2 & 15) * 4; R.aw = *(const f32x4*)(p.in[9] + r * 256 + h * 64 + d4); }
    R.ba = p.in[10][h * 64 + (tid & 63)];
    { const int j = tid & 63, v8 = (tid >> 6) * 8; R.v0 = *(const u32x4v*)(P + (size_t)(row0 + j) * NIN + 512 + h * 128 + v8); R.v1 = *(const u32x4v*)(P + (size_t)(row0 + j) * NIN + 512 + h * 128 + 64 + v8); }
    if (OUT) { const bf16_t* St = (const bf16_t*)(p.ws + WS_ST) + (size_t)item * 8192; const int v = tid >> 3, d8 = (tid & 7) * 8;
        R.s0 = *(const u32x4v*)(St + v * 64 + d8); R.s1 = *(const u32x4v*)(St + (v + 64) * 64 + d8);
        const int j = tid >> 4, v8 = (tid & 15) * 8; R.r0 = *(const u32x4v*)(P + (size_t)(row0 + j) * NIN + 1024 + h * 128 + v8); R.r1 = *(const u32x4v*)(P + (size_t)(row0 + j + 32) * NIN + 1024 + h * 128 + v8); }
}
__device__ __forceinline__ void vt_scatter(LAS bf16_t* LVt, const u32x4v w, int v8, int j) {
    LVt[(v8 + 0) * 72 + j] = (bf16_t)(w.x & 0xffff); LVt[(v8 + 1) * 72 + j] = (bf16_t)(w.x >> 16); LVt[(v8 + 2) * 72 + j] = (bf16_t)(w.y & 0xffff); LVt[(v8 + 3) * 72 + j] = (bf16_t)(w.y >> 16);
    LVt[(v8 + 4) * 72 + j] = (bf16_t)(w.z & 0xffff); LVt[(v8 + 5) * 72 + j] = (bf16_t)(w.z >> 16); LVt[(v8 + 6) * 72 + j] = (bf16_t)(w.w & 0xffff); LVt[(v8 + 7) * 72 + j] = (bf16_t)(w.w >> 16);
}
template <bool OUT>
__device__ __forceinline__ void gla_fill(const GlaPre& R, LAS unsigned char* lds) {
    const int tid = threadIdx.x;
    LAS bf16_t* Lq = (LAS bf16_t*)(lds + G_Q); LAS bf16_t* Lk = (LAS bf16_t*)(lds + G_K); LAS float* Lb = (LAS float*)(lds + G_B);
    LAS float* La = (LAS float*)(lds + G_A); LAS float* Lwa = (LAS float*)(lds + G_WA); LAS float* Lba = (LAS float*)(lds + G_BA);
    LAS bf16_t* LVt = (LAS bf16_t*)(lds + G_VT); LAS float* Lseg = (LAS float*)(lds + G_SEG);
    { const int i = tid >> 3, d8 = (tid & 7) * 8; *(LAS u32x4v*)(Lq + i * 72 + d8) = R.q; *(LAS u32x4v*)(Lk + i * 72 + d8) = R.k; }
    if (tid < 256) { const int i = tid >> 2, r4 = (tid & 3) * 4; *(LAS f32x4*)(La + i * 16 + r4) = R.aw; }
    else { const int t2 = tid - 256, r = t2 >> 4, d4 = (t2 & 15) * 4; *(LAS f32x4*)(Lwa + r * 64 + d4) = R.aw; }
    if (tid < 64) Lba[tid] = R.ba;
    { const int j = tid & 63, v8 = (tid >> 6) * 8; vt_scatter(LVt, R.v0, v8, j); vt_scatter(LVt, R.v1, v8 + 64, j); }
    if (OUT) { LAS bf16_t* LSt = (LAS bf16_t*)(lds + G_ST); LAS bf16_t* Lr = (LAS bf16_t*)(lds + G_R); const int v = tid >> 3, d8 = (tid & 7) * 8;
        *(LAS u32x4v*)(LSt + v * 72 + d8) = R.s0; *(LAS u32x4v*)(LSt + (v + 64) * 72 + d8) = R.s1;
        const int j = tid >> 4, v8 = (tid & 15) * 8; *(LAS u32x4v*)(Lr + j * 136 + v8) = R.r0; *(LAS u32x4v*)(Lr + (j + 32) * 136 + v8) = R.r1; }
    __syncthreads();
}
__device__ __forceinline__ void gla_gates(LAS unsigned char* lds) {
    const int tid = threadIdx.x;
    LAS float* Lb = (LAS float*)(lds + G_B); LAS float* La = (LAS float*)(lds + G_A); LAS float* Lwa = (LAS float*)(lds + G_WA); LAS float* Lba = (LAS float*)(lds + G_BA); LAS float* Lseg = (LAS float*)(lds + G_SEG);
    const int d = tid & 63, seg = tid >> 6; float acc = 0.f; float pre[8];
#pragma unroll
    for (int ii = 0; ii < 8; ++ii) { const int i = seg * 8 + ii; float z = Lba[d];
#pragma unroll
        for (int r = 0; r < 16; ++r) z += La[i * 16 + r] * Lwa[r * 64 + d];
        acc += logsig(z) * (1.0f / 16.0f); pre[ii] = acc; }
    Lseg[seg * 64 + d] = acc;
    __syncthreads();
    float off = 0.f;
#pragma unroll
    for (int s = 0; s < 8; ++s) if (s < seg) off += Lseg[s * 64 + d];
#pragma unroll
    for (int ii = 0; ii < 8; ++ii) Lb[(seg * 8 + ii) * 65 + d] = pre[ii] + off;
    __syncthreads();
}
__device__ __forceinline__ void gla_local_loop(const Params& p, LAS unsigned char* lds, int first, int stride, int nitems) {
    const int tid = threadIdx.x, lane = tid & 63, wave = tid >> 6;
    GlaPre R; if (first < nitems) gla_issue<false>(R, p, first);
    for (int item = first; item < nitems; item += stride) {
        gla_fill<false>(R, lds);
        if (item + stride < nitems) gla_issue<false>(R, p, item + stride);
        gla_gates(lds);
        LAS bf16_t* Lk = (LAS bf16_t*)(lds + G_K); LAS float* Lb = (LAS float*)(lds + G_B); LAS bf16_t* LVt = (LAS bf16_t*)(lds + G_VT); LAS bf16_t* LKt = (LAS bf16_t*)(lds + G_X);
        float* dS = (float*)(p.ws + WS_DS) + (size_t)item * 8192; float* dec = (float*)(p.ws + WS_DEC) + (size_t)item * 64;
        { const int j = tid >> 3, d8 = (tid & 7) * 8;
#pragma unroll
          for (int e = 0; e < 8; ++e) { const float kv = bf2f(Lk[j * 72 + d8 + e]); LKt[(d8 + e) * 72 + j] = f2bf(kv * __expf(Lb[63 * 65 + d8 + e] - Lb[j * 65 + d8 + e])); } }
        if (tid < 64) dec[tid] = __expf(Lb[63 * 65 + tid]);
        __syncthreads();
        const int db = wave & 1, vb = wave >> 1, r = lane & 31, hh = lane >> 5;
        f32x16 acc = zero16();
#pragma unroll
        for (int ks = 0; ks < 4; ++ks) { const bf16x8 a = *(const LAS bf16x8*)(LKt + (db * 32 + r) * 72 + ks * 16 + 8 * hh); const bf16x8 bb = *(const LAS bf16x8*)(LVt + (vb * 32 + r) * 72 + ks * 16 + 8 * hh); acc = mma32(a, bb, acc); }
#pragma unroll
        for (int i = 0; i < 16; ++i) { const int d = db * 32 + (i & 3) + 8 * (i >> 2) + 4 * hh; dS[d * 128 + vb * 32 + r] = acc[i]; }
        __syncthreads();
    }
}
__device__ __forceinline__ void gla_out_loop(const Params& p, LAS unsigned char* lds, int first, int stride, int nitems) {
    const int tid = threadIdx.x, lane = tid & 63, wave = tid >> 6;
    GlaPre R; if (first < nitems) gla_issue<true>(R, p, first);
    for (int item = first; item < nitems; item += stride) {
        const int b = item >> 7, h = (item >> 5) & 3, c = item & 31; const int row0 = b * 2048 + c * 64;
        gla_fill<true>(R, lds);
        if (item + stride < nitems) gla_issue<true>(R, p, item + stride);
        gla_gates(lds);
        LAS bf16_t* Lq = (LAS bf16_t*)(lds + G_Q); LAS bf16_t* Lk = (LAS bf16_t*)(lds + G_K); LAS float* Lb = (LAS float*)(lds + G_B); LAS bf16_t* LVt = (LAS bf16_t*)(lds + G_VT);
        LAS bf16_t* Lsc = (LAS bf16_t*)(lds + G_X); LAS bf16_t* LSt = (LAS bf16_t*)(lds + G_ST); LAS float* Lred = (LAS float*)(lds + G_RED); LAS bf16_t* Lr = (LAS bf16_t*)(lds + G_R);
        bf16_t* mix = (bf16_t*)(p.ws + WS_A);
        { const int i = tid >> 3, d8 = (tid & 7) * 8;
#pragma unroll
          for (int e = 0; e < 8; e += 2) { const float b0 = Lb[i * 65 + d8 + e], b1 = Lb[i * 65 + d8 + e + 1];
              const float q0 = bf2f(Lq[i * 72 + d8 + e]) * __expf(b0) * 0.125f, q1 = bf2f(Lq[i * 72 + d8 + e + 1]) * __expf(b1) * 0.125f;
              const float k0 = bf2f(Lk[i * 72 + d8 + e]) * __expf(-b0), k1 = bf2f(Lk[i * 72 + d8 + e + 1]) * __expf(-b1);
              *(LAS unsigned*)(Lq + i * 72 + d8 + e) = pk2(q0, q1); *(LAS unsigned*)(Lk + i * 72 + d8 + e) = pk2(k0, k1); } }
        __syncthreads();
        const int r = lane & 31, hh = lane >> 5;
        if (wave < 4) { const int ib = wave & 1, jb = wave >> 1;
            f32x16 acc = zero16();
            if (jb <= ib) {
#pragma unroll
                for (int ks = 0; ks < 4; ++ks) { const bf16x8 a = *(const LAS bf16x8*)(Lq + (ib * 32 + r) * 72 + ks * 16 + 8 * hh); const bf16x8 bb = *(const LAS bf16x8*)(Lk + (jb * 32 + r) * 72 + ks * 16 + 8 * hh); acc = mma32(a, bb, acc); } }
#pragma unroll
            for (int i = 0; i < 16; ++i) { const int ii = ib * 32 + (i & 3) + 8 * (i >> 2) + 4 * hh, jj = jb * 32 + r; Lsc[ii * 72 + jj] = f2bf(jj <= ii ? acc[i] : 0.f); } }
        __syncthreads();
        const int ib = wave & 1, vb = wave >> 1;
        f32x16 acc = zero16();
#pragma unroll
        for (int ks = 0; ks < 4; ++ks) { const bf16x8 a = *(const LAS bf16x8*)(Lsc + (ib * 32 + r) * 72 + ks * 16 + 8 * hh); const bf16x8 bb = *(const LAS bf16x8*)(LVt + (vb * 32 + r) * 72 + ks * 16 + 8 * hh); acc = mma32(a, bb, acc); }
#pragma unroll
        for (int ks = 0; ks < 4; ++ks) { const bf16x8 a = *(const LAS bf16x8*)(Lq + (ib * 32 + r) * 72 + ks * 16 + 8 * hh); const bf16x8 bb = *(const LAS bf16x8*)(LSt + (vb * 32 + r) * 72 + ks * 16 + 8 * hh); acc = mma32(a, bb, acc); }
#pragma unroll
        for (int i = 0; i < 16; ++i) { float s = row_sum16(acc[i] * acc[i]); s += __shfl_xor(s, 16);
            if (r == 0) Lred[(ib * 32 + (i & 3) + 8 * (i >> 2) + 4 * hh) * 4 + vb] = s; }
        __syncthreads();
        const float gg = p.in[11][h * 128 + vb * 32 + r];
#pragma unroll
        for (int i = 0; i < 16; ++i) { const int ii = ib * 32 + (i & 3) + 8 * (i >> 2) + 4 * hh; const f32x4 q = *(const LAS f32x4*)(Lred + ii * 4);
            const float rs = rsqrtf(((q[0] + q[1]) + (q[2] + q[3])) * (1.0f / 128.0f) + EPS);
            const float rg = bf2f(Lr[ii * 136 + vb * 32 + r]);
            mix[(size_t)(row0 + ii) * 1024 + h * 128 + vb * 32 + r] = f2bf(acc[i] * rs * gg * silu_f(rg)); }
        __syncthreads();
    }
}
__device__ __forceinline__ void gla_scan(const Params& p) {
    for (int gt = blockIdx.x * 512 + threadIdx.x; gt < 131072; gt += gridDim.x * 512) {
    const int bh = gt >> 12, rem = gt & 4095, v = rem & 127, d = (rem >> 7) * 2;
    const float* dS = (const float*)(p.ws + WS_DS); const float* dec = (const float*)(p.ws + WS_DEC); bf16_t* St = (bf16_t*)(p.ws + WS_ST);
    float s0 = 0.f, s1 = 0.f;
#pragma unroll 8
    for (int c = 0; c < 32; ++c) { const size_t item = (size_t)bh * 32 + c;
        *(unsigned*)(St + item * 8192 + v * 64 + d) = pk2(s0, s1);
        const float a0 = dec[item * 64 + d], a1 = dec[item * 64 + d + 1];
        s0 = a0 * s0 + dS[item * 8192 + d * 128 + v]; s1 = a1 * s1 + dS[item * 8192 + (d + 1) * 128 + v]; }
    float* o = p.out + O_SGP + (size_t)bh * 8192; o[d * 128 + v] = s0; o[(d + 1) * 128 + v] = s1; }
}

__device__ __forceinline__ void sgu_item(const Params& p, LAS unsigned char* lds, int item) {
    const int b = item >> 6, nck = (item >> 2) & 15, h = item & 3; const int tid = threadIdx.x, lane = tid & 63, wave = tid >> 6;
    LAS bf16_t* LW = (LAS bf16_t*)lds; LAS bf16_t* LsvT = (LAS bf16_t*)(lds + 34816);
    const bf16_t* P = (const bf16_t*)(p.ws + WS_P); bf16_t* mix = (bf16_t*)(p.ws + WS_A); const int row0 = b * 2048 + nck * 128;
    const float* Wsrc = p.in[13] + (size_t)h * 16384;
#pragma unroll
    for (int k = 0; k < 8; ++k) { const int idx = tid + 512 * k, i = idx >> 5, j4 = (idx & 31) * 4; const f32x4 w = *(const f32x4*)(Wsrc + i * 128 + j4);
        u32x2 o; o.x = pk2(j4 <= i ? w[0] : 0.f, j4 + 1 <= i ? w[1] : 0.f); o.y = pk2(j4 + 2 <= i ? w[2] : 0.f, j4 + 3 <= i ? w[3] : 0.f); *(LAS u32x2*)(LW + i * 136 + j4) = o; }
    { const int j = tid >> 2, q4 = tid & 3; const bf16_t* src = P + (size_t)(row0 + j) * NIN + 2048 + h * 128 + q4 * 32; float g[32]; float ss = 0.f;
#pragma unroll
      for (int k = 0; k < 4; ++k) { const u32x4v w = *(const u32x4v*)(src + k * 8); const unsigned ww[4] = {w.x, w.y, w.z, w.w};
#pragma unroll
          for (int e = 0; e < 4; ++e) { const float a = gelu_t(bflo(ww[e])), c = gelu_t(bfhi(ww[e])); g[k * 8 + e * 2] = a; g[k * 8 + e * 2 + 1] = c; ss += a * a + c * c; } }
      ss += __shfl_xor(ss, 1); ss += __shfl_xor(ss, 2); const float rs = rsqrtf(ss * (1.0f / 128.0f) + EPS);
#pragma unroll
      for (int e = 0; e < 32; ++e) { const int d = q4 * 32 + e; LsvT[d * 136 + j] = f2bf(g[e] * rs * p.in[12][h * 128 + d]); } }
    __syncthreads();
    const int r = lane & 31, hh = lane >> 5, ib = wave & 3;
    bf16_t uraw[2][16]; float bsv[16];
#pragma unroll
    for (int i = 0; i < 16; ++i) { const int ii = ib * 32 + (i & 3) + 8 * (i >> 2) + 4 * hh; bsv[i] = p.in[14][h * 128 + ii];
#pragma unroll
        for (int t = 0; t < 2; ++t) uraw[t][i] = P[(size_t)(row0 + ii) * NIN + 1536 + h * 128 + ((wave >> 2) * 2 + t) * 32 + r]; }
    f32x16 accs[2];
#pragma unroll
    for (int t = 0; t < 2; ++t) { const int db = (wave >> 2) * 2 + t; f32x16 acc = zero16();
        for (int ks = 0; ks <= ib * 2 + 1; ++ks) { const bf16x8 a = *(const LAS bf16x8*)(LW + (ib * 32 + r) * 136 + ks * 16 + 8 * hh); const bf16x8 bb = *(const LAS bf16x8*)(LsvT + (db * 32 + r) * 136 + ks * 16 + 8 * hh); acc = mma32(a, bb, acc); }
        accs[t] = acc; }
#pragma unroll
    for (int t = 0; t < 2; ++t) { const int db = (wave >> 2) * 2 + t;
#pragma unroll
        for (int i = 0; i < 16; ++i) { const int ii = ib * 32 + (i & 3) + 8 * (i >> 2) + 4 * hh, d = db * 32 + r; const float z = accs[t][i] + bsv[i];
            const float u = gelu_t(bf2f(uraw[t][i])); mix[(size_t)(row0 + ii) * 1024 + 512 + h * 128 + d] = f2bf(u * z); } }
    __syncthreads();
}

constexpr int SM_Q = 0, SM_K = 4096, SM_B = 8192, SM_V = 12288, SM_A = 20480, SM_RED = 21504, SM_O = 22016, SM_END = 30208;
__device__ __forceinline__ void sample_mixer(const Params& p, LAS unsigned char* lds, int b, int hp) {
    const int tid = threadIdx.x, lane = tid & 63, wave = tid >> 6; const int rowb = MPR + b * 4;
    const bf16_t* P = (const bf16_t*)(p.ws + WS_P); const float* af = (const float*)(p.ws + WS_AF); bf16_t* mix = (bf16_t*)(p.ws + WS_A);
    LAS float* Lq = (LAS float*)(lds + SM_Q); LAS float* Lk = (LAS float*)(lds + SM_K); LAS float* Lb = (LAS float*)(lds + SM_B); LAS float* Lv = (LAS float*)(lds + SM_V);
    LAS float* LA = (LAS float*)(lds + SM_A); LAS float* Lred = (LAS float*)(lds + SM_RED); LAS float* Lo = (LAS float*)(lds + SM_O);
    if (hp == 0) { const int ch = tid, h = tid >> 7; float g[4], u[4];
#pragma unroll
      for (int t = 0; t < 4; ++t) { g[t] = gelu_t(bf2f(P[(size_t)(rowb + t) * NIN + 2048 + ch])); u[t] = gelu_t(bf2f(P[(size_t)(rowb + t) * NIN + 1536 + ch])); const float s = wave_sum(g[t] * g[t]); if (lane == 0) Lred[wave * 4 + t] = s; }
      __syncthreads();
      const float gs = p.in[12][ch]; float sv[4];
#pragma unroll
      for (int t = 0; t < 4; ++t) { const float tot = Lred[(2 * h) * 4 + t] + Lred[(2 * h + 1) * 4 + t]; sv[t] = g[t] * rsqrtf(tot * (1.0f / 128.0f) + EPS) * gs; p.out[O_SV + (size_t)(b * 4 + t) * 512 + ch] = sv[t]; }
#pragma unroll
      for (int i = 0; i < 4; ++i) { float z = p.in[14][h * 128 + i];
#pragma unroll
          for (int j = 0; j < 4; ++j) if (j <= i) z += p.in[13][(size_t)h * 16384 + i * 128 + j] * sv[j];
          mix[(size_t)(rowb + i) * 1024 + 512 + ch] = f2bf(u[i] * z); }
      __syncthreads();
    }
#pragma unroll
    for (int k = 0; k < 2; ++k) { const int idx = tid + 512 * k, t = idx >> 8, c = idx & 255;
        Lq[t * 256 + c] = bf2f(P[(size_t)(rowb + t) * NIN + c]); Lk[t * 256 + c] = bf2f(P[(size_t)(rowb + t) * NIN + 256 + c]);
        float z = p.in[10][c];
#pragma unroll
        for (int r = 0; r < 16; ++r) z += af[(size_t)(rowb + t) * 16 + r] * p.in[9][r * 256 + c];
        Lb[t * 256 + c] = logsig(z) * (1.0f / 16.0f); }
#pragma unroll
    for (int t = 0; t < 4; ++t) Lv[t * 512 + tid] = bf2f(P[(size_t)(rowb + t) * NIN + 512 + tid]);
    __syncthreads();
    if (tid < 256) { float a = 0.f;
#pragma unroll
        for (int t = 0; t < 4; ++t) { a += Lb[t * 256 + tid]; Lb[t * 256 + tid] = a; } }
    __syncthreads();
    { const int h = tid >> 7, pr = (tid >> 3) & 15, i = pr >> 2, j = pr & 3, part = tid & 7; float s = 0.f;
      if (j <= i) {
#pragma unroll
          for (int e = 0; e < 8; ++e) { const int c = h * 64 + part * 8 + e; s += Lq[i * 256 + c] * Lk[j * 256 + c] * __expf(Lb[i * 256 + c] - Lb[j * 256 + c]); } }
      s += __shfl_xor(s, 1); s += __shfl_xor(s, 2); s += __shfl_xor(s, 4);
      if (part == 0) LA[h * 16 + pr] = s * 0.125f; }
    __syncthreads();
    LAS float* Le3 = (LAS float*)(lds + SM_END);
    { float qn[2], kn[2];
#pragma unroll
      for (int k = 0; k < 2; ++k) { const int idx = tid + 512 * k, t = idx >> 8, c = idx & 255; const float bt = Lb[t * 256 + c], b3 = Lb[3 * 256 + c];
          qn[k] = Lq[t * 256 + c] * __expf(bt) * 0.125f; kn[k] = Lk[t * 256 + c] * __expf(b3 - bt); }
      const float e3 = tid < 256 ? __expf(Lb[3 * 256 + tid]) : 0.f;
      __syncthreads();
#pragma unroll
      for (int k = 0; k < 2; ++k) { const int idx = tid + 512 * k; Lq[idx] = qn[k]; Lk[idx] = kn[k]; }
      if (tid < 256) Le3[tid] = e3; }
    __syncthreads();
    const int v = tid & 127, dq = tid >> 7;
    for (int h = 2 * hp; h < 2 * hp + 2; ++h) {
        const float* S0 = p.in[3] + (size_t)(b * 4 + h) * 8192; float* So = p.out + O_SGS + (size_t)(b * 4 + h) * 8192;
        float op[4] = {0.f, 0.f, 0.f, 0.f}; float vv[4];
#pragma unroll
        for (int t = 0; t < 4; ++t) vv[t] = Lv[t * 512 + h * 128 + v];
        float s0v[16];
#pragma unroll
        for (int dd = 0; dd < 16; ++dd) s0v[dd] = __builtin_nontemporal_load(S0 + (dq * 16 + dd) * 128 + v);
#pragma unroll
        for (int dd = 0; dd < 16; ++dd) { const int d = dq * 16 + dd, c = h * 64 + d; const float s0 = s0v[dd];
            float sn = Le3[c] * s0;
#pragma unroll
            for (int t = 0; t < 4; ++t) { op[t] += Lq[t * 256 + c] * s0; sn += Lk[t * 256 + c] * vv[t]; }
            So[d * 128 + v] = sn; }
#pragma unroll
        for (int t = 0; t < 4; ++t) Lo[(dq * 4 + t) * 128 + v] = op[t];
        __syncthreads();
        { const int i = tid >> 7; float o = Lo[(0 * 4 + i) * 128 + v] + Lo[(1 * 4 + i) * 128 + v] + Lo[(2 * 4 + i) * 128 + v] + Lo[(3 * 4 + i) * 128 + v];
#pragma unroll
          for (int j = 0; j < 4; ++j) if (j <= i) o += LA[h * 16 + i * 4 + j] * Lv[j * 512 + h * 128 + v];
          const float s = wave_sum(o * o); if (lane == 0) Lred[wave] = s;
          __syncthreads();
          const float tot = Lred[2 * i] + Lred[2 * i + 1]; const float rg = bf2f(P[(size_t)(rowb + i) * NIN + 1024 + h * 128 + v]);
          mix[(size_t)(rowb + i) * 1024 + h * 128 + v] = f2bf(o * rsqrtf(tot * (1.0f / 128.0f) + EPS) * p.in[11][h * 128 + v] * silu_f(rg)); }
        __syncthreads();
    }
}

__device__ __forceinline__ void attn_prompt(const Params& p, LAS unsigned char* lds, int item) {
    const int b = item >> 5, h = (item >> 3) & 3, rt = item & 7; const int tid = threadIdx.x, lane = tid & 63, wave = tid >> 6, r = lane & 31, hh = lane >> 5;
    LAS bf16_t* LK = (LAS bf16_t*)lds; bf16_t* qx = (bf16_t*)(p.ws + WS_A);
    const bf16_t* mkb = (const bf16_t*)(p.ws + WS_MKB) + (size_t)b * 256 * 1024 + h * 256; const bf16_t* mvt = (const bf16_t*)(p.ws + WS_MVT) + (size_t)(b * 4 + h) * 65536;
    const int r0 = b * 2048 + rt * 256 + wave * 32; const bf16_t* qrow = qx + (size_t)(r0 + r) * 1024 + h * 256 + 8 * hh;
    bf16x8 qf[16];
#pragma unroll
    for (int ks = 0; ks < 16; ++ks) qf[ks] = *(const bf16x8*)(qrow + ks * 16);
#pragma unroll 4
    for (int k = 0; k < 16; ++k) { const int idx = tid + 512 * k, m = idx >> 5, d8 = (idx & 31) * 8; *(LAS u32x4v*)(LK + m * 264 + d8) = *(const u32x4v*)(mkb + (size_t)m * 1024 + d8); }
    __syncthreads();
    f32x16 s[8];
#pragma unroll
    for (int mb = 0; mb < 8; ++mb) s[mb] = zero16();
#pragma unroll
    for (int ks = 0; ks < 16; ++ks) {
#pragma unroll
        for (int mb = 0; mb < 8; ++mb) { const bf16x8 kf = *(const LAS bf16x8*)(LK + (mb * 32 + r) * 264 + ks * 16 + 8 * hh); s[mb] = mma32(kf, qf[ks], s[mb]); } }
    float mx = -3.0e38f;
#pragma unroll
    for (int mb = 0; mb < 8; ++mb)
#pragma unroll
        for (int i = 0; i < 16; ++i) mx = fmaxf(mx, s[mb][i]);
    mx = fmaxf(mx, __shfl_xor(mx, 32)); float sum = 0.f;
#pragma unroll
    for (int mb = 0; mb < 8; ++mb)
#pragma unroll
        for (int i = 0; i < 16; ++i) { const float e = __expf((s[mb][i] - mx) * 0.0625f); s[mb][i] = e; sum += e; }
    sum += __shfl_xor(sum, 32); const float inv = __builtin_amdgcn_rcpf(sum);
    bf16x8 pf[8][2];
#pragma unroll
    for (int mb = 0; mb < 8; ++mb)
#pragma unroll
        for (int sI = 0; sI < 2; ++sI) { u32x4v w; w.x = pk2(s[mb][8 * sI + 0] * inv, s[mb][8 * sI + 1] * inv); w.y = pk2(s[mb][8 * sI + 2] * inv, s[mb][8 * sI + 3] * inv);
            w.z = pk2(s[mb][8 * sI + 4] * inv, s[mb][8 * sI + 5] * inv); w.w = pk2(s[mb][8 * sI + 6] * inv, s[mb][8 * sI + 7] * inv); pf[mb][sI] = __builtin_bit_cast(bf16x8, w); }
    __syncthreads();
#pragma unroll 4
    for (int k = 0; k < 16; ++k) { const int idx = tid + 512 * k, d = idx >> 5, m8 = (idx & 31) * 8; *(LAS u32x4v*)(LK + d * 264 + m8) = *(const u32x4v*)(mvt + (size_t)d * 256 + m8); }
    __syncthreads();
    for (int dh = 0; dh < 2; ++dh) {
        f32x16 o[4];
#pragma unroll
        for (int q = 0; q < 4; ++q) o[q] = zero16();
#pragma unroll
        for (int mb = 0; mb < 8; ++mb)
#pragma unroll
            for (int sI = 0; sI < 2; ++sI)
#pragma unroll
                for (int q = 0; q < 4; ++q) { const LAS bf16_t* vp = LK + ((dh * 4 + q) * 32 + r) * 264 + mb * 32 + 16 * sI + 4 * hh;
                    const u32x2 lo = *(const LAS u32x2*)vp, hi = *(const LAS u32x2*)(vp + 8); u32x4v w; w.x = lo.x; w.y = lo.y; w.z = hi.x; w.w = hi.y;
                    o[q] = mma32(pf[mb][sI], __builtin_bit_cast(bf16x8, w), o[q]); }
#pragma unroll
        for (int q = 0; q < 4; ++q)
#pragma unroll
            for (int i = 0; i < 16; ++i) { const int ii = (i & 3) + 8 * (i >> 2) + 4 * hh; qx[(size_t)(r0 + ii) * 1024 + h * 256 + (dh * 4 + q) * 32 + r] = f2bf(o[q][i]); }
    }
    __syncthreads();
}
__device__ __forceinline__ void attn_sample(const Params& p, LAS unsigned char* lds, int item) {
    const int b = item >> 2, h = item & 3; const int tid = threadIdx.x, lane = tid & 63, wave = tid >> 6; const int rowb = MPR + b * 4;
    bf16_t* qx = (bf16_t*)(p.ws + WS_A); LAS float* Ls = (LAS float*)lds;   LAS float* Lred = (LAS float*)(lds + 4096); LAS float* Lo = (LAS float*)(lds + 8192);
    const float* Kc = p.in[5] + ((size_t)b * 256 * 4 + h) * 256; const float* Vc = p.in[6] + ((size_t)b * 256 * 4 + h) * 256;
    f32x4 q[4];
#pragma unroll
    for (int t = 0; t < 4; ++t) { const u32x2 w = *(const u32x2*)(qx + (size_t)(rowb + t) * 1024 + h * 256 + lane * 4); q[t] = (f32x4){bflo(w.x), bfhi(w.x), bflo(w.y), bfhi(w.y)}; }
    const bool b5 = lane & 32, b4 = lane & 16, b3 = lane & 8, b2 = lane & 4, b1 = lane & 2;
    for (int mb = 0; mb < 4; ++mb) {
        f32x4 kv[8];
#pragma unroll
        for (int rr = 0; rr < 8; ++rr) kv[rr] = __builtin_nontemporal_load((const f32x4*)(Kc + (size_t)(wave * 32 + mb * 8 + rr) * 1024 + lane * 4));
        float a[32];
#pragma unroll
        for (int rr = 0; rr < 8; ++rr)
#pragma unroll
            for (int t = 0; t < 4; ++t) a[rr * 4 + t] = (kv[rr][0] * q[t][0] + kv[rr][1] * q[t][1]) + (kv[rr][2] * q[t][2] + kv[rr][3] * q[t][3]);
        float c16[16], c8[8], c4[4], c2[2], c1;
#pragma unroll
        for (int j = 0; j < 16; ++j) { const float send = b5 ? a[j] : a[j + 16]; const float keep = b5 ? a[j + 16] : a[j]; c16[j] = keep + __shfl_xor(send, 32); }
#pragma unroll
        for (int j = 0; j < 8; ++j) { const float send = b4 ? c16[j] : c16[j + 8]; const float keep = b4 ? c16[j + 8] : c16[j]; c8[j] = keep + __shfl_xor(send, 16); }
#pragma unroll
        for (int j = 0; j < 4; ++j) { const float send = b3 ? c8[j] : c8[j + 4]; const float keep = b3 ? c8[j + 4] : c8[j]; c4[j] = keep + __shfl_xor(send, 8); }
#pragma unroll
        for (int j = 0; j < 2; ++j) { const float send = b2 ? c4[j] : c4[j + 2]; const float keep = b2 ? c4[j + 2] : c4[j]; c2[j] = keep + __shfl_xor(send, 4); }
        { const float send = b1 ? c2[0] : c2[1]; const float keep = b1 ? c2[1] : c2[0]; c1 = keep + __shfl_xor(send, 2); }
        c1 += __shfl_xor(c1, 1);
        if ((lane & 1) == 0) { const int j = (lane >> 1) & 31; Ls[(j & 3) * 256 + wave * 32 + mb * 8 + (j >> 2)] = c1 * 0.0625f; }
    }
    __syncthreads();
    { const int t = tid >> 7, m0 = tid & 127; const float a = Ls[t * 256 + m0], c = Ls[t * 256 + m0 + 128]; const float mx = wave_max(fmaxf(a, c)); if (lane == 0) Lred[wave] = mx;
      __syncthreads();
      const float mxx = fmaxf(Lred[2 * t], Lred[2 * t + 1]); const float ea = __expf(a - mxx), ec = __expf(c - mxx); const float sm = wave_sum(ea + ec); if (lane == 0) Lred[16 + wave] = sm;
      __syncthreads();
      const float inv = __builtin_amdgcn_rcpf(Lred[16 + 2 * t] + Lred[16 + 2 * t + 1]); Ls[t * 256 + m0] = ea * inv; Ls[t * 256 + m0 + 128] = ec * inv; }
    __syncthreads();
    f32x4 o[4];
#pragma unroll
    for (int t = 0; t < 4; ++t) o[t] = (f32x4){0.f, 0.f, 0.f, 0.f};
#pragma unroll 2
    for (int mm = 0; mm < 32; mm += 4) { const int m = wave * 32 + mm; f32x4 vv[4], pp[4];
#pragma unroll
        for (int rr = 0; rr < 4; ++rr) vv[rr] = __builtin_nontemporal_load((const f32x4*)(Vc + (size_t)(m + rr) * 1024 + lane * 4));
#pragma unroll
        for (int t = 0; t < 4; ++t) pp[t] = *(const LAS f32x4*)(Ls + t * 256 + m);
#pragma unroll
        for (int rr = 0; rr < 4; ++rr)
#pragma unroll
            for (int t = 0; t < 4; ++t) o[t] += vv[rr] * pp[t][rr]; }
#pragma unroll
    for (int t = 0; t < 4; ++t) *(LAS f32x4*)(Lo + (wave * 4 + t) * 256 + lane * 4) = o[t];
    __syncthreads();
#pragma unroll
    for (int k = 0; k < 2; ++k) { const int idx = tid + 512 * k, t = idx >> 8, d = idx & 255; float s = 0.f;
#pragma unroll
        for (int w = 0; w < 8; ++w) s += Lo[(w * 4 + t) * 256 + d];
        qx[(size_t)(rowb + t) * 1024 + h * 256 + d] = f2bf(s); }
    __syncthreads();
}

__device__ __forceinline__ void phase_act(const Params& p) {
    const bf16_t* G = (const bf16_t*)(p.ws + WS_P); bf16_t* U = (bf16_t*)(p.ws + WS_U);
    const float* cw = p.in[25]; const float* cb = p.in[26];
    const int nthr = gridDim.x * 512, gt = blockIdx.x * 512 + threadIdx.x;
    for (int it = gt; it < 1024 * 352; it += nthr) { const int run = it / 352, cc = (it % 352) * 8; const int row0 = run * 16; const bool first = (row0 & 2047) == 0;
        float w0[8], w1[8], w2[8], bb[8], g2[8], g1[8];
#pragma unroll
        for (int e = 0; e < 8; ++e) { w0[e] = cw[cc + e]; w1[e] = cw[DFF + cc + e]; w2[e] = cw[2 * DFF + cc + e]; bb[e] = cb[cc + e]; g2[e] = 0.f; g1[e] = 0.f; }
        if (!first) { const u32x4v a = *(const u32x4v*)(G + (size_t)(row0 - 2) * DFF + cc), c = *(const u32x4v*)(G + (size_t)(row0 - 1) * DFF + cc);
            g2[0] = bflo(a.x); g2[1] = bfhi(a.x); g2[2] = bflo(a.y); g2[3] = bfhi(a.y); g2[4] = bflo(a.z); g2[5] = bfhi(a.z); g2[6] = bflo(a.w); g2[7] = bfhi(a.w);
            g1[0] = bflo(c.x); g1[1] = bfhi(c.x); g1[2] = bflo(c.y); g1[3] = bfhi(c.y); g1[4] = bflo(c.z); g1[5] = bfhi(c.z); g1[6] = bflo(c.w); g1[7] = bfhi(c.w); }
#pragma unroll 4
        for (int t = 0; t < 16; ++t) { const size_t off = (size_t)(row0 + t) * DFF + cc; const u32x4v a = *(const u32x4v*)(G + off), uu = *(const u32x4v*)(U + off);
            float g0[8] = {bflo(a.x), bfhi(a.x), bflo(a.y), bfhi(a.y), bflo(a.z), bfhi(a.z), bflo(a.w), bfhi(a.w)};
            const float uf[8] = {bflo(uu.x), bfhi(uu.x), bflo(uu.y), bfhi(uu.y), bflo(uu.z), bfhi(uu.z), bflo(uu.w), bfhi(uu.w)}; float r[8];
#pragma unroll
            for (int e = 0; e < 8; ++e) { r[e] = gelu_t(bb[e] + w0[e] * g2[e] + w1[e] * g1[e] + w2[e] * g0[e]) * uf[e]; g2[e] = g1[e]; g1[e] = g0[e]; }
            u32x4v o; o.x = pk2(r[0], r[1]); o.y = pk2(r[2], r[3]); o.z = pk2(r[4], r[5]); o.w = pk2(r[6], r[7]); *(u32x4v*)(U + off) = o; }
    }
    for (int it = gt; it < 128 * 352; it += nthr) { const int b = it / 352, cc = (it % 352) * 8; const int row0 = MPR + b * 4;
        float w0[8], w1[8], w2[8], bb[8], g2[8], g1[8];
#pragma unroll
        for (int e = 0; e < 8; ++e) { w0[e] = cw[cc + e]; w1[e] = cw[DFF + cc + e]; w2[e] = cw[2 * DFF + cc + e]; bb[e] = cb[cc + e]; g2[e] = p.in[4][(size_t)(b * 2) * DFF + cc + e]; g1[e] = p.in[4][(size_t)(b * 2 + 1) * DFF + cc + e]; }
#pragma unroll
        for (int t = 0; t < 4; ++t) { const size_t off = (size_t)(row0 + t) * DFF + cc; const u32x4v a = *(const u32x4v*)(G + off), uu = *(const u32x4v*)(U + off);
            float g0[8] = {bflo(a.x), bfhi(a.x), bflo(a.y), bfhi(a.y), bflo(a.z), bfhi(a.z), bflo(a.w), bfhi(a.w)};
            const float uf[8] = {bflo(uu.x), bfhi(uu.x), bflo(uu.y), bfhi(uu.y), bflo(uu.z), bfhi(uu.z), bflo(uu.w), bfhi(uu.w)}; float r[8];
#pragma unroll
            for (int e = 0; e < 8; ++e) { r[e] = gelu_t(bb[e] + w0[e] * g2[e] + w1[e] * g1[e] + w2[e] * g0[e]) * uf[e]; g2[e] = g1[e]; g1[e] = g0[e]; }
            u32x4v o; o.x = pk2(r[0], r[1]); o.y = pk2(r[2], r[3]); o.z = pk2(r[4], r[5]); o.w = pk2(r[6], r[7]); *(u32x4v*)(U + off) = o; }
    }
}
__device__ __forceinline__ void phase_final(const Params& p) {
    const float* h32 = (const float*)(p.ws + WS_H); const float* ssq = (const float*)(p.ws + WS_SSQ) + (size_t)2 * MT * 16; const float* g = p.in[28];
    const int lane = threadIdx.x & 63, wave = threadIdx.x >> 6;
    const float* ssq64 = (const float*)(p.ws + WS_SSQS) + (size_t)2 * 512 * 64;
    for (int r = blockIdx.x * 8 + wave; r < MT; r += gridDim.x * 8) { const float rs = row_rs2(ssq, ssq64, r);
#pragma unroll
        for (int i = 0; i < 4; ++i) { const size_t off = (size_t)r * 1024 + i * 256 + lane * 4; *(f32x4*)(p.out + O_Y + off) = *(const f32x4*)(h32 + off) * rs * *(const f32x4*)(g + i * 256 + lane * 4); } }
}

template <int DUMMY>
__device__ __forceinline__ void run_phases(const Params& p, LAS unsigned char* lds, const int lo, const int hi) {
    unsigned char* ws = p.ws; const int G = gridDim.x, bx = blockIdx.x;
#define IN(k) (lo <= (k) && (k) < hi)
#define MKBAR() XcdBarrier bar; bar.bar = (unsigned*)(p.ws + WS_BAR) + (size_t)p.bar_region * XCD_BAR_WORDS; bar.x = xb_xcc_id(); bar.st = (volatile LAS unsigned*)(lds + LDS_BYTES - 16)
#define SEAM(k) do { if (IN(k) && IN((k) + 1)) { MKBAR(); xcd_barrier(bar); } } while (0)
    if (IN(0)) { phase_prep(p, lds); } SEAM(0);
    if (IN(0) && IN(1)) {
        volatile LAS unsigned* stw = (volatile LAS unsigned*)(lds + LDS_BYTES - 16);
        if (threadIdx.x == 0 && (G % 8) == 0) { unsigned* barw = (unsigned*)(p.ws + WS_BAR) + (size_t)p.bar_region * XCD_BAR_WORDS; const unsigned x = xb_xcc_id(); unsigned pre = 0;
            for (unsigned j = 0; j < 16; ++j) { const unsigned cj = xb_ld(&barw[XB_XCNT(j)]); if (j < x) pre += cj; }
            const unsigned clin = pre + stw[2], per = (unsigned)G / 8u; stw[3] = (clin % per) * 8u + clin / per; }
        __syncthreads();
    }
#define CX ((int)((volatile LAS unsigned*)(lds + LDS_BYTES - 16))[3])
    if (IN(1)) {
        { pg8::Gemm g{(const bf16_t*)(ws + WS_A), (const bf16_t*)(ws + WS_WIN), MT, 2560, 1024}; pg8::StaticOrder S; S.init(MT, 2560, G, CX);
          EpiIn E{(bf16_t*)(ws + WS_P), (float*)(ws + WS_AF)}; pg8::gemm_phase<EpiIn, pg8::StaticOrder>(lds, g, S, E, nullptr); }
        __syncthreads();
        { pg8::Gemm g{(const bf16_t*)(ws + WS_MN), (const bf16_t*)(ws + WS_WKV), 2048, 2048, 1024}; pg8::StaticOrder S; S.init(2048, 2048, G, (CX + 104) % G);
          EpiKV E{p.out + O_MK, p.out + O_MV, (bf16_t*)(ws + WS_MKB), (bf16_t*)(ws + WS_MVT)}; pg8::gemm_phase<EpiKV, pg8::StaticOrder>(lds, g, S, E, nullptr); }
        __syncthreads();
    } SEAM(1);
    if (IN(2)) {
        gla_local_loop(p, lds, bx, G, 1024);
        for (int it = bx; it < 512; it += G) sgu_item(p, lds, it);
        for (int it = G - 1 - bx; it < 256; it += G) sample_mixer(p, lds, it >> 1, it & 1);
    } SEAM(2);
    if (IN(3)) { gla_scan(p); } SEAM(3);
    if (IN(4)) { gla_out_loop(p, lds, bx, G, 1024); } SEAM(4);
    if (IN(5)) {
        pg8::Gemm g{(const bf16_t*)(ws + WS_A), (const bf16_t*)(ws + WS_WOUT), MPR, 1024, 1024}; pg8::StaticOrder S; S.init(MPR, 1024, G, CX);
        EpiRes E{p.in[0], (bf16_t*)(ws + WS_HB), (float*)(ws + WS_SSQ)}; pg8::gemm_phase<EpiRes, pg8::StaticOrder>(lds, g, S, E, nullptr);
        __syncthreads();
        { const float* xs = p.in[1]; bf16_t* hb = (bf16_t*)(ws + WS_HB) + (size_t)MPR * 1024; float* sq = (float*)(ws + WS_SSQS);
          gemm_small<256>((const bf16_t*)(ws + WS_A) + (size_t)MPR * 1024, (const bf16_t*)(ws + WS_WOUT), 1024, 16, lds, [=](int r, int c, int cb, int fq, f32x4 a) {
              const size_t off = (size_t)r * 1024 + c; const f32x4 v = a + *(const f32x4*)(xs + off); u32x2 w; w.x = pk2(v[0], v[1]); w.y = pk2(v[2], v[3]); *(u32x2*)(hb + off) = w;
              float s = sq4(v); s += __shfl_xor(s, 16); s += __shfl_xor(s, 32); if (fq == 0) sq[(size_t)r * 64 + cb] = s; }); }
    } SEAM(5);
    if (IN(6)) {
        pg8::Gemm g{(const bf16_t*)(ws + WS_HB), (const bf16_t*)(ws + WS_WQ), MPR, 1024, 1024}; pg8::StaticOrder S; S.init(MPR, 1024, G, CX);
        EpiQ E{(bf16_t*)(ws + WS_A), (const float*)(ws + WS_SSQ)}; pg8::gemm_phase<EpiQ, pg8::StaticOrder>(lds, g, S, E, nullptr);
        __syncthreads();
        { bf16_t* Q = (bf16_t*)(ws + WS_A) + (size_t)MPR * 1024; const float* sq = (const float*)(ws + WS_SSQS);
          gemm_small<256>((const bf16_t*)(ws + WS_HB) + (size_t)MPR * 1024, (const bf16_t*)(ws + WS_WQ), 1024, 16, lds, [=](int r, int c, int cb, int fq, f32x4 a) {
              const f32x4 v = a * row_rs64(sq, r); u32x2 w; w.x = pk2(v[0], v[1]); w.y = pk2(v[2], v[3]); *(u32x2*)(Q + (size_t)r * 1024 + c) = w; }); }
    } SEAM(6);
    if (IN(7)) {
        if ((bx >> 3) & 1) { for (int it = bx; it < 512; it += G) attn_sample(p, lds, it); for (int it = bx; it < 256; it += G) attn_prompt(p, lds, it); }
        else { for (int it = bx; it < 256; it += G) attn_prompt(p, lds, it); for (int it = bx; it < 512; it += G) attn_sample(p, lds, it); }
    } SEAM(7);
    if (IN(8)) {
        pg8::Gemm g{(const bf16_t*)(ws + WS_A), (const bf16_t*)(ws + WS_WO), MPR, 1024, 1024}; pg8::StaticOrder S; S.init(MPR, 1024, G, CX);
        EpiRes E{nullptr, (bf16_t*)(ws + WS_HB), (float*)(ws + WS_SSQ) + (size_t)MT * 16};
        pg8::gemm_phase<EpiRes, pg8::StaticOrder>(lds, g, S, E, nullptr);
        __syncthreads();
        { bf16_t* hb = (bf16_t*)(ws + WS_HB) + (size_t)MPR * 1024; float* sq = (float*)(ws + WS_SSQS) + (size_t)512 * 64;
          gemm_small<256>((const bf16_t*)(ws + WS_A) + (size_t)MPR * 1024, (const bf16_t*)(ws + WS_WO), 1024, 16, lds, [=](int r, int c, int cb, int fq, f32x4 a) {
              const size_t off = (size_t)r * 1024 + c; const u32x2 hw = *(const u32x2*)(hb + off); const f32x4 v = a + (f32x4){bflo(hw.x), bfhi(hw.x), bflo(hw.y), bfhi(hw.y)};
              u32x2 w; w.x = pk2(v[0], v[1]); w.y = pk2(v[2], v[3]); *(u32x2*)(hb + off) = w;
              float s = sq4(v); s += __shfl_xor(s, 16); s += __shfl_xor(s, 32); if (fq == 0) sq[(size_t)r * 64 + cb] = s; }); }
    } SEAM(8);
    if (IN(9)) {
        pg8::Gemm g{(const bf16_t*)(ws + WS_HB), (const bf16_t*)(ws + WS_WGU), MT, 5632, 1024}; pg8::StaticOrder S; S.init(MT, 5632, G, CX);
        EpiGU E{(bf16_t*)(ws + WS_U), (const float*)(ws + WS_SSQ) + (size_t)MT * 16, (const float*)(ws + WS_SSQS) + (size_t)512 * 64, p.out + O_SCP, p.out + O_SCS, p.in[25], p.in[26], p.in[4], (float*)(ws + WS_GX), (float*)(ws + WS_UX), p.pad}; pg8::gemm_phase<EpiGU, pg8::StaticOrder>(lds, g, S, E, nullptr);
        __syncthreads();
    } if (IN(9) && IN(11)) { MKBAR(); xcd_barrier(bar); }
    if (IN(11)) {
        pg8::Gemm g{(const bf16_t*)(ws + WS_U), (const bf16_t*)(ws + WS_WD), MPR, 1024, 2816}; pg8::StaticOrder S; S.init(MPR, 1024, G, CX);
        if (!(p.pad & 2)) { Unit fu; for (int i = 0; S.next(i, fu); ++i) act_fixup(p, fu.pm); asm volatile("s_waitcnt vmcnt(0)" ::: "memory"); __syncthreads(); }
        EpiFin E{(const bf16_t*)(ws + WS_HB), (float*)(ws + WS_SSQ) + (size_t)2 * MT * 16, (unsigned*)(ws + WS_BAR) + (size_t)p.bar_region * XCD_BAR_WORDS, p.in[28], p.out + O_Y, p.pad,
                 (const bf16_t*)(ws + WS_U) + (size_t)MPR * 2816, (const bf16_t*)(ws + WS_WD), (float*)(ws + WS_SSQS) + (size_t)2 * 512 * 64};
        pg8::gemm_phase<EpiFin, pg8::StaticOrder>(lds, g, S, E, nullptr);
        __syncthreads();
    }
#undef IN
#undef SEAM
#undef CX
}
__global__ void __launch_bounds__(512) mega(Params p) {
    extern __shared__ __attribute__((aligned(16))) unsigned char lds_raw[];
    LAS unsigned char* lds = (LAS unsigned char*)lds_raw;
    if (p.ph_lo < 0) { cg::grid_group grid = cg::this_grid(); grid.sync(); }
    volatile LAS unsigned* st = (volatile LAS unsigned*)(lds + LDS_BYTES - 16);
    if (threadIdx.x < 4) st[threadIdx.x] = 0u;
    __syncthreads();
    if (threadIdx.x == 0) { unsigned* barw = (unsigned*)(p.ws + WS_BAR) + (size_t)p.bar_region * XCD_BAR_WORDS;
        st[2] = xb_add(&barw[XB_XCNT(xb_xcc_id())], 1u);
        st[3] = blockIdx.x; }
    __syncthreads();
    run_phases<0>(p, lds, p.ph_lo, p.ph_hi);
#ifdef EXTRA_SYNC
    for (int i = 0; i < EXTRA_SYNC; ++i) { MKBAR(); xcd_barrier(bar); }
#endif
}

extern "C" void kernel_launch(void* const* d_in, const int* in_sizes, int n_in, void* d_out, int out_size, void* d_ws, size_t ws_size, hipStream_t stream) {
    static int grid = 0;
    if (grid == 0) {
        if (n_in != 29 || ws_size < WS_END) { fprintf(stderr, "kernel_launch: unexpected n_in %d / ws %zu (need %zu)\n", n_in, ws_size, (size_t)WS_END); grid = -1; return; }
        int dev = 0, cus = 0, per_cu = 0;
        hipGetDevice(&dev); hipDeviceGetAttribute(&cus, hipDeviceAttributeMultiprocessorCount, dev);
        if (hipFuncSetAttribute((const void*)mega, hipFuncAttributeMaxDynamicSharedMemorySize, LDS_BYTES) != hipSuccess) { fprintf(stderr, "kernel_launch: hipFuncSetAttribute failed\n"); grid = -1; return; }
        if (hipOccupancyMaxActiveBlocksPerMultiprocessor(&per_cu, (const void*)mega, 512, LDS_BYTES) != hipSuccess || per_cu < 1) { fprintf(stderr, "kernel_launch: occupancy query gives %d\n", per_cu); (void)hipGetLastError(); per_cu = 1; }
        grid = cus;
    }
    if (grid < 0) return;
    Params p{};
    for (int i = 0; i < 29; ++i) p.in[i] = (const float*)d_in[i];
    p.out = (float*)d_out; p.ws = (unsigned char*)d_ws;
    (void)hipMemsetAsync((unsigned char*)d_ws + WS_BAR, 0, (size_t)2 * XCD_BAR_WORDS * 4, stream);
#if N_LAUNCH_MODE == 1
    p.ph_lo = 0; p.ph_hi = NPHASE;
    void* args[] = {&p};
    hipError_t e = hipLaunchCooperativeKernel((const void*)mega, dim3(grid), dim3(512), args, LDS_BYTES, stream);
    if (e != hipSuccess) fprintf(stderr, "cooperative launch failed: %s (grid %d)\n", hipGetErrorString(e), grid);
#if EXTRA_HI > 0
    Params p2 = p; p2.ph_lo = EXTRA_LO; p2.ph_hi = EXTRA_HI; p2.bar_region = 1; p2.pad = EXTRA_FLAGS; void* args2[] = {&p2};
    (void)hipLaunchCooperativeKernel((const void*)mega, dim3(grid), dim3(512), args2, LDS_BYTES, stream);
#endif
#else
    for (int ph = 0; ph < NPHASE; ++ph) { p.ph_lo = ph; p.ph_hi = ph + 1; hipLaunchKernelGGL(mega, dim3(grid), dim3(512), LDS_BYTES, stream, p); }
#endif
}
```

```cpp
#include <hip/hip_runtime.h>
namespace pg8 {
#define PG8_LAS __attribute__((address_space(3)))
typedef unsigned short bf16_t;
typedef short bf16x8 __attribute__((ext_vector_type(8)));
typedef float f32x4 __attribute__((ext_vector_type(4)));
typedef unsigned u32x4 __attribute__((ext_vector_type(4)));
constexpr int BM = 256, BK = 64, HALF = 128, HTB = HALF * BK * 2  , STAGE_BYTES = 8 * HTB, NXCD = 8, WGM = 8;

__host__ __device__ __forceinline__ int lds_byte(int r, int c) { const int st = (r >> 4) * 2 + (c >> 5), rr = r & 15, cc = c & 31, ob = rr * 64 + cc * 2; return st * 1024 + (ob ^ (((ob >> 9) & 1) << 5)); }
__host__ __device__ __forceinline__ void stage_rc(int b, int& R, int& C) { const int st = b / 1024, sb = b % 1024, swz = sb ^ (((sb >> 9) & 1) << 5); R = (st >> 1) * 16 + swz / 64; C = (st & 1) * 32 + (swz % 64) / 2; }
__host__ __device__ __forceinline__ int perm32(int rho) { const int n = rho >> 4, i = rho & 15; return 8 * (i >> 2) + 4 * n + (i & 3); }

struct Unit { int pm, pn; };
struct Gemm { const bf16_t* A; const bf16_t* Bt; int M, N, K; };

struct StaticOrder {
    int nM, nN, nwg, G, c;
    __host__ __device__ void init(int M, int N, int G_, int c_) { nM = M / BM; nN = N / BM; nwg = nM * nN; G = G_; c = c_; }
    __host__ __device__ __forceinline__ bool next(int i, Unit& u) const {
        const long L = (long)i * G + c; if (L >= nwg) return false;
        int wgid = (int)L; { const int q = nwg / NXCD, r = nwg % NXCD, xcd = wgid % NXCD, off = wgid / NXCD; wgid = (xcd < r ? xcd * (q + 1) : r * (q + 1) + (xcd - r) * q) + off; }
        const int nig = WGM * nN, gid = wgid / nig, fm = gid * WGM, gsz = (nM - fm) < WGM ? (nM - fm) : WGM;
        u.pm = fm + ((wgid % nig) % gsz); u.pn = (wgid % nig) / gsz; return true;
    }
    __device__ __forceinline__ void a_ready(const Unit&) const {}
    __device__ __forceinline__ void done(const Unit&) const {}
};
struct CountedOrder : StaticOrder {
    const unsigned* ready; unsigned need; unsigned* tmo;
    __device__ __forceinline__ void a_ready(const Unit& u) const {
        if (threadIdx.x < 64) {
            const unsigned long long t0 = __builtin_amdgcn_s_memrealtime(); unsigned polls = 0;
            while ((unsigned)__builtin_amdgcn_readfirstlane(__hip_atomic_load(ready + 64 * u.pm, __ATOMIC_RELAXED, __HIP_MEMORY_SCOPE_AGENT)) < need) {
                if ((++polls & 255u) == 0u && __builtin_amdgcn_readfirstlane(__hip_atomic_load(tmo, __ATOMIC_RELAXED, __HIP_MEMORY_SCOPE_AGENT)) != 0u) break;
                if (__builtin_amdgcn_s_memrealtime() - t0 > 2000000ull) {
                    if (threadIdx.x == 0) { unsigned expect = 0u; __hip_atomic_compare_exchange_strong(tmo + 1, &expect, 0x600u | (unsigned)(u.pm & 0xff), __ATOMIC_RELAXED, __ATOMIC_RELAXED, __HIP_MEMORY_SCOPE_AGENT); __hip_atomic_store(tmo, 1u, __ATOMIC_RELAXED, __HIP_MEMORY_SCOPE_AGENT); }
                    break; }
                __builtin_amdgcn_s_sleep(2); }
            __builtin_amdgcn_fence(__ATOMIC_ACQUIRE, "agent");
            asm volatile("s_waitcnt vmcnt(0)" ::: "memory");
        }
#if !defined(BROKEN_HOOK_NO_BARRIER)
        asm volatile("" ::: "memory"); __builtin_amdgcn_s_barrier(); asm volatile("" ::: "memory");
#endif
    }
};

__device__ __forceinline__ unsigned cvt_pk_bf16(float lo, float hi) { unsigned r; asm volatile("v_cvt_pk_bf16_f32 %0, %1, %2" : "=v"(r) : "v"(lo), "v"(hi)); return r; }
typedef float f32x2 __attribute__((ext_vector_type(2)));
__device__ __forceinline__ f32x2 gelu_pk(f32x2 v) {
    const f32x2 av = __builtin_elementwise_abs(v), d = av * 0.2316418882f + 1.0f;
    f32x2 t; t.x = __builtin_amdgcn_rcpf(d.x); t.y = __builtin_amdgcn_rcpf(d.y);
    f32x2 q = t * 0.5307027145f + (-0.7265760135f); q = q * t + 0.7107068705f; q = q * t + (-0.142248368f); q = q * t + 0.127414796f; q = q * t;
    const f32x2 s = (v * v) * (-0.72134752044f);
    f32x2 e; e.x = __builtin_amdgcn_exp2f(s.x); e.y = __builtin_amdgcn_exp2f(s.y);
    const f32x2 m = v * (q * e), r = v - m;
    f32x2 o; o.x = v.x < 0.f ? m.x : r.x; o.y = v.y < 0.f ? m.y : r.y; return o;
}

struct EpiF32 {
    static constexpr bool PERM = false, AFTER_DRAIN = false;
    float* C; int ldc; const float* bias;
    __device__ __forceinline__ void operator()(const f32x4 (&acc)[2][2][4][2], const Unit& u, int wr, int wc, int fr, int fq) const {
        const int row0 = u.pm * BM + wr * 64 + fr, col0 = u.pn * BM + wc * 32 + 4 * fq;
        f32x4 bv[2][2];
#pragma unroll
        for (int bj = 0; bj < 2; ++bj)
#pragma unroll
            for (int n = 0; n < 2; ++n) bv[bj][n] = bias ? *(const f32x4*)(bias + col0 + bj * HALF + n * 16) : (f32x4){0.f, 0.f, 0.f, 0.f};
#pragma unroll
        for (int ai = 0; ai < 2; ++ai)
#pragma unroll
            for (int m = 0; m < 4; ++m) { float* rowp = C + (size_t)(row0 + ai * HALF + m * 16) * ldc + col0;
#pragma unroll
                for (int bj = 0; bj < 2; ++bj)
#pragma unroll
                    for (int n = 0; n < 2; ++n) *(f32x4*)(rowp + bj * HALF + n * 16) = acc[ai][bj][m][n] + bv[bj][n]; }
    }
};
template <int ACT  > struct EpiBf16 {
    static constexpr bool PERM = true, AFTER_DRAIN = false;
    bf16_t* O; int ldc; const float* bias; int split_cols; size_t split_stride;
    __device__ __forceinline__ void operator()(const f32x4 (&acc)[2][2][4][2], const Unit& u, int wr, int wc, int fr, int fq) const {
        const int row0 = u.pm * BM + wr * 64 + fr; int colt = u.pn * BM; bf16_t* base = O;
        if (split_cols) { const int t = colt / split_cols; base += (size_t)t * split_stride; colt -= t * split_cols; }
        const int col0 = colt + wc * 32 + 8 * fq, bcol0 = u.pn * BM + wc * 32 + 8 * fq;
        f32x4 bv[2][2];
#pragma unroll
        for (int bj = 0; bj < 2; ++bj)
#pragma unroll
            for (int n = 0; n < 2; ++n) bv[bj][n] = bias ? *(const f32x4*)(bias + bcol0 + bj * HALF + 4 * n) : (f32x4){0.f, 0.f, 0.f, 0.f};
#pragma unroll
        for (int ai = 0; ai < 2; ++ai)
#pragma unroll
            for (int m = 0; m < 4; ++m) { bf16_t* rowp = base + (size_t)(row0 + ai * HALF + m * 16) * ldc + col0;
#pragma unroll
                for (int bj = 0; bj < 2; ++bj) { f32x4 v0 = acc[ai][bj][m][0] + bv[bj][0], v1 = acc[ai][bj][m][1] + bv[bj][1];
                    if (ACT == 1) { f32x2 a = gelu_pk((f32x2){v0[0], v0[1]}), b = gelu_pk((f32x2){v0[2], v0[3]}), c = gelu_pk((f32x2){v1[0], v1[1]}), d = gelu_pk((f32x2){v1[2], v1[3]});
                        v0 = (f32x4){a.x, a.y, b.x, b.y}; v1 = (f32x4){c.x, c.y, d.x, d.y}; }
                    if (ACT == 2) {
#pragma unroll
                        for (int j = 0; j < 4; ++j) { v0[j] = 0.5f * v0[j] * (1.0f + erff(v0[j] * 0.70710678f)); v1[j] = 0.5f * v1[j] * (1.0f + erff(v1[j] * 0.70710678f)); } }
                    u32x4 w; w.x = cvt_pk_bf16(v0[0], v0[1]); w.y = cvt_pk_bf16(v0[2], v0[3]); w.z = cvt_pk_bf16(v1[0], v1[1]); w.w = cvt_pk_bf16(v1[2], v1[3]);
                    *(u32x4*)(rowp + bj * HALF) = w; } }
    }
};

struct PanelStats {
    unsigned* xbuf;
    unsigned* cnt;
    unsigned* tmo;
    int ntn; float eps;
    unsigned code;
    __device__ __forceinline__ bool run(const f32x4 (&v)[2][2][4][2], const Unit& u, int wr, int wc, int fr, int fq, PG8_LAS unsigned char* lds, int wid, int lane) const {
        typedef float f32x2v __attribute__((ext_vector_type(2)));
        PG8_LAS f32x2v* P = (PG8_LAS f32x2v*)lds;
        PG8_LAS f32x2v* S = (PG8_LAS f32x2v*)(lds + 8192);
        PG8_LAS unsigned* flag = (PG8_LAS unsigned*)(lds + 8192 + 2048);
#pragma unroll
        for (int ai = 0; ai < 2; ++ai)
#pragma unroll
            for (int m = 0; m < 4; ++m) {
                float s = 0.f;
#pragma unroll
                for (int bj = 0; bj < 2; ++bj)
#pragma unroll
                    for (int n = 0; n < 2; ++n) { const f32x4 x = v[ai][bj][m][n]; s += (x[0] + x[1]) + (x[2] + x[3]); }
                s += __shfl_xor(s, 16); s += __shfl_xor(s, 32);
                const float mw = s * (1.0f / 64.0f); float q = 0.f;
#pragma unroll
                for (int bj = 0; bj < 2; ++bj)
#pragma unroll
                    for (int n = 0; n < 2; ++n) { const f32x4 d = v[ai][bj][m][n] - mw; q += (d[0] * d[0] + d[1] * d[1]) + (d[2] * d[2] + d[3] * d[3]); }
                q += __shfl_xor(q, 16); q += __shfl_xor(q, 32);
                if (fq == 0) P[(ai * HALF + wr * 64 + m * 16 + fr) * 4 + wc] = (f32x2v){mw, q};
            }
        asm volatile("s_waitcnt lgkmcnt(0)" ::: "memory"); __builtin_amdgcn_s_barrier(); asm volatile("" ::: "memory");
#if defined(BROKEN_NO_WAIT)
        if (blockIdx.x >= 64) { const long long t0 = clock64(); while (clock64() - t0 < 60000) __builtin_amdgcn_s_sleep(8); }
#endif
        const int row = wid * 32 + (lane & 31);
        if (lane < 32) {
            const f32x2v a = P[row * 4 + 0], b = P[row * 4 + 1], c = P[row * 4 + 2], d = P[row * 4 + 3];
            const float mt = (a.x + b.x + c.x + d.x) * 0.25f;
            const float da = a.x - mt, db = b.x - mt, dc = c.x - mt, dd = d.x - mt;
            const float m2 = (a.y + b.y) + (c.y + d.y) + 64.0f * ((da * da + db * db) + (dc * dc + dd * dd));
            unsigned long long* slot = (unsigned long long*)xbuf + ((size_t)(u.pm * BM + row) * 4 + u.pn);
            __hip_atomic_store(slot, ((unsigned long long)__float_as_uint(m2) << 32) | __float_as_uint(mt), __ATOMIC_RELAXED, __HIP_MEMORY_SCOPE_AGENT);
        }
        asm volatile("s_waitcnt vmcnt(0)" ::: "memory");
        if (lane == 0) __hip_atomic_fetch_add(cnt + 64 * u.pm, 1u, __ATOMIC_RELAXED, __HIP_MEMORY_SCOPE_AGENT);
        if (wid == 0) {
            bool dead = false; const unsigned long long t0 = __builtin_amdgcn_s_memrealtime(); const unsigned want = 8u * (unsigned)ntn;
            for (;;) {
#if defined(BROKEN_NO_WAIT)
                break;
#endif
                if ((unsigned)__builtin_amdgcn_readfirstlane(__hip_atomic_load(cnt + 64 * u.pm, __ATOMIC_RELAXED, __HIP_MEMORY_SCOPE_AGENT)) >= want) break;
                if (__builtin_amdgcn_s_memrealtime() - t0 > 2000000ull) {
                    if (lane == 0) { unsigned expect = 0u; __hip_atomic_compare_exchange_strong(tmo + 1, &expect, code | (unsigned)(u.pm & 0xff), __ATOMIC_RELAXED, __ATOMIC_RELAXED, __HIP_MEMORY_SCOPE_AGENT);
                                     __hip_atomic_store(tmo, 1u, __ATOMIC_RELAXED, __HIP_MEMORY_SCOPE_AGENT); }
                    dead = true; break; }
                __builtin_amdgcn_s_sleep(2);
            }
            __builtin_amdgcn_fence(__ATOMIC_ACQUIRE, "agent");
            if (lane == 0) flag[0] = dead ? 1u : 0u;
        }
        asm volatile("s_waitcnt vmcnt(0) lgkmcnt(0)" ::: "memory"); __builtin_amdgcn_s_barrier(); asm volatile("" ::: "memory");
        const bool bad = flag[0] != 0u;
        if (lane < 32) {
            const unsigned long long* slot = (const unsigned long long*)xbuf + (size_t)(u.pm * BM + row) * 4; float mt[4], m2[4]; float ms = 0.f;
#pragma unroll
            for (int t = 0; t < 4; ++t) { if (t < ntn) { const unsigned long long w = __hip_atomic_load(slot + t, __ATOMIC_RELAXED, __HIP_MEMORY_SCOPE_AGENT); mt[t] = __uint_as_float((unsigned)w); m2[t] = __uint_as_float((unsigned)(w >> 32)); } else { mt[t] = 0.f; m2[t] = 0.f; } ms += mt[t]; }
            const float mean = ms / (float)ntn; float q = 0.f;
#pragma unroll
            for (int t = 0; t < 4; ++t) if (t < ntn) { const float dm = mt[t] - mean; q += m2[t] + 256.0f * dm * dm; }
            S[row] = (f32x2v){mean, 1.0f / sqrtf(q / (256.0f * (float)ntn) + eps)};
        }
        asm volatile("s_waitcnt lgkmcnt(0)" ::: "memory"); __builtin_amdgcn_s_barrier(); asm volatile("" ::: "memory");
        return bad;
    }
};
struct EpiLnRes {
    static constexpr bool PERM = false, AFTER_DRAIN = true;
    const float* base; float* out; int ldc; const float* bias; PanelStats st; unsigned poison;
    __device__ __forceinline__ void refuse(size_t i0, size_t stride, int M, int N) const { const float q = __builtin_nanf(""); for (size_t i = i0; i < (size_t)M * N; i += stride) out[(i / N) * ldc + i % N] = q;
        if (i0 == 0) { unsigned expect = 0u; __hip_atomic_compare_exchange_strong(st.tmo + 1, &expect, 0x7f0u, __ATOMIC_RELAXED, __ATOMIC_RELAXED, __HIP_MEMORY_SCOPE_AGENT); __hip_atomic_store(st.tmo, 1u, __ATOMIC_RELAXED, __HIP_MEMORY_SCOPE_AGENT); } }
    __device__ __forceinline__ void fused(f32x4 (&acc)[2][2][4][2], const Unit& u, int wr, int wc, int fr, int fq, PG8_LAS unsigned char* lds, int wid, int lane) const {
        typedef float f32x2v __attribute__((ext_vector_type(2)));
        const PG8_LAS f32x2v* S = (const PG8_LAS f32x2v*)(lds + 8192);
        const int col0 = u.pn * BM + wc * 32 + 4 * fq;
#pragma unroll
        for (int bj = 0; bj < 2; ++bj)
#pragma unroll
            for (int n = 0; n < 2; ++n) { const f32x4 bv = bias ? *(const f32x4*)(bias + col0 + bj * HALF + n * 16) : (f32x4){0.f, 0.f, 0.f, 0.f};
#pragma unroll
                for (int ai = 0; ai < 2; ++ai)
#pragma unroll
                    for (int m = 0; m < 4; ++m) acc[ai][bj][m][n] += bv; }
        const bool bad = st.run(acc, u, wr, wc, fr, fq, lds, wid, lane) || poison != 0u;
        const float qnan = __builtin_nanf("");
#pragma unroll
        for (int ai = 0; ai < 2; ++ai)
#pragma unroll
            for (int m = 0; m < 4; ++m) { const int r = ai * HALF + wr * 64 + m * 16 + fr; const f32x2v sr = S[r]; const size_t off = (size_t)(u.pm * BM + r) * ldc + col0;
#pragma unroll
                for (int bj = 0; bj < 2; ++bj)
#pragma unroll
                    for (int n = 0; n < 2; ++n) { const f32x4 bs = *(const f32x4*)(base + off + bj * HALF + n * 16); f32x4 o = bs + (acc[ai][bj][m][n] - sr.x) * sr.y;
                        if (bad) o = (f32x4){qnan, qnan, qnan, qnan}; *(f32x4*)(out + off + bj * HALF + n * 16) = o; }
                asm volatile("" ::: "memory"); }
    }
};
struct EpiLnResLn {
    static constexpr bool PERM = false, AFTER_DRAIN = true;
    const float* base; float* out; bf16_t* xn; int ldc; const float* bias; PanelStats st1, st2; unsigned poison;
    __device__ __forceinline__ void refuse(size_t i0, size_t stride, int M, int N) const { const float q = __builtin_nanf(""); for (size_t i = i0; i < (size_t)M * N; i += stride) { const size_t o = (i / N) * ldc + i % N; out[o] = q; xn[o] = (bf16_t)0x7fc0u; }
        if (i0 == 0) { unsigned expect = 0u; __hip_atomic_compare_exchange_strong(st1.tmo + 1, &expect, 0x7f0u, __ATOMIC_RELAXED, __ATOMIC_RELAXED, __HIP_MEMORY_SCOPE_AGENT); __hip_atomic_store(st1.tmo, 1u, __ATOMIC_RELAXED, __HIP_MEMORY_SCOPE_AGENT); } }
    __device__ __forceinline__ void fused(f32x4 (&acc)[2][2][4][2], const Unit& u, int wr, int wc, int fr, int fq, PG8_LAS unsigned char* lds, int wid, int lane) const {
        typedef float f32x2v __attribute__((ext_vector_type(2))); typedef unsigned u32x2v __attribute__((ext_vector_type(2)));
        const PG8_LAS f32x2v* S = (const PG8_LAS f32x2v*)(lds + 8192);
        const int col0 = u.pn * BM + wc * 32 + 4 * fq;
#pragma unroll
        for (int bj = 0; bj < 2; ++bj)
#pragma unroll
            for (int n = 0; n < 2; ++n) { const f32x4 bv = bias ? *(const f32x4*)(bias + col0 + bj * HALF + n * 16) : (f32x4){0.f, 0.f, 0.f, 0.f};
#pragma unroll
                for (int ai = 0; ai < 2; ++ai)
#pragma unroll
                    for (int m = 0; m < 4; ++m) acc[ai][bj][m][n] += bv; }
        bool bad = st1.run(acc, u, wr, wc, fr, fq, lds, wid, lane) || poison != 0u;
        const float qnan = __builtin_nanf("");
#pragma unroll
        for (int ai = 0; ai < 2; ++ai)
#pragma unroll
            for (int m = 0; m < 4; ++m) { const int r = ai * HALF + wr * 64 + m * 16 + fr; const f32x2v sr = S[r]; const size_t off = (size_t)(u.pm * BM + r) * ldc + col0;
#pragma unroll
                for (int bj = 0; bj < 2; ++bj)
#pragma unroll
                    for (int n = 0; n < 2; ++n) { const f32x4 bs = *(const f32x4*)(base + off + bj * HALF + n * 16); acc[ai][bj][m][n] = bs + (acc[ai][bj][m][n] - sr.x) * sr.y; }
                asm volatile("" : "+v"(acc[ai][0][m][0]), "+v"(acc[ai][0][m][1]), "+v"(acc[ai][1][m][0]), "+v"(acc[ai][1][m][1]));
                if (m & 1) asm volatile("" ::: "memory"); }
        const bool bad1 = bad;
        bad = st2.run(acc, u, wr, wc, fr, fq, lds, wid, lane) || bad;
#pragma unroll
        for (int ai = 0; ai < 2; ++ai)
#pragma unroll
            for (int m = 0; m < 4; ++m) { const int r = ai * HALF + wr * 64 + m * 16 + fr; const f32x2v sr = S[r]; const size_t off = (size_t)(u.pm * BM + r) * ldc + col0;
#pragma unroll
                for (int bj = 0; bj < 2; ++bj)
#pragma unroll
                    for (int n = 0; n < 2; ++n) { const f32x4 x1 = acc[ai][bj][m][n]; *(f32x4*)(out + off + bj * HALF + n * 16) = bad1 ? (f32x4){qnan, qnan, qnan, qnan} : x1;
                        const f32x4 o = (x1 - sr.x) * sr.y; u32x2v w; w.x = cvt_pk_bf16(o[0], o[1]); w.y = cvt_pk_bf16(o[2], o[3]);
                        if (bad) { w.x = 0x7fc07fc0u; w.y = 0x7fc07fc0u; } *(u32x2v*)(xn + off + bj * HALF + n * 16) = w; }
                asm volatile("" ::: "memory"); }
    }
};

template <class Epi, class Sched, bool STAMP = false>
__device__ __forceinline__ void gemm_phase(PG8_LAS unsigned char* lds, const Gemm g, const Sched& S, const Epi& E, unsigned long long* stamps) {
    const int tid = threadIdx.x, wid = __builtin_amdgcn_readfirstlane(tid >> 6), lane = tid & 63, wr = wid >> 2, wc = wid & 3, fr = lane & 15, fq = lane >> 4;
    const int K = g.K, nt = K / BK;
    int ts_lo = 0, ts_hi = 0, nts = 0; const unsigned long long rt_entry = STAMP ? (unsigned long long)wall_clock64() : 0ull;
#define PG8_STAMP() do { if (STAMP && wid == 0 && nts < 64) { const unsigned long long _c = (unsigned long long)clock64(); \
        ts_lo = (lane == nts) ? (int)(unsigned)_c : ts_lo; ts_hi = (lane == nts) ? (int)(unsigned)(_c >> 32) : ts_hi; ++nts; } } while (0)
    PG8_STAMP();
    unsigned voffA[2], voffB[2];
#pragma unroll
    for (int i = 0; i < 2; ++i) { int R, C; stage_rc(tid * 16 + i * 8192, R, C); const int Rb = Epi::PERM ? ((R & ~31) + perm32(R & 31)) : R;
        voffA[i] = (unsigned)(R * K + C) * 2u; voffB[i] = (unsigned)(Rb * K + C) * 2u; }
    const size_t kstep = (size_t)(BK * 2);
    const size_t hstep = (size_t)HALF * K * 2;
    const size_t tstep = 2 * hstep;
    const unsigned ldsw = (unsigned)wid * 1024u;
    const int aoff = lds_byte(wr * 64 + fr, fq * 8), boff = lds_byte(wc * 32 + fr, fq * 8);
#define PG8_SA(b, h) (((b) * 2 + (h)) * HTB)
#define PG8_SB(b, h) ((4 + (b) * 2 + (h)) * HTB)
#define PG8_STAGE(bufoff, gbase, voff) do { _Pragma("unroll") for (int _i = 0; _i < 2; ++_i) \
        __builtin_amdgcn_global_load_lds((const unsigned*)((const char*)(gbase) + (voff)[_i]), (PG8_LAS unsigned*)(lds + (bufoff) + ldsw + _i * 8192), 16, 0, 0); } while (0)
#define PG8_LDA(dst, b, h) do { _Pragma("unroll") for (int m = 0; m < 4; ++m) _Pragma("unroll") for (int k = 0; k < 2; ++k) dst[m][k] = *(const PG8_LAS bf16x8*)(lds + PG8_SA(b, h) + aoff + m * 2048 + k * 1024); } while (0)
#define PG8_LDB(dst, b, h) do { _Pragma("unroll") for (int n = 0; n < 2; ++n) _Pragma("unroll") for (int k = 0; k < 2; ++k) dst[n][k] = *(const PG8_LAS bf16x8*)(lds + PG8_SB(b, h) + boff + n * 2048 + k * 1024); } while (0)
#define PG8_MMA(ai, bj, At, Bt) do { __builtin_amdgcn_s_setprio(1); _Pragma("unroll") for (int m = 0; m < 4; ++m) _Pragma("unroll") for (int n = 0; n < 2; ++n) _Pragma("unroll") for (int k = 0; k < 2; ++k) \
        acc[ai][bj][m][n] = __builtin_amdgcn_mfma_f32_16x16x32_bf16(Bt[n][k], At[m][k], acc[ai][bj][m][n], 0, 0, 0); __builtin_amdgcn_s_setprio(0); } while (0)
#define PG8_WAIT_V(n) asm volatile("s_waitcnt vmcnt(" #n ")" ::: "memory")
#define PG8_WAIT_L(n) asm volatile("s_waitcnt lgkmcnt(" #n ")" ::: "memory")
#define PG8_BAR __builtin_amdgcn_s_barrier()
#define PG8_SCHED __builtin_amdgcn_sched_barrier(0)
    Unit cur, nxt; int ui = 0;
    if (!S.next(0, cur)) return;
    f32x4 acc[2][2][4][2];
#pragma unroll
    for (int a = 0; a < 2; ++a)
#pragma unroll
        for (int b = 0; b < 2; ++b)
#pragma unroll
            for (int m = 0; m < 4; ++m)
#pragma unroll
                for (int n = 0; n < 2; ++n) acc[a][b][m][n] = (f32x4){0.f, 0.f, 0.f, 0.f};
    bf16x8 At[4][2], B0[2][2], B1[2][2];
    const char* cA = (const char*)g.A + (size_t)cur.pm * tstep; const char* cB = (const char*)g.Bt + (size_t)cur.pn * tstep;
    S.a_ready(cur);
    PG8_STAGE(PG8_SB(0, 0), cB, voffB); PG8_STAGE(PG8_SA(0, 0), cA, voffA); PG8_STAGE(PG8_SB(0, 1), cB + hstep, voffB); PG8_STAGE(PG8_SA(0, 1), cA + hstep, voffA);
    if (wr == 1) PG8_BAR;
    PG8_WAIT_V(4); PG8_BAR;
    PG8_STAGE(PG8_SB(1, 0), cB + kstep, voffB); PG8_STAGE(PG8_SA(1, 0), cA + kstep, voffA); PG8_STAGE(PG8_SB(1, 1), cB + hstep + kstep, voffB);
    PG8_WAIT_V(6); PG8_BAR;
    PG8_STAMP();
    for (;;) {
        const bool has_next = S.next(ui + 1, nxt);
        const char* nA = has_next ? (const char*)g.A + (size_t)nxt.pm * tstep : cA; const char* nB = has_next ? (const char*)g.Bt + (size_t)nxt.pn * tstep : cB;
        for (int t = 0; t < nt; t += 2) {
            const bool last = (t == nt - 2);
            const char* a1 = cA + (size_t)(t + 1) * kstep;
            const char* a2 = last ? nA : cA + (size_t)(t + 2) * kstep; const char* b2 = last ? nB : cB + (size_t)(t + 2) * kstep;
            const char* a3 = a2 + kstep; const char* b3 = b2 + kstep;
            if (last && has_next) S.a_ready(nxt);
            PG8_LDB(B0, 0, 0); PG8_SCHED; PG8_LDA(At, 0, 0); PG8_STAGE(PG8_SA(1, 1), a1 + hstep, voffA);
            PG8_WAIT_L(8); PG8_BAR; PG8_WAIT_L(0); PG8_MMA(0, 0, At, B0); PG8_BAR; PG8_SCHED;
            PG8_LDB(B1, 0, 1); PG8_STAGE(PG8_SB(0, 0), b2, voffB);
            PG8_BAR; PG8_WAIT_L(0); PG8_MMA(0, 1, At, B1); PG8_BAR;
            PG8_LDA(At, 0, 1); PG8_STAGE(PG8_SA(0, 0), a2, voffA);
            PG8_BAR; PG8_WAIT_L(0); PG8_MMA(1, 0, At, B0); PG8_BAR; PG8_SCHED;
            PG8_STAGE(PG8_SB(0, 1), b2 + hstep, voffB);
            PG8_WAIT_V(6); PG8_BAR; PG8_MMA(1, 1, At, B1); PG8_BAR;
            PG8_LDB(B0, 1, 0); PG8_SCHED; PG8_LDA(At, 1, 0); PG8_STAGE(PG8_SA(0, 1), a2 + hstep, voffA);
            PG8_WAIT_L(8); PG8_BAR; PG8_WAIT_L(0); PG8_MMA(0, 0, At, B0); PG8_BAR; PG8_SCHED;
            PG8_LDB(B1, 1, 1); PG8_STAGE(PG8_SB(1, 0), b3, voffB);
            PG8_BAR; PG8_WAIT_L(0); PG8_MMA(0, 1, At, B1); PG8_BAR;
            PG8_LDA(At, 1, 1); PG8_STAGE(PG8_SA(1, 0), a3, voffA);
            PG8_BAR; PG8_WAIT_L(0); PG8_MMA(1, 0, At, B0); PG8_BAR; PG8_SCHED;
            PG8_STAGE(PG8_SB(1, 1), b3 + hstep, voffB);
            PG8_WAIT_V(6); PG8_BAR; PG8_MMA(1, 1, At, B1); PG8_BAR;
        }
        PG8_STAMP();
        if constexpr (!Epi::AFTER_DRAIN) { E(acc, cur, wr, wc, fr, fq); S.done(cur); }
        PG8_STAMP();
        if (!has_next) break;
#pragma unroll
        for (int a = 0; a < 2; ++a)
#pragma unroll
            for (int b = 0; b < 2; ++b)
#pragma unroll
                for (int m = 0; m < 4; ++m)
#pragma unroll
                    for (int n = 0; n < 2; ++n) acc[a][b][m][n] = (f32x4){0.f, 0.f, 0.f, 0.f};
        cur = nxt; cA = nA; cB = nB; ++ui;
    }
    PG8_WAIT_V(0);
    if (wr == 0) PG8_BAR;
    PG8_BAR;
    if constexpr (Epi::AFTER_DRAIN) { E.fused(acc, cur, wr, wc, fr, fq, lds, wid, lane); S.done(cur); }
    PG8_STAMP();
    if (STAMP && wid == 0) { stamps[lane] = lane < nts ? (((unsigned long long)(unsigned)ts_hi << 32) | (unsigned)ts_lo) : 0ull;
        if (lane == 62) stamps[62] = rt_entry; if (lane == 63) stamps[63] = (unsigned long long)wall_clock64(); }
#undef PG8_STAMP
#undef PG8_SA
#undef PG8_SB
#undef PG8_STAGE
#undef PG8_LDA
#undef PG8_LDB
#undef PG8_MMA
#undef PG8_WAIT_V
#undef PG8_WAIT_L
#undef PG8_BAR
#undef PG8_SCHED
}
}

#include <hip/hip_cooperative_groups.h>
#include <cstdio>
namespace cg = cooperative_groups;
using pg8::bf16_t; using pg8::bf16x8; using pg8::f32x4; using pg8::Unit;
typedef float f32x16 __attribute__((ext_vector_type(16)));
typedef float f32x2 __attribute__((ext_vector_type(2)));
typedef unsigned u32x2 __attribute__((ext_vector_type(2)));
typedef unsigned u32x4v __attribute__((ext_vector_type(4)));
#define LAS __attribute__((address_space(3)))
#define XB_TMO      128
#define XB_XCNT(j)  (256  + 64 * (j))
#define XB_XSUB(j)  (1280 + 64 * (j))
#define XB_XGEN(j)  (2304 + 64 * (j))
#define XB_TOP      3328
#define XB_TOPGEN   3392
#define XCD_BAR_WORDS 3456
#define XB_SPIN_CAP (1u << 18)

__device__ __forceinline__ unsigned xb_ld(unsigned* p)              { return __hip_atomic_load(p, __ATOMIC_RELAXED, __HIP_MEMORY_SCOPE_AGENT); }
__device__ __forceinline__ unsigned xb_add(unsigned* p, unsigned v) { return __hip_atomic_fetch_add(p, v, __ATOMIC_RELAXED, __HIP_MEMORY_SCOPE_AGENT); }
__device__ __forceinline__ unsigned xb_xcc_id() { return (unsigned)__builtin_amdgcn_s_getreg((3 << 11) | 20) & 0xFu; }
#define XB_SPIN(cond, bar) do { unsigned _sp = 0; while (cond) { __builtin_amdgcn_s_sleep(1); \
    if ((++_sp & 255u) == 0u) { if (xb_ld(&(bar)[XB_TMO])) break; if (_sp > XB_SPIN_CAP) { atomicAdd(&(bar)[XB_TMO], 1u); break; } } } } while (0)

struct XcdBarrier {
    unsigned* bar; unsigned x;
    volatile LAS unsigned* st;
};

__device__ __forceinline__ XcdBarrier xcd_barrier_post(unsigned* bar, volatile LAS unsigned* st) {
    XcdBarrier b; b.bar = bar; b.x = xb_xcc_id(); b.st = st;
    if (threadIdx.x == 0) (void)xb_add(&bar[XB_XCNT(b.x)], 1u);
    return b;
}
__device__ __forceinline__ void xcd_barrier_complete(unsigned* bar, unsigned x, unsigned& nloc, unsigned& nx) {
    const unsigned G = gridDim.x * gridDim.y * gridDim.z;
    unsigned sum, cnt, mine, sp = 0u;
    for (;;) {
        sum = 0u; cnt = 0u; mine = 0u;
#pragma unroll
        for (unsigned j = 0; j < 16; ++j) { const unsigned c = xb_ld(&bar[XB_XCNT(j)]); sum += c; cnt += (c > 0u) ? 1u : 0u; mine = (j == x) ? c : mine; }
        if (sum == G) break;
        __builtin_amdgcn_s_sleep(1);
        if ((++sp & 255u) == 0u) { if (xb_ld(&bar[XB_TMO])) break; if (sp > XB_SPIN_CAP) { atomicAdd(&bar[XB_TMO], 1u); break; } }
    }
    nloc = mine > 0u ? mine : 1u; nx = cnt > 0u ? cnt : 1u;
}

__device__ __forceinline__ void xcd_barrier(const XcdBarrier& b) {
    asm volatile("s_waitcnt vmcnt(0)" ::: "memory");
    __syncthreads();
    if (threadIdx.x == 0) {
        unsigned* bar = b.bar;
        __builtin_amdgcn_s_waitcnt(0);
        unsigned nloc = b.st[0], nx = b.st[1];
        if (nloc == 0u) { xcd_barrier_complete(bar, b.x, nloc, nx); b.st[0] = nloc; b.st[1] = nx; }
        const unsigned old = xb_add(&bar[XB_XSUB(b.x)], 1u);
        const unsigned gen = old / nloc;
        if (old + 1u == (gen + 1u) * nloc) {
            __builtin_amdgcn_fence(__ATOMIC_RELEASE, "agent");
            asm volatile("s_waitcnt vmcnt(0)" ::: "memory");
            const unsigned og = xb_add(&bar[XB_TOP], 1u);
            const unsigned tg = og / nx;
            if (og + 1u == (tg + 1u) * nx) xb_add(&bar[XB_TOPGEN], 1u);
            else XB_SPIN(xb_ld(&bar[XB_TOPGEN]) == tg, bar);
            __builtin_amdgcn_fence(__ATOMIC_ACQUIRE, "agent");
            xb_add(&bar[XB_XGEN(b.x)], 1u);
            asm volatile("s_waitcnt vmcnt(0)" ::: "memory");
        } else {
            XB_SPIN(xb_ld(&bar[XB_XGEN(b.x)]) == gen, bar);
            __builtin_amdgcn_fence(__ATOMIC_ACQUIRE, "agent");
            asm volatile("s_waitcnt vmcnt(0)" ::: "memory");
        }
    }
    __syncthreads();
}

constexpr int MT = 16896, MPR = 16384, DM = 1024, NIN = 2816, DFF = 2816;
constexpr float EPS = 1e-6f;
constexpr int LDS_BYTES = 143360;
#ifndef N_LAUNCH_MODE
#define N_LAUNCH_MODE 1
#endif
constexpr int NPHASE = 13;
#ifndef EXTRA_LO
#define EXTRA_LO 0
#endif
#ifndef EXTRA_FLAGS
#define EXTRA_FLAGS 0
#endif
#ifndef EXTRA_HI
#define EXTRA_HI 0
#endif

constexpr size_t WS_WIN = 0;
constexpr size_t WS_WOUT = WS_WIN + (size_t)2816 * 1024 * 2;
constexpr size_t WS_WQ = WS_WOUT + (size_t)1024 * 1024 * 2;
constexpr size_t WS_WKV = WS_WQ + (size_t)1024 * 1024 * 2;
constexpr size_t WS_WO = WS_WKV + (size_t)2048 * 1024 * 2;
constexpr size_t WS_WGU = WS_WO + (size_t)1024 * 1024 * 2;
constexpr size_t WS_WD = WS_WGU + (size_t)5632 * 1024 * 2;
constexpr size_t WS_A = WS_WD + (size_t)1024 * 2816 * 2;
constexpr size_t WS_MN = WS_A + (size_t)MT * 1024 * 2;
constexpr size_t WS_MKB = WS_MN + (size_t)2048 * 1024 * 2;
constexpr size_t WS_MVT = WS_MKB + (size_t)2048 * 1024 * 2;
constexpr size_t WS_P = WS_MVT + (size_t)2048 * 1024 * 2;
constexpr size_t WS_U = WS_P + (size_t)MT * 2816 * 2;
constexpr size_t WS_DS = WS_U;
constexpr size_t WS_ST = WS_DS + (size_t)1024 * 8192 * 4;
constexpr size_t WS_AF = WS_ST + (size_t)1024 * 8192 * 2;
constexpr size_t WS_DEC = WS_AF + (size_t)MT * 16 * 4;
constexpr size_t WS_BQ = WS_DEC + (size_t)1024 * 64 * 4;
constexpr size_t WS_H = WS_U + (size_t)MT * 2816 * 2;
constexpr size_t WS_HB = WS_H + (size_t)MT * 1024 * 4;
constexpr size_t WS_SSQ = WS_HB + (size_t)MT * 1024 * 2;
constexpr size_t WS_SSQS = WS_SSQ + (size_t)3 * MT * 16 * 4;
constexpr size_t WS_BAR = WS_SSQS + (size_t)3 * 512 * 64 * 4;
constexpr size_t WS_GX = WS_BAR + (size_t)2 * XCD_BAR_WORDS * 4;
constexpr size_t WS_UX = WS_GX + (size_t)256 * 4 * 2816 * 4;
constexpr size_t WS_END = WS_UX + (size_t)256 * 2 * 2816 * 4;

constexpr size_t O_Y = 0;
constexpr size_t O_SGP = 17301504;
constexpr size_t O_SCP = 17563648;
constexpr size_t O_MK = 17608704;
constexpr size_t O_MV = 19705856;
constexpr size_t O_SGS = 21803008;
constexpr size_t O_SCS = 25997312;
constexpr size_t O_SV = 26718208;

struct Params { const float* in[29]; float* out; unsigned char* ws; int ph_lo, ph_hi, bar_region, pad; };

__device__ __forceinline__ unsigned pk2(float lo, float hi) { return pg8::cvt_pk_bf16(lo, hi); }
__device__ __forceinline__ bf16_t f2bf(float f) { return (bf16_t)(pk2(f, 0.f) & 0xffffu); }
__device__ __forceinline__ float bf2f(bf16_t b) { return __uint_as_float(((unsigned)b) << 16); }
__device__ __forceinline__ float bflo(unsigned w) { return __uint_as_float(w << 16); }
__device__ __forceinline__ float bfhi(unsigned w) { return __uint_as_float(w & 0xffff0000u); }
__device__ __forceinline__ float gelu_t(float x) { const float t = __builtin_fmaf(x * x, 0.044715f, 1.0f); const float e = __builtin_amdgcn_exp2f(x * t * -2.3022082f); return x * __builtin_amdgcn_rcpf(1.0f + e); }
__device__ __forceinline__ float silu_f(float x) { return x * __builtin_amdgcn_rcpf(1.0f + __builtin_amdgcn_exp2f(x * -1.44269504f)); }
__device__ __forceinline__ float logsig(float z) { return fminf(z, 0.f) - __logf(1.0f + __expf(-fabsf(z))); }
template <int CTRL> __device__ __forceinline__ float dppr(float x) { return __builtin_bit_cast(float, __builtin_amdgcn_update_dpp(0, __builtin_bit_cast(int, x), CTRL, 0xf, 0xf, true)); }
__device__ __forceinline__ float row_sum16(float s) { s += dppr<0x128>(s); s += dppr<0x124>(s); s += dppr<0x122>(s); s += dppr<0x121>(s); return s; }
__device__ __forceinline__ float wave_sum(float s) { s = row_sum16(s); s += __shfl_xor(s, 16); s += __shfl_xor(s, 32); return s; }
__device__ __forceinline__ float wave_max(float s) { for (int o = 32; o >= 1; o >>= 1) s = fmaxf(s, __shfl_xor(s, o)); return s; }
__device__ __forceinline__ f32x16 mma32(bf16x8 a, bf16x8 b, f32x16 c) { return __builtin_amdgcn_mfma_f32_32x32x16_bf16(a, b, c, 0, 0, 0); }
__device__ __forceinline__ f32x16 zero16() { f32x16 z; for (int i = 0; i < 16; ++i) z[i] = 0.f; return z; }
__device__ __forceinline__ float row_rs(const float* ssq, int row) {
    const f32x4* p = (const f32x4*)(ssq + (size_t)row * 16); f32x4 a = p[0], b = p[1], c = p[2], d = p[3];
    const float s = ((a[0] + a[1]) + (a[2] + a[3])) + ((b[0] + b[1]) + (b[2] + b[3])) + ((c[0] + c[1]) + (c[2] + c[3])) + ((d[0] + d[1]) + (d[2] + d[3]));
    return rsqrtf(s * (1.0f / 1024.0f) + EPS);
}

__device__ __forceinline__ float row_rs64(const float* ssq64, int r) {
    const f32x4* p = (const f32x4*)(ssq64 + (size_t)r * 64); float s = 0.f;
#pragma unroll
    for (int i = 0; i < 16; ++i) { const f32x4 a = p[i]; s += (a[0] + a[1]) + (a[2] + a[3]); }
    return rsqrtf(s * (1.0f / 1024.0f) + EPS);
}
__device__ __forceinline__ float row_rs2(const float* ssq16, const float* ssq64, int row) { return row < MPR ? row_rs(ssq16, row) : row_rs64(ssq64, row - MPR); }
template <int KC, class F>
__device__ __forceinline__ void gemm_small(const bf16_t* A, const bf16_t* Bt, int K, int ncb, LAS unsigned char* lds, F f) {
    constexpr int PITCH = KC * 2 + 16, PPR = KC / 8, NP = 96 * PPR, NPT = (NP + 511) / 512, BUF = 96 * PITCH; static_assert(KC % 32 == 0 && 2 * BUF <= 140000, "KC must be a multiple of the MFMA K; two buffers must fit");
    const int tid = threadIdx.x, lane = tid & 63, wave = tid >> 6, fr = lane & 15, fq = lane >> 4;
    for (int t = blockIdx.x; t < 16 * ncb; t += gridDim.x) { const int rb = t & 15, cb = t >> 4;
        f32x4 acc = (f32x4){0.f, 0.f, 0.f, 0.f};
        u32x4v v[NPT]; const bf16_t* src[NPT]; int dsto[NPT];
#pragma unroll
        for (int i = 0; i < NPT; ++i) { const int idx = tid + 512 * i, row = idx / PPR, pc = idx % PPR;
            src[i] = (row < 32 ? A + (size_t)(rb * 32 + row) * K : Bt + (size_t)(cb * 64 + row - 32) * K) + pc * 8; dsto[i] = row * PITCH + pc * 16;
            if (idx < NP) v[i] = *(const u32x4v*)(src[i]); }
        int buf = 0;
        for (int k0 = 0; k0 < K; k0 += KC) {
            LAS unsigned char* L = lds + buf * BUF;
#pragma unroll
            for (int i = 0; i < NPT; ++i) { const int idx = tid + 512 * i; if (idx < NP) *(LAS u32x4v*)(L + dsto[i]) = v[i]; }
            __syncthreads();
            if (k0 + KC < K) {
#pragma unroll
                for (int i = 0; i < NPT; ++i) { const int idx = tid + 512 * i; if (idx < NP) v[i] = *(const u32x4v*)(src[i] + k0 + KC); } }
            const LAS unsigned char* ap = L + ((wave & 1) * 16 + fr) * PITCH + fq * 16; const LAS unsigned char* bp = L + (32 + (wave >> 1) * 16 + fr) * PITCH + fq * 16;
#pragma unroll
            for (int k = 0; k < KC; k += 32) { const bf16x8 av = *(const LAS bf16x8*)(ap + k * 2); const bf16x8 bv = *(const LAS bf16x8*)(bp + k * 2);
                acc = __builtin_amdgcn_mfma_f32_16x16x32_bf16(bv, av, acc, 0, 0, 0); }
            buf ^= 1;
            __syncthreads();
        }
        __syncthreads();
        f(rb * 32 + (wave & 1) * 16 + fr, cb * 64 + (wave >> 1) * 16 + 4 * fq, cb * 4 + (wave >> 1), fq, acc);
    }
}
#define EPI_LOOP_ROWS for (int ai = 0; ai < 2; ++ai) _Pragma("unroll") for (int m = 0; m < 4; ++m)
__device__ __forceinline__ u32x4v pack8(const f32x4 a, const f32x4 c) { u32x4v w; w.x = pk2(a[0], a[1]); w.y = pk2(a[2], a[3]); w.z = pk2(c[0], c[1]); w.w = pk2(c[2], c[3]); return w; }
__device__ __forceinline__ float sq4(const f32x4 v) { return (v[0] * v[0] + v[1] * v[1]) + (v[2] * v[2] + v[3] * v[3]); }
template <int CTRL> __device__ __forceinline__ float dpp_f(float x) { return __builtin_bit_cast(float, __builtin_amdgcn_update_dpp(0, __builtin_bit_cast(int, x), CTRL, 0xf, 0xf, true)); }
template <int CTRL> __device__ __forceinline__ f32x4 dpp4(const f32x4 v) { return (f32x4){dpp_f<CTRL>(v[0]), dpp_f<CTRL>(v[1]), dpp_f<CTRL>(v[2]), dpp_f<CTRL>(v[3])}; }
__device__ __forceinline__ f32x4 gelu4(const f32x4 v) { return (f32x4){gelu_t(v[0]), gelu_t(v[1]), gelu_t(v[2]), gelu_t(v[3])}; }
__device__ __forceinline__ void rs_rows8(float (&rsv)[2][4], const float* ssq, int row0, int fq) {
    f32x4 q[2][4];
#pragma unroll
    for (int ai = 0; ai < 2; ++ai)
#pragma unroll
        for (int m = 0; m < 4; ++m) q[ai][m] = *(const f32x4*)(ssq + (size_t)(row0 + ai * 128 + m * 16) * 16 + 4 * fq);
#pragma unroll
    for (int ai = 0; ai < 2; ++ai)
#pragma unroll
        for (int m = 0; m < 4; ++m) { float t = (q[ai][m][0] + q[ai][m][1]) + (q[ai][m][2] + q[ai][m][3]); t += __shfl_xor(t, 16); t += __shfl_xor(t, 32); rsv[ai][m] = rsqrtf(t * (1.0f / 1024.0f) + EPS); }
}
__device__ __forceinline__ void rs_rows8_s(float (&rsv)[2][4], const float* ssq64, int r0, int fq) {
#pragma unroll
    for (int ai = 0; ai < 2; ++ai) { f32x4 q[4][4];
#pragma unroll
        for (int m = 0; m < 4; ++m) { const f32x4* pp = (const f32x4*)(ssq64 + (size_t)(r0 + ai * 128 + m * 16) * 64 + 16 * fq); q[m][0] = pp[0]; q[m][1] = pp[1]; q[m][2] = pp[2]; q[m][3] = pp[3]; }
#pragma unroll
        for (int m = 0; m < 4; ++m) { const f32x4 v = (q[m][0] + q[m][1]) + (q[m][2] + q[m][3]); float t = (v[0] + v[1]) + (v[2] + v[3]); t += __shfl_xor(t, 16); t += __shfl_xor(t, 32); rsv[ai][m] = rsqrtf(t * (1.0f / 1024.0f) + EPS); } }
}
struct EpiIn {
    static constexpr bool PERM = true, AFTER_DRAIN = false;
    bf16_t* P; float* af;
    __device__ __forceinline__ void operator()(const f32x4 (&acc)[2][2][4][2], const Unit& u, int wr, int wc, int fr, int fq) const {
        const int row0 = u.pm * 256 + wr * 64 + fr, col0 = u.pn * 256 + wc * 32 + 8 * fq;
#pragma unroll
        EPI_LOOP_ROWS { const int row = row0 + ai * 128 + m * 16;
#pragma unroll
            for (int bj = 0; bj < 2; ++bj) *(u32x4v*)(P + (size_t)row * NIN + col0 + bj * 128) = pack8(acc[ai][bj][m][0], acc[ai][bj][m][1]);
        }
    }
};
struct EpiKV {
    static constexpr bool PERM = true, AFTER_DRAIN = false;
    float* omk; float* omv; bf16_t* mkb; bf16_t* mvt;
    __device__ __forceinline__ void operator()(const f32x4 (&acc)[2][2][4][2], const Unit& u, int wr, int wc, int fr, int fq) const {
        const int row0 = u.pm * 256 + wr * 64 + fr, col0 = u.pn * 256 + wc * 32 + 8 * fq;
#pragma unroll
        EPI_LOOP_ROWS { const int row = row0 + ai * 128 + m * 16;
#pragma unroll
            for (int bj = 0; bj < 2; ++bj) { const f32x4 v0 = acc[ai][bj][m][0], v1 = acc[ai][bj][m][1]; const int col = col0 + bj * 128;
                if (col < 1024) { float* o = omk + (size_t)row * 1024 + col; *(f32x4*)o = v0; *(f32x4*)(o + 4) = v1; *(u32x4v*)(mkb + (size_t)row * 1024 + col) = pack8(v0, v1); }
                else { const int c2 = col - 1024; float* o = omv + (size_t)row * 1024 + c2; *(f32x4*)o = v0; *(f32x4*)(o + 4) = v1;
                    const int b = row >> 8, mt = row & 255, h = c2 >> 8, d = c2 & 255; bf16_t* t = mvt + ((size_t)(b * 4 + h) * 256 + d) * 256 + mt;
                    t[0] = f2bf(v0[0]); t[256] = f2bf(v0[1]); t[512] = f2bf(v0[2]); t[768] = f2bf(v0[3]); t[1024] = f2bf(v1[0]); t[1280] = f2bf(v1[1]); t[1536] = f2bf(v1[2]); t[1792] = f2bf(v1[3]); } }
        }
    }
};
__device__ __forceinline__ void unpack8(const u32x4v w, f32x4& a, f32x4& c) { a = (f32x4){bflo(w.x), bfhi(w.x), bflo(w.y), bfhi(w.y)}; c = (f32x4){bflo(w.z), bfhi(w.z), bflo(w.w), bfhi(w.w)}; }
struct EpiRes {
    static constexpr bool PERM = true, AFTER_DRAIN = false;
    const float* xf; bf16_t* hb; float* ssq;
    __device__ __forceinline__ void operator()(const f32x4 (&acc)[2][2][4][2], const Unit& u, int wr, int wc, int fr, int fq) const {
        const int row0 = u.pm * 256 + wr * 64 + fr, col0 = u.pn * 256 + wc * 32 + 8 * fq;
#pragma unroll
        for (int h2 = 0; h2 < 4; ++h2) { const int ai = h2 >> 1, mb = (h2 & 1) * 2;
            f32x4 bs[2][2][2];
            if (xf) {
#pragma unroll
                for (int mm = 0; mm < 2; ++mm)
#pragma unroll
                    for (int bj = 0; bj < 2; ++bj) { const float* pb = xf + (size_t)(row0 + ai * 128 + (mb + mm) * 16) * 1024 + col0 + bj * 128; bs[mm][bj][0] = *(const f32x4*)pb; bs[mm][bj][1] = *(const f32x4*)(pb + 4); }
            } else { u32x4v raw[2][2];
#pragma unroll
                for (int mm = 0; mm < 2; ++mm)
#pragma unroll
                    for (int bj = 0; bj < 2; ++bj) raw[mm][bj] = *(const u32x4v*)(hb + (size_t)(row0 + ai * 128 + (mb + mm) * 16) * 1024 + col0 + bj * 128);
#pragma unroll
                for (int mm = 0; mm < 2; ++mm)
#pragma unroll
                    for (int bj = 0; bj < 2; ++bj) unpack8(raw[mm][bj], bs[mm][bj][0], bs[mm][bj][1]); }
#pragma unroll
            for (int mm = 0; mm < 2; ++mm) { const int m = mb + mm, row = row0 + ai * 128 + m * 16; float s = 0.f;
#pragma unroll
                for (int bj = 0; bj < 2; ++bj) { const f32x4 v0 = acc[ai][bj][m][0] + bs[mm][bj][0], v1 = acc[ai][bj][m][1] + bs[mm][bj][1];
                    *(u32x4v*)(hb + (size_t)row * 1024 + col0 + bj * 128) = pack8(v0, v1); s += sq4(v0) + sq4(v1); }
                s += __shfl_xor(s, 16); s += __shfl_xor(s, 32);
                if (fq == 0) ssq[(size_t)row * 16 + u.pn * 4 + wc] = s; }
        }
    }
};
#define RLXA __ATOMIC_RELAXED, __HIP_MEMORY_SCOPE_AGENT
__device__ __forceinline__ void ld_coh16x4(f32x4& a, f32x4& b_, f32x4& c, f32x4& d, const float* pa, const float* pb, const float* pc, const float* pd) {
    asm volatile("global_load_dwordx4 %0, %4, off sc1\n\tglobal_load_dwordx4 %1, %5, off sc1\n\tglobal_load_dwordx4 %2, %6, off sc1\n\tglobal_load_dwordx4 %3, %7, off sc1\n\ts_waitcnt vmcnt(0)"
                 : "=&v"(a), "=&v"(b_), "=&v"(c), "=&v"(d) : "v"(pa), "v"(pb), "v"(pc), "v"(pd) : "memory");
}
__device__ __forceinline__ void spin_poll(unsigned* cnt, unsigned want) {
    unsigned sp = 0; while ((unsigned)__builtin_amdgcn_readfirstlane(__hip_atomic_load(cnt, RLXA)) < want) { __builtin_amdgcn_s_sleep(2); if (++sp > (1u << 22)) break; }
}
__device__ __forceinline__ void wg_wait2(unsigned* c1, unsigned w1, unsigned* c2, unsigned w2) {
    if (threadIdx.x < 64) { spin_poll(c1, w1); if (c2) spin_poll(c2, w2); __builtin_amdgcn_fence(__ATOMIC_ACQUIRE, "agent"); asm volatile("s_waitcnt vmcnt(0)" ::: "memory"); }
    __syncthreads();
}
struct EpiFin {
    static constexpr bool PERM = true, AFTER_DRAIN = true;
    const bf16_t* hb; float* ssq; unsigned* cnt; const float* gfin; float* out; int flags;
    const bf16_t* sA; const bf16_t* sBt; float* ssq64;
    __device__ __forceinline__ void fused(f32x4 (&acc)[2][2][4][2], const Unit& u, int wr, int wc, int fr, int fq, LAS unsigned char* lds_, int wid_, int lane_) const {
        const int row0 = u.pm * 256 + wr * 64 + fr, col0 = u.pn * 256 + wc * 32 + 8 * fq;
#pragma unroll
        for (int ai = 0; ai < 2; ++ai) { u32x4v raw[4][2];
#pragma unroll
            for (int m = 0; m < 4; ++m)
#pragma unroll
                for (int bj = 0; bj < 2; ++bj) raw[m][bj] = *(const u32x4v*)(hb + (size_t)(row0 + ai * 128 + m * 16) * 1024 + col0 + bj * 128);
#pragma unroll
            for (int m = 0; m < 4; ++m) { const int row = row0 + ai * 128 + m * 16; float s = 0.f;
#pragma unroll
                for (int bj = 0; bj < 2; ++bj) { f32x4 b0, b1; unpack8(raw[m][bj], b0, b1);
                    acc[ai][bj][m][0] += b0; acc[ai][bj][m][1] += b1; s += sq4(acc[ai][bj][m][0]) + sq4(acc[ai][bj][m][1]); }
                s += __shfl_xor(s, 16); s += __shfl_xor(s, 32);
                if (fq == 0) __hip_atomic_store((unsigned*)(ssq + (size_t)row * 16 + u.pn * 4 + wc), __float_as_uint(s), RLXA); }
        }
        asm volatile("s_waitcnt vmcnt(0)" ::: "memory");
        if ((threadIdx.x & 63) == 0) __hip_atomic_fetch_add(cnt + u.pm, 1u, RLXA);
        f32x4 sv = (f32x4){0.f, 0.f, 0.f, 0.f}; int sr = -1, sc = 0; unsigned* scw = cnt;
        { const bf16_t* hbs = hb + (size_t)MPR * 1024; float* sq = ssq64; unsigned* cnt2 = cnt + 64;
          gemm_small<256>(sA, sBt, 2816, 16, lds_, [&](int r, int c, int cb, int fq2, f32x4 a) {
              const size_t off = (size_t)r * 1024 + c; const u32x2 hw = *(const u32x2*)(hbs + off); const f32x4 v = a + (f32x4){bflo(hw.x), bfhi(hw.x), bflo(hw.y), bfhi(hw.y)};
              float s = sq4(v); s += __shfl_xor(s, 16); s += __shfl_xor(s, 32); if (fq2 == 0) __hip_atomic_store((unsigned*)(sq + (size_t)r * 64 + cb), __float_as_uint(s), RLXA);
              asm volatile("s_waitcnt vmcnt(0)" ::: "memory");
              scw = cnt2 + (r >> 5); if ((threadIdx.x & 63) == 0) __hip_atomic_fetch_add(scw, 1u, RLXA);
              sv = v; sr = r; sc = c; }); }
        wg_wait2(cnt + u.pm, 32u, sr >= 0 ? scw : nullptr, 128u);
        f32x4 g[2][2];
#pragma unroll
        for (int bj = 0; bj < 2; ++bj) { g[bj][0] = *(const f32x4*)(gfin + col0 + bj * 128); g[bj][1] = *(const f32x4*)(gfin + col0 + bj * 128 + 4); }
        f32x4 pq[2][4];
#pragma unroll
        for (int ai = 0; ai < 2; ++ai) { const float* b0 = ssq + (size_t)(row0 + ai * 128) * 16 + 4 * fq; ld_coh16x4(pq[ai][0], pq[ai][1], pq[ai][2], pq[ai][3], b0, b0 + 16 * 16, b0 + 32 * 16, b0 + 48 * 16); }
#pragma unroll
        EPI_LOOP_ROWS { const int row = row0 + ai * 128 + m * 16; const f32x4 q4 = pq[ai][m];
            float s = (q4[0] + q4[1]) + (q4[2] + q4[3]);
            s += __shfl_xor(s, 16); s += __shfl_xor(s, 32); const float rs = rsqrtf(s * (1.0f / 1024.0f) + EPS);
#pragma unroll
            for (int bj = 0; bj < 2; ++bj) { float* o = out + (size_t)row * 1024 + col0 + bj * 128; *(f32x4*)o = acc[ai][bj][m][0] * rs * g[bj][0]; *(f32x4*)(o + 4) = acc[ai][bj][m][1] * rs * g[bj][1]; }
        }
        if (sr >= 0) {

            const float* sp = ssq64 + (size_t)sr * 64 + 16 * fq; f32x4 q0, q1, q2, q3; ld_coh16x4(q0, q1, q2, q3, sp, sp + 4, sp + 8, sp + 12);
            const f32x4 qs = (q0 + q1) + (q2 + q3); float t = (qs[0] + qs[1]) + (qs[2] + qs[3]);
            t += __shfl_xor(t, 16); t += __shfl_xor(t, 32); const float rs = rsqrtf(t * (1.0f / 1024.0f) + EPS);
            *(f32x4*)(out + (size_t)(MPR + sr) * 1024 + sc) = sv * rs * *(const f32x4*)(gfin + sc);
        }
    }
};
struct EpiQ {
    static constexpr bool PERM = true, AFTER_DRAIN = false;
    bf16_t* Q; const float* ssq;
    __device__ __forceinline__ void operator()(const f32x4 (&acc)[2][2][4][2], const Unit& u, int wr, int wc, int fr, int fq) const {
        const int row0 = u.pm * 256 + wr * 64 + fr, col0 = u.pn * 256 + wc * 32 + 8 * fq;
        float rsv[2][4]; rs_rows8(rsv, ssq, row0, fq);
#pragma unroll
        EPI_LOOP_ROWS { const int row = row0 + ai * 128 + m * 16; const float rs = rsv[ai][m];
#pragma unroll
            for (int bj = 0; bj < 2; ++bj) *(u32x4v*)(Q + (size_t)row * 1024 + col0 + bj * 128) = pack8(acc[ai][bj][m][0] * rs, acc[ai][bj][m][1] * rs);
        }
    }
};
struct EpiGU {
    static constexpr bool PERM = true, AFTER_DRAIN = false;
    bf16_t* U; const float* ssq; const float* ssq64; float* scp; float* scs; const float* cw; const float* cbias; const float* sconv; float* GX; float* UX; int flags;
    __device__ __forceinline__ void operator()(const f32x4 (&acc)[2][2][4][2], const Unit& u, int wr, int wc, int fr, int fq) const {
        const int row0 = u.pm * 256 + wr * 64 + fr, ch0 = u.pn * 128 + wc * 32 + 8 * fq;
        if (flags & 48) {
            if (flags & 16) {
#pragma unroll
                EPI_LOOP_ROWS { const int row = row0 + ai * 128 + m * 16; *(u32x4v*)(U + (size_t)row * DFF + ch0) = pack8(acc[ai][0][m][0] * acc[ai][1][m][0], acc[ai][0][m][1] * acc[ai][1][m][1]); } }
            return; }
        float rsv[2][4]; if (u.pm < 64) rs_rows8(rsv, ssq, row0, fq); else rs_rows8_s(rsv, ssq64, row0 - MPR, fq);
        f32x4 w0[2], w1[2], w2[2], bb[2];
#pragma unroll
        for (int n = 0; n < 2; ++n) { w0[n] = *(const f32x4*)(cw + ch0 + 4 * n); w1[n] = *(const f32x4*)(cw + DFF + ch0 + 4 * n); w2[n] = *(const f32x4*)(cw + 2 * DFF + ch0 + 4 * n); bb[n] = *(const f32x4*)(cbias + ch0 + 4 * n); }
        if (u.pm < 64) {
#pragma unroll
            for (int ai = 0; ai < 2; ++ai) { f32x4 pr1[2], pr2[2];
#pragma unroll
                for (int n = 0; n < 2; ++n) { pr1[n] = (f32x4){0.f, 0.f, 0.f, 0.f}; pr2[n] = pr1[n]; }
#pragma unroll
                for (int m = 0; m < 4; ++m) { const int row = row0 + ai * 128 + m * 16; const float rs = rsv[ai][m]; const int t = row & 2047, t6 = row & 63;
                    f32x4 a[2];
#pragma unroll
                    for (int n = 0; n < 2; ++n) { const f32x4 g = acc[ai][0][m][n] * rs, up = acc[ai][1][m][n] * rs; const f32x4 r1 = dpp4<0x121>(g), r2 = dpp4<0x122>(g);
                        const f32x4 p1 = fr >= 1 ? r1 : pr1[n], p2 = fr >= 2 ? r2 : pr2[n]; pr1[n] = r1; pr2[n] = r2;
                        a[n] = gelu4(bb[n] + w0[n] * p2 + w1[n] * p1 + w2[n] * g) * up;
                        if (t >= 2046) *(f32x4*)(scp + (size_t)((row >> 11) * 2 + (t - 2046)) * DFF + ch0 + 4 * n) = g;
                        if (t6 < 2) { *(f32x4*)(GX + ((size_t)(row >> 6) * 4 + t6) * DFF + ch0 + 4 * n) = g; *(f32x4*)(UX + ((size_t)(row >> 6) * 2 + t6) * DFF + ch0 + 4 * n) = up; }
                        if (t6 >= 62) *(f32x4*)(GX + ((size_t)(row >> 6) * 4 + (t6 - 60)) * DFF + ch0 + 4 * n) = g; }
                    *(u32x4v*)(U + (size_t)row * DFF + ch0) = pack8(a[0], a[1]); } }
        } else {
            const int tt = fr & 3;
#pragma unroll
            EPI_LOOP_ROWS { const int row = row0 + ai * 128 + m * 16, r2i = row - MPR, bq = r2i >> 2; const float rs = rsv[ai][m];
                f32x4 a[2];
#pragma unroll
                for (int n = 0; n < 2; ++n) { const f32x4 g = acc[ai][0][m][n] * rs, up = acc[ai][1][m][n] * rs; const f32x4 r1 = dpp4<0x121>(g), r2 = dpp4<0x122>(g);
                    f32x4 p1 = r1, p2 = r2;
                    if (tt < 2) { const f32x4 s1 = *(const f32x4*)(sconv + (size_t)(bq * 2 + 1) * DFF + ch0 + 4 * n); if (tt == 0) { p1 = s1; p2 = *(const f32x4*)(sconv + (size_t)(bq * 2) * DFF + ch0 + 4 * n); } else p2 = s1; }
                    a[n] = gelu4(bb[n] + w0[n] * p2 + w1[n] * p1 + w2[n] * g) * up;
                    if (tt >= 2) *(f32x4*)(scs + (size_t)(bq * 2 + (tt - 2)) * DFF + ch0 + 4 * n) = g; }
                *(u32x4v*)(U + (size_t)row * DFF + ch0) = pack8(a[0], a[1]); }
        }
    }
};
__device__ __forceinline__ void act_fixup(const Params& p, int pm) {
    const float* GX = (const float*)(p.ws + WS_GX); const float* UX = (const float*)(p.ws + WS_UX); bf16_t* U = (bf16_t*)(p.ws + WS_U); const float* cw = p.in[25]; const float* cbias = p.in[26];
    for (int i0 = threadIdx.x; i0 < 4 * 704; i0 += 1024) {
        f32x4 w0[2], w1[2], w2[2], bb[2], g0[2], g1[2], u0[2], u1[2], gm2[2], gm1[2]; int t0v[2], chv[2]; bool ok[2];
#pragma unroll
        for (int k = 0; k < 2; ++k) { const int i = i0 + 512 * k; ok[k] = i < 4 * 704; const int ii = ok[k] ? i : i0; const int q = ii / 704, ch = (ii % 704) * 4, blk = pm * 4 + q, t0 = blk * 64; t0v[k] = t0; chv[k] = ch;
            w0[k] = *(const f32x4*)(cw + ch); w1[k] = *(const f32x4*)(cw + DFF + ch); w2[k] = *(const f32x4*)(cw + 2 * DFF + ch); bb[k] = *(const f32x4*)(cbias + ch);
            g0[k] = *(const f32x4*)(GX + ((size_t)blk * 4 + 0) * DFF + ch); g1[k] = *(const f32x4*)(GX + ((size_t)blk * 4 + 1) * DFF + ch);
            u0[k] = *(const f32x4*)(UX + ((size_t)blk * 2 + 0) * DFF + ch); u1[k] = *(const f32x4*)(UX + ((size_t)blk * 2 + 1) * DFF + ch);
            gm2[k] = (f32x4){0.f, 0.f, 0.f, 0.f}; gm1[k] = gm2[k];
            if ((t0 & 2047) != 0) { gm2[k] = *(const f32x4*)(GX + ((size_t)(blk - 1) * 4 + 2) * DFF + ch); gm1[k] = *(const f32x4*)(GX + ((size_t)(blk - 1) * 4 + 3) * DFF + ch); } }
#pragma unroll
        for (int k = 0; k < 2; ++k) if (ok[k]) {
            const f32x4 a0 = gelu4(bb[k] + w0[k] * gm2[k] + w1[k] * gm1[k] + w2[k] * g0[k]) * u0[k], a1 = gelu4(bb[k] + w0[k] * gm1[k] + w1[k] * g0[k] + w2[k] * g1[k]) * u1[k];
            u32x2 o0, o1; o0.x = pk2(a0[0], a0[1]); o0.y = pk2(a0[2], a0[3]); o1.x = pk2(a1[0], a1[1]); o1.y = pk2(a1[2], a1[3]);
            *(u32x2*)(U + (size_t)t0v[k] * DFF + chv[k]) = o0; *(u32x2*)(U + (size_t)(t0v[k] + 1) * DFF + chv[k]) = o1; }
    }
}

__device__ __forceinline__ int win_src_col(int n) { return n < 1536 ? n : (n < 2560 ? n + 16 : (n < 2576 ? n - 1024 : -1)); }
__device__ __forceinline__ void tr_strip(LAS float* T, const float* src, int ldn, bf16_t* dst, int K, int k0, int n0, const float* ksc, bool cmap, int rmode) {
    const int tid = threadIdx.x;
    f32x4 v[8];
    { const int n4 = (tid & 63) * 4; int sc = n0 + n4; if (cmap) sc = win_src_col(sc);
#pragma unroll
      for (int i = 0; i < 8; ++i) { const int kk = (tid >> 6) + 8 * i; v[i] = (f32x4){0.f, 0.f, 0.f, 0.f}; if (sc >= 0) v[i] = *(const f32x4*)(src + (size_t)(k0 + kk) * ldn + sc); }
#pragma unroll
      for (int i = 0; i < 8; ++i) { const int kk = (tid >> 6) + 8 * i; f32x4 w = v[i]; if (ksc) w = w * ksc[k0 + kk];
          T[kk * 257 + n4] = w[0]; T[kk * 257 + n4 + 1] = w[1]; T[kk * 257 + n4 + 2] = w[2]; T[kk * 257 + n4 + 3] = w[3]; } }
    __syncthreads();
    { const int n = tid >> 1, kh = (tid & 1) * 32;
#pragma unroll
      for (int q = 0; q < 4; ++q) { const int kb = kh + q * 8; u32x4v w;
          w.x = pk2(T[(kb + 0) * 257 + n], T[(kb + 1) * 257 + n]); w.y = pk2(T[(kb + 2) * 257 + n], T[(kb + 3) * 257 + n]);
          w.z = pk2(T[(kb + 4) * 257 + n], T[(kb + 5) * 257 + n]); w.w = pk2(T[(kb + 6) * 257 + n], T[(kb + 7) * 257 + n]);
          const int nn = n0 + n, drow = rmode ? ((nn >> 7) * 256 + (rmode == 2 ? 128 : 0) + (nn & 127)) : nn;
          *(u32x4v*)(dst + (size_t)drow * K + k0 + kb) = w; } }
    __syncthreads();
}
struct NormRow { f32x4 v[4]; };
__device__ __forceinline__ void norm_load(NormRow& R, const float* x, int lane) {
#pragma unroll
    for (int i = 0; i < 4; ++i) R.v[i] = __builtin_nontemporal_load((const f32x4*)(x + i * 256 + lane * 4));
}
constexpr int PREP_TA = 66048;
__device__ __forceinline__ void norm_a(const NormRow& R, float rs, const LAS float* Ta, float* af_row, int lane) {
    float acc[16];
#pragma unroll
    for (int c = 0; c < 16; ++c) { float s = 0.f;
#pragma unroll
        for (int i = 0; i < 4; ++i) { const f32x4 w = *(const LAS f32x4*)(Ta + c * 1024 + i * 256 + lane * 4); s += (R.v[i][0] * w[0] + R.v[i][1] * w[1]) + (R.v[i][2] * w[2] + R.v[i][3] * w[3]); }
        acc[c] = s; }
    const bool b5 = lane & 32, b4 = lane & 16, b3 = lane & 8, b2 = lane & 4;
    float a8[8], a4[4], a2[2], a1;
#pragma unroll
    for (int j = 0; j < 8; ++j) { const float send = b5 ? acc[j] : acc[j + 8]; const float keep = b5 ? acc[j + 8] : acc[j]; a8[j] = keep + __shfl_xor(send, 32); }
#pragma unroll
    for (int j = 0; j < 4; ++j) { const float send = b4 ? a8[j] : a8[j + 4]; const float keep = b4 ? a8[j + 4] : a8[j]; a4[j] = keep + __shfl_xor(send, 16); }
#pragma unroll
    for (int j = 0; j < 2; ++j) { const float send = b3 ? a4[j] : a4[j + 2]; const float keep = b3 ? a4[j + 2] : a4[j]; a2[j] = keep + __shfl_xor(send, 8); }
    { const float send = b2 ? a2[0] : a2[1]; const float keep = b2 ? a2[1] : a2[0]; a1 = keep + __shfl_xor(send, 4); }
    a1 += __shfl_xor(a1, 2); a1 += __shfl_xor(a1, 1);
    if ((lane & 3) == 0) af_row[(lane >> 2) & 15] = a1 * rs;
}
__device__ __forceinline__ void norm_fin(const NormRow& R, const float* g, bf16_t* o, int lane, const LAS float* Ta = nullptr, float* af_row = nullptr) {
    float s = 0.f;
#pragma unroll
    for (int i = 0; i < 4; ++i) s += (R.v[i][0] * R.v[i][0] + R.v[i][1] * R.v[i][1]) + (R.v[i][2] * R.v[i][2] + R.v[i][3] * R.v[i][3]);
    s = wave_sum(s); const float rs = rsqrtf(s * (1.0f / 1024.0f) + EPS);
#pragma unroll
    for (int i = 0; i < 4; ++i) { const f32x4 gg = *(const f32x4*)(g + i * 256 + lane * 4); const f32x4 y = R.v[i] * rs * gg; u32x2 w; w.x = pk2(y[0], y[1]); w.y = pk2(y[2], y[3]);
        *(u32x2*)(o + i * 256 + lane * 4) = w; }
    if (af_row) norm_a(R, rs, Ta, af_row, lane);
}
__device__ __forceinline__ void norm_addr(const Params& p, int r, const float*& x, const float*& g, bf16_t*& o) {
    if (r < MPR) { x = p.in[0] + (size_t)r * 1024; g = p.in[7]; o = (bf16_t*)(p.ws + WS_A) + (size_t)r * 1024; }
    else if (r < MT) { x = p.in[1] + (size_t)(r - MPR) * 1024; g = p.in[7]; o = (bf16_t*)(p.ws + WS_A) + (size_t)r * 1024; }
    else { x = p.in[2] + (size_t)(r - MT) * 1024; g = p.in[17]; o = (bf16_t*)(p.ws + WS_MN) + (size_t)(r - MT) * 1024; }
}
__device__ __forceinline__ void phase_prep(const Params& p, LAS unsigned char* lds) {
    unsigned char* ws = p.ws; LAS float* T = (LAS float*)lds;
    const int tid = threadIdx.x, lane = tid & 63, wave = tid >> 6;
    LAS float* Ta = (LAS float*)(lds + PREP_TA);
#pragma unroll
    for (int i = 0; i < 8; ++i) { const int idx = tid + 512 * i, k = idx >> 2, c4 = (idx & 3) * 4; const f32x4 w = *(const f32x4*)(p.in[8] + (size_t)k * 2576 + 1536 + c4) * p.in[7][k];
        Ta[(c4 + 0) * 1024 + k] = w[0]; Ta[(c4 + 1) * 1024 + k] = w[1]; Ta[(c4 + 2) * 1024 + k] = w[2]; Ta[(c4 + 3) * 1024 + k] = w[3]; }
    __syncthreads();
    for (int j = blockIdx.x; j < 1008; j += gridDim.x) {
        const float* src; int ldn, K, nt; bf16_t* dst; const float* ksc = nullptr; bool cmap = false; int jj = j, rmode = 0;
        if (jj < 160) { src = p.in[8]; ldn = 2576; K = 1024; nt = 10; dst = (bf16_t*)(ws + WS_WIN); cmap = true; }
        else if ((jj -= 160) < 64) { src = p.in[15]; ldn = 1024; K = 1024; nt = 4; dst = (bf16_t*)(ws + WS_WOUT); }
        else if ((jj -= 64) < 64) { src = p.in[18]; ldn = 1024; K = 1024; nt = 4; dst = (bf16_t*)(ws + WS_WQ); ksc = p.in[16]; }
        else if ((jj -= 64) < 64) { src = p.in[19]; ldn = 1024; K = 1024; nt = 4; dst = (bf16_t*)(ws + WS_WKV); }
        else if ((jj -= 64) < 64) { src = p.in[20]; ldn = 1024; K = 1024; nt = 4; dst = (bf16_t*)(ws + WS_WKV) + (size_t)1024 * 1024; }
        else if ((jj -= 64) < 64) { src = p.in[21]; ldn = 1024; K = 1024; nt = 4; dst = (bf16_t*)(ws + WS_WO); }
        else if ((jj -= 64) < 176) { src = p.in[23]; ldn = 2816; K = 1024; nt = 11; dst = (bf16_t*)(ws + WS_WGU); ksc = p.in[22]; rmode = 1; }
        else if ((jj -= 176) < 176) { src = p.in[24]; ldn = 2816; K = 1024; nt = 11; dst = (bf16_t*)(ws + WS_WGU); ksc = p.in[22]; rmode = 2; }
        else { jj -= 176; src = p.in[27]; ldn = 1024; K = 2816; nt = 4; dst = (bf16_t*)(ws + WS_WD); }
        const int kt = jj / nt, ntile = jj % nt;
        tr_strip(T, src, ldn, dst, K, kt * 64, ntile * 256, ksc, cmap, rmode);
    }
    const int stride = gridDim.x * 8;
    for (int r = blockIdx.x * 8 + wave; r < MT + 2048; r += 2 * stride) {
        const int r2 = r + stride; const bool has2 = r2 < MT + 2048;
        const float *x1, *g1, *x2 = nullptr, *g2 = nullptr; bf16_t *o1, *o2 = nullptr; NormRow A, B;
        norm_addr(p, r, x1, g1, o1); norm_load(A, x1, lane);
        if (has2) { norm_addr(p, r2, x2, g2, o2); norm_load(B, x2, lane); }
        float* af = (float*)(ws + WS_AF);
        norm_fin(A, g1, o1, lane, Ta, r < MT ? af + (size_t)r * 16 : nullptr);
        if (has2) norm_fin(B, g2, o2, lane, Ta, r2 < MT ? af + (size_t)r2 * 16 : nullptr);
    }
}

constexpr int G_Q = 0, G_K = 9216, G_B = 18432, G_A = 35072, G_WA = 39168, G_BA = 43264, G_VT = 43520, G_X = 61952  , G_ST = 71168, G_RED = 89600, G_SEG = 90624, G_R = 92672, G_END = 110080;
struct GlaPre { u32x4v q, k, v0, v1, s0, s1, r0, r1; f32x4 aw, b0, b1; float ba; };
template <bool OUT>
__device__ __forceinline__ void gla_issue(GlaPre& R, const Params& p, int item) {
    const int b = item >> 7, h = (item >> 5) & 3, c = item & 31; const int tid = threadIdx.x; const int row0 = b * 2048 + c * 64;
    const bf16_t* P = (const bf16_t*)(p.ws + WS_P); const float* af = (const float*)(p.ws + WS_AF);
    { const int i = tid >> 3, d8 = (tid & 7) * 8; const bf16_t* src = P + (size_t)(row0 + i) * NIN + h * 64 + d8; R.q = *(const u32x4v*)src; R.k = *(const u32x4v*)(src + 256); }
    if (!OUT) {
        if (tid < 256) { const int i = tid >> 2, r4 = (tid & 3) * 4; R.aw = *(const f32x4*)(af + (size_t)(row0 + i) * 16 + r4); }
        else { const int t2 = tid - 256, r = t2 >> 4, d4 = (t2 & 15) * 4; R.aw = *(const f32x4*)(p.in[9] + r * 256 + h * 64 + d4); }
        R.ba = p.in[10][h * 64 + (tid & 63)];
    } else { const float* bq = (const float*)(p.ws + WS_BQ) + (size_t)item * 4096 + (tid >> 3) * 64 + (tid & 7) * 8; R.b0 = *(const f32x4*)bq; R.b1 = *(const f32x4*)(bq + 4); }
    { const int j = tid & 63, v8 = (tid >> 6) * 8; R.v0 = *(const u32x4v*)(P + (size_t)(row0 + j) * NIN + 512 + h * 128 + v8); R.v1 = *(const u32x4v*)(P + (size_t)(row0 + j) * NIN + 512 + h * 128 + 64 + v8); }
    if (OUT) { const bf16_t* St = (const bf16_t*)(p.ws + WS_ST) + (size_t)item * 8192; const int v = tid >> 3, d8 = (tid & 7) * 8;
        R.s0 = *(const u32x4v*)(St + v * 64 + d8); R.s1 = *(const u32x4v*)(St + (v + 64) * 64 + d8);
        const int j = tid >> 4, v8 = (tid & 15) * 8; R.r0 = *(const u32x4v*)(P + (size_t)(row0 + j) * NIN + 1024 + h * 128 + v8); R.r1 = *(const u32x4v*)(P + (size_t)(row0 + j + 32) * NIN + 1024 + h * 128 + v8); }
}
__device__ __forceinline__ void vt_scatter(LAS bf16_t* LVt, const u32x4v w, int v8, int j) {
    LVt[(v8 + 0) * 72 + j] = (bf16_t)(w.x & 0xffff); LVt[(v8 + 1) * 72 + j] = (bf16_t)(w.x >> 16); LVt[(v8 + 2) * 72 + j] = (bf16_t)(w.y & 0xffff); LVt[(v8 + 3) * 72 + j] = (bf16_t)(w.y >> 16);
    LVt[(v8 + 4) * 72 + j] = (bf16_t)(w.z & 0xffff); LVt[(v8 + 5) * 72 + j] = (bf16_t)(w.z >> 16); LVt[(v8 + 6) * 72 + j] = (bf16_t)(w.w & 0xffff); LVt[(v8 + 7) * 72 + j] = (bf16_t)(w.w >> 16);
}
template <bool OUT>
__device__ __forceinline__ void gla_fill(const GlaPre& R, LAS unsigned char* lds) {
    const int tid = threadIdx.x;
    LAS bf16_t* Lq = (LAS bf16_t*)(lds + G_Q); LAS bf16_t* Lk = (LAS bf16_t*)(lds + G_K); LAS float* Lb = (LAS float*)(lds + G_B);
    LAS float* La = (LAS float*)(lds + G_A); LAS float* Lwa = (LAS float*)(lds + G_WA); LAS float* Lba = (LAS float*)(lds + G_BA);
    LAS bf16_t* LVt = (LAS bf16_t*)(lds + G_VT); LAS float* Lseg = (LAS float*)(lds + G_SEG);
    { const int i = tid >> 3, d8 = (tid & 7) * 8; *(LAS u32x4v*)(Lq + i * 72 + d8) = R.q; *(LAS u32x4v*)(Lk + i * 72 + d8) = R.k; }
    if (!OUT) {
        if (tid < 256) { const int i = tid >> 2, r4 = (tid & 3) * 4; *(LAS f32x4*)(La + i * 16 + r4) = R.aw; }
        else { const int t2 = tid - 256, r = t2 >> 4, d4 = (t2 & 15) * 4; *(LAS f32x4*)(Lwa + r * 64 + d4) = R.aw; }
        if (tid < 64) Lba[tid] = R.ba;
    } else { const int i = tid >> 3, d8 = (tid & 7) * 8;
#pragma unroll
        for (int e = 0; e < 4; ++e) { Lb[i * 65 + d8 + e] = R.b0[e]; Lb[i * 65 + d8 + 4 + e] = R.b1[e]; } }
    { const int j = tid & 63, v8 = (tid >> 6) * 8; vt_scatter(LVt, R.v0, v8, j); vt_scatter(LVt, R.v1, v8 + 64, j); }
    if (OUT) { LAS bf16_t* LSt = (LAS bf16_t*)(lds + G_ST); LAS bf16_t* Lr = (LAS bf16_t*)(lds + G_R); const int v = tid >> 3, d8 = (tid & 7) * 8;
        *(LAS u32x4v*)(LSt + v * 72 + d8) = R.s0; *(LAS u32x4v*)(LSt + (v + 64) * 72 + d8) = R.s1;
        const int j = tid >> 4, v8 = (tid & 15) * 8; *(LAS u32x4v*)(Lr + j * 136 + v8) = R.r0; *(LAS u32x4v*)(Lr + (j + 32) * 136 + v8) = R.r1; }
    __syncthreads();
}
__device__ __forceinline__ void gla_gates(LAS unsigned char* lds) {
    const int tid = threadIdx.x;
    LAS float* Lb = (LAS float*)(lds + G_B); LAS float* La = (LAS float*)(lds + G_A); LAS float* Lwa = (LAS float*)(lds + G_WA); LAS float* Lba = (LAS float*)(lds + G_BA); LAS float* Lseg = (LAS float*)(lds + G_SEG);
    const int d = tid & 63, seg = tid >> 6; float acc = 0.f; float pre[8];
#pragma unroll
    for (int ii = 0; ii < 8; ++ii) { const int i = seg * 8 + ii; float z = Lba[d];
#pragma unroll
        for (int r = 0; r < 16; ++r) z += La[i * 16 + r] * Lwa[r * 64 + d];
        acc += logsig(z) * (1.0f / 16.0f); pre[ii] = acc; }
    Lseg[seg * 64 + d] = acc;
    __syncthreads();
    float off = 0.f;
#pragma unroll
    for (int s = 0; s < 8; ++s) if (s < seg) off += Lseg[s * 64 + d];
#pragma unroll
    for (int ii = 0; ii < 8; ++ii) Lb[(seg * 8 + ii) * 65 + d] = pre[ii] + off;
    __syncthreads();
}
__device__ __forceinline__ void gla_local_loop(const Params& p, LAS unsigned char* lds, int first, int stride, int nitems) {
    const int tid = threadIdx.x, lane = tid & 63, wave = tid >> 6;
    GlaPre R; if (first < nitems) gla_issue<false>(R, p, first);
    for (int item = first; item < nitems; item += stride) {
        gla_fill<false>(R, lds);
        if (item + stride < nitems) gla_issue<false>(R, p, item + stride);
        gla_gates(lds);
        LAS bf16_t* Lk = (LAS bf16_t*)(lds + G_K); LAS float* Lb = (LAS float*)(lds + G_B); LAS bf16_t* LVt = (LAS bf16_t*)(lds + G_VT); LAS bf16_t* LKt = (LAS bf16_t*)(lds + G_X);
        { float* bq = (float*)(p.ws + WS_BQ) + (size_t)item * 4096 + (tid >> 3) * 64 + (tid & 7) * 8; const int i = tid >> 3, d8 = (tid & 7) * 8; f32x4 x0, x1;
#pragma unroll
          for (int e = 0; e < 4; ++e) { x0[e] = Lb[i * 65 + d8 + e]; x1[e] = Lb[i * 65 + d8 + 4 + e]; }
          *(f32x4*)bq = x0; *(f32x4*)(bq + 4) = x1; }
        float* dS = (float*)(p.ws + WS_DS) + (size_t)item * 8192; float* dec = (float*)(p.ws + WS_DEC) + (size_t)item * 64;
        { const int j = tid >> 3, d8 = (tid & 7) * 8;
#pragma unroll
          for (int e = 0; e < 8; ++e) { const float kv = bf2f(Lk[j * 72 + d8 + e]); LKt[(d8 + e) * 72 + j] = f2bf(kv * __expf(Lb[63 * 65 + d8 + e] - Lb[j * 65 + d8 + e])); } }
        if (tid < 64) dec[tid] = __expf(Lb[63 * 65 + tid]);
        __syncthreads();
        const int db = wave & 1, vb = wave >> 1, r = lane & 31, hh = lane >> 5;
        f32x16 acc = zero16();
#pragma unroll
        for (int ks = 0; ks < 4; ++ks) { const bf16x8 a = *(const LAS bf16x8*)(LKt + (db * 32 + r) * 72 + ks * 16 + 8 * hh); const bf16x8 bb = *(const LAS bf16x8*)(LVt + (vb * 32 + r) * 72 + ks * 16 + 8 * hh); acc = mma32(a, bb, acc); }
#pragma unroll
        for (int i = 0; i < 16; ++i) { const int d = db * 32 + (i & 3) + 8 * (i >> 2) + 4 * hh; dS[d * 128 + vb * 32 + r] = acc[i]; }
        __syncthreads();
    }
}
__device__ __forceinline__ void gla_out_loop(const Params& p, LAS unsigned char* lds, int first, int stride, int nitems) {
    const int tid = threadIdx.x, lane = tid & 63, wave = tid >> 6;
    GlaPre R; if (first < nitems) gla_issue<true>(R, p, first);
    for (int item = first; item < nitems; item += stride) {
        const int b = item >> 7, h = (item >> 5) & 3, c = item & 31; const int row0 = b * 2048 + c * 64;
        gla_fill<true>(R, lds);
        if (item + stride < nitems) gla_issue<true>(R, p, item + stride);
        LAS bf16_t* Lq = (LAS bf16_t*)(lds + G_Q); LAS bf16_t* Lk = (LAS bf16_t*)(lds + G_K); LAS float* Lb = (LAS float*)(lds + G_B); LAS bf16_t* LVt = (LAS bf16_t*)(lds + G_VT);
        LAS bf16_t* Lsc = (LAS bf16_t*)(lds + G_X); LAS bf16_t* LSt = (LAS bf16_t*)(lds + G_ST); LAS float* Lred = (LAS float*)(lds + G_RED); LAS bf16_t* Lr = (LAS bf16_t*)(lds + G_R);
        bf16_t* mix = (bf16_t*)(p.ws + WS_A);
        { const int i = tid >> 3, d8 = (tid & 7) * 8;
#pragma unroll
          for (int e = 0; e < 8; e += 2) { const float b0 = Lb[i * 65 + d8 + e], b1 = Lb[i * 65 + d8 + e + 1];
              const float q0 = bf2f(Lq[i * 72 + d8 + e]) * __expf(b0) * 0.125f, q1 = bf2f(Lq[i * 72 + d8 + e + 1]) * __expf(b1) * 0.125f;
              const float k0 = bf2f(Lk[i * 72 + d8 + e]) * __expf(-b0), k1 = bf2f(Lk[i * 72 + d8 + e + 1]) * __expf(-b1);
              *(LAS unsigned*)(Lq + i * 72 + d8 + e) = pk2(q0, q1); *(LAS unsigned*)(Lk + i * 72 + d8 + e) = pk2(k0, k1); } }
        __syncthreads();
        const int r = lane & 31, hh = lane >> 5;
        if (wave < 4) { const int ib = wave & 1, jb = wave >> 1;
            f32x16 acc = zero16();
            if (jb <= ib) {
#pragma unroll
                for (int ks = 0; ks < 4; ++ks) { const bf16x8 a = *(const LAS bf16x8*)(Lq + (ib * 32 + r) * 72 + ks * 16 + 8 * hh); const bf16x8 bb = *(const LAS bf16x8*)(Lk + (jb * 32 + r) * 72 + ks * 16 + 8 * hh); acc = mma32(a, bb, acc); } }
#pragma unroll
            for (int i = 0; i < 16; ++i) { const int ii = ib * 32 + (i & 3) + 8 * (i >> 2) + 4 * hh, jj = jb * 32 + r; Lsc[ii * 72 + jj] = f2bf(jj <= ii ? acc[i] : 0.f); } }
        __syncthreads();
        const int ib = wave & 1, vb = wave >> 1;
        f32x16 acc = zero16();
#pragma unroll
        for (int ks = 0; ks < 4; ++ks) { const bf16x8 a = *(const LAS bf16x8*)(Lsc + (ib * 32 + r) * 72 + ks * 16 + 8 * hh); const bf16x8 bb = *(const LAS bf16x8*)(LVt + (vb * 32 + r) * 72 + ks * 16 + 8 * hh); acc = mma32(a, bb, acc); }
#pragma unroll
        for (int ks = 0; ks < 4; ++ks) { const bf16x8 a = *(const LAS bf16x8*)(Lq + (ib * 32 + r) * 72 + ks * 16 + 8 * hh); const bf16x8 bb = *(const LAS bf16x8*)(LSt + (vb * 32 + r) * 72 + ks * 16 + 8 * hh); acc = mma32(a, bb, acc); }
#pragma unroll
        for (int i = 0; i < 16; ++i) { float s = row_sum16(acc[i] * acc[i]); s += __shfl_xor(s, 16);
            if (r == 0) Lred[(ib * 32 + (i & 3) + 8 * (i >> 2) + 4 * hh) * 4 + vb] = s; }
        __syncthreads();
        const float gg = p.in[11][h * 128 + vb * 32 + r];
#pragma unroll
        for (int i = 0; i < 16; ++i) { const int ii = ib * 32 + (i & 3) + 8 * (i >> 2) + 4 * hh; const f32x4 q = *(const LAS f32x4*)(Lred + ii * 4);
            const float rs = rsqrtf(((q[0] + q[1]) + (q[2] + q[3])) * (1.0f / 128.0f) + EPS);
            const float rg = bf2f(Lr[ii * 136 + vb * 32 + r]);
            mix[(size_t)(row0 + ii) * 1024 + h * 128 + vb * 32 + r] = f2bf(acc[i] * rs * gg * silu_f(rg)); }
        __syncthreads();
    }
}
__device__ __forceinline__ void gla_scan(const Params& p) {
    for (int gt = blockIdx.x * 512 + threadIdx.x; gt < 131072; gt += gridDim.x * 512) {
    const int bh = gt >> 12, rem = gt & 4095, v = rem & 127, d = (rem >> 7) * 2;
    const float* dS = (const float*)(p.ws + WS_DS); const float* dec = (const float*)(p.ws + WS_DEC); bf16_t* St = (bf16_t*)(p.ws + WS_ST);
    float s0 = 0.f, s1 = 0.f;
#pragma unroll 8
    for (int c = 0; c < 32; ++c) { const size_t item = (size_t)bh * 32 + c;
        *(unsigned*)(St + item * 8192 + v * 64 + d) = pk2(s0, s1);
        const float a0 = dec[item * 64 + d], a1 = dec[item * 64 + d + 1];
        s0 = a0 * s0 + dS[item * 8192 + d * 128 + v]; s1 = a1 * s1 + dS[item * 8192 + (d + 1) * 128 + v]; }
    float* o = p.out + O_SGP + (size_t)bh * 8192; o[d * 128 + v] = s0; o[(d + 1) * 128 + v] = s1; }
}

__device__ __forceinline__ void sgu_item(const Params& p, LAS unsigned char* lds, int item) {
    const int b = item >> 6, nck = (item >> 2) & 15, h = item & 3; const int tid = threadIdx.x, lane = tid & 63, wave = tid >> 6;
    LAS bf16_t* LW = (LAS bf16_t*)lds; LAS bf16_t* LsvT = (LAS bf16_t*)(lds + 34816);
    const bf16_t* P = (const bf16_t*)(p.ws + WS_P); bf16_t* mix = (bf16_t*)(p.ws + WS_A); const int row0 = b * 2048 + nck * 128;
    const float* Wsrc = p.in[13] + (size_t)h * 16384;
#pragma unroll
    for (int k = 0; k < 8; ++k) { const int idx = tid + 512 * k, i = idx >> 5, j4 = (idx & 31) * 4; const f32x4 w = *(const f32x4*)(Wsrc + i * 128 + j4);
        u32x2 o; o.x = pk2(j4 <= i ? w[0] : 0.f, j4 + 1 <= i ? w[1] : 0.f); o.y = pk2(j4 + 2 <= i ? w[2] : 0.f, j4 + 3 <= i ? w[3] : 0.f); *(LAS u32x2*)(LW + i * 136 + j4) = o; }
    { const int j = tid >> 2, q4 = tid & 3; const bf16_t* src = P + (size_t)(row0 + j) * NIN + 2048 + h * 128 + q4 * 32; float g[32]; float ss = 0.f;
#pragma unroll
      for (int k = 0; k < 4; ++k) { const u32x4v w = *(const u32x4v*)(src + k * 8); const unsigned ww[4] = {w.x, w.y, w.z, w.w};
#pragma unroll
          for (int e = 0; e < 4; ++e) { const float a = gelu_t(bflo(ww[e])), c = gelu_t(bfhi(ww[e])); g[k * 8 + e * 2] = a; g[k * 8 + e * 2 + 1] = c; ss += a * a + c * c; } }
      ss += __shfl_xor(ss, 1); ss += __shfl_xor(ss, 2); const float rs = rsqrtf(ss * (1.0f / 128.0f) + EPS);
#pragma unroll
      for (int e = 0; e < 32; ++e) { const int d = q4 * 32 + e; LsvT[d * 136 + j] = f2bf(g[e] * rs * p.in[12][h * 128 + d]); } }
    __syncthreads();
    const int r = lane & 31, hh = lane >> 5, ib = wave & 3;
    bf16_t uraw[2][16]; float bsv[16];
#pragma unroll
    for (int i = 0; i < 16; ++i) { const int ii = ib * 32 + (i & 3) + 8 * (i >> 2) + 4 * hh; bsv[i] = p.in[14][h * 128 + ii];
#pragma unroll
        for (int t = 0; t < 2; ++t) uraw[t][i] = P[(size_t)(row0 + ii) * NIN + 1536 + h * 128 + ((wave >> 2) * 2 + t) * 32 + r]; }
    f32x16 accs[2];
#pragma unroll
    for (int t = 0; t < 2; ++t) { const int db = (wave >> 2) * 2 + t; f32x16 acc = zero16();
        for (int ks = 0; ks <= ib * 2 + 1; ++ks) { const bf16x8 a = *(const LAS bf16x8*)(LW + (ib * 32 + r) * 136 + ks * 16 + 8 * hh); const bf16x8 bb = *(const LAS bf16x8*)(LsvT + (db * 32 + r) * 136 + ks * 16 + 8 * hh); acc = mma32(a, bb, acc); }
        accs[t] = acc; }
#pragma unroll
    for (int t = 0; t < 2; ++t) { const int db = (wave >> 2) * 2 + t;
#pragma unroll
        for (int i = 0; i < 16; ++i) { const int ii = ib * 32 + (i & 3) + 8 * (i >> 2) + 4 * hh, d = db * 32 + r; const float z = accs[t][i] + bsv[i];
            const float u = gelu_t(bf2f(uraw[t][i])); mix[(size_t)(row0 + ii) * 1024 + 512 + h * 128 + d] = f2bf(u * z); } }
    __syncthreads();
}

constexpr int SM_Q = 0, SM_K = 4096, SM_B = 8192, SM_V = 12288, SM_A = 20480, SM_RED = 21504, SM_O = 22016, SM_END = 30208;
__device__ __forceinline__ void sample_mixer(const Params& p, LAS unsigned char* lds, int b, int hp) {
    const int tid = threadIdx.x, lane = tid & 63, wave = tid >> 6; const int rowb = MPR + b * 4;
    const bf16_t* P = (const bf16_t*)(p.ws + WS_P); const float* af = (const float*)(p.ws + WS_AF); bf16_t* mix = (bf16_t*)(p.ws + WS_A);
    LAS float* Lq = (LAS float*)(lds + SM_Q); LAS float* Lk = (LAS float*)(lds + SM_K); LAS float* Lb = (LAS float*)(lds + SM_B); LAS float* Lv = (LAS float*)(lds + SM_V);
    LAS float* LA = (LAS float*)(lds + SM_A); LAS float* Lred = (LAS float*)(lds + SM_RED); LAS float* Lo = (LAS float*)(lds + SM_O);
    if (hp == 0) { const int ch = tid, h = tid >> 7; float g[4], u[4];
#pragma unroll
      for (int t = 0; t < 4; ++t) { g[t] = gelu_t(bf2f(P[(size_t)(rowb + t) * NIN + 2048 + ch])); u[t] = gelu_t(bf2f(P[(size_t)(rowb + t) * NIN + 1536 + ch])); const float s = wave_sum(g[t] * g[t]); if (lane == 0) Lred[wave * 4 + t] = s; }
      __syncthreads();
      const float gs = p.in[12][ch]; float sv[4];
#pragma unroll
      for (int t = 0; t < 4; ++t) { const float tot = Lred[(2 * h) * 4 + t] + Lred[(2 * h + 1) * 4 + t]; sv[t] = g[t] * rsqrtf(tot * (1.0f / 128.0f) + EPS) * gs; p.out[O_SV + (size_t)(b * 4 + t) * 512 + ch] = sv[t]; }
#pragma unroll
      for (int i = 0; i < 4; ++i) { float z = p.in[14][h * 128 + i];
#pragma unroll
          for (int j = 0; j < 4; ++j) if (j <= i) z += p.in[13][(size_t)h * 16384 + i * 128 + j] * sv[j];
          mix[(size_t)(rowb + i) * 1024 + 512 + ch] = f2bf(u[i] * z); }
      __syncthreads();
    }
#pragma unroll
    for (int k = 0; k < 2; ++k) { const int idx = tid + 512 * k, t = idx >> 8, c = idx & 255;
        Lq[t * 256 + c] = bf2f(P[(size_t)(rowb + t) * NIN + c]); Lk[t * 256 + c] = bf2f(P[(size_t)(rowb + t) * NIN + 256 + c]);
        float z = p.in[10][c];
#pragma unroll
        for (int r = 0; r < 16; ++r) z += af[(size_t)(rowb + t) * 16 + r] * p.in[9][r * 256 + c];
        Lb[t * 256 + c] = logsig(z) * (1.0f / 16.0f); }
#pragma unroll
    for (int t = 0; t < 4; ++t) Lv[t * 512 + tid] = bf2f(P[(size_t)(rowb + t) * NIN + 512 + tid]);
    __syncthreads();
    if (tid < 256) { float a = 0.f;
#pragma unroll
        for (int t = 0; t < 4; ++t) { a += Lb[t * 256 + tid]; Lb[t * 256 + tid] = a; } }
    __syncthreads();
    { const int h = tid >> 7, pr = (tid >> 3) & 15, i = pr >> 2, j = pr & 3, part = tid & 7; float s = 0.f;
      if (j <= i) {
#pragma unroll
          for (int e = 0; e < 8; ++e) { const int c = h * 64 + part * 8 + e; s += Lq[i * 256 + c] * Lk[j * 256 + c] * __expf(Lb[i * 256 + c] - Lb[j * 256 + c]); } }
      s += __shfl_xor(s, 1); s += __shfl_xor(s, 2); s += __shfl_xor(s, 4);
      if (part == 0) LA[h * 16 + pr] = s * 0.125f; }
    __syncthreads();
    LAS float* Le3 = (LAS float*)(lds + SM_END);
    { float qn[2], kn[2];
#pragma unroll
      for (int k = 0; k < 2; ++k) { const int idx = tid + 512 * k, t = idx >> 8, c = idx & 255; const float bt = Lb[t * 256 + c], b3 = Lb[3 * 256 + c];
          qn[k] = Lq[t * 256 + c] * __expf(bt) * 0.125f; kn[k] = Lk[t * 256 + c] * __expf(b3 - bt); }
      const float e3 = tid < 256 ? __expf(Lb[3 * 256 + tid]) : 0.f;
      __syncthreads();
#pragma unroll
      for (int k = 0; k < 2; ++k) { const int idx = tid + 512 * k; Lq[idx] = qn[k]; Lk[idx] = kn[k]; }
      if (tid < 256) Le3[tid] = e3; }
    __syncthreads();
    const int v = tid & 127, dq = tid >> 7;
    for (int h = 2 * hp; h < 2 * hp + 2; ++h) {
        const float* S0 = p.in[3] + (size_t)(b * 4 + h) * 8192; float* So = p.out + O_SGS + (size_t)(b * 4 + h) * 8192;
        float op[4] = {0.f, 0.f, 0.f, 0.f}; float vv[4];
#pragma unroll
        for (int t = 0; t < 4; ++t) vv[t] = Lv[t * 512 + h * 128 + v];
        float s0v[16];
#pragma unroll
        for (int dd = 0; dd < 16; ++dd) s0v[dd] = __builtin_nontemporal_load(S0 + (dq * 16 + dd) * 128 + v);
#pragma unroll
        for (int dd = 0; dd < 16; ++dd) { const int d = dq * 16 + dd, c = h * 64 + d; const float s0 = s0v[dd];
            float sn = Le3[c] * s0;
#pragma unroll
            for (int t = 0; t < 4; ++t) { op[t] += Lq[t * 256 + c] * s0; sn += Lk[t * 256 + c] * vv[t]; }
            So[d * 128 + v] = sn; }
#pragma unroll
        for (int t = 0; t < 4; ++t) Lo[(dq * 4 + t) * 128 + v] = op[t];
        __syncthreads();
        { const int i = tid >> 7; float o = Lo[(0 * 4 + i) * 128 + v] + Lo[(1 * 4 + i) * 128 + v] + Lo[(2 * 4 + i) * 128 + v] + Lo[(3 * 4 + i) * 128 + v];
#pragma unroll
          for (int j = 0; j < 4; ++j) if (j <= i) o += LA[h * 16 + i * 4 + j] * Lv[j * 512 + h * 128 + v];
          const float s = wave_sum(o * o); if (lane == 0) Lred[wave] = s;
          __syncthreads();
          const float tot = Lred[2 * i] + Lred[2 * i + 1]; const float rg = bf2f(P[(size_t)(rowb + i) * NIN + 1024 + h * 128 + v]);
          mix[(size_t)(rowb + i) * 1024 + h * 128 + v] = f2bf(o * rsqrtf(tot * (1.0f / 128.0f) + EPS) * p.in[11][h * 128 + v] * silu_f(rg)); }
        __syncthreads();
    }
}

__device__ __forceinline__ void attn_prompt(const Params& p, LAS unsigned char* lds, int item) {
    const int b = item >> 5, h = (item >> 3) & 3, rt = item & 7; const int tid = threadIdx.x, lane = tid & 63, wave = tid >> 6, r = lane & 31, hh = lane >> 5;
    LAS bf16_t* LK = (LAS bf16_t*)lds; bf16_t* qx = (bf16_t*)(p.ws + WS_A);
    const bf16_t* mkb = (const bf16_t*)(p.ws + WS_MKB) + (size_t)b * 256 * 1024 + h * 256; const bf16_t* mvt = (const bf16_t*)(p.ws + WS_MVT) + (size_t)(b * 4 + h) * 65536;
    const int r0 = b * 2048 + rt * 256 + wave * 32; const bf16_t* qrow = qx + (size_t)(r0 + r) * 1024 + h * 256 + 8 * hh;
    bf16x8 qf[16];
#pragma unroll
    for (int ks = 0; ks < 16; ++ks) qf[ks] = *(const bf16x8*)(qrow + ks * 16);
#pragma unroll 4
    for (int k = 0; k < 16; ++k) { const int idx = tid + 512 * k, m = idx >> 5, d8 = (idx & 31) * 8; *(LAS u32x4v*)(LK + m * 264 + d8) = *(const u32x4v*)(mkb + (size_t)m * 1024 + d8); }
    __syncthreads();
    f32x16 s[8];
#pragma unroll
    for (int mb = 0; mb < 8; ++mb) s[mb] = zero16();
#pragma unroll
    for (int ks = 0; ks < 16; ++ks) {
#pragma unroll
        for (int mb = 0; mb < 8; ++mb) { const bf16x8 kf = *(const LAS bf16x8*)(LK + (mb * 32 + r) * 264 + ks * 16 + 8 * hh); s[mb] = mma32(kf, qf[ks], s[mb]); } }
    float mx = -3.0e38f;
#pragma unroll
    for (int mb = 0; mb < 8; ++mb)
#pragma unroll
        for (int i = 0; i < 16; ++i) mx = fmaxf(mx, s[mb][i]);
    mx = fmaxf(mx, __shfl_xor(mx, 32)); float sum = 0.f;
#pragma unroll
    for (int mb = 0; mb < 8; ++mb)
#pragma unroll
        for (int i = 0; i < 16; ++i) { const float e = __expf((s[mb][i] - mx) * 0.0625f); s[mb][i] = e; sum += e; }
    sum += __shfl_xor(sum, 32); const float inv = __builtin_amdgcn_rcpf(sum);
    bf16x8 pf[8][2];
#pragma unroll
    for (int mb = 0; mb < 8; ++mb)
#pragma unroll
        for (int sI = 0; sI < 2; ++sI) { u32x4v w; w.x = pk2(s[mb][8 * sI + 0] * inv, s[mb][8 * sI + 1] * inv); w.y = pk2(s[mb][8 * sI + 2] * inv, s[mb][8 * sI + 3] * inv);
            w.z = pk2(s[mb][8 * sI + 4] * inv, s[mb][8 * sI + 5] * inv); w.w = pk2(s[mb][8 * sI + 6] * inv, s[mb][8 * sI + 7] * inv); pf[mb][sI] = __builtin_bit_cast(bf16x8, w); }
    __syncthreads();
#pragma unroll 4
    for (int k = 0; k < 16; ++k) { const int idx = tid + 512 * k, d = idx >> 5, m8 = (idx & 31) * 8; *(LAS u32x4v*)(LK + d * 264 + m8) = *(const u32x4v*)(mvt + (size_t)d * 256 + m8); }
    __syncthreads();
    for (int dh = 0; dh < 2; ++dh) {
        f32x16 o[4];
#pragma unroll
        for (int q = 0; q < 4; ++q) o[q] = zero16();
#pragma unroll
        for (int mb = 0; mb < 8; ++mb)
#pragma unroll
            for (int sI = 0; sI < 2; ++sI)
#pragma unroll
                for (int q = 0; q < 4; ++q) { const LAS bf16_t* vp = LK + ((dh * 4 + q) * 32 + r) * 264 + mb * 32 + 16 * sI + 4 * hh;
                    const u32x2 lo = *(const LAS u32x2*)vp, hi = *(const LAS u32x2*)(vp + 8); u32x4v w; w.x = lo.x; w.y = lo.y; w.z = hi.x; w.w = hi.y;
                    o[q] = mma32(pf[mb][sI], __builtin_bit_cast(bf16x8, w), o[q]); }
#pragma unroll
        for (int q = 0; q < 4; ++q)
#pragma unroll
            for (int i = 0; i < 16; ++i) { const int ii = (i & 3) + 8 * (i >> 2) + 4 * hh; qx[(size_t)(r0 + ii) * 1024 + h * 256 + (dh * 4 + q) * 32 + r] = f2bf(o[q][i]); }
    }
    __syncthreads();
}
__device__ __forceinline__ void attn_sample(const Params& p, LAS unsigned char* lds, int item) {
    const int b = item >> 2, h = item & 3; const int tid = threadIdx.x, lane = tid & 63, wave = tid >> 6; const int rowb = MPR + b * 4;
    bf16_t* qx = (bf16_t*)(p.ws + WS_A); LAS float* Ls = (LAS float*)lds;   LAS float* Lred = (LAS float*)(lds + 4096); LAS float* Lo = (LAS float*)(lds + 8192);
    const float* Kc = p.in[5] + ((size_t)b * 256 * 4 + h) * 256; const float* Vc = p.in[6] + ((size_t)b * 256 * 4 + h) * 256;
    f32x4 q[4];
#pragma unroll
    for (int t = 0; t < 4; ++t) { const u32x2 w = *(const u32x2*)(qx + (size_t)(rowb + t) * 1024 + h * 256 + lane * 4); q[t] = (f32x4){bflo(w.x), bfhi(w.x), bflo(w.y), bfhi(w.y)}; }
    const bool b5 = lane & 32, b4 = lane & 16, b3 = lane & 8, b2 = lane & 4, b1 = lane & 2;
    for (int mb = 0; mb < 4; ++mb) {
        f32x4 kv[8];
#pragma unroll
        for (int rr = 0; rr < 8; ++rr) kv[rr] = __builtin_nontemporal_load((const f32x4*)(Kc + (size_t)(wave * 32 + mb * 8 + rr) * 1024 + lane * 4));
        float a[32];
#pragma unroll
        for (int rr = 0; rr < 8; ++rr)
#pragma unroll
            for (int t = 0; t < 4; ++t) a[rr * 4 + t] = (kv[rr][0] * q[t][0] + kv[rr][1] * q[t][1]) + (kv[rr][2] * q[t][2] + kv[rr][3] * q[t][3]);
        float c16[16], c8[8], c4[4], c2[2], c1;
#pragma unroll
        for (int j = 0; j < 16; ++j) { const float send = b5 ? a[j] : a[j + 16]; const float keep = b5 ? a[j + 16] : a[j]; c16[j] = keep + __shfl_xor(send, 32); }
#pragma unroll
        for (int j = 0; j < 8; ++j) { const float send = b4 ? c16[j] : c16[j + 8]; const float keep = b4 ? c16[j + 8] : c16[j]; c8[j] = keep + __shfl_xor(send, 16); }
#pragma unroll
        for (int j = 0; j < 4; ++j) { const float send = b3 ? c8[j] : c8[j + 4]; const float keep = b3 ? c8[j + 4] : c8[j]; c4[j] = keep + __shfl_xor(send, 8); }
#pragma unroll
        for (int j = 0; j < 2; ++j) { const float send = b2 ? c4[j] : c4[j + 2]; const float keep = b2 ? c4[j + 2] : c4[j]; c2[j] = keep + __shfl_xor(send, 4); }
        { const float send = b1 ? c2[0] : c2[1]; const float keep = b1 ? c2[1] : c2[0]; c1 = keep + __shfl_xor(send, 2); }
        c1 += __shfl_xor(c1, 1);
        if ((lane & 1) == 0) { const int j = (lane >> 1) & 31; Ls[(j & 3) * 256 + wave * 32 + mb * 8 + (j >> 2)] = c1 * 0.0625f; }
    }
    __syncthreads();
    { const int t = tid >> 7, m0 = tid & 127; const float a = Ls[t * 256 + m0], c = Ls[t * 256 + m0 + 128]; const float mx = wave_max(fmaxf(a, c)); if (lane == 0) Lred[wave] = mx;
      __syncthreads();
      const float mxx = fmaxf(Lred[2 * t], Lred[2 * t + 1]); const float ea = __expf(a - mxx), ec = __expf(c - mxx); const float sm = wave_sum(ea + ec); if (lane == 0) Lred[16 + wave] = sm;
      __syncthreads();
      const float inv = __builtin_amdgcn_rcpf(Lred[16 + 2 * t] + Lred[16 + 2 * t + 1]); Ls[t * 256 + m0] = ea * inv; Ls[t * 256 + m0 + 128] = ec * inv; }
    __syncthreads();
    f32x4 o[4];
#pragma unroll
    for (int t = 0; t < 4; ++t) o[t] = (f32x4){0.f, 0.f, 0.f, 0.f};
#pragma unroll 2
    for (int mm = 0; mm < 32; mm += 4) { const int m = wave * 32 + mm; f32x4 vv[4], pp[4];
#pragma unroll
        for (int rr = 0; rr < 4; ++rr) vv[rr] = __builtin_nontemporal_load((const f32x4*)(Vc + (size_t)(m + rr) * 1024 + lane * 4));
#pragma unroll
        for (int t = 0; t < 4; ++t) pp[t] = *(const LAS f32x4*)(Ls + t * 256 + m);
#pragma unroll
        for (int rr = 0; rr < 4; ++rr)
#pragma unroll
            for (int t = 0; t < 4; ++t) o[t] += vv[rr] * pp[t][rr]; }
#pragma unroll
    for (int t = 0; t < 4; ++t) *(LAS f32x4*)(Lo + (wave * 4 + t) * 256 + lane * 4) = o[t];
    __syncthreads();
#pragma unroll
    for (int k = 0; k < 2; ++k) { const int idx = tid + 512 * k, t = idx >> 8, d = idx & 255; float s = 0.f;
#pragma unroll
        for (int w = 0; w < 8; ++w) s += Lo[(w * 4 + t) * 256 + d];
        qx[(size_t)(rowb + t) * 1024 + h * 256 + d] = f2bf(s); }
    __syncthreads();
}

__device__ __forceinline__ void phase_act(const Params& p) {
    const bf16_t* G = (const bf16_t*)(p.ws + WS_P); bf16_t* U = (bf16_t*)(p.ws + WS_U);
    const float* cw = p.in[25]; const float* cb = p.in[26];
    const int nthr = gridDim.x * 512, gt = blockIdx.x * 512 + threadIdx.x;
    for (int it = gt; it < 1024 * 352; it += nthr) { const int run = it / 352, cc = (it % 352) * 8; const int row0 = run * 16; const bool first = (row0 & 2047) == 0;
        float w0[8], w1[8], w2[8], bb[8], g2[8], g1[8];
#pragma unroll
        for (int e = 0; e < 8; ++e) { w0[e] = cw[cc + e]; w1[e] = cw[DFF + cc + e]; w2[e] = cw[2 * DFF + cc + e]; bb[e] = cb[cc + e]; g2[e] = 0.f; g1[e] = 0.f; }
        if (!first) { const u32x4v a = *(const u32x4v*)(G + (size_t)(row0 - 2) * DFF + cc), c = *(const u32x4v*)(G + (size_t)(row0 - 1) * DFF + cc);
            g2[0] = bflo(a.x); g2[1] = bfhi(a.x); g2[2] = bflo(a.y); g2[3] = bfhi(a.y); g2[4] = bflo(a.z); g2[5] = bfhi(a.z); g2[6] = bflo(a.w); g2[7] = bfhi(a.w);
            g1[0] = bflo(c.x); g1[1] = bfhi(c.x); g1[2] = bflo(c.y); g1[3] = bfhi(c.y); g1[4] = bflo(c.z); g1[5] = bfhi(c.z); g1[6] = bflo(c.w); g1[7] = bfhi(c.w); }
#pragma unroll 4
        for (int t = 0; t < 16; ++t) { const size_t off = (size_t)(row0 + t) * DFF + cc; const u32x4v a = *(const u32x4v*)(G + off), uu = *(const u32x4v*)(U + off);
            float g0[8] = {bflo(a.x), bfhi(a.x), bflo(a.y), bfhi(a.y), bflo(a.z), bfhi(a.z), bflo(a.w), bfhi(a.w)};
            const float uf[8] = {bflo(uu.x), bfhi(uu.x), bflo(uu.y), bfhi(uu.y), bflo(uu.z), bfhi(uu.z), bflo(uu.w), bfhi(uu.w)}; float r[8];
#pragma unroll
            for (int e = 0; e < 8; ++e) { r[e] = gelu_t(bb[e] + w0[e] * g2[e] + w1[e] * g1[e] + w2[e] * g0[e]) * uf[e]; g2[e] = g1[e]; g1[e] = g0[e]; }
            u32x4v o; o.x = pk2(r[0], r[1]); o.y = pk2(r[2], r[3]); o.z = pk2(r[4], r[5]); o.w = pk2(r[6], r[7]); *(u32x4v*)(U + off) = o; }
    }
    for (int it = gt; it < 128 * 352; it += nthr) { const int b = it / 352, cc = (it % 352) * 8; const int row0 = MPR + b * 4;
        float w0[8], w1[8], w2[8], bb[8], g2[8], g1[8];
#pragma unroll
        for (int e = 0; e < 8; ++e) { w0[e] = cw[cc + e]; w1[e] = cw[DFF + cc + e]; w2[e] = cw[2 * DFF + cc + e]; bb[e] = cb[cc + e]; g2[e] = p.in[4][(size_t)(b * 2) * DFF + cc + e]; g1[e] = p.in[4][(size_t)(b * 2 + 1) * DFF + cc + e]; }
#pragma unroll
        for (int t = 0; t < 4; ++t) { const size_t off = (size_t)(row0 + t) * DFF + cc; const u32x4v a = *(const u32x4v*)(G + off), uu = *(const u32x4v*)(U + off);
            float g0[8] = {bflo(a.x), bfhi(a.x), bflo(a.y), bfhi(a.y), bflo(a.z), bfhi(a.z), bflo(a.w), bfhi(a.w)};
            const float uf[8] = {bflo(uu.x), bfhi(uu.x), bflo(uu.y), bfhi(uu.y), bflo(uu.z), bfhi(uu.z), bflo(uu.w), bfhi(uu.w)}; float r[8];
#pragma unroll
            for (int e = 0; e < 8; ++e) { r[e] = gelu_t(bb[e] + w0[e] * g2[e] + w1[e] * g1[e] + w2[e] * g0[e]) * uf[e]; g2[e] = g1[e]; g1[e] = g0[e]; }
            u32x4v o; o.x = pk2(r[0], r[1]); o.y = pk2(r[2], r[3]); o.z = pk2(r[4], r[5]); o.w = pk2(r[6], r[7]); *(u32x4v*)(U + off) = o; }
    }
}
__device__ __forceinline__ void phase_final(const Params& p) {
    const float* h32 = (const float*)(p.ws + WS_H); const float* ssq = (const float*)(p.ws + WS_SSQ) + (size_t)2 * MT * 16; const float* g = p.in[28];
    const int lane = threadIdx.x & 63, wave = threadIdx.x >> 6;
    const float* ssq64 = (const float*)(p.ws + WS_SSQS) + (size_t)2 * 512 * 64;
    for (int r = blockIdx.x * 8 + wave; r < MT; r += gridDim.x * 8) { const float rs = row_rs2(ssq, ssq64, r);
#pragma unroll
        for (int i = 0; i < 4; ++i) { const size_t off = (size_t)r * 1024 + i * 256 + lane * 4; *(f32x4*)(p.out + O_Y + off) = *(const f32x4*)(h32 + off) * rs * *(const f32x4*)(g + i * 256 + lane * 4); } }
}

template <int DUMMY>
__device__ __forceinline__ void run_phases(const Params& p, LAS unsigned char* lds, const int lo, const int hi) {
    unsigned char* ws = p.ws; const int G = gridDim.x, bx = blockIdx.x;
#define IN(k) (lo <= (k) && (k) < hi)
#define MKBAR() XcdBarrier bar; bar.bar = (unsigned*)(p.ws + WS_BAR) + (size_t)p.bar_region * XCD_BAR_WORDS; bar.x = xb_xcc_id(); bar.st = (volatile LAS unsigned*)(lds + LDS_BYTES - 16)
#define SEAM(k) do { if (IN(k) && IN((k) + 1)) { MKBAR(); xcd_barrier(bar); } } while (0)
    if (IN(0)) { phase_prep(p, lds); } SEAM(0);
    if (IN(0) && IN(1)) {
        volatile LAS unsigned* stw = (volatile LAS unsigned*)(lds + LDS_BYTES - 16);
        if (threadIdx.x == 0 && (G % 8) == 0) { unsigned* barw = (unsigned*)(p.ws + WS_BAR) + (size_t)p.bar_region * XCD_BAR_WORDS; const unsigned x = xb_xcc_id(); unsigned pre = 0;
            for (unsigned j = 0; j < 16; ++j) { const unsigned cj = xb_ld(&barw[XB_XCNT(j)]); if (j < x) pre += cj; }
            const unsigned clin = pre + stw[2], per = (unsigned)G / 8u; stw[3] = (clin % per) * 8u + clin / per; }
        __syncthreads();
    }
#define CX ((int)((volatile LAS unsigned*)(lds + LDS_BYTES - 16))[3])
    if (IN(1)) {
        { pg8::Gemm g{(const bf16_t*)(ws + WS_A), (const bf16_t*)(ws + WS_WIN), MT, 2560, 1024}; pg8::StaticOrder S; S.init(MT, 2560, G, CX);
          EpiIn E{(bf16_t*)(ws + WS_P), (float*)(ws + WS_AF)}; pg8::gemm_phase<EpiIn, pg8::StaticOrder>(lds, g, S, E, nullptr); }
        __syncthreads();
        { pg8::Gemm g{(const bf16_t*)(ws + WS_MN), (const bf16_t*)(ws + WS_WKV), 2048, 2048, 1024}; pg8::StaticOrder S; S.init(2048, 2048, G, (CX + 104) % G);
          EpiKV E{p.out + O_MK, p.out + O_MV, (bf16_t*)(ws + WS_MKB), (bf16_t*)(ws + WS_MVT)}; pg8::gemm_phase<EpiKV, pg8::StaticOrder>(lds, g, S, E, nullptr); }
        __syncthreads();
    } SEAM(1);
    if (IN(2)) {
        gla_local_loop(p, lds, bx, G, 1024);
        for (int it = bx; it < 512; it += G) sgu_item(p, lds, it);
        for (int it = G - 1 - bx; it < 256; it += G) sample_mixer(p, lds, it >> 1, it & 1);
    } SEAM(2);
    if (IN(3)) { gla_scan(p); } SEAM(3);
    if (IN(4)) { gla_out_loop(p, lds, bx, G, 1024); } SEAM(4);
    if (IN(5)) {
        pg8::Gemm g{(const bf16_t*)(ws + WS_A), (const bf16_t*)(ws + WS_WOUT), MPR, 1024, 1024}; pg8::StaticOrder S; S.init(MPR, 1024, G, CX);
        EpiRes E{p.in[0], (bf16_t*)(ws + WS_HB), (float*)(ws + WS_SSQ)}; pg8::gemm_phase<EpiRes, pg8::StaticOrder>(lds, g, S, E, nullptr);
        __syncthreads();
        { const float* xs = p.in[1]; bf16_t* hb = (bf16_t*)(ws + WS_HB) + (size_t)MPR * 1024; float* sq = (float*)(ws + WS_SSQS);
          gemm_small<256>((const bf16_t*)(ws + WS_A) + (size_t)MPR * 1024, (const bf16_t*)(ws + WS_WOUT), 1024, 16, lds, [=](int r, int c, int cb, int fq, f32x4 a) {
              const size_t off = (size_t)r * 1024 + c; const f32x4 v = a + *(const f32x4*)(xs + off); u32x2 w; w.x = pk2(v[0], v[1]); w.y = pk2(v[2], v[3]); *(u32x2*)(hb + off) = w;
              float s = sq4(v); s += __shfl_xor(s, 16); s += __shfl_xor(s, 32); if (fq == 0) sq[(size_t)r * 64 + cb] = s; }); }
    } SEAM(5);
    if (IN(6)) {
        pg8::Gemm g{(const bf16_t*)(ws + WS_HB), (const bf16_t*)(ws + WS_WQ), MPR, 1024, 1024}; pg8::StaticOrder S; S.init(MPR, 1024, G, CX);
        EpiQ E{(bf16_t*)(ws + WS_A), (const float*)(ws + WS_SSQ)}; pg8::gemm_phase<EpiQ, pg8::StaticOrder>(lds, g, S, E, nullptr);
        __syncthreads();
        { bf16_t* Q = (bf16_t*)(ws + WS_A) + (size_t)MPR * 1024; const float* sq = (const float*)(ws + WS_SSQS);
          gemm_small<256>((const bf16_t*)(ws + WS_HB) + (size_t)MPR * 1024, (const bf16_t*)(ws + WS_WQ), 1024, 16, lds, [=](int r, int c, int cb, int fq, f32x4 a) {
              const f32x4 v = a * row_rs64(sq, r); u32x2 w; w.x = pk2(v[0], v[1]); w.y = pk2(v[2], v[3]); *(u32x2*)(Q + (size_t)r * 1024 + c) = w; }); }
    } SEAM(6);
    if (IN(7)) {
        if ((bx >> 3) & 1) { for (int it = bx; it < 512; it += G) attn_sample(p, lds, it); for (int it = bx; it < 256; it += G) attn_prompt(p, lds, it); }
        else { for (int it = bx; it < 256; it += G) attn_prompt(p, lds, it); for (int it = bx; it < 512; it += G) attn_sample(p, lds, it); }
    } SEAM(7);
    if (IN(8)) {
        pg8::Gemm g{(const bf16_t*)(ws + WS_A), (const bf16_t*)(ws + WS_WO), MPR, 1024, 1024}; pg8::StaticOrder S; S.init(MPR, 1024, G, CX);
        EpiRes E{nullptr, (bf16_t*)(ws + WS_HB), (float*)(ws + WS_SSQ) + (size_t)MT * 16};
        pg8::gemm_phase<EpiRes, pg8::StaticOrder>(lds, g, S, E, nullptr);
        __syncthreads();
        { bf16_t* hb = (bf16_t*)(ws + WS_HB) + (size_t)MPR * 1024; float* sq = (float*)(ws + WS_SSQS) + (size_t)512 * 64;
          gemm_small<256>((const bf16_t*)(ws + WS_A) + (size_t)MPR * 1024, (const bf16_t*)(ws + WS_WO), 1024, 16, lds, [=](int r, int c, int cb, int fq, f32x4 a) {
              const size_t off = (size_t)r * 1024 + c; const u32x2 hw = *(const u32x2*)(hb + off); const f32x4 v = a + (f32x4){bflo(hw.x), bfhi(hw.x), bflo(hw.y), bfhi(hw.y)};
              u32x2 w; w.x = pk2(v[0], v[1]); w.y = pk2(v[2], v[3]); *(u32x2*)(hb + off) = w;
              float s = sq4(v); s += __shfl_xor(s, 16); s += __shfl_xor(s, 32); if (fq == 0) sq[(size_t)r * 64 + cb] = s; }); }
    } SEAM(8);
    if (IN(9)) {
        pg8::Gemm g{(const bf16_t*)(ws + WS_HB), (const bf16_t*)(ws + WS_WGU), MT, 5632, 1024}; pg8::StaticOrder S; S.init(MT, 5632, G, CX);
        EpiGU E{(bf16_t*)(ws + WS_U), (const float*)(ws + WS_SSQ) + (size_t)MT * 16, (const float*)(ws + WS_SSQS) + (size_t)512 * 64, p.out + O_SCP, p.out + O_SCS, p.in[25], p.in[26], p.in[4], (float*)(ws + WS_GX), (float*)(ws + WS_UX), p.pad}; pg8::gemm_phase<EpiGU, pg8::StaticOrder>(lds, g, S, E, nullptr);
        __syncthreads();
    } if (IN(9) && IN(11)) { MKBAR(); xcd_barrier(bar); }
    if (IN(11)) {
        pg8::Gemm g{(const bf16_t*)(ws + WS_U), (const bf16_t*)(ws + WS_WD), MPR, 1024, 2816}; pg8::StaticOrder S; S.init(MPR, 1024, G, CX);
        if (!(p.pad & 2)) { Unit fu; for (int i = 0; S.next(i, fu); ++i) act_fixup(p, fu.pm); asm volatile("s_waitcnt vmcnt(0)" ::: "memory"); __syncthreads(); }
        EpiFin E{(const bf16_t*)(ws + WS_HB), (float*)(ws + WS_SSQ) + (size_t)2 * MT * 16, (unsigned*)(ws + WS_BAR) + (size_t)p.bar_region * XCD_BAR_WORDS, p.in[28], p.out + O_Y, p.pad,
                 (const bf16_t*)(ws + WS_U) + (size_t)MPR * 2816, (const bf16_t*)(ws + WS_WD), (float*)(ws + WS_SSQS) + (size_t)2 * 512 * 64};
        pg8::gemm_phase<EpiFin, pg8::StaticOrder>(lds, g, S, E, nullptr);
        __syncthreads();
    }
#undef IN
#undef SEAM
#undef CX
}
__global__ void __launch_bounds__(512) mega(Params p) {
    extern __shared__ __attribute__((aligned(16))) unsigned char lds_raw[];
    LAS unsigned char* lds = (LAS unsigned char*)lds_raw;
    if (p.ph_lo < 0) { cg::grid_group grid = cg::this_grid(); grid.sync(); }
    volatile LAS unsigned* st = (volatile LAS unsigned*)(lds + LDS_BYTES - 16);
    if (threadIdx.x < 4) st[threadIdx.x] = 0u;
    __syncthreads();
    if (threadIdx.x == 0) { unsigned* barw = (unsigned*)(p.ws + WS_BAR) + (size_t)p.bar_region * XCD_BAR_WORDS;
        st[2] = xb_add(&barw[XB_XCNT(xb_xcc_id())], 1u);
        st[3] = blockIdx.x; }
    __syncthreads();
    run_phases<0>(p, lds, p.ph_lo, p.ph_hi);
#ifdef EXTRA_SYNC
    for (int i = 0; i < EXTRA_SYNC; ++i) { MKBAR(); xcd_barrier(bar); }
#endif
}

extern "C" void kernel_launch(void* const* d_in, const int* in_sizes, int n_in, void* d_out, int out_size, void* d_ws, size_t ws_size, hipStream_t stream) {
    static int grid = 0;
    if (grid == 0) {
        if (n_in != 29 || ws_size < WS_END) { fprintf(stderr, "kernel_launch: unexpected n_in %d / ws %zu (need %zu)\n", n_in, ws_size, (size_t)WS_END); grid = -1; return; }
        int dev = 0, cus = 0, per_cu = 0;
        hipGetDevice(&dev); hipDeviceGetAttribute(&cus, hipDeviceAttributeMultiprocessorCount, dev);
        if (hipFuncSetAttribute((const void*)mega, hipFuncAttributeMaxDynamicSharedMemorySize, LDS_BYTES) != hipSuccess) { fprintf(stderr, "kernel_launch: hipFuncSetAttribute failed\n"); grid = -1; return; }
        if (hipOccupancyMaxActiveBlocksPerMultiprocessor(&per_cu, (const void*)mega, 512, LDS_BYTES) != hipSuccess || per_cu < 1) { fprintf(stderr, "kernel_launch: occupancy query gives %d\n", per_cu); (void)hipGetLastError(); per_cu = 1; }
        grid = cus;
    }
    if (grid < 0) return;
    Params p{};
    for (int i = 0; i < 29; ++i) p.in[i] = (const float*)d_in[i];
    p.out = (float*)d_out; p.ws = (unsigned char*)d_ws;
    (void)hipMemsetAsync((unsigned char*)d_ws + WS_BAR, 0, (size_t)2 * XCD_BAR_WORDS * 4, stream);
#if N_LAUNCH_MODE == 1
    p.ph_lo = 0; p.ph_hi = NPHASE;
    void* args[] = {&p};
    hipError_t e = hipLaunchCooperativeKernel((const void*)mega, dim3(grid), dim3(512), args, LDS_BYTES, stream);
    if (e != hipSuccess) fprintf(stderr, "cooperative launch failed: %s (grid %d)\n", hipGetErrorString(e), grid);
#if EXTRA_HI > 0
    Params p2 = p; p2.ph_lo = EXTRA_LO; p2.ph_hi = EXTRA_HI; p2.bar_region = 1; p2.pad = EXTRA_FLAGS; void* args2[] = {&p2};
    (void)hipLaunchCooperativeKernel((const void*)mega, dim3(grid), dim3(512), args2, LDS_BYTES, stream);
#endif
#else
    for (int ph = 0; ph < NPHASE; ++ph) { p.ph_lo = ph; p.ph_hi = ph + 1; hipLaunchKernelGGL(mega, dim3(grid), dim3(512), LDS_BYTES, stream, p); }
#endif
}
```

```cpp
#include <hip/hip_runtime.h>
namespace pg8 {
#define PG8_LAS __attribute__((address_space(3)))
typedef unsigned short bf16_t;
typedef short bf16x8 __attribute__((ext_vector_type(8)));
typedef float f32x4 __attribute__((ext_vector_type(4)));
typedef unsigned u32x4 __attribute__((ext_vector_type(4)));
constexpr int BM = 256, BK = 64, HALF = 128, HTB = HALF * BK * 2  , STAGE_BYTES = 8 * HTB, NXCD = 8, WGM = 8;

__host__ __device__ __forceinline__ int lds_byte(int r, int c) { const int st = (r >> 4) * 2 + (c >> 5), rr = r & 15, cc = c & 31, ob = rr * 64 + cc * 2; return st * 1024 + (ob ^ (((ob >> 9) & 1) << 5)); }
__host__ __device__ __forceinline__ void stage_rc(int b, int& R, int& C) { const int st = b / 1024, sb = b % 1024, swz = sb ^ (((sb >> 9) & 1) << 5); R = (st >> 1) * 16 + swz / 64; C = (st & 1) * 32 + (swz % 64) / 2; }
__host__ __device__ __forceinline__ int perm32(int rho) { const int n = rho >> 4, i = rho & 15; return 8 * (i >> 2) + 4 * n + (i & 3); }

struct Unit { int pm, pn; };
struct Gemm { const bf16_t* A; const bf16_t* Bt; int M, N, K; };

struct StaticOrder {
    int nM, nN, nwg, G, c;
    __host__ __device__ void init(int M, int N, int G_, int c_) { nM = M / BM; nN = N / BM; nwg = nM * nN; G = G_; c = c_; }
    __host__ __device__ __forceinline__ bool next(int i, Unit& u) const {
        const long L = (long)i * G + c; if (L >= nwg) return false;
        int wgid = (int)L; { const int q = nwg / NXCD, r = nwg % NXCD, xcd = wgid % NXCD, off = wgid / NXCD; wgid = (xcd < r ? xcd * (q + 1) : r * (q + 1) + (xcd - r) * q) + off; }
        const int nig = WGM * nN, gid = wgid / nig, fm = gid * WGM, gsz = (nM - fm) < WGM ? (nM - fm) : WGM;
        u.pm = fm + ((wgid % nig) % gsz); u.pn = (wgid % nig) / gsz; return true;
    }
    __device__ __forceinline__ void a_ready(const Unit&) const {}
    __device__ __forceinline__ void done(const Unit&) const {}
};
struct CountedOrder : StaticOrder {
    const unsigned* ready; unsigned need; unsigned* tmo;
    __device__ __forceinline__ void a_ready(const Unit& u) const {
        if (threadIdx.x < 64) {
            const unsigned long long t0 = __builtin_amdgcn_s_memrealtime(); unsigned polls = 0;
            while ((unsigned)__builtin_amdgcn_readfirstlane(__hip_atomic_load(ready + 64 * u.pm, __ATOMIC_RELAXED, __HIP_MEMORY_SCOPE_AGENT)) < need) {
                if ((++polls & 255u) == 0u && __builtin_amdgcn_readfirstlane(__hip_atomic_load(tmo, __ATOMIC_RELAXED, __HIP_MEMORY_SCOPE_AGENT)) != 0u) break;
                if (__builtin_amdgcn_s_memrealtime() - t0 > 2000000ull) {
                    if (threadIdx.x == 0) { unsigned expect = 0u; __hip_atomic_compare_exchange_strong(tmo + 1, &expect, 0x600u | (unsigned)(u.pm & 0xff), __ATOMIC_RELAXED, __ATOMIC_RELAXED, __HIP_MEMORY_SCOPE_AGENT); __hip_atomic_store(tmo, 1u, __ATOMIC_RELAXED, __HIP_MEMORY_SCOPE_AGENT); }
                    break; }
                __builtin_amdgcn_s_sleep(2); }
            __builtin_amdgcn_fence(__ATOMIC_ACQUIRE, "agent");
            asm volatile("s_waitcnt vmcnt(0)" ::: "memory");
        }
#if !defined(BROKEN_HOOK_NO_BARRIER)
        asm volatile("" ::: "memory"); __builtin_amdgcn_s_barrier(); asm volatile("" ::: "memory");
#endif
    }
};

__device__ __forceinline__ unsigned cvt_pk_bf16(float lo, float hi) { unsigned r; asm volatile("v_cvt_pk_bf16_f32 %0, %1, %2" : "=v"(r) : "v"(lo), "v"(hi)); return r; }
typedef float f32x2 __attribute__((ext_vector_type(2)));
__device__ __forceinline__ f32x2 gelu_pk(f32x2 v) {
    const f32x2 av = __builtin_elementwise_abs(v), d = av * 0.2316418882f + 1.0f;
    f32x2 t; t.x = __builtin_amdgcn_rcpf(d.x); t.y = __builtin_amdgcn_rcpf(d.y);
    f32x2 q = t * 0.5307027145f + (-0.7265760135f); q = q * t + 0.7107068705f; q = q * t + (-0.142248368f); q = q * t + 0.127414796f; q = q * t;
    const f32x2 s = (v * v) * (-0.72134752044f);
    f32x2 e; e.x = __builtin_amdgcn_exp2f(s.x); e.y = __builtin_amdgcn_exp2f(s.y);
    const f32x2 m = v * (q * e), r = v - m;
    f32x2 o; o.x = v.x < 0.f ? m.x : r.x; o.y = v.y < 0.f ? m.y : r.y; return o;
}

struct EpiF32 {
    static constexpr bool PERM = false, AFTER_DRAIN = false;
    float* C; int ldc; const float* bias;
    __device__ __forceinline__ void operator()(const f32x4 (&acc)[2][2][4][2], const Unit& u, int wr, int wc, int fr, int fq) const {
        const int row0 = u.pm * BM + wr * 64 + fr, col0 = u.pn * BM + wc * 32 + 4 * fq;
        f32x4 bv[2][2];
#pragma unroll
        for (int bj = 0; bj < 2; ++bj)
#pragma unroll
            for (int n = 0; n < 2; ++n) bv[bj][n] = bias ? *(const f32x4*)(bias + col0 + bj * HALF + n * 16) : (f32x4){0.f, 0.f, 0.f, 0.f};
#pragma unroll
        for (int ai = 0; ai < 2; ++ai)
#pragma unroll
            for (int m = 0; m < 4; ++m) { float* rowp = C + (size_t)(row0 + ai * HALF + m * 16) * ldc + col0;
#pragma unroll
                for (int bj = 0; bj < 2; ++bj)
#pragma unroll
                    for (int n = 0; n < 2; ++n) *(f32x4*)(rowp + bj * HALF + n * 16) = acc[ai][bj][m][n] + bv[bj][n]; }
    }
};
template <int ACT  > struct EpiBf16 {
    static constexpr bool PERM = true, AFTER_DRAIN = false;
    bf16_t* O; int ldc; const float* bias; int split_cols; size_t split_stride;
    __device__ __forceinline__ void operator()(const f32x4 (&acc)[2][2][4][2], const Unit& u, int wr, int wc, int fr, int fq) const {
        const int row0 = u.pm * BM + wr * 64 + fr; int colt = u.pn * BM; bf16_t* base = O;
        if (split_cols) { const int t = colt / split_cols; base += (size_t)t * split_stride; colt -= t * split_cols; }
        const int col0 = colt + wc * 32 + 8 * fq, bcol0 = u.pn * BM + wc * 32 + 8 * fq;
        f32x4 bv[2][2];
#pragma unroll
        for (int bj = 0; bj < 2; ++bj)
#pragma unroll
            for (int n = 0; n < 2; ++n) bv[bj][n] = bias ? *(const f32x4*)(bias + bcol0 + bj * HALF + 4 * n) : (f32x4){0.f, 0.f, 0.f, 0.f};
#pragma unroll
        for (int ai = 0; ai < 2; ++ai)
#pragma unroll
            for (int m = 0; m < 4; ++m) { bf16_t* rowp = base + (size_t)(row0 + ai * HALF + m * 16) * ldc + col0;
#pragma unroll
                for (int bj = 0; bj < 2; ++bj) { f32x4 v0 = acc[ai][bj][m][0] + bv[bj][0], v1 = acc[ai][bj][m][1] + bv[bj][1];
                    if (ACT == 1) { f32x2 a = gelu_pk((f32x2){v0[0], v0[1]}), b = gelu_pk((f32x2){v0[2], v0[3]}), c = gelu_pk((f32x2){v1[0], v1[1]}), d = gelu_pk((f32x2){v1[2], v1[3]});
                        v0 = (f32x4){a.x, a.y, b.x, b.y}; v1 = (f32x4){c.x, c.y, d.x, d.y}; }
                    if (ACT == 2) {
#pragma unroll
                        for (int j = 0; j < 4; ++j) { v0[j] = 0.5f * v0[j] * (1.0f + erff(v0[j] * 0.70710678f)); v1[j] = 0.5f * v1[j] * (1.0f + erff(v1[j] * 0.70710678f)); } }
                    u32x4 w; w.x = cvt_pk_bf16(v0[0], v0[1]); w.y = cvt_pk_bf16(v0[2], v0[3]); w.z = cvt_pk_bf16(v1[0], v1[1]); w.w = cvt_pk_bf16(v1[2], v1[3]);
                    *(u32x4*)(rowp + bj * HALF) = w; } }
    }
};

struct PanelStats {
    unsigned* xbuf;
    unsigned* cnt;
    unsigned* tmo;
    int ntn; float eps;
    unsigned code;
    __device__ __forceinline__ bool run(const f32x4 (&v)[2][2][4][2], const Unit& u, int wr, int wc, int fr, int fq, PG8_LAS unsigned char* lds, int wid, int lane) const {
        typedef float f32x2v __attribute__((ext_vector_type(2)));
        PG8_LAS f32x2v* P = (PG8_LAS f32x2v*)lds;
        PG8_LAS f32x2v* S = (PG8_LAS f32x2v*)(lds + 8192);
        PG8_LAS unsigned* flag = (PG8_LAS unsigned*)(lds + 8192 + 2048);
#pragma unroll
        for (int ai = 0; ai < 2; ++ai)
#pragma unroll
            for (int m = 0; m < 4; ++m) {
                float s = 0.f;
#pragma unroll
                for (int bj = 0; bj < 2; ++bj)
#pragma unroll
                    for (int n = 0; n < 2; ++n) { const f32x4 x = v[ai][bj][m][n]; s += (x[0] + x[1]) + (x[2] + x[3]); }
                s += __shfl_xor(s, 16); s += __shfl_xor(s, 32);
                const float mw = s * (1.0f / 64.0f); float q = 0.f;
#pragma unroll
                for (int bj = 0; bj < 2; ++bj)
#pragma unroll
                    for (int n = 0; n < 2; ++n) { const f32x4 d = v[ai][bj][m][n] - mw; q += (d[0] * d[0] + d[1] * d[1]) + (d[2] * d[2] + d[3] * d[3]); }
                q += __shfl_xor(q, 16); q += __shfl_xor(q, 32);
                if (fq == 0) P[(ai * HALF + wr * 64 + m * 16 + fr) * 4 + wc] = (f32x2v){mw, q};
            }
        asm volatile("s_waitcnt lgkmcnt(0)" ::: "memory"); __builtin_amdgcn_s_barrier(); asm volatile("" ::: "memory");
#if defined(BROKEN_NO_WAIT)
        if (blockIdx.x >= 64) { const long long t0 = clock64(); while (clock64() - t0 < 60000) __builtin_amdgcn_s_sleep(8); }
#endif
        const int row = wid * 32 + (lane & 31);
        if (lane < 32) {
            const f32x2v a = P[row * 4 + 0], b = P[row * 4 + 1], c = P[row * 4 + 2], d = P[row * 4 + 3];
            const float mt = (a.x + b.x + c.x + d.x) * 0.25f;
            const float da = a.x - mt, db = b.x - mt, dc = c.x - mt, dd = d.x - mt;
            const float m2 = (a.y + b.y) + (c.y + d.y) + 64.0f * ((da * da + db * db) + (dc * dc + dd * dd));
            unsigned long long* slot = (unsigned long long*)xbuf + ((size_t)(u.pm * BM + row) * 4 + u.pn);
            __hip_atomic_store(slot, ((unsigned long long)__float_as_uint(m2) << 32) | __float_as_uint(mt), __ATOMIC_RELAXED, __HIP_MEMORY_SCOPE_AGENT);
        }
        asm volatile("s_waitcnt vmcnt(0)" ::: "memory");
        if (lane == 0) __hip_atomic_fetch_add(cnt + 64 * u.pm, 1u, __ATOMIC_RELAXED, __HIP_MEMORY_SCOPE_AGENT);
        if (wid == 0) {
            bool dead = false; const unsigned long long t0 = __builtin_amdgcn_s_memrealtime(); const unsigned want = 8u * (unsigned)ntn;
            for (;;) {
#if defined(BROKEN_NO_WAIT)
                break;
#endif
                if ((unsigned)__builtin_amdgcn_readfirstlane(__hip_atomic_load(cnt + 64 * u.pm, __ATOMIC_RELAXED, __HIP_MEMORY_SCOPE_AGENT)) >= want) break;
                if (__builtin_amdgcn_s_memrealtime() - t0 > 2000000ull) {
                    if (lane == 0) { unsigned expect = 0u; __hip_atomic_compare_exchange_strong(tmo + 1, &expect, code | (unsigned)(u.pm & 0xff), __ATOMIC_RELAXED, __ATOMIC_RELAXED, __HIP_MEMORY_SCOPE_AGENT);
                                     __hip_atomic_store(tmo, 1u, __ATOMIC_RELAXED, __HIP_MEMORY_SCOPE_AGENT); }
                    dead = true; break; }
                __builtin_amdgcn_s_sleep(2);
            }
            __builtin_amdgcn_fence(__ATOMIC_ACQUIRE, "agent");
            if (lane == 0) flag[0] = dead ? 1u : 0u;
        }
        asm volatile("s_waitcnt vmcnt(0) lgkmcnt(0)" ::: "memory"); __builtin_amdgcn_s_barrier(); asm volatile("" ::: "memory");
        const bool bad = flag[0] != 0u;
        if (lane < 32) {
            const unsigned long long* slot = (const unsigned long long*)xbuf + (size_t)(u.pm * BM + row) * 4; float mt[4], m2[4]; float ms = 0.f;
#pragma unroll
            for (int t = 0; t < 4; ++t) { if (t < ntn) { const unsigned long long w = __hip_atomic_load(slot + t, __ATOMIC_RELAXED, __HIP_MEMORY_SCOPE_AGENT); mt[t] = __uint_as_float((unsigned)w); m2[t] = __uint_as_float((unsigned)(w >> 32)); } else { mt[t] = 0.f; m2[t] = 0.f; } ms += mt[t]; }
            const float mean = ms / (float)ntn; float q = 0.f;
#pragma unroll
            for (int t = 0; t < 4; ++t) if (t < ntn) { const float dm = mt[t] - mean; q += m2[t] + 256.0f * dm * dm; }
            S[row] = (f32x2v){mean, 1.0f / sqrtf(q / (256.0f * (float)ntn) + eps)};
        }
        asm volatile("s_waitcnt lgkmcnt(0)" ::: "memory"); __builtin_amdgcn_s_barrier(); asm volatile("" ::: "memory");
        return bad;
    }
};
struct EpiLnRes {
    static constexpr bool PERM = false, AFTER_DRAIN = true;
    const float* base; float* out; int ldc; const float* bias; PanelStats st; unsigned poison;
    __device__ __forceinline__ void refuse(size_t i0, size_t stride, int M, int N) const { const float q = __builtin_nanf(""); for (size_t i = i0; i < (size_t)M * N; i += stride) out[(i / N) * ldc + i % N] = q;
        if (i0 == 0) { unsigned expect = 0u; __hip_atomic_compare_exchange_strong(st.tmo + 1, &expect, 0x7f0u, __ATOMIC_RELAXED, __ATOMIC_RELAXED, __HIP_MEMORY_SCOPE_AGENT); __hip_atomic_store(st.tmo, 1u, __ATOMIC_RELAXED, __HIP_MEMORY_SCOPE_AGENT); } }
    __device__ __forceinline__ void fused(f32x4 (&acc)[2][2][4][2], const Unit& u, int wr, int wc, int fr, int fq, PG8_LAS unsigned char* lds, int wid, int lane) const {
        typedef float f32x2v __attribute__((ext_vector_type(2)));
        const PG8_LAS f32x2v* S = (const PG8_LAS f32x2v*)(lds + 8192);
        const int col0 = u.pn * BM + wc * 32 + 4 * fq;
#pragma unroll
        for (int bj = 0; bj < 2; ++bj)
#pragma unroll
            for (int n = 0; n < 2; ++n) { const f32x4 bv = bias ? *(const f32x4*)(bias + col0 + bj * HALF + n * 16) : (f32x4){0.f, 0.f, 0.f, 0.f};
#pragma unroll
                for (int ai = 0; ai < 2; ++ai)
#pragma unroll
                    for (int m = 0; m < 4; ++m) acc[ai][bj][m][n] += bv; }
        const bool bad = st.run(acc, u, wr, wc, fr, fq, lds, wid, lane) || poison != 0u;
        const float qnan = __builtin_nanf("");
#pragma unroll
        for (int ai = 0; ai < 2; ++ai)
#pragma unroll
            for (int m = 0; m < 4; ++m) { const int r = ai * HALF + wr * 64 + m * 16 + fr; const f32x2v sr = S[r]; const size_t off = (size_t)(u.pm * BM + r) * ldc + col0;
#pragma unroll
                for (int bj = 0; bj < 2; ++bj)
#pragma unroll
                    for (int n = 0; n < 2; ++n) { const f32x4 bs = *(const f32x4*)(base + off + bj * HALF + n * 16); f32x4 o = bs + (acc[ai][bj][m][n] - sr.x) * sr.y;
                        if (bad) o = (f32x4){qnan, qnan, qnan, qnan}; *(f32x4*)(out + off + bj * HALF + n * 16) = o; }
                asm volatile("" ::: "memory"); }
    }
};
struct EpiLnResLn {
    static constexpr bool PERM = false, AFTER_DRAIN = true;
    const float* base; float* out; bf16_t* xn; int ldc; const float* bias; PanelStats st1, st2; unsigned poison;
    __device__ __forceinline__ void refuse(size_t i0, size_t stride, int M, int N) const { const float q = __builtin_nanf(""); for (size_t i = i0; i < (size_t)M * N; i += stride) { const size_t o = (i / N) * ldc + i % N; out[o] = q; xn[o] = (bf16_t)0x7fc0u; }
        if (i0 == 0) { unsigned expect = 0u; __hip_atomic_compare_exchange_strong(st1.tmo + 1, &expect, 0x7f0u, __ATOMIC_RELAXED, __ATOMIC_RELAXED, __HIP_MEMORY_SCOPE_AGENT); __hip_atomic_store(st1.tmo, 1u, __ATOMIC_RELAXED, __HIP_MEMORY_SCOPE_AGENT); } }
    __device__ __forceinline__ void fused(f32x4 (&acc)[2][2][4][2], const Unit& u, int wr, int wc, int fr, int fq, PG8_LAS unsigned char* lds, int wid, int lane) const {
        typedef float f32x2v __attribute__((ext_vector_type(2))); typedef unsigned u32x2v __attribute__((ext_vector_type(2)));
        const PG8_LAS f32x2v* S = (const PG8_LAS f32x2v*)(lds + 8192);
        const int col0 = u.pn * BM + wc * 32 + 4 * fq;
#pragma unroll
        for (int bj = 0; bj < 2; ++bj)
#pragma unroll
            for (int n = 0; n < 2; ++n) { const f32x4 bv = bias ? *(const f32x4*)(bias + col0 + bj * HALF + n * 16) : (f32x4){0.f, 0.f, 0.f, 0.f};
#pragma unroll
                for (int ai = 0; ai < 2; ++ai)
#pragma unroll
                    for (int m = 0; m < 4; ++m) acc[ai][bj][m][n] += bv; }
        bool bad = st1.run(acc, u, wr, wc, fr, fq, lds, wid, lane) || poison != 0u;
        const float qnan = __builtin_nanf("");
#pragma unroll
        for (int ai = 0; ai < 2; ++ai)
#pragma unroll
            for (int m = 0; m < 4; ++m) { const int r = ai * HALF + wr * 64 + m * 16 + fr; const f32x2v sr = S[r]; const size_t off = (size_t)(u.pm * BM + r) * ldc + col0;
#pragma unroll
                for (int bj = 0; bj < 2; ++bj)
#pragma unroll
                    for (int n = 0; n < 2; ++n) { const f32x4 bs = *(const f32x4*)(base + off + bj * HALF + n * 16); acc[ai][bj][m][n] = bs + (acc[ai][bj][m][n] - sr.x) * sr.y; }
                asm volatile("" : "+v"(acc[ai][0][m][0]), "+v"(acc[ai][0][m][1]), "+v"(acc[ai][1][m][0]), "+v"(acc[ai][1][m][1]));
                if (m & 1) asm volatile("" ::: "memory"); }
        const bool bad1 = bad;
        bad = st2.run(acc, u, wr, wc, fr, fq, lds, wid, lane) || bad;
#pragma unroll
        for (int ai = 0; ai < 2; ++ai)
#pragma unroll
            for (int m = 0; m < 4; ++m) { const int r = ai * HALF + wr * 64 + m * 16 + fr; const f32x2v sr = S[r]; const size_t off = (size_t)(u.pm * BM + r) * ldc + col0;
#pragma unroll
                for (int bj = 0; bj < 2; ++bj)
#pragma unroll
                    for (int n = 0; n < 2; ++n) { const f32x4 x1 = acc[ai][bj][m][n]; *(f32x4*)(out + off + bj * HALF + n * 16) = bad1 ? (f32x4){qnan, qnan, qnan, qnan} : x1;
                        const f32x4 o = (x1 - sr.x) * sr.y; u32x2v w; w.x = cvt_pk_bf16(o[0], o[1]); w.y = cvt_pk_bf16(o[2], o[3]);
                        if (bad) { w.x = 0x7fc07fc0u; w.y = 0x7fc07fc0u; } *(u32x2v*)(xn + off + bj * HALF + n * 16) = w; }
                asm volatile("" ::: "memory"); }
    }
};

template <class Epi, class Sched, bool STAMP = false>
__device__ __forceinline__ void gemm_phase(PG8_LAS unsigned char* lds, const Gemm g, const Sched& S, const Epi& E, unsigned long long* stamps) {
    const int tid = threadIdx.x, wid = __builtin_amdgcn_readfirstlane(tid >> 6), lane = tid & 63, wr = wid >> 2, wc = wid & 3, fr = lane & 15, fq = lane >> 4;
    const int K = g.K, nt = K / BK;
    int ts_lo = 0, ts_hi = 0, nts = 0; const unsigned long long rt_entry = STAMP ? (unsigned long long)wall_clock64() : 0ull;
#define PG8_STAMP() do { if (STAMP && wid == 0 && nts < 64) { const unsigned long long _c = (unsigned long long)clock64(); \
        ts_lo = (lane == nts) ? (int)(unsigned)_c : ts_lo; ts_hi = (lane == nts) ? (int)(unsigned)(_c >> 32) : ts_hi; ++nts; } } while (0)
    PG8_STAMP();
    unsigned voffA[2], voffB[2];
#pragma unroll
    for (int i = 0; i < 2; ++i) { int R, C; stage_rc(tid * 16 + i * 8192, R, C); const int Rb = Epi::PERM ? ((R & ~31) + perm32(R & 31)) : R;
        voffA[i] = (unsigned)(R * K + C) * 2u; voffB[i] = (unsigned)(Rb * K + C) * 2u; }
    const size_t kstep = (size_t)(BK * 2);
    const size_t hstep = (size_t)HALF * K * 2;
    const size_t tstep = 2 * hstep;
    const unsigned ldsw = (unsigned)wid * 1024u;
    const int aoff = lds_byte(wr * 64 + fr, fq * 8), boff = lds_byte(wc * 32 + fr, fq * 8);
#define PG8_SA(b, h) (((b) * 2 + (h)) * HTB)
#define PG8_SB(b, h) ((4 + (b) * 2 + (h)) * HTB)
#define PG8_STAGE(bufoff, gbase, voff) do { _Pragma("unroll") for (int _i = 0; _i < 2; ++_i) \
        __builtin_amdgcn_global_load_lds((const unsigned*)((const char*)(gbase) + (voff)[_i]), (PG8_LAS unsigned*)(lds + (bufoff) + ldsw + _i * 8192), 16, 0, 0); } while (0)
#define PG8_LDA(dst, b, h) do { _Pragma("unroll") for (int m = 0; m < 4; ++m) _Pragma("unroll") for (int k = 0; k < 2; ++k) dst[m][k] = *(const PG8_LAS bf16x8*)(lds + PG8_SA(b, h) + aoff + m * 2048 + k * 1024); } while (0)
#define PG8_LDB(dst, b, h) do { _Pragma("unroll") for (int n = 0; n < 2; ++n) _Pragma("unroll") for (int k = 0; k < 2; ++k) dst[n][k] = *(const PG8_LAS bf16x8*)(lds + PG8_SB(b, h) + boff + n * 2048 + k * 1024); } while (0)
#define PG8_MMA(ai, bj, At, Bt) do { __builtin_amdgcn_s_setprio(1); _Pragma("unroll") for (int m = 0; m < 4; ++m) _Pragma("unroll") for (int n = 0; n < 2; ++n) _Pragma("unroll") for (int k = 0; k < 2; ++k) \
        acc[ai][bj][m][n] = __builtin_amdgcn_mfma_f32_16x16x32_bf16(Bt[n][k], At[m][k], acc[ai][bj][m][n], 0, 0, 0); __builtin_amdgcn_s_setprio(0); } while (0)
#define PG8_WAIT_V(n) asm volatile("s_waitcnt vmcnt(" #n ")" ::: "memory")
#define PG8_WAIT_L(n) asm volatile("s_waitcnt lgkmcnt(" #n ")" ::: "memory")
#define PG8_BAR __builtin_amdgcn_s_barrier()
#define PG8_SCHED __builtin_amdgcn_sched_barrier(0)
    Unit cur, nxt; int ui = 0;
    if (!S.next(0, cur)) return;
    f32x4 acc[2][2][4][2];
#pragma unroll
    for (int a = 0; a < 2; ++a)
#pragma unroll
        for (int b = 0; b < 2; ++b)
#pragma unroll
            for (int m = 0; m < 4; ++m)
#pragma unroll
                for (int n = 0; n < 2; ++n) acc[a][b][m][n] = (f32x4){0.f, 0.f, 0.f, 0.f};
    bf16x8 At[4][2], B0[2][2], B1[2][2];
    const char* cA = (const char*)g.A + (size_t)cur.pm * tstep; const char* cB = (const char*)g.Bt + (size_t)cur.pn * tstep;
    S.a_ready(cur);
    PG8_STAGE(PG8_SB(0, 0), cB, voffB); PG8_STAGE(PG8_SA(0, 0), cA, voffA); PG8_STAGE(PG8_SB(0, 1), cB + hstep, voffB); PG8_STAGE(PG8_SA(0, 1), cA + hstep, voffA);
    if (wr == 1) PG8_BAR;
    PG8_WAIT_V(4); PG8_BAR;
    PG8_STAGE(PG8_SB(1, 0), cB + kstep, voffB); PG8_STAGE(PG8_SA(1, 0), cA + kstep, voffA); PG8_STAGE(PG8_SB(1, 1), cB + hstep + kstep, voffB);
    PG8_WAIT_V(6); PG8_BAR;
    PG8_STAMP();
    for (;;) {
        const bool has_next = S.next(ui + 1, nxt);
        const char* nA = has_next ? (const char*)g.A + (size_t)nxt.pm * tstep : cA; const char* nB = has_next ? (const char*)g.Bt + (size_t)nxt.pn * tstep : cB;
        for (int t = 0; t < nt; t += 2) {
            const bool last = (t == nt - 2);
            const char* a1 = cA + (size_t)(t + 1) * kstep;
            const char* a2 = last ? nA : cA + (size_t)(t + 2) * kstep; const char* b2 = last ? nB : cB + (size_t)(t + 2) * kstep;
            const char* a3 = a2 + kstep; const char* b3 = b2 + kstep;
            if (last && has_next) S.a_ready(nxt);
            PG8_LDB(B0, 0, 0); PG8_SCHED; PG8_LDA(At, 0, 0); PG8_STAGE(PG8_SA(1, 1), a1 + hstep, voffA);
            PG8_WAIT_L(8); PG8_BAR; PG8_WAIT_L(0); PG8_MMA(0, 0, At, B0); PG8_BAR; PG8_SCHED;
            PG8_LDB(B1, 0, 1); PG8_STAGE(PG8_SB(0, 0), b2, voffB);
            PG8_BAR; PG8_WAIT_L(0); PG8_MMA(0, 1, At, B1); PG8_BAR;
            PG8_LDA(At, 0, 1); PG8_STAGE(PG8_SA(0, 0), a2, voffA);
            PG8_BAR; PG8_WAIT_L(0); PG8_MMA(1, 0, At, B0); PG8_BAR; PG8_SCHED;
            PG8_STAGE(PG8_SB(0, 1), b2 + hstep, voffB);
            PG8_WAIT_V(6); PG8_BAR; PG8_MMA(1, 1, At, B1); PG8_BAR;
            PG8_LDB(B0, 1, 0); PG8_SCHED; PG8_LDA(At, 1, 0); PG8_STAGE(PG8_SA(0, 1), a2 + hstep, voffA);
            PG8_WAIT_L(8); PG8_BAR; PG8_WAIT_L(0); PG8_MMA(0, 0, At, B0); PG8_BAR; PG8_SCHED;
            PG8_LDB(B1, 1, 1); PG8_STAGE(PG8_SB(1, 0), b3, voffB);
            PG8_BAR; PG8_WAIT_L(0); PG8_MMA(0, 1, At, B1); PG8_BAR;
            PG8_LDA(At, 1, 1); PG8_STAGE(PG8_SA(1, 0), a3, voffA);
            PG8_BAR; PG8_WAIT_L(0); PG8_MMA(1, 0, At, B0); PG8_BAR; PG8_SCHED;
            PG8_STAGE(PG8_SB(1, 1), b3 + hstep, voffB);
            PG8_WAIT_V(6); PG8_BAR; PG8_MMA(1, 1, At, B1); PG8_BAR;
        }
        PG8_STAMP();
        if constexpr (!Epi::AFTER_DRAIN) { E(acc, cur, wr, wc, fr, fq); S.done(cur); }
        PG8_STAMP();
        if (!has_next) break;
#pragma unroll
        for (int a = 0; a < 2; ++a)
#pragma unroll
            for (int b = 0; b < 2; ++b)
#pragma unroll
                for (int m = 0; m < 4; ++m)
#pragma unroll
                    for (int n = 0; n < 2; ++n) acc[a][b][m][n] = (f32x4){0.f, 0.f, 0.f, 0.f};
        cur = nxt; cA = nA; cB = nB; ++ui;
    }
    PG8_WAIT_V(0);
    if (wr == 0) PG8_BAR;
    PG8_BAR;
    if constexpr (Epi::AFTER_DRAIN) { E.fused(acc, cur, wr, wc, fr, fq, lds, wid, lane); S.done(cur); }
    PG8_STAMP();
    if (STAMP && wid == 0) { stamps[lane] = lane < nts ? (((unsigned long long)(unsigned)ts_hi << 32) | (unsigned)ts_lo) : 0ull;
        if (lane == 62) stamps[62] = rt_entry; if (lane == 63) stamps[63] = (unsigned long long)wall_clock64(); }
#undef PG8_STAMP
#undef PG8_SA
#undef PG8_SB
#undef PG8_STAGE
#undef PG8_LDA
#undef PG8_LDB
#undef PG8_MMA
#undef PG8_WAIT_V
#undef PG8_WAIT_L
#undef PG8_BAR
#undef PG8_SCHED
}
}

#include <hip/hip_cooperative_groups.h>
#include <cstdio>
namespace cg = cooperative_groups;
using pg8::bf16_t; using pg8::bf16x8; using pg8::f32x4; using pg8::Unit;
typedef float f32x16 __attribute__((ext_vector_type(16)));
typedef float f32x2 __attribute__((ext_vector_type(2)));
typedef unsigned u32x2 __attribute__((ext_vector_type(2)));
typedef unsigned u32x4v __attribute__((ext_vector_type(4)));
#define LAS __attribute__((address_space(3)))
#define XB_TMO      128
#define XB_XCNT(j)  (256  + 64 * (j))
#define XB_XSUB(j)  (1280 + 64 * (j))
#define XB_XGEN(j)  (2304 + 64 * (j))
#define XB_TOP      3328
#define XB_TOPGEN   3392
#define XCD_BAR_WORDS 3456
#define XB_SPIN_CAP (1u << 18)

__device__ __forceinline__ unsigned xb_ld(unsigned* p)              { return __hip_atomic_load(p, __ATOMIC_RELAXED, __HIP_MEMORY_SCOPE_AGENT); }
__device__ __forceinline__ unsigned xb_add(unsigned* p, unsigned v) { return __hip_atomic_fetch_add(p, v, __ATOMIC_RELAXED, __HIP_MEMORY_SCOPE_AGENT); }
__device__ __forceinline__ unsigned xb_xcc_id() { return (unsigned)__builtin_amdgcn_s_getreg((3 << 11) | 20) & 0xFu; }
#define XB_SPIN(cond, bar) do { unsigned _sp = 0; while (cond) { __builtin_amdgcn_s_sleep(1); \
    if ((++_sp & 255u) == 0u) { if (xb_ld(&(bar)[XB_TMO])) break; if (_sp > XB_SPIN_CAP) { atomicAdd(&(bar)[XB_TMO], 1u); break; } } } } while (0)

struct XcdBarrier {
    unsigned* bar; unsigned x;
    volatile LAS unsigned* st;
};

__device__ __forceinline__ XcdBarrier xcd_barrier_post(unsigned* bar, volatile LAS unsigned* st) {
    XcdBarrier b; b.bar = bar; b.x = xb_xcc_id(); b.st = st;
    if (threadIdx.x == 0) (void)xb_add(&bar[XB_XCNT(b.x)], 1u);
    return b;
}
__device__ __forceinline__ void xcd_barrier_complete(unsigned* bar, unsigned x, unsigned& nloc, unsigned& nx) {
    const unsigned G = gridDim.x * gridDim.y * gridDim.z;
    unsigned sum, cnt, mine, sp = 0u;
    for (;;) {
        sum = 0u; cnt = 0u; mine = 0u;
#pragma unroll
        for (unsigned j = 0; j < 16; ++j) { const unsigned c = xb_ld(&bar[XB_XCNT(j)]); sum += c; cnt += (c > 0u) ? 1u : 0u; mine = (j == x) ? c : mine; }
        if (sum == G) break;
        __builtin_amdgcn_s_sleep(1);
        if ((++sp & 255u) == 0u) { if (xb_ld(&bar[XB_TMO])) break; if (sp > XB_SPIN_CAP) { atomicAdd(&bar[XB_TMO], 1u); break; } }
    }
    nloc = mine > 0u ? mine : 1u; nx = cnt > 0u ? cnt : 1u;
}

__device__ __forceinline__ void xcd_barrier(const XcdBarrier& b) {
    asm volatile("s_waitcnt vmcnt(0)" ::: "memory");
    __syncthreads();
    if (threadIdx.x == 0) {
        unsigned* bar = b.bar;
        __builtin_amdgcn_s_waitcnt(0);
        unsigned nloc = b.st[0], nx = b.st[1];
        if (nloc == 0u) { xcd_barrier_complete(bar, b.x, nloc, nx); b.st[0] = nloc; b.st[1] = nx; }
        const unsigned old = xb_add(&bar[XB_XSUB(b.x)], 1u);
        const unsigned gen = old / nloc;
        if (old + 1u == (gen + 1u) * nloc) {
            __builtin_amdgcn_fence(__ATOMIC_RELEASE, "agent");
            asm volatile("s_waitcnt vmcnt(0)" ::: "memory");
            const unsigned og = xb_add(&bar[XB_TOP], 1u);
            const unsigned tg = og / nx;
            if (og + 1u == (tg + 1u) * nx) xb_add(&bar[XB_TOPGEN], 1u);
            else XB_SPIN(xb_ld(&bar[XB_TOPGEN]) == tg, bar);
            __builtin_amdgcn_fence(__ATOMIC_ACQUIRE, "agent");
            xb_add(&bar[XB_XGEN(b.x)], 1u);
            asm volatile("s_waitcnt vmcnt(0)" ::: "memory");
        } else {
            XB_SPIN(xb_ld(&bar[XB_XGEN(b.x)]) == gen, bar);
            __builtin_amdgcn_fence(__ATOMIC_ACQUIRE, "agent");
            asm volatile("s_waitcnt vmcnt(0)" ::: "memory");
        }
    }
    __syncthreads();
}

constexpr int MT = 16896, MPR = 16384, DM = 1024, NIN = 2816, DFF = 2816;
constexpr float EPS = 1e-6f;
constexpr int LDS_BYTES = 143360;
#ifndef N_LAUNCH_MODE
#define N_LAUNCH_MODE 1
#endif
constexpr int NPHASE = 13;
#ifndef EXTRA_LO
#define EXTRA_LO 0
#endif
#ifndef EXTRA_FLAGS
#define EXTRA_FLAGS 0
#endif
#ifndef EXTRA_HI
#define EXTRA_HI 0
#endif

constexpr size_t WS_WIN = 0;
constexpr size_t WS_WOUT = WS_WIN + (size_t)2816 * 1024 * 2;
constexpr size_t WS_WQ = WS_WOUT + (size_t)1024 * 1024 * 2;
constexpr size_t WS_WKV = WS_WQ + (size_t)1024 * 1024 * 2;
constexpr size_t WS_WO = WS_WKV + (size_t)2048 * 1024 * 2;
constexpr size_t WS_WGU = WS_WO + (size_t)1024 * 1024 * 2;
constexpr size_t WS_WD = WS_WGU + (size_t)5632 * 1024 * 2;
constexpr size_t WS_A = WS_WD + (size_t)1024 * 2816 * 2;
constexpr size_t WS_MN = WS_A + (size_t)MT * 1024 * 2;
constexpr size_t WS_MKB = WS_MN + (size_t)2048 * 1024 * 2;
constexpr size_t WS_MVT = WS_MKB + (size_t)2048 * 1024 * 2;
constexpr size_t WS_P = WS_MVT + (size_t)2048 * 1024 * 2;
constexpr size_t WS_U = WS_P + (size_t)MT * 2816 * 2;
constexpr size_t WS_DS = WS_U;
constexpr size_t WS_ST = WS_DS + (size_t)1024 * 8192 * 4;
constexpr size_t WS_AF = WS_ST + (size_t)1024 * 8192 * 2;
constexpr size_t WS_DEC = WS_AF + (size_t)MT * 16 * 4;
constexpr size_t WS_BQ = WS_DEC + (size_t)1024 * 64 * 4;
constexpr size_t WS_H = WS_U + (size_t)MT * 2816 * 2;
constexpr size_t WS_HB = WS_H + (size_t)MT * 1024 * 4;
constexpr size_t WS_SSQ = WS_HB + (size_t)MT * 1024 * 2;
constexpr size_t WS_SSQS = WS_SSQ + (size_t)3 * MT * 16 * 4;
constexpr size_t WS_BAR = WS_SSQS + (size_t)3 * 512 * 64 * 4;
constexpr size_t WS_GX = WS_BAR + (size_t)2 * XCD_BAR_WORDS * 4;
constexpr size_t WS_UX = WS_GX + (size_t)256 * 4 * 2816 * 4;
constexpr size_t WS_END = WS_UX + (size_t)256 * 2 * 2816 * 4;

constexpr size_t O_Y = 0;
constexpr size_t O_SGP = 17301504;
constexpr size_t O_SCP = 17563648;
constexpr size_t O_MK = 17608704;
constexpr size_t O_MV = 19705856;
constexpr size_t O_SGS = 21803008;
constexpr size_t O_SCS = 25997312;
constexpr size_t O_SV = 26718208;

struct Params { const float* in[29]; float* out; unsigned char* ws; int ph_lo, ph_hi, bar_region, pad; };

__device__ __forceinline__ unsigned pk2(float lo, float hi) { return pg8::cvt_pk_bf16(lo, hi); }
__device__ __forceinline__ bf16_t f2bf(float f) { return (bf16_t)(pk2(f, 0.f) & 0xffffu); }
__device__ __forceinline__ float bf2f(bf16_t b) { return __uint_as_float(((unsigned)b) << 16); }
__device__ __forceinline__ float bflo(unsigned w) { return __uint_as_float(w << 16); }
__device__ __forceinline__ float bfhi(unsigned w) { return __uint_as_float(w & 0xffff0000u); }
__device__ __forceinline__ float gelu_t(float x) { const float t = __builtin_fmaf(x * x, 0.044715f, 1.0f); const float e = __builtin_amdgcn_exp2f(x * t * -2.3022082f); return x * __builtin_amdgcn_rcpf(1.0f + e); }
__device__ __forceinline__ float silu_f(float x) { return x * __builtin_amdgcn_rcpf(1.0f + __builtin_amdgcn_exp2f(x * -1.44269504f)); }
__device__ __forceinline__ float logsig(float z) { return fminf(z, 0.f) - __logf(1.0f + __expf(-fabsf(z))); }
template <int CTRL> __device__ __forceinline__ float dppr(float x) { return __builtin_bit_cast(float, __builtin_amdgcn_update_dpp(0, __builtin_bit_cast(int, x), CTRL, 0xf, 0xf, true)); }
__device__ __forceinline__ float row_sum16(float s) { s += dppr<0x128>(s); s += dppr<0x124>(s); s += dppr<0x122>(s); s += dppr<0x121>(s); return s; }
__device__ __forceinline__ float wave_sum(float s) { s = row_sum16(s); s += __shfl_xor(s, 16); s += __shfl_xor(s, 32); return s; }
__device__ __forceinline__ float wave_max(float s) { for (int o = 32; o >= 1; o >>= 1) s = fmaxf(s, __shfl_xor(s, o)); return s; }
__device__ __forceinline__ f32x16 mma32(bf16x8 a, bf16x8 b, f32x16 c) { return __builtin_amdgcn_mfma_f32_32x32x16_bf16(a, b, c, 0, 0, 0); }
__device__ __forceinline__ f32x16 zero16() { f32x16 z; for (int i = 0; i < 16; ++i) z[i] = 0.f; return z; }
__device__ __forceinline__ float row_rs(const float* ssq, int row) {
    const f32x4* p = (const f32x4*)(ssq + (size_t)row * 16); f32x4 a = p[0], b = p[1], c = p[2], d = p[3];
    const float s = ((a[0] + a[1]) + (a[2] + a[3])) + ((b[0] + b[1]) + (b[2] + b[3])) + ((c[0] + c[1]) + (c[2] + c[3])) + ((d[0] + d[1]) + (d[2] + d[3]));
    return rsqrtf(s * (1.0f / 1024.0f) + EPS);
}

__device__ __forceinline__ float row_rs64(const float* ssq64, int r) {
    const f32x4* p = (const f32x4*)(ssq64 + (size_t)r * 64); float s = 0.f;
#pragma unroll
    for (int i = 0; i < 16; ++i) { const f32x4 a = p[i]; s += (a[0] + a[1]) + (a[2] + a[3]); }
    return rsqrtf(s * (1.0f / 1024.0f) + EPS);
}
__device__ __forceinline__ float row_rs2(const float* ssq16, const float* ssq64, int row) { return row < MPR ? row_rs(ssq16, row) : row_rs64(ssq64, row - MPR); }
template <int KC, class F>
__device__ __forceinline__ void gemm_small(const bf16_t* A, const bf16_t* Bt, int K, int ncb, LAS unsigned char* lds, F f) {
    constexpr int PITCH = KC * 2 + 16, PPR = KC / 8, NP = 96 * PPR, NPT = (NP + 511) / 512, BUF = 96 * PITCH; static_assert(KC % 32 == 0 && 2 * BUF <= 140000, "KC must be a multiple of the MFMA K; two buffers must fit");
    const int tid = threadIdx.x, lane = tid & 63, wave = tid >> 6, fr = lane & 15, fq = lane >> 4;
    for (int t = blockIdx.x; t < 16 * ncb; t += gridDim.x) { const int rb = t & 15, cb = t >> 4;
        f32x4 acc = (f32x4){0.f, 0.f, 0.f, 0.f};
        u32x4v v[NPT]; const bf16_t* src[NPT]; int dsto[NPT];
#pragma unroll
        for (int i = 0; i < NPT; ++i) { const int idx = tid + 512 * i, row = idx / PPR, pc = idx % PPR;
            src[i] = (row < 32 ? A + (size_t)(rb * 32 + row) * K : Bt + (size_t)(cb * 64 + row - 32) * K) + pc * 8; dsto[i] = row * PITCH + pc * 16;
            if (idx < NP) v[i] = *(const u32x4v*)(src[i]); }
        int buf = 0;
        for (int k0 = 0; k0 < K; k0 += KC) {
            LAS unsigned char* L = lds + buf * BUF;
#pragma unroll
            for (int i = 0; i < NPT; ++i) { const int idx = tid + 512 * i; if (idx < NP) *(LAS u32x4v*)(L + dsto[i]) = v[i]; }
            __syncthreads();
            if (k0 + KC < K) {
#pragma unroll
                for (int i = 0; i < NPT; ++i) { const int idx = tid + 512 * i; if (idx < NP) v[i] = *(const u32x4v*)(src[i] + k0 + KC); } }
            const LAS unsigned char* ap = L + ((wave & 1) * 16 + fr) * PITCH + fq * 16; const LAS unsigned char* bp = L + (32 + (wave >> 1) * 16 + fr) * PITCH + fq * 16;
#pragma unroll
            for (int k = 0; k < KC; k += 32) { const bf16x8 av = *(const LAS bf16x8*)(ap + k * 2); const bf16x8 bv = *(const LAS bf16x8*)(bp + k * 2);
                acc = __builtin_amdgcn_mfma_f32_16x16x32_bf16(bv, av, acc, 0, 0, 0); }
            buf ^= 1;
            __syncthreads();
        }
        __syncthreads();
        f(rb * 32 + (wave & 1) * 16 + fr, cb * 64 + (wave >> 1) * 16 + 4 * fq, cb * 4 + (wave >> 1), fq, acc);
    }
}
#define EPI_LOOP_ROWS for (int ai = 0; ai < 2; ++ai) _Pragma("unroll") for (int m = 0; m < 4; ++m)
__device__ __forceinline__ u32x4v pack8(const f32x4 a, const f32x4 c) { u32x4v w; w.x = pk2(a[0], a[1]); w.y = pk2(a[2], a[3]); w.z = pk2(c[0], c[1]); w.w = pk2(c[2], c[3]); return w; }
__device__ __forceinline__ float sq4(const f32x4 v) { return (v[0] * v[0] + v[1] * v[1]) + (v[2] * v[2] + v[3] * v[3]); }
template <int CTRL> __device__ __forceinline__ float dpp_f(float x) { return __builtin_bit_cast(float, __builtin_amdgcn_update_dpp(0, __builtin_bit_cast(int, x), CTRL, 0xf, 0xf, true)); }
template <int CTRL> __device__ __forceinline__ f32x4 dpp4(const f32x4 v) { return (f32x4){dpp_f<CTRL>(v[0]), dpp_f<CTRL>(v[1]), dpp_f<CTRL>(v[2]), dpp_f<CTRL>(v[3])}; }
__device__ __forceinline__ f32x4 gelu4(const f32x4 v) { return (f32x4){gelu_t(v[0]), gelu_t(v[1]), gelu_t(v[2]), gelu_t(v[3])}; }
__device__ __forceinline__ void rs_rows8(float (&rsv)[2][4], const float* ssq, int row0, int fq) {
    f32x4 q[2][4];
#pragma unroll
    for (int ai = 0; ai < 2; ++ai)
#pragma unroll
        for (int m = 0; m < 4; ++m) q[ai][m] = *(const f32x4*)(ssq + (size_t)(row0 + ai * 128 + m * 16) * 16 + 4 * fq);
#pragma unroll
    for (int ai = 0; ai < 2; ++ai)
#pragma unroll
        for (int m = 0; m < 4; ++m) { float t = (q[ai][m][0] + q[ai][m][1]) + (q[ai][m][2] + q[ai][m][3]); t += __shfl_xor(t, 16); t += __shfl_xor(t, 32); rsv[ai][m] = rsqrtf(t * (1.0f / 1024.0f) + EPS); }
}
__device__ __forceinline__ void rs_rows8_s(float (&rsv)[2][4], const float* ssq64, int r0, int fq) {
#pragma unroll
    for (int ai = 0; ai < 2; ++ai) { f32x4 q[4][4];
#pragma unroll
        for (int m = 0; m < 4; ++m) { const f32x4* pp = (const f32x4*)(ssq64 + (size_t)(r0 + ai * 128 + m * 16) * 64 + 16 * fq); q[m][0] = pp[0]; q[m][1] = pp[1]; q[m][2] = pp[2]; q[m][3] = pp[3]; }
#pragma unroll
        for (int m = 0; m < 4; ++m) { const f32x4 v = (q[m][0] + q[m][1]) + (q[m][2] + q[m][3]); float t = (v[0] + v[1]) + (v[2] + v[3]); t += __shfl_xor(t, 16); t += __shfl_xor(t, 32); rsv[ai][m] = rsqrtf(t * (1.0f / 1024.0f) + EPS); } }
}
struct EpiIn {
    static constexpr bool PERM = true, AFTER_DRAIN = false;
    bf16_t* P; float* af;
    __device__ __forceinline__ void operator()(const f32x4 (&acc)[2][2][4][2], const Unit& u, int wr, int wc, int fr, int fq) const {
        const int row0 = u.pm * 256 + wr * 64 + fr, col0 = u.pn * 256 + wc * 32 + 8 * fq;
#pragma unroll
        EPI_LOOP_ROWS { const int row = row0 + ai * 128 + m * 16;
#pragma unroll
            for (int bj = 0; bj < 2; ++bj) *(u32x4v*)(P + (size_t)row * NIN + col0 + bj * 128) = pack8(acc[ai][bj][m][0], acc[ai][bj][m][1]);
        }
    }
};
struct EpiKV {
    static constexpr bool PERM = true, AFTER_DRAIN = false;
    float* omk; float* omv; bf16_t* mkb; bf16_t* mvt;
    __device__ __forceinline__ void operator()(const f32x4 (&acc)[2][2][4][2], const Unit& u, int wr, int wc, int fr, int fq) const {
        const int row0 = u.pm * 256 + wr * 64 + fr, col0 = u.pn * 256 + wc * 32 + 8 * fq;
#pragma unroll
        EPI_LOOP_ROWS { const int row = row0 + ai * 128 + m * 16;
#pragma unroll
            for (int bj = 0; bj < 2; ++bj) { const f32x4 v0 = acc[ai][bj][m][0], v1 = acc[ai][bj][m][1]; const int col = col0 + bj * 128;
                if (col < 1024) { float* o = omk + (size_t)row * 1024 + col; *(f32x4*)o = v0; *(f32x4*)(o + 4) = v1; *(u32x4v*)(mkb + (size_t)row * 1024 + col) = pack8(v0, v1); }
                else { const int c2 = col - 1024; float* o = omv + (size_t)row * 1024 + c2; *(f32x4*)o = v0; *(f32x4*)(o + 4) = v1;
                    const int b = row >> 8, mt = row & 255, h = c2 >> 8, d = c2 & 255; bf16_t* t = mvt + ((size_t)(b * 4 + h) * 256 + d) * 256 + mt;
                    t[0] = f2bf(v0[0]); t[256] = f2bf(v0[1]); t[512] = f2bf(v0[2]); t[768] = f2bf(v0[3]); t[1024] = f2bf(v1[0]); t[1280] = f2bf(v1[1]); t[1536] = f2bf(v1[2]); t[1792] = f2bf(v1[3]); } }
        }
    }
};
__device__ __forceinline__ void unpack8(const u32x4v w, f32x4& a, f32x4& c) { a = (f32x4){bflo(w.x), bfhi(w.x), bflo(w.y), bfhi(w.y)}; c = (f32x4){bflo(w.z), bfhi(w.z), bflo(w.w), bfhi(w.w)}; }
struct EpiRes {
    static constexpr bool PERM = true, AFTER_DRAIN = false;
    const float* xf; bf16_t* hb; float* ssq;
    __device__ __forceinline__ void operator()(const f32x4 (&acc)[2][2][4][2], const Unit& u, int wr, int wc, int fr, int fq) const {
        const int row0 = u.pm * 256 + wr * 64 + fr, col0 = u.pn * 256 + wc * 32 + 8 * fq;
#pragma unroll
        for (int h2 = 0; h2 < 4; ++h2) { const int ai = h2 >> 1, mb = (h2 & 1) * 2;
            f32x4 bs[2][2][2];
            if (xf) {
#pragma unroll
                for (int mm = 0; mm < 2; ++mm)
#pragma unroll
                    for (int bj = 0; bj < 2; ++bj) { const float* pb = xf + (size_t)(row0 + ai * 128 + (mb + mm) * 16) * 1024 + col0 + bj * 128; bs[mm][bj][0] = *(const f32x4*)pb; bs[mm][bj][1] = *(const f32x4*)(pb + 4); }
            } else { u32x4v raw[2][2];
#pragma unroll
                for (int mm = 0; mm < 2; ++mm)
#pragma unroll
                    for (int bj = 0; bj < 2; ++bj) raw[mm][bj] = *(const u32x4v*)(hb + (size_t)(row0 + ai * 128 + (mb + mm) * 16) * 1024 + col0 + bj * 128);
#pragma unroll
                for (int mm = 0; mm < 2; ++mm)
#pragma unroll
                    for (int bj = 0; bj < 2; ++bj) unpack8(raw[mm][bj], bs[mm][bj][0], bs[mm][bj][1]); }
#pragma unroll
            for (int mm = 0; mm < 2; ++mm) { const int m = mb + mm, row = row0 + ai * 128 + m * 16; float s = 0.f;
#pragma unroll
                for (int bj = 0; bj < 2; ++bj) { const f32x4 v0 = acc[ai][bj][m][0] + bs[mm][bj][0], v1 = acc[ai][bj][m][1] + bs[mm][bj][1];
                    *(u32x4v*)(hb + (size_t)row * 1024 + col0 + bj * 128) = pack8(v0, v1); s += sq4(v0) + sq4(v1); }
                s += __shfl_xor(s, 16); s += __shfl_xor(s, 32);
                if (fq == 0) ssq[(size_t)row * 16 + u.pn * 4 + wc] = s; }
        }
    }
};
#define RLXA __ATOMIC_RELAXED, __HIP_MEMORY_SCOPE_AGENT
__device__ __forceinline__ void ld_coh16x4(f32x4& a, f32x4& b_, f32x4& c, f32x4& d, const float* pa, const float* pb, const float* pc, const float* pd) {
    asm volatile("global_load_dwordx4 %0, %4, off sc1\n\tglobal_load_dwordx4 %1, %5, off sc1\n\tglobal_load_dwordx4 %2, %6, off sc1\n\tglobal_load_dwordx4 %3, %7, off sc1\n\ts_waitcnt vmcnt(0)"
                 : "=&v"(a), "=&v"(b_), "=&v"(c), "=&v"(d) : "v"(pa), "v"(pb), "v"(pc), "v"(pd) : "memory");
}
__device__ __forceinline__ void spin_poll(unsigned* cnt, unsigned want) {
    unsigned sp = 0; while ((unsigned)__builtin_amdgcn_readfirstlane(__hip_atomic_load(cnt, RLXA)) < want) { __builtin_amdgcn_s_sleep(2); if (++sp > (1u << 22)) break; }
}
__device__ __forceinline__ void wg_wait2(unsigned* c1, unsigned w1, unsigned* c2, unsigned w2) {
    if (threadIdx.x < 64) { spin_poll(c1, w1); if (c2) spin_poll(c2, w2); __builtin_amdgcn_fence(__ATOMIC_ACQUIRE, "agent"); asm volatile("s_waitcnt vmcnt(0)" ::: "memory"); }
    __syncthreads();
}
struct EpiFin {
    static constexpr bool PERM = true, AFTER_DRAIN = true;
    const bf16_t* hb; float* ssq; unsigned* cnt; const float* gfin; float* out; int flags;
    const bf16_t* sA; const bf16_t* sBt; float* ssq64;
    __device__ __forceinline__ void fused(f32x4 (&acc)[2][2][4][2], const Unit& u, int wr, int wc, int fr, int fq, LAS unsigned char* lds_, int wid_, int lane_) const {
        const int row0 = u.pm * 256 + wr * 64 + fr, col0 = u.pn * 256 + wc * 32 + 8 * fq;
#pragma unroll
        for (int ai = 0; ai < 2; ++ai) { u32x4v raw[4][2];
#pragma unroll
            for (int m = 0; m < 4; ++m)
#pragma unroll
                for (int bj = 0; bj < 2; ++bj) raw[m][bj] = *(const u32x4v*)(hb + (size_t)(row0 + ai * 128 + m * 16) * 1024 + col0 + bj * 128);
#pragma unroll
            for (int m = 0; m < 4; ++m) { const int row = row0 + ai * 128 + m * 16; float s = 0.f;
#pragma unroll
                for (int bj = 0; bj < 2; ++bj) { f32x4 b0, b1; unpack8(raw[m][bj], b0, b1);
                    acc[ai][bj][m][0] += b0; acc[ai][bj][m][1] += b1; s += sq4(acc[ai][bj][m][0]) + sq4(acc[ai][bj][m][1]); }
                s += __shfl_xor(s, 16); s += __shfl_xor(s, 32);
                if (fq == 0) __hip_atomic_store((unsigned*)(ssq + (size_t)row * 16 + u.pn * 4 + wc), __float_as_uint(s), RLXA); }
        }
        asm volatile("s_waitcnt vmcnt(0)" ::: "memory");
        if ((threadIdx.x & 63) == 0) __hip_atomic_fetch_add(cnt + u.pm, 1u, RLXA);
        f32x4 sv = (f32x4){0.f, 0.f, 0.f, 0.f}; int sr = -1, sc = 0; unsigned* scw = cnt;
        { const bf16_t* hbs = hb + (size_t)MPR * 1024; float* sq = ssq64; unsigned* cnt2 = cnt + 64;
          gemm_small<256>(sA, sBt, 2816, 16, lds_, [&](int r, int c, int cb, int fq2, f32x4 a) {
              const size_t off = (size_t)r * 1024 + c; const u32x2 hw = *(const u32x2*)(hbs + off); const f32x4 v = a + (f32x4){bflo(hw.x), bfhi(hw.x), bflo(hw.y), bfhi(hw.y)};
              float s = sq4(v); s += __shfl_xor(s, 16); s += __shfl_xor(s, 32); if (fq2 == 0) __hip_atomic_store((unsigned*)(sq + (size_t)r * 64 + cb), __float_as_uint(s), RLXA);
              asm volatile("s_waitcnt vmcnt(0)" ::: "memory");
              scw = cnt2 + (r >> 5); if ((threadIdx.x & 63) == 0) __hip_atomic_fetch_add(scw, 1u, RLXA);
              sv = v; sr = r; sc = c; }); }
        wg_wait2(cnt + u.pm, 32u, sr >= 0 ? scw : nullptr, 128u);
        f32x4 g[2][2];
#pragma unroll
        for (int bj = 0; bj < 2; ++bj) { g[bj][0] = *(const f32x4*)(gfin + col0 + bj * 128); g[bj][1] = *(const f32x4*)(gfin + col0 + bj * 128 + 4); }
        f32x4 pq[2][4];
#pragma unroll
        for (int ai = 0; ai < 2; ++ai) { const float* b0 = ssq + (size_t)(row0 + ai * 128) * 16 + 4 * fq; ld_coh16x4(pq[ai][0], pq[ai][1], pq[ai][2], pq[ai][3], b0, b0 + 16 * 16, b0 + 32 * 16, b0 + 48 * 16); }
#pragma unroll
        EPI_LOOP_ROWS { const int row = row0 + ai * 128 + m * 16; const f32x4 q4 = pq[ai][m];
            float s = (q4[0] + q4[1]) + (q4[2] + q4[3]);
            s += __shfl_xor(s, 16); s += __shfl_xor(s, 32); const float rs = rsqrtf(s * (1.0f / 1024.0f) + EPS);
#pragma unroll
            for (int bj = 0; bj < 2; ++bj) { float* o = out + (size_t)row * 1024 + col0 + bj * 128; *(f32x4*)o = acc[ai][bj][m][0] * rs * g[bj][0]; *(f32x4*)(o + 4) = acc[ai][bj][m][1] * rs * g[bj][1]; }
        }
        if (sr >= 0) {

            const float* sp = ssq64 + (size_t)sr * 64 + 16 * fq; f32x4 q0, q1, q2, q3; ld_coh16x4(q0, q1, q2, q3, sp, sp + 4, sp + 8, sp + 12);
            const f32x4 qs = (q0 + q1) + (q2 + q3); float t = (qs[0] + qs[1]) + (qs[2] + qs[3]);
            t += __shfl_xor(t, 16); t += __shfl_xor(t, 32); const float rs = rsqrtf(t * (1.0f / 1024.0f) + EPS);
            *(f32x4*)(out + (size_t)(MPR + sr) * 1024 + sc) = sv * rs * *(const f32x4*)(gfin + sc);
        }
    }
};
struct EpiQ {
    static constexpr bool PERM = true, AFTER_DRAIN = false;
    bf16_t* Q; const float* ssq;
    __device__ __forceinline__ void operator()(const f32x4 (&acc)[2][2][4][2], const Unit& u, int wr, int wc, int fr, int fq) const {
        const int row0 = u.pm * 256 + wr * 64 + fr, col0 = u.pn * 256 + wc * 32 + 8 * fq;
        float rsv[2][4]; rs_rows8(rsv, ssq, row0, fq);
#pragma unroll
        EPI_LOOP_ROWS { const int row = row0 + ai * 128 + m * 16; const float rs = rsv[ai][m];
#pragma unroll
            for (int bj = 0; bj < 2; ++bj) *(u32x4v*)(Q + (size_t)row * 1024 + col0 + bj * 128) = pack8(acc[ai][bj][m][0] * rs, acc[ai][bj][m][1] * rs);
        }
    }
};
struct EpiGU {
    static constexpr bool PERM = true, AFTER_DRAIN = false;
    bf16_t* U; const float* ssq; const float* ssq64; float* scp; float* scs; const float* cw; const float* cbias; const float* sconv; float* GX; float* UX; int flags;
    __device__ __forceinline__ void operator()(const f32x4 (&acc)[2][2][4][2], const Unit& u, int wr, int wc, int fr, int fq) const {
        const int row0 = u.pm * 256 + wr * 64 + fr, ch0 = u.pn * 128 + wc * 32 + 8 * fq;
        if (flags & 48) {
            if (flags & 16) {
#pragma unroll
                EPI_LOOP_ROWS { const int row = row0 + ai * 128 + m * 16; *(u32x4v*)(U + (size_t)row * DFF + ch0) = pack8(acc[ai][0][m][0] * acc[ai][1][m][0], acc[ai][0][m][1] * acc[ai][1][m][1]); } }
            return; }
        float rsv[2][4]; if (u.pm < 64) rs_rows8(rsv, ssq, row0, fq); else rs_rows8_s(rsv, ssq64, row0 - MPR, fq);
        f32x4 w0[2], w1[2], w2[2], bb[2];
#pragma unroll
        for (int n = 0; n < 2; ++n) { w0[n] = *(const f32x4*)(cw + ch0 + 4 * n); w1[n] = *(const f32x4*)(cw + DFF + ch0 + 4 * n); w2[n] = *(const f32x4*)(cw + 2 * DFF + ch0 + 4 * n); bb[n] = *(const f32x4*)(cbias + ch0 + 4 * n); }
        if (u.pm < 64) {
#pragma unroll
            for (int ai = 0; ai < 2; ++ai) { f32x4 pr1[2], pr2[2];
#pragma unroll
                for (int n = 0; n < 2; ++n) { pr1[n] = (f32x4){0.f, 0.f, 0.f, 0.f}; pr2[n] = pr1[n]; }
#pragma unroll
                for (int m = 0; m < 4; ++m) { const int row = row0 + ai * 128 + m * 16; const float rs = rsv[ai][m]; const int t = row & 2047, t6 = row & 63;
                    f32x4 a[2];
#pragma unroll
                    for (int n = 0; n < 2; ++n) { const f32x4 g = acc[ai][0][m][n] * rs, up = acc[ai][1][m][n] * rs; const f32x4 r1 = dpp4<0x121>(g), r2 = dpp4<0x122>(g);
                        const f32x4 p1 = fr >= 1 ? r1 : pr1[n], p2 = fr >= 2 ? r2 : pr2[n]; pr1[n] = r1; pr2[n] = r2;
                        a[n] = gelu4(bb[n] + w0[n] * p2 + w1[n] * p1 + w2[n] * g) * up;
                        if (t >= 2046) *(f32x4*)(scp + (size_t)((row >> 11) * 2 + (t - 2046)) * DFF + ch0 + 4 * n) = g;
                        if (t6 < 2) { *(f32x4*)(GX + ((size_t)(row >> 6) * 4 + t6) * DFF + ch0 + 4 * n) = g; *(f32x4*)(UX + ((size_t)(row >> 6) * 2 + t6) * DFF + ch0 + 4 * n) = up; }
                        if (t6 >= 62) *(f32x4*)(GX + ((size_t)(row >> 6) * 4 + (t6 - 60)) * DFF + ch0 + 4 * n) = g; }
                    *(u32x4v*)(U + (size_t)row * DFF + ch0) = pack8(a[0], a[1]); } }
        } else {
            const int tt = fr & 3;
#pragma unroll
            EPI_LOOP_ROWS { const int row = row0 + ai * 128 + m * 16, r2i = row - MPR, bq = r2i >> 2; const float rs = rsv[ai][m];
                f32x4 a[2];
#pragma unroll
                for (int n = 0; n < 2; ++n) { const f32x4 g = acc[ai][0][m][n] * rs, up = acc[ai][1][m][n] * rs; const f32x4 r1 = dpp4<0x121>(g), r2 = dpp4<0x122>(g);
                    f32x4 p1 = r1, p2 = r2;
                    if (tt < 2) { const f32x4 s1 = *(const f32x4*)(sconv + (size_t)(bq * 2 + 1) * DFF + ch0 + 4 * n); if (tt == 0) { p1 = s1; p2 = *(const f32x4*)(sconv + (size_t)(bq * 2) * DFF + ch0 + 4 * n); } else p2 = s1; }
                    a[n] = gelu4(bb[n] + w0[n] * p2 + w1[n] * p1 + w2[n] * g) * up;
                    if (tt >= 2) *(f32x4*)(scs + (size_t)(bq * 2 + (tt - 2)) * DFF + ch0 + 4 * n) = g; }
                *(u32x4v*)(U + (size_t)row * DFF + ch0) = pack8(a[0], a[1]); }
        }
    }
};
__device__ __forceinline__ void act_fixup(const Params& p, int pm) {
    const float* GX = (const float*)(p.ws + WS_GX); const float* UX = (const float*)(p.ws + WS_UX); bf16_t* U = (bf16_t*)(p.ws + WS_U); const float* cw = p.in[25]; const float* cbias = p.in[26];
    for (int i0 = threadIdx.x; i0 < 4 * 704; i0 += 1024) {
        f32x4 w0[2], w1[2], w2[2], bb[2], g0[2], g1[2], u0[2], u1[2], gm2[2], gm1[2]; int t0v[2], chv[2]; bool ok[2];
#pragma unroll
        for (int k = 0; k < 2; ++k) { const int i = i0 + 512 * k; ok[k] = i < 4 * 704; const int ii = ok[k] ? i : i0; const int q = ii / 704, ch = (ii % 704) * 4, blk = pm * 4 + q, t0 = blk * 64; t0v[k] = t0; chv[k] = ch;
            w0[k] = *(const f32x4*)(cw + ch); w1[k] = *(const f32x4*)(cw + DFF + ch); w2[k] = *(const f32x4*)(cw + 2 * DFF + ch); bb[k] = *(const f32x4*)(cbias + ch);
            g0[k] = *(const f32x4*)(GX + ((size_t)blk * 4 + 0) * DFF + ch); g1[k] = *(const f32x4*)(GX + ((size_t)blk * 4 + 1) * DFF + ch);
            u0[k] = *(const f32x4*)(UX + ((size_t)blk * 2 + 0) * DFF + ch); u1[k] = *(const f32x4*)(UX + ((size_t)blk * 2 + 1) * DFF + ch);
            gm2[k] = (f32x4){0.f, 0.f, 0.f, 0.f}; gm1[k] = gm2[k];
            if ((t0 & 2047) != 0) { gm2[k] = *(const f32x4*)(GX + ((size_t)(blk - 1) * 4 + 2) * DFF + ch); gm1[k] = *(const f32x4*)(GX + ((size_t)(blk - 1) * 4 + 3) * DFF + ch); } }
#pragma unroll
        for (int k = 0; k < 2; ++k) if (ok[k]) {
            const f32x4 a0 = gelu4(bb[k] + w0[k] * gm2[k] + w1[k] * gm1[k] + w2[k] * g0[k]) * u0[k], a1 = gelu4(bb[k] + w0[k] * gm1[k] + w1[k] * g0[k] + w2[k] * g1[k]) * u1[k];
            u32x2 o0, o1; o0.x = pk2(a0[0], a0[1]); o0.y = pk2(a0[2], a0[3]); o1.x = pk2(a1[0], a1[1]); o1.y = pk2(a1[2], a1[3]);
            *(u32x2*)(U + (size_t)t0v[k] * DFF + chv[k]) = o0; *(u32x2*)(U + (size_t)(t0v[k] + 1) * DFF + chv[k]) = o1; }
    }
}

__device__ __forceinline__ int win_src_col(int n) { return n < 1536 ? n : (n < 2560 ? n + 16 : (n < 2576 ? n - 1024 : -1)); }
__device__ __forceinline__ void tr_strip(LAS float* T, const float* src, int ldn, bf16_t* dst, int K, int k0, int n0, const float* ksc, bool cmap, int rmode) {
    const int tid = threadIdx.x;
    f32x4 v[8];
    { const int n4 = (tid & 63) * 4; int sc = n0 + n4; if (cmap) sc = win_src_col(sc);
#pragma unroll
      for (int i = 0; i < 8; ++i) { const int kk = (tid >> 6) + 8 * i; v[i] = (f32x4){0.f, 0.f, 0.f, 0.f}; if (sc >= 0) v[i] = *(const f32x4*)(src + (size_t)(k0 + kk) * ldn + sc); }
#pragma unroll
      for (int i = 0; i < 8; ++i) { const int kk = (tid >> 6) + 8 * i; f32x4 w = v[i]; if (ksc) w = w * ksc[k0 + kk];
          T[kk * 257 + n4] = w[0]; T[kk * 257 + n4 + 1] = w[1]; T[kk * 257 + n4 + 2] = w[2]; T[kk * 257 + n4 + 3] = w[3]; } }
    __syncthreads();
    { const int n = tid >> 1, kh = (tid & 1) * 32;
#pragma unroll
      for (int q = 0; q < 4; ++q) { const int kb = kh + q * 8; u32x4v w;
          w.x = pk2(T[(kb + 0) * 257 + n], T[(kb + 1) * 257 + n]); w.y = pk2(T[(kb + 2) * 257 + n], T[(kb + 3) * 257 + n]);
          w.z = pk2(T[(kb + 4) * 257 + n], T[(kb + 5) * 257 + n]); w.w = pk2(T[(kb + 6) * 257 + n], T[(kb + 7) * 257 + n]);
          const int nn = n0 + n, drow = rmode ? ((nn >> 7) * 256 + (rmode == 2 ? 128 : 0) + (nn & 127)) : nn;
          *(u32x4v*)(dst + (size_t)drow * K + k0 + kb) = w; } }
    __syncthreads();
}
struct NormRow { f32x4 v[4]; };
__device__ __forceinline__ void norm_load(NormRow& R, const float* x, int lane) {
#pragma unroll
    for (int i = 0; i < 4; ++i) R.v[i] = __builtin_nontemporal_load((const f32x4*)(x + i * 256 + lane * 4));
}
constexpr int PREP_TA = 66048;
__device__ __forceinline__ void norm_a(const NormRow& R, float rs, const LAS float* Ta, float* af_row, int lane) {
    float acc[16];
#pragma unroll
    for (int c = 0; c < 16; ++c) { float s = 0.f;
#pragma unroll
        for (int i = 0; i < 4; ++i) { const f32x4 w = *(const LAS f32x4*)(Ta + c * 1024 + i * 256 + lane * 4); s += (R.v[i][0] * w[0] + R.v[i][1] * w[1]) + (R.v[i][2] * w[2] + R.v[i][3] * w[3]); }
        acc[c] = s; }
    const bool b5 = lane & 32, b4 = lane & 16, b3 = lane & 8, b2 = lane & 4;
    float a8[8], a4[4], a2[2], a1;
#pragma unroll
    for (int j = 0; j < 8; ++j) { const float send = b5 ? acc[j] : acc[j + 8]; const float keep = b5 ? acc[j + 8] : acc[j]; a8[j] = keep + __shfl_xor(send, 32); }
#pragma unroll
    for (int j = 0; j < 4; ++j) { const float send = b4 ? a8[j] : a8[j + 4]; const float keep = b4 ? a8[j + 4] : a8[j]; a4[j] = keep + __shfl_xor(send, 16); }
#pragma unroll
    for (int j = 0; j < 2; ++j) { const float send = b3 ? a4[j] : a4[j + 2]; const float keep = b3 ? a4[j + 2] : a4[j]; a2[j] = keep + __shfl_xor(send, 8); }
    { const float send = b2 ? a2[0] : a2[1]; const float keep = b2 ? a2[1] : a2[0]; a1 = keep + __shfl_xor(send, 4); }
    a1 += __shfl_xor(a1, 2); a1 += __shfl_xor(a1, 1);
    if ((lane & 3) == 0) af_row[(lane >> 2) & 15] = a1 * rs;
}
__device__ __forceinline__ void norm_fin(const NormRow& R, const float* g, bf16_t* o, int lane, const LAS float* Ta = nullptr, float* af_row = nullptr) {
    float s = 0.f;
#pragma unroll
    for (int i = 0; i < 4; ++i) s += (R.v[i][0] * R.v[i][0] + R.v[i][1] * R.v[i][1]) + (R.v[i][2] * R.v[i][2] + R.v[i][3] * R.v[i][3]);
    s = wave_sum(s); const float rs = rsqrtf(s * (1.0f / 1024.0f) + EPS);
#pragma unroll
    for (int i = 0; i < 4; ++i) { const f32x4 gg = *(const f32x4*)(g + i * 256 + lane * 4); const f32x4 y = R.v[i] * rs * gg; u32x2 w; w.x = pk2(y[0], y[1]); w.y = pk2(y[2], y[3]);
        *(u32x2*)(o + i * 256 + lane * 4) = w; }
    if (af_row) norm_a(R, rs, Ta, af_row, lane);
}
__device__ __forceinline__ void norm_addr(const Params& p, int r, const float*& x, const float*& g, bf16_t*& o) {
    if (r < MPR) { x = p.in[0] + (size_t)r * 1024; g = p.in[7]; o = (bf16_t*)(p.ws + WS_A) + (size_t)r * 1024; }
    else if (r < MT) { x = p.in[1] + (size_t)(r - MPR) * 1024; g = p.in[7]; o = (bf16_t*)(p.ws + WS_A) + (size_t)r * 1024; }
    else { x = p.in[2] + (size_t)(r - MT) * 1024; g = p.in[17]; o = (bf16_t*)(p.ws + WS_MN) + (size_t)(r - MT) * 1024; }
}
__device__ __forceinline__ void phase_prep(const Params& p, LAS unsigned char* lds) {
    unsigned char* ws = p.ws; LAS float* T = (LAS float*)lds;
    const int tid = threadIdx.x, lane = tid & 63, wave = tid >> 6;
    LAS float* Ta = (LAS float*)(lds + PREP_TA);
#pragma unroll
    for (int i = 0; i < 8; ++i) { const int idx = tid + 512 * i, k = idx >> 2, c4 = (idx & 3) * 4; const f32x4 w = *(const f32x4*)(p.in[8] + (size_t)k * 2576 + 1536 + c4) * p.in[7][k];
        Ta[(c4 + 0) * 1024 + k] = w[0]; Ta[(c4 + 1) * 1024 + k] = w[1]; Ta[(c4 + 2) * 1024 + k] = w[2]; Ta[(c4 + 3) * 1024 + k] = w[3]; }
    __syncthreads();
    for (int j = blockIdx.x; j < 1008; j += gridDim.x) {
        const float* src; int ldn, K, nt; bf16_t* dst; const float* ksc = nullptr; bool cmap = false; int jj = j, rmode = 0;
        if (jj < 160) { src = p.in[8]; ldn = 2576; K = 1024; nt = 10; dst = (bf16_t*)(ws + WS_WIN); cmap = true; }
        else if ((jj -= 160) < 64) { src = p.in[15]; ldn = 1024; K = 1024; nt = 4; dst = (bf16_t*)(ws + WS_WOUT); }
        else if ((jj -= 64) < 64) { src = p.in[18]; ldn = 1024; K = 1024; nt = 4; dst = (bf16_t*)(ws + WS_WQ); ksc = p.in[16]; }
        else if ((jj -= 64) < 64) { src = p.in[19]; ldn = 1024; K = 1024; nt = 4; dst = (bf16_t*)(ws + WS_WKV); }
        else if ((jj -= 64) < 64) { src = p.in[20]; ldn = 1024; K = 1024; nt = 4; dst = (bf16_t*)(ws + WS_WKV) + (size_t)1024 * 1024; }
        else if ((jj -= 64) < 64) { src = p.in[21]; ldn = 1024; K = 1024; nt = 4; dst = (bf16_t*)(ws + WS_WO); }
        else if ((jj -= 64) < 176) { src = p.in[23]; ldn = 2816; K = 1024; nt = 11; dst = (bf16_t*)(ws + WS_WGU); ksc = p.in[22]; rmode = 1; }
        else if ((jj -= 176) < 176) { src = p.in[24]; ldn = 2816; K = 1024; nt = 11; dst = (bf16_t*)(ws + WS_WGU); ksc = p.in[22]; rmode = 2; }
        else { jj -= 176; src = p.in[27]; ldn = 1024; K = 2816; nt = 4; dst = (bf16_t*)(ws + WS_WD); }
        const int kt = jj / nt, ntile = jj % nt;
        tr_strip(T, src, ldn, dst, K, kt * 64, ntile * 256, ksc, cmap, rmode);
    }
    const int stride = gridDim.x * 8;
    for (int r = blockIdx.x * 8 + wave; r < MT + 2048; r += 2 * stride) {
        const int r2 = r + stride; const bool has2 = r2 < MT + 2048;
        const float *x1, *g1, *x2 = nullptr, *g2 = nullptr; bf16_t *o1, *o2 = nullptr; NormRow A, B;
        norm_addr(p, r, x1, g1, o1); norm_load(A, x1, lane);
        if (has2) { norm_addr(p, r2, x2, g2, o2); norm_load(B, x2, lane); }
        float* af = (float*)(ws + WS_AF);
        norm_fin(A, g1, o1, lane, Ta, r < MT ? af + (size_t)r * 16 : nullptr);
        if (has2) norm_fin(B, g2, o2, lane, Ta, r2 < MT ? af + (size_t)r2 * 16 : nullptr);
    }
}

constexpr int G_Q = 0, G_K = 9216, G_B = 18432, G_A = 35072, G_WA = 39168, G_BA = 43264, G_VT = 43520, G_X = 61952  , G_ST = 71168, G_RED = 89600, G_SEG = 90624, G_R = 92672, G_END = 110080;
struct GlaPre { u32x4v q, k, v0, v1, s0, s1, r0, r1; f32x4 aw, b0, b1; float ba; };
template <bool OUT>
__device__ __forceinline__ void gla_issue(GlaPre& R, const Params& p, int item) {
    const int b = item >> 7, h = (item >> 5) & 3, c = item & 31; const int tid = threadIdx.x; const int row0 = b * 2048 + c * 64;
    const bf16_t* P = (const bf16_t*)(p.ws + WS_P); const float* af = (const float*)(p.ws + WS_AF);
    { const int i = tid >> 3, d8 = (tid & 7) * 8; const bf16_t* src = P + (size_t)(row0 + i) * NIN + h * 64 + d8; R.q = *(const u32x4v*)src; R.k = *(const u32x4v*)(src + 256); }
    if (!OUT) {
        if (tid < 256) { const int i = tid >> 2, r4 = (tid & 3) * 4; R.aw = *(const f32x4*)(af + (size_t)(row0 + i) * 16 + r4); }
        else { const int t2 = tid - 256, r = t2 >> 4, d4 = (t2 & 15) * 4; R.aw = *(const f32x4*)(p.in[9] + r * 256 + h * 64 + d4); }
        R.ba = p.in[10][h * 64 + (tid & 63)];
    } else { const float* bq = (const float*)(p.ws + WS_BQ) + (size_t)item * 4096 + (tid >> 3) * 64 + (tid & 7) * 8; R.b0 = *(const f32x4*)bq; R.b1 = *(const f32x4*)(bq + 4); }
    { const int j = tid & 63, v8 = (tid >> 6) * 8; R.v0 = *(const u32x4v*)(P + (size_t)(row0 + j) * NIN + 512 + h * 128 + v8); R.v1 = *(const u32x4v*)(P + (size_t)(row0 + j) * NIN + 512 + h * 128 + 64 + v8); }
    if (OUT) { const bf16_t* St = (const bf16_t*)(p.ws + WS_ST) + (size_t)item * 8192; const int dl = tid & 63, sv8 = (tid >> 6) * 8;
        R.s0 = *(const u32x4v*)(St + dl * 128 + sv8); R.s1 = *(const u32x4v*)(St + dl * 128 + 64 + sv8);
        const int j = tid >> 4, v8 = (tid & 15) * 8; R.r0 = *(const u32x4v*)(P + (size_t)(row0 + j) * NIN + 1024 + h * 128 + v8); R.r1 = *(const u32x4v*)(P + (size_t)(row0 + j + 32) * NIN + 1024 + h * 128 + v8); }
}
__device__ __forceinline__ void vt_scatter(LAS bf16_t* LVt, const u32x4v w, int v8, int j) {
    LVt[(v8 + 0) * 72 + j] = (bf16_t)(w.x & 0xffff); LVt[(v8 + 1) * 72 + j] = (bf16_t)(w.x >> 16); LVt[(v8 + 2) * 72 + j] = (bf16_t)(w.y & 0xffff); LVt[(v8 + 3) * 72 + j] = (bf16_t)(w.y >> 16);
    LVt[(v8 + 4) * 72 + j] = (bf16_t)(w.z & 0xffff); LVt[(v8 + 5) * 72 + j] = (bf16_t)(w.z >> 16); LVt[(v8 + 6) * 72 + j] = (bf16_t)(w.w & 0xffff); LVt[(v8 + 7) * 72 + j] = (bf16_t)(w.w >> 16);
}
template <bool OUT>
__device__ __forceinline__ void gla_fill(const GlaPre& R, LAS unsigned char* lds) {
    const int tid = threadIdx.x;
    LAS bf16_t* Lq = (LAS bf16_t*)(lds + G_Q); LAS bf16_t* Lk = (LAS bf16_t*)(lds + G_K); LAS float* Lb = (LAS float*)(lds + G_B);
    LAS float* La = (LAS float*)(lds + G_A); LAS float* Lwa = (LAS float*)(lds + G_WA); LAS float* Lba = (LAS float*)(lds + G_BA);
    LAS bf16_t* LVt = (LAS bf16_t*)(lds + G_VT); LAS float* Lseg = (LAS float*)(lds + G_SEG);
    { const int i = tid >> 3, d8 = (tid & 7) * 8; *(LAS u32x4v*)(Lq + i * 72 + d8) = R.q; *(LAS u32x4v*)(Lk + i * 72 + d8) = R.k; }
    if (!OUT) {
        if (tid < 256) { const int i = tid >> 2, r4 = (tid & 3) * 4; *(LAS f32x4*)(La + i * 16 + r4) = R.aw; }
        else { const int t2 = tid - 256, r = t2 >> 4, d4 = (t2 & 15) * 4; *(LAS f32x4*)(Lwa + r * 64 + d4) = R.aw; }
        if (tid < 64) Lba[tid] = R.ba;
    } else { const int i = tid >> 3, d8 = (tid & 7) * 8;
#pragma unroll
        for (int e = 0; e < 4; ++e) { Lb[i * 65 + d8 + e] = R.b0[e]; Lb[i * 65 + d8 + 4 + e] = R.b1[e]; } }
    { const int j = tid & 63, v8 = (tid >> 6) * 8; vt_scatter(LVt, R.v0, v8, j); vt_scatter(LVt, R.v1, v8 + 64, j); }
    if (OUT) { LAS bf16_t* LSt = (LAS bf16_t*)(lds + G_ST); LAS bf16_t* Lr = (LAS bf16_t*)(lds + G_R);
        { const int dl = tid & 63, sv8 = (tid >> 6) * 8; vt_scatter(LSt, R.s0, sv8, dl); vt_scatter(LSt, R.s1, sv8 + 64, dl); }
        const int j = tid >> 4, v8 = (tid & 15) * 8; *(LAS u32x4v*)(Lr + j * 136 + v8) = R.r0; *(LAS u32x4v*)(Lr + (j + 32) * 136 + v8) = R.r1; }
    __syncthreads();
}
__device__ __forceinline__ void gla_gates(LAS unsigned char* lds) {
    const int tid = threadIdx.x;
    LAS float* Lb = (LAS float*)(lds + G_B); LAS float* La = (LAS float*)(lds + G_A); LAS float* Lwa = (LAS float*)(lds + G_WA); LAS float* Lba = (LAS float*)(lds + G_BA); LAS float* Lseg = (LAS float*)(lds + G_SEG);
    const int d = tid & 63, seg = tid >> 6; float acc = 0.f; float pre[8];
#pragma unroll
    for (int ii = 0; ii < 8; ++ii) { const int i = seg * 8 + ii; float z = Lba[d];
#pragma unroll
        for (int r = 0; r < 16; ++r) z += La[i * 16 + r] * Lwa[r * 64 + d];
        acc += logsig(z) * (1.0f / 16.0f); pre[ii] = acc; }
    Lseg[seg * 64 + d] = acc;
    __syncthreads();
    float off = 0.f;
#pragma unroll
    for (int s = 0; s < 8; ++s) if (s < seg) off += Lseg[s * 64 + d];
#pragma unroll
    for (int ii = 0; ii < 8; ++ii) Lb[(seg * 8 + ii) * 65 + d] = pre[ii] + off;
    __syncthreads();
}
__device__ __forceinline__ void gla_local_loop(const Params& p, LAS unsigned char* lds, int first, int stride, int nitems) {
    const int tid = threadIdx.x, lane = tid & 63, wave = tid >> 6;
    GlaPre R; if (first < nitems) gla_issue<false>(R, p, first);
    for (int item = first; item < nitems; item += stride) {
        gla_fill<false>(R, lds);
        if (item + stride < nitems) gla_issue<false>(R, p, item + stride);
        gla_gates(lds);
        LAS bf16_t* Lk = (LAS bf16_t*)(lds + G_K); LAS float* Lb = (LAS float*)(lds + G_B); LAS bf16_t* LVt = (LAS bf16_t*)(lds + G_VT); LAS bf16_t* LKt = (LAS bf16_t*)(lds + G_X);
        { float* bq = (float*)(p.ws + WS_BQ) + (size_t)item * 4096 + (tid >> 3) * 64 + (tid & 7) * 8; const int i = tid >> 3, d8 = (tid & 7) * 8; f32x4 x0, x1;
#pragma unroll
          for (int e = 0; e < 4; ++e) { x0[e] = Lb[i * 65 + d8 + e]; x1[e] = Lb[i * 65 + d8 + 4 + e]; }
          *(f32x4*)bq = x0; *(f32x4*)(bq + 4) = x1; }
        float* dS = (float*)(p.ws + WS_DS) + (size_t)item * 8192; float* dec = (float*)(p.ws + WS_DEC) + (size_t)item * 64;
        { const int j = tid >> 3, d8 = (tid & 7) * 8;
#pragma unroll
          for (int e = 0; e < 8; ++e) { const float kv = bf2f(Lk[j * 72 + d8 + e]); LKt[(d8 + e) * 72 + j] = f2bf(kv * __expf(Lb[63 * 65 + d8 + e] - Lb[j * 65 + d8 + e])); } }
        if (tid < 64) dec[tid] = __expf(Lb[63 * 65 + tid]);
        __syncthreads();
        const int db = wave & 1, vb = wave >> 1, r = lane & 31, hh = lane >> 5;
        f32x16 acc = zero16();
#pragma unroll
        for (int ks = 0; ks < 4; ++ks) { const bf16x8 a = *(const LAS bf16x8*)(LKt + (db * 32 + r) * 72 + ks * 16 + 8 * hh); const bf16x8 bb = *(const LAS bf16x8*)(LVt + (vb * 32 + r) * 72 + ks * 16 + 8 * hh); acc = mma32(a, bb, acc); }
#pragma unroll
        for (int i = 0; i < 16; ++i) { const int d = db * 32 + (i & 3) + 8 * (i >> 2) + 4 * hh; dS[d * 128 + vb * 32 + r] = acc[i]; }
        __syncthreads();
    }
}
__device__ __forceinline__ void gla_out_loop(const Params& p, LAS unsigned char* lds, int first, int stride, int nitems) {
    const int tid = threadIdx.x, lane = tid & 63, wave = tid >> 6;
    GlaPre R; if (first < nitems) gla_issue<true>(R, p, first);
    for (int item = first; item < nitems; item += stride) {
        const int b = item >> 7, h = (item >> 5) & 3, c = item & 31; const int row0 = b * 2048 + c * 64;
        gla_fill<true>(R, lds);
        if (item + stride < nitems) gla_issue<true>(R, p, item + stride);
        LAS bf16_t* Lq = (LAS bf16_t*)(lds + G_Q); LAS bf16_t* Lk = (LAS bf16_t*)(lds + G_K); LAS float* Lb = (LAS float*)(lds + G_B); LAS bf16_t* LVt = (LAS bf16_t*)(lds + G_VT);
        LAS bf16_t* Lsc = (LAS bf16_t*)(lds + G_X); LAS bf16_t* LSt = (LAS bf16_t*)(lds + G_ST); LAS float* Lred = (LAS float*)(lds + G_RED); LAS bf16_t* Lr = (LAS bf16_t*)(lds + G_R);
        bf16_t* mix = (bf16_t*)(p.ws + WS_A);
        { const int i = tid >> 3, d8 = (tid & 7) * 8;
#pragma unroll
          for (int e = 0; e < 8; e += 2) { const float b0 = Lb[i * 65 + d8 + e], b1 = Lb[i * 65 + d8 + e + 1];
              const float q0 = bf2f(Lq[i * 72 + d8 + e]) * __expf(b0) * 0.125f, q1 = bf2f(Lq[i * 72 + d8 + e + 1]) * __expf(b1) * 0.125f;
              const float k0 = bf2f(Lk[i * 72 + d8 + e]) * __expf(-b0), k1 = bf2f(Lk[i * 72 + d8 + e + 1]) * __expf(-b1);
              *(LAS unsigned*)(Lq + i * 72 + d8 + e) = pk2(q0, q1); *(LAS unsigned*)(Lk + i * 72 + d8 + e) = pk2(k0, k1); } }
        __syncthreads();
        const int r = lane & 31, hh = lane >> 5;
        if (wave < 4) { const int ib = wave & 1, jb = wave >> 1;
            f32x16 acc = zero16();
            if (jb <= ib) {
#pragma unroll
                for (int ks = 0; ks < 4; ++ks) { const bf16x8 a = *(const LAS bf16x8*)(Lq + (ib * 32 + r) * 72 + ks * 16 + 8 * hh); const bf16x8 bb = *(const LAS bf16x8*)(Lk + (jb * 32 + r) * 72 + ks * 16 + 8 * hh); acc = mma32(a, bb, acc); } }
#pragma unroll
            for (int i = 0; i < 16; ++i) { const int ii = ib * 32 + (i & 3) + 8 * (i >> 2) + 4 * hh, jj = jb * 32 + r; Lsc[ii * 72 + jj] = f2bf(jj <= ii ? acc[i] : 0.f); } }
        __syncthreads();
        const int ib = wave & 1, vb = wave >> 1;
        f32x16 acc = zero16();
#pragma unroll
        for (int ks = 0; ks < 4; ++ks) { const bf16x8 a = *(const LAS bf16x8*)(Lsc + (ib * 32 + r) * 72 + ks * 16 + 8 * hh); const bf16x8 bb = *(const LAS bf16x8*)(LVt + (vb * 32 + r) * 72 + ks * 16 + 8 * hh); acc = mma32(a, bb, acc); }
#pragma unroll
        for (int ks = 0; ks < 4; ++ks) { const bf16x8 a = *(const LAS bf16x8*)(Lq + (ib * 32 + r) * 72 + ks * 16 + 8 * hh); const bf16x8 bb = *(const LAS bf16x8*)(LSt + (vb * 32 + r) * 72 + ks * 16 + 8 * hh); acc = mma32(a, bb, acc); }
#pragma unroll
        for (int i = 0; i < 16; ++i) { float s = row_sum16(acc[i] * acc[i]); s += __shfl_xor(s, 16);
            if (r == 0) Lred[(ib * 32 + (i & 3) + 8 * (i >> 2) + 4 * hh) * 4 + vb] = s; }
        __syncthreads();
        const float gg = p.in[11][h * 128 + vb * 32 + r];
#pragma unroll
        for (int i = 0; i < 16; ++i) { const int ii = ib * 32 + (i & 3) + 8 * (i >> 2) + 4 * hh; const f32x4 q = *(const LAS f32x4*)(Lred + ii * 4);
            const float rs = rsqrtf(((q[0] + q[1]) + (q[2] + q[3])) * (1.0f / 128.0f) + EPS);
            const float rg = bf2f(Lr[ii * 136 + vb * 32 + r]);
            mix[(size_t)(row0 + ii) * 1024 + h * 128 + vb * 32 + r] = f2bf(acc[i] * rs * gg * silu_f(rg)); }
        __syncthreads();
    }
}
__device__ __forceinline__ void gla_scan(const Params& p) {
    for (int gt = blockIdx.x * 512 + threadIdx.x; gt < 131072; gt += gridDim.x * 512) {
    const int bh = gt >> 12, rem = gt & 4095, v = rem & 127, d = (rem >> 7) * 2;
    const float* dS = (const float*)(p.ws + WS_DS); const float* dec = (const float*)(p.ws + WS_DEC); bf16_t* St = (bf16_t*)(p.ws + WS_ST);
    float s0 = 0.f, s1 = 0.f;
#pragma unroll 8
    for (int c = 0; c < 32; ++c) { const size_t item = (size_t)bh * 32 + c;
        { const unsigned w = pk2(s0, s1); St[item * 8192 + d * 128 + v] = (bf16_t)(w & 0xffffu); St[item * 8192 + (d + 1) * 128 + v] = (bf16_t)(w >> 16); }
        const float a0 = dec[item * 64 + d], a1 = dec[item * 64 + d + 1];
        s0 = a0 * s0 + dS[item * 8192 + d * 128 + v]; s1 = a1 * s1 + dS[item * 8192 + (d + 1) * 128 + v]; }
    float* o = p.out + O_SGP + (size_t)bh * 8192; o[d * 128 + v] = s0; o[(d + 1) * 128 + v] = s1; }
}

__device__ __forceinline__ void sgu_item(const Params& p, LAS unsigned char* lds, int item) {
    const int b = item >> 6, nck = (item >> 2) & 15, h = item & 3; const int tid = threadIdx.x, lane = tid & 63, wave = tid >> 6;
    LAS bf16_t* LW = (LAS bf16_t*)lds; LAS bf16_t* LsvT = (LAS bf16_t*)(lds + 34816);
    const bf16_t* P = (const bf16_t*)(p.ws + WS_P); bf16_t* mix = (bf16_t*)(p.ws + WS_A); const int row0 = b * 2048 + nck * 128;
    const float* Wsrc = p.in[13] + (size_t)h * 16384;
#pragma unroll
    for (int k = 0; k < 8; ++k) { const int idx = tid + 512 * k, i = idx >> 5, j4 = (idx & 31) * 4; const f32x4 w = *(const f32x4*)(Wsrc + i * 128 + j4);
        u32x2 o; o.x = pk2(j4 <= i ? w[0] : 0.f, j4 + 1 <= i ? w[1] : 0.f); o.y = pk2(j4 + 2 <= i ? w[2] : 0.f, j4 + 3 <= i ? w[3] : 0.f); *(LAS u32x2*)(LW + i * 136 + j4) = o; }
    { const int j = tid >> 2, q4 = tid & 3; const bf16_t* src = P + (size_t)(row0 + j) * NIN + 2048 + h * 128 + q4 * 32; float g[32]; float ss = 0.f;
#pragma unroll
      for (int k = 0; k < 4; ++k) { const u32x4v w = *(const u32x4v*)(src + k * 8); const unsigned ww[4] = {w.x, w.y, w.z, w.w};
#pragma unroll
          for (int e = 0; e < 4; ++e) { const float a = gelu_t(bflo(ww[e])), c = gelu_t(bfhi(ww[e])); g[k * 8 + e * 2] = a; g[k * 8 + e * 2 + 1] = c; ss += a * a + c * c; } }
      ss += __shfl_xor(ss, 1); ss += __shfl_xor(ss, 2); const float rs = rsqrtf(ss * (1.0f / 128.0f) + EPS);
#pragma unroll
      for (int e = 0; e < 32; ++e) { const int d = q4 * 32 + e; LsvT[d * 136 + j] = f2bf(g[e] * rs * p.in[12][h * 128 + d]); } }
    __syncthreads();
    const int r = lane & 31, hh = lane >> 5, ib = wave & 3;
    bf16_t uraw[2][16]; float bsv[16];
#pragma unroll
    for (int i = 0; i < 16; ++i) { const int ii = ib * 32 + (i & 3) + 8 * (i >> 2) + 4 * hh; bsv[i] = p.in[14][h * 128 + ii];
#pragma unroll
        for (int t = 0; t < 2; ++t) uraw[t][i] = P[(size_t)(row0 + ii) * NIN + 1536 + h * 128 + ((wave >> 2) * 2 + t) * 32 + r]; }
    f32x16 accs[2];
#pragma unroll
    for (int t = 0; t < 2; ++t) { const int db = (wave >> 2) * 2 + t; f32x16 acc = zero16();
        for (int ks = 0; ks <= ib * 2 + 1; ++ks) { const bf16x8 a = *(const LAS bf16x8*)(LW + (ib * 32 + r) * 136 + ks * 16 + 8 * hh); const bf16x8 bb = *(const LAS bf16x8*)(LsvT + (db * 32 + r) * 136 + ks * 16 + 8 * hh); acc = mma32(a, bb, acc); }
        accs[t] = acc; }
#pragma unroll
    for (int t = 0; t < 2; ++t) { const int db = (wave >> 2) * 2 + t;
#pragma unroll
        for (int i = 0; i < 16; ++i) { const int ii = ib * 32 + (i & 3) + 8 * (i >> 2) + 4 * hh, d = db * 32 + r; const float z = accs[t][i] + bsv[i];
            const float u = gelu_t(bf2f(uraw[t][i])); mix[(size_t)(row0 + ii) * 1024 + 512 + h * 128 + d] = f2bf(u * z); } }
    __syncthreads();
}

constexpr int SM_Q = 0, SM_K = 4096, SM_B = 8192, SM_V = 12288, SM_A = 20480, SM_RED = 21504, SM_O = 22016, SM_END = 30208;
__device__ __forceinline__ void sample_mixer(const Params& p, LAS unsigned char* lds, int b, int hp) {
    const int tid = threadIdx.x, lane = tid & 63, wave = tid >> 6; const int rowb = MPR + b * 4;
    const bf16_t* P = (const bf16_t*)(p.ws + WS_P); const float* af = (const float*)(p.ws + WS_AF); bf16_t* mix = (bf16_t*)(p.ws + WS_A);
    LAS float* Lq = (LAS float*)(lds + SM_Q); LAS float* Lk = (LAS float*)(lds + SM_K); LAS float* Lb = (LAS float*)(lds + SM_B); LAS float* Lv = (LAS float*)(lds + SM_V);
    LAS float* LA = (LAS float*)(lds + SM_A); LAS float* Lred = (LAS float*)(lds + SM_RED); LAS float* Lo = (LAS float*)(lds + SM_O);
    if (hp == 0) { const int ch = tid, h = tid >> 7; float g[4], u[4];
#pragma unroll
      for (int t = 0; t < 4; ++t) { g[t] = gelu_t(bf2f(P[(size_t)(rowb + t) * NIN + 2048 + ch])); u[t] = gelu_t(bf2f(P[(size_t)(rowb + t) * NIN + 1536 + ch])); const float s = wave_sum(g[t] * g[t]); if (lane == 0) Lred[wave * 4 + t] = s; }
      __syncthreads();
      const float gs = p.in[12][ch]; float sv[4];
#pragma unroll
      for (int t = 0; t < 4; ++t) { const float tot = Lred[(2 * h) * 4 + t] + Lred[(2 * h + 1) * 4 + t]; sv[t] = g[t] * rsqrtf(tot * (1.0f / 128.0f) + EPS) * gs; p.out[O_SV + (size_t)(b * 4 + t) * 512 + ch] = sv[t]; }
#pragma unroll
      for (int i = 0; i < 4; ++i) { float z = p.in[14][h * 128 + i];
#pragma unroll
          for (int j = 0; j < 4; ++j) if (j <= i) z += p.in[13][(size_t)h * 16384 + i * 128 + j] * sv[j];
          mix[(size_t)(rowb + i) * 1024 + 512 + ch] = f2bf(u[i] * z); }
      __syncthreads();
    }
#pragma unroll
    for (int k = 0; k < 2; ++k) { const int idx = tid + 512 * k, t = idx >> 8, c = idx & 255;
        Lq[t * 256 + c] = bf2f(P[(size_t)(rowb + t) * NIN + c]); Lk[t * 256 + c] = bf2f(P[(size_t)(rowb + t) * NIN + 256 + c]);
        float z = p.in[10][c];
#pragma unroll
        for (int r = 0; r < 16; ++r) z += af[(size_t)(rowb + t) * 16 + r] * p.in[9][r * 256 + c];
        Lb[t * 256 + c] = logsig(z) * (1.0f / 16.0f); }
#pragma unroll
    for (int t = 0; t < 4; ++t) Lv[t * 512 + tid] = bf2f(P[(size_t)(rowb + t) * NIN + 512 + tid]);
    __syncthreads();
    if (tid < 256) { float a = 0.f;
#pragma unroll
        for (int t = 0; t < 4; ++t) { a += Lb[t * 256 + tid]; Lb[t * 256 + tid] = a; } }
    __syncthreads();
    { const int h = tid >> 7, pr = (tid >> 3) & 15, i = pr >> 2, j = pr & 3, part = tid & 7; float s = 0.f;
      if (j <= i) {
#pragma unroll
          for (int e = 0; e < 8; ++e) { const int c = h * 64 + part * 8 + e; s += Lq[i * 256 + c] * Lk[j * 256 + c] * __expf(Lb[i * 256 + c] - Lb[j * 256 + c]); } }
      s += __shfl_xor(s, 1); s += __shfl_xor(s, 2); s += __shfl_xor(s, 4);
      if (part == 0) LA[h * 16 + pr] = s * 0.125f; }
    __syncthreads();
    LAS float* Le3 = (LAS float*)(lds + SM_END);
    { float qn[2], kn[2];
#pragma unroll
      for (int k = 0; k < 2; ++k) { const int idx = tid + 512 * k, t = idx >> 8, c = idx & 255; const float bt = Lb[t * 256 + c], b3 = Lb[3 * 256 + c];
          qn[k] = Lq[t * 256 + c] * __expf(bt) * 0.125f; kn[k] = Lk[t * 256 + c] * __expf(b3 - bt); }
      const float e3 = tid < 256 ? __expf(Lb[3 * 256 + tid]) : 0.f;
      __syncthreads();
#pragma unroll
      for (int k = 0; k < 2; ++k) { const int idx = tid + 512 * k; Lq[idx] = qn[k]; Lk[idx] = kn[k]; }
      if (tid < 256) Le3[tid] = e3; }
    __syncthreads();
    const int v = tid & 127, dq = tid >> 7;
    for (int h = 2 * hp; h < 2 * hp + 2; ++h) {
        const float* S0 = p.in[3] + (size_t)(b * 4 + h) * 8192; float* So = p.out + O_SGS + (size_t)(b * 4 + h) * 8192;
        float op[4] = {0.f, 0.f, 0.f, 0.f}; float vv[4];
#pragma unroll
        for (int t = 0; t < 4; ++t) vv[t] = Lv[t * 512 + h * 128 + v];
        float s0v[16];
#pragma unroll
        for (int dd = 0; dd < 16; ++dd) s0v[dd] = __builtin_nontemporal_load(S0 + (dq * 16 + dd) * 128 + v);
#pragma unroll
        for (int dd = 0; dd < 16; ++dd) { const int d = dq * 16 + dd, c = h * 64 + d; const float s0 = s0v[dd];
            float sn = Le3[c] * s0;
#pragma unroll
            for (int t = 0; t < 4; ++t) { op[t] += Lq[t * 256 + c] * s0; sn += Lk[t * 256 + c] * vv[t]; }
            So[d * 128 + v] = sn; }
#pragma unroll
        for (int t = 0; t < 4; ++t) Lo[(dq * 4 + t) * 128 + v] = op[t];
        __syncthreads();
        { const int i = tid >> 7; float o = Lo[(0 * 4 + i) * 128 + v] + Lo[(1 * 4 + i) * 128 + v] + Lo[(2 * 4 + i) * 128 + v] + Lo[(3 * 4 + i) * 128 + v];
#pragma unroll
          for (int j = 0; j < 4; ++j) if (j <= i) o += LA[h * 16 + i * 4 + j] * Lv[j * 512 + h * 128 + v];
          const float s = wave_sum(o * o); if (lane == 0) Lred[wave] = s;
          __syncthreads();
          const float tot = Lred[2 * i] + Lred[2 * i + 1]; const float rg = bf2f(P[(size_t)(rowb + i) * NIN + 1024 + h * 128 + v]);
          mix[(size_t)(rowb + i) * 1024 + h * 128 + v] = f2bf(o * rsqrtf(tot * (1.0f / 128.0f) + EPS) * p.in[11][h * 128 + v] * silu_f(rg)); }
        __syncthreads();
    }
}

__device__ __forceinline__ void attn_prompt(const Params& p, LAS unsigned char* lds, int item) {
    const int b = item >> 5, h = (item >> 3) & 3, rt = item & 7; const int tid = threadIdx.x, lane = tid & 63, wave = tid >> 6, r = lane & 31, hh = lane >> 5;
    LAS bf16_t* LK = (LAS bf16_t*)lds; bf16_t* qx = (bf16_t*)(p.ws + WS_A);
    const bf16_t* mkb = (const bf16_t*)(p.ws + WS_MKB) + (size_t)b * 256 * 1024 + h * 256; const bf16_t* mvt = (const bf16_t*)(p.ws + WS_MVT) + (size_t)(b * 4 + h) * 65536;
    const int r0 = b * 2048 + rt * 256 + wave * 32; const bf16_t* qrow = qx + (size_t)(r0 + r) * 1024 + h * 256 + 8 * hh;
    bf16x8 qf[16];
#pragma unroll
    for (int ks = 0; ks < 16; ++ks) qf[ks] = *(const bf16x8*)(qrow + ks * 16);
#pragma unroll 4
    for (int k = 0; k < 16; ++k) { const int idx = tid + 512 * k, m = idx >> 5, d8 = (idx & 31) * 8; *(LAS u32x4v*)(LK + m * 264 + d8) = *(const u32x4v*)(mkb + (size_t)m * 1024 + d8); }
    __syncthreads();
    f32x16 s[8];
#pragma unroll
    for (int mb = 0; mb < 8; ++mb) s[mb] = zero16();
#pragma unroll
    for (int ks = 0; ks < 16; ++ks) {
#pragma unroll
        for (int mb = 0; mb < 8; ++mb) { const bf16x8 kf = *(const LAS bf16x8*)(LK + (mb * 32 + r) * 264 + ks * 16 + 8 * hh); s[mb] = mma32(kf, qf[ks], s[mb]); } }
    float mx = -3.0e38f;
#pragma unroll
    for (int mb = 0; mb < 8; ++mb)
#pragma unroll
        for (int i = 0; i < 16; ++i) mx = fmaxf(mx, s[mb][i]);
    mx = fmaxf(mx, __shfl_xor(mx, 32)); float sum = 0.f;
#pragma unroll
    for (int mb = 0; mb < 8; ++mb)
#pragma unroll
        for (int i = 0; i < 16; ++i) { const float e = __expf((s[mb][i] - mx) * 0.0625f); s[mb][i] = e; sum += e; }
    sum += __shfl_xor(sum, 32); const float inv = __builtin_amdgcn_rcpf(sum);
    bf16x8 pf[8][2];
#pragma unroll
    for (int mb = 0; mb < 8; ++mb)
#pragma unroll
        for (int sI = 0; sI < 2; ++sI) { u32x4v w; w.x = pk2(s[mb][8 * sI + 0] * inv, s[mb][8 * sI + 1] * inv); w.y = pk2(s[mb][8 * sI + 2] * inv, s[mb][8 * sI + 3] * inv);
            w.z = pk2(s[mb][8 * sI + 4] * inv, s[mb][8 * sI + 5] * inv); w.w = pk2(s[mb][8 * sI + 6] * inv, s[mb][8 * sI + 7] * inv); pf[mb][sI] = __builtin_bit_cast(bf16x8, w); }
    __syncthreads();
#pragma unroll 4
    for (int k = 0; k < 16; ++k) { const int idx = tid + 512 * k, d = idx >> 5, m8 = (idx & 31) * 8; *(LAS u32x4v*)(LK + d * 264 + m8) = *(const u32x4v*)(mvt + (size_t)d * 256 + m8); }
    __syncthreads();
    for (int dh = 0; dh < 2; ++dh) {
        f32x16 o[4];
#pragma unroll
        for (int q = 0; q < 4; ++q) o[q] = zero16();
#pragma unroll
        for (int mb = 0; mb < 8; ++mb)
#pragma unroll
            for (int sI = 0; sI < 2; ++sI)
#pragma unroll
                for (int q = 0; q < 4; ++q) { const LAS bf16_t* vp = LK + ((dh * 4 + q) * 32 + r) * 264 + mb * 32 + 16 * sI + 4 * hh;
                    const u32x2 lo = *(const LAS u32x2*)vp, hi = *(const LAS u32x2*)(vp + 8); u32x4v w; w.x = lo.x; w.y = lo.y; w.z = hi.x; w.w = hi.y;
                    o[q] = mma32(pf[mb][sI], __builtin_bit_cast(bf16x8, w), o[q]); }
#pragma unroll
        for (int q = 0; q < 4; ++q)
#pragma unroll
            for (int i = 0; i < 16; ++i) { const int ii = (i & 3) + 8 * (i >> 2) + 4 * hh; qx[(size_t)(r0 + ii) * 1024 + h * 256 + (dh * 4 + q) * 32 + r] = f2bf(o[q][i]); }
    }
    __syncthreads();
}
__device__ __forceinline__ void attn_sample(const Params& p, LAS unsigned char* lds, int item) {
    const int b = item >> 2, h = item & 3; const int tid = threadIdx.x, lane = tid & 63, wave = tid >> 6; const int rowb = MPR + b * 4;
    bf16_t* qx = (bf16_t*)(p.ws + WS_A); LAS float* Ls = (LAS float*)lds;   LAS float* Lred = (LAS float*)(lds + 4096); LAS float* Lo = (LAS float*)(lds + 8192);
    const float* Kc = p.in[5] + ((size_t)b * 256 * 4 + h) * 256; const float* Vc = p.in[6] + ((size_t)b * 256 * 4 + h) * 256;
    f32x4 q[4];
#pragma unroll
    for (int t = 0; t < 4; ++t) { const u32x2 w = *(const u32x2*)(qx + (size_t)(rowb + t) * 1024 + h * 256 + lane * 4); q[t] = (f32x4){bflo(w.x), bfhi(w.x), bflo(w.y), bfhi(w.y)}; }
    const bool b5 = lane & 32, b4 = lane & 16, b3 = lane & 8, b2 = lane & 4, b1 = lane & 2;
    for (int mb = 0; mb < 4; ++mb) {
        f32x4 kv[8];
#pragma unroll
        for (int rr = 0; rr < 8; ++rr) kv[rr] = __builtin_nontemporal_load((const f32x4*)(Kc + (size_t)(wave * 32 + mb * 8 + rr) * 1024 + lane * 4));
        float a[32];
#pragma unroll
        for (int rr = 0; rr < 8; ++rr)
#pragma unroll
            for (int t = 0; t < 4; ++t) a[rr * 4 + t] = (kv[rr][0] * q[t][0] + kv[rr][1] * q[t][1]) + (kv[rr][2] * q[t][2] + kv[rr][3] * q[t][3]);
        float c16[16], c8[8], c4[4], c2[2], c1;
#pragma unroll
        for (int j = 0; j < 16; ++j) { const float send = b5 ? a[j] : a[j + 16]; const float keep = b5 ? a[j + 16] : a[j]; c16[j] = keep + __shfl_xor(send, 32); }
#pragma unroll
        for (int j = 0; j < 8; ++j) { const float send = b4 ? c16[j] : c16[j + 8]; const float keep = b4 ? c16[j + 8] : c16[j]; c8[j] = keep + __shfl_xor(send, 16); }
#pragma unroll
        for (int j = 0; j < 4; ++j) { const float send = b3 ? c8[j] : c8[j + 4]; const float keep = b3 ? c8[j + 4] : c8[j]; c4[j] = keep + __shfl_xor(send, 8); }
#pragma unroll
        for (int j = 0; j < 2; ++j) { const float send = b2 ? c4[j] : c4[j + 2]; const float keep = b2 ? c4[j + 2] : c4[j]; c2[j] = keep + __shfl_xor(send, 4); }
        { const float send = b1 ? c2[0] : c2[1]; const float keep = b1 ? c2[1] : c2[0]; c1 = keep + __shfl_xor(send, 2); }
        c1 += __shfl_xor(c1, 1);
        if ((lane & 1) == 0) { const int j = (lane >> 1) & 31; Ls[(j & 3) * 256 + wave * 32 + mb * 8 + (j >> 2)] = c1 * 0.0625f; }
    }
    __syncthreads();
    { const int t = tid >> 7, m0 = tid & 127; const float a = Ls[t * 256 + m0], c = Ls[t * 256 + m0 + 128]; const float mx = wave_max(fmaxf(a, c)); if (lane == 0) Lred[wave] = mx;
      __syncthreads();
      const float mxx = fmaxf(Lred[2 * t], Lred[2 * t + 1]); const float ea = __expf(a - mxx), ec = __expf(c - mxx); const float sm = wave_sum(ea + ec); if (lane == 0) Lred[16 + wave] = sm;
      __syncthreads();
      const float inv = __builtin_amdgcn_rcpf(Lred[16 + 2 * t] + Lred[16 + 2 * t + 1]); Ls[t * 256 + m0] = ea * inv; Ls[t * 256 + m0 + 128] = ec * inv; }
    __syncthreads();
    f32x4 o[4];
#pragma unroll
    for (int t = 0; t < 4; ++t) o[t] = (f32x4){0.f, 0.f, 0.f, 0.f};
#pragma unroll 2
    for (int mm = 0; mm < 32; mm += 4) { const int m = wave * 32 + mm; f32x4 vv[4], pp[4];
#pragma unroll
        for (int rr = 0; rr < 4; ++rr) vv[rr] = __builtin_nontemporal_load((const f32x4*)(Vc + (size_t)(m + rr) * 1024 + lane * 4));
#pragma unroll
        for (int t = 0; t < 4; ++t) pp[t] = *(const LAS f32x4*)(Ls + t * 256 + m);
#pragma unroll
        for (int rr = 0; rr < 4; ++rr)
#pragma unroll
            for (int t = 0; t < 4; ++t) o[t] += vv[rr] * pp[t][rr]; }
#pragma unroll
    for (int t = 0; t < 4; ++t) *(LAS f32x4*)(Lo + (wave * 4 + t) * 256 + lane * 4) = o[t];
    __syncthreads();
#pragma unroll
    for (int k = 0; k < 2; ++k) { const int idx = tid + 512 * k, t = idx >> 8, d = idx & 255; float s = 0.f;
#pragma unroll
        for (int w = 0; w < 8; ++w) s += Lo[(w * 4 + t) * 256 + d];
        qx[(size_t)(rowb + t) * 1024 + h * 256 + d] = f2bf(s); }
    __syncthreads();
}

__device__ __forceinline__ void phase_act(const Params& p) {
    const bf16_t* G = (const bf16_t*)(p.ws + WS_P); bf16_t* U = (bf16_t*)(p.ws + WS_U);
    const float* cw = p.in[25]; const float* cb = p.in[26];
    const int nthr = gridDim.x * 512, gt = blockIdx.x * 512 + threadIdx.x;
    for (int it = gt; it < 1024 * 352; it += nthr) { const int run = it / 352, cc = (it % 352) * 8; const int row0 = run * 16; const bool first = (row0 & 2047) == 0;
        float w0[8], w1[8], w2[8], bb[8], g2[8], g1[8];
#pragma unroll
        for (int e = 0; e < 8; ++e) { w0[e] = cw[cc + e]; w1[e] = cw[DFF + cc + e]; w2[e] = cw[2 * DFF + cc + e]; bb[e] = cb[cc + e]; g2[e] = 0.f; g1[e] = 0.f; }
        if (!first) { const u32x4v a = *(const u32x4v*)(G + (size_t)(row0 - 2) * DFF + cc), c = *(const u32x4v*)(G + (size_t)(row0 - 1) * DFF + cc);
            g2[0] = bflo(a.x); g2[1] = bfhi(a.x); g2[2] = bflo(a.y); g2[3] = bfhi(a.y); g2[4] = bflo(a.z); g2[5] = bfhi(a.z); g2[6] = bflo(a.w); g2[7] = bfhi(a.w);
            g1[0] = bflo(c.x); g1[1] = bfhi(c.x); g1[2] = bflo(c.y); g1[3] = bfhi(c.y); g1[4] = bflo(c.z); g1[5] = bfhi(c.z); g1[6] = bflo(c.w); g1[7] = bfhi(c.w); }
#pragma unroll 4
        for (int t = 0; t < 16; ++t) { const size_t off = (size_t)(row0 + t) * DFF + cc; const u32x4v a = *(const u32x4v*)(G + off), uu = *(const u32x4v*)(U + off);
            float g0[8] = {bflo(a.x), bfhi(a.x), bflo(a.y), bfhi(a.y), bflo(a.z), bfhi(a.z), bflo(a.w), bfhi(a.w)};
            const float uf[8] = {bflo(uu.x), bfhi(uu.x), bflo(uu.y), bfhi(uu.y), bflo(uu.z), bfhi(uu.z), bflo(uu.w), bfhi(uu.w)}; float r[8];
#pragma unroll
            for (int e = 0; e < 8; ++e) { r[e] = gelu_t(bb[e] + w0[e] * g2[e] + w1[e] * g1[e] + w2[e] * g0[e]) * uf[e]; g2[e] = g1[e]; g1[e] = g0[e]; }
            u32x4v o; o.x = pk2(r[0], r[1]); o.y = pk2(r[2], r[3]); o.z = pk2(r[4], r[5]); o.w = pk2(r[6], r[7]); *(u32x4v*)(U + off) = o; }
    }
    for (int it = gt; it < 128 * 352; it += nthr) { const int b = it / 352, cc = (it % 352) * 8; const int row0 = MPR + b * 4;
        float w0[8], w1[8], w2[8], bb[8], g2[8], g1[8];
#pragma unroll
        for (int e = 0; e < 8; ++e) { w0[e] = cw[cc + e]; w1[e] = cw[DFF + cc + e]; w2[e] = cw[2 * DFF + cc + e]; bb[e] = cb[cc + e]; g2[e] = p.in[4][(size_t)(b * 2) * DFF + cc + e]; g1[e] = p.in[4][(size_t)(b * 2 + 1) * DFF + cc + e]; }
#pragma unroll
        for (int t = 0; t < 4; ++t) { const size_t off = (size_t)(row0 + t) * DFF + cc; const u32x4v a = *(const u32x4v*)(G + off), uu = *(const u32x4v*)(U + off);
            float g0[8] = {bflo(a.x), bfhi(a.x), bflo(a.y), bfhi(a.y), bflo(a.z), bfhi(a.z), bflo(a.w), bfhi(a.w)};
            const float uf[8] = {bflo(uu.x), bfhi(uu.x), bflo(uu.y), bfhi(uu.y), bflo(uu.z), bfhi(uu.z), bflo(uu.w), bfhi(uu.w)}; float r[8];
#pragma unroll
            for (int e = 0; e < 8; ++e) { r[e] = gelu_t(bb[e] + w0[e] * g2[e] + w1[e] * g1[e] + w2[e] * g0[e]) * uf[e]; g2[e] = g1[e]; g1[e] = g0[e]; }
            u32x4v o; o.x = pk2(r[0], r[1]); o.y = pk2(r[2], r[3]); o.z = pk2(r[4], r[5]); o.w = pk2(r[6], r[7]); *(u32x4v*)(U + off) = o; }
    }
}
__device__ __forceinline__ void phase_final(const Params& p) {
    const float* h32 = (const float*)(p.ws + WS_H); const float* ssq = (const float*)(p.ws + WS_SSQ) + (size_t)2 * MT * 16; const float* g = p.in[28];
    const int lane = threadIdx.x & 63, wave = threadIdx.x >> 6;
    const float* ssq64 = (const float*)(p.ws + WS_SSQS) + (size_t)2 * 512 * 64;
    for (int r = blockIdx.x * 8 + wave; r < MT; r += gridDim.x * 8) { const float rs = row_rs2(ssq, ssq64, r);
#pragma unroll
        for (int i = 0; i < 4; ++i) { const size_t off = (size_t)r * 1024 + i * 256 + lane * 4; *(f32x4*)(p.out + O_Y + off) = *(const f32x4*)(h32 + off) * rs * *(const f32x4*)(g + i * 256 + lane * 4); } }
}

template <int DUMMY>
__device__ __forceinline__ void run_phases(const Params& p, LAS unsigned char* lds, const int lo, const int hi) {
    unsigned char* ws = p.ws; const int G = gridDim.x, bx = blockIdx.x;
#define IN(k) (lo <= (k) && (k) < hi)
#define MKBAR() XcdBarrier bar; bar.bar = (unsigned*)(p.ws + WS_BAR) + (size_t)p.bar_region * XCD_BAR_WORDS; bar.x = xb_xcc_id(); bar.st = (volatile LAS unsigned*)(lds + LDS_BYTES - 16)
#define SEAM(k) do { if (IN(k) && IN((k) + 1)) { MKBAR(); xcd_barrier(bar); } } while (0)
    if (IN(0)) { phase_prep(p, lds); } SEAM(0);
    if (IN(0) && IN(1)) {
        volatile LAS unsigned* stw = (volatile LAS unsigned*)(lds + LDS_BYTES - 16);
        if (threadIdx.x == 0 && (G % 8) == 0) { unsigned* barw = (unsigned*)(p.ws + WS_BAR) + (size_t)p.bar_region * XCD_BAR_WORDS; const unsigned x = xb_xcc_id(); unsigned pre = 0;
            for (unsigned j = 0; j < 16; ++j) { const unsigned cj = xb_ld(&barw[XB_XCNT(j)]); if (j < x) pre += cj; }
            const unsigned clin = pre + stw[2], per = (unsigned)G / 8u; stw[3] = (clin % per) * 8u + clin / per; }
        __syncthreads();
    }
#define CX ((int)((volatile LAS unsigned*)(lds + LDS_BYTES - 16))[3])
    if (IN(1)) {
        { pg8::Gemm g{(const bf16_t*)(ws + WS_A), (const bf16_t*)(ws + WS_WIN), MT, 2560, 1024}; pg8::StaticOrder S; S.init(MT, 2560, G, CX);
          EpiIn E{(bf16_t*)(ws + WS_P), (float*)(ws + WS_AF)}; pg8::gemm_phase<EpiIn, pg8::StaticOrder>(lds, g, S, E, nullptr); }
        __syncthreads();
        { pg8::Gemm g{(const bf16_t*)(ws + WS_MN), (const bf16_t*)(ws + WS_WKV), 2048, 2048, 1024}; pg8::StaticOrder S; S.init(2048, 2048, G, (CX + 104) % G);
          EpiKV E{p.out + O_MK, p.out + O_MV, (bf16_t*)(ws + WS_MKB), (bf16_t*)(ws + WS_MVT)}; pg8::gemm_phase<EpiKV, pg8::StaticOrder>(lds, g, S, E, nullptr); }
        __syncthreads();
    } SEAM(1);
    if (IN(2)) {
        gla_local_loop(p, lds, bx, G, 1024);
        for (int it = bx; it < 512; it += G) sgu_item(p, lds, it);
        for (int it = G - 1 - bx; it < 256; it += G) sample_mixer(p, lds, it >> 1, it & 1);
    } SEAM(2);
    if (IN(3)) { gla_scan(p); } SEAM(3);
    if (IN(4)) { gla_out_loop(p, lds, bx, G, 1024); } SEAM(4);
    if (IN(5)) {
        pg8::Gemm g{(const bf16_t*)(ws + WS_A), (const bf16_t*)(ws + WS_WOUT), MPR, 1024, 1024}; pg8::StaticOrder S; S.init(MPR, 1024, G, CX);
        EpiRes E{p.in[0], (bf16_t*)(ws + WS_HB), (float*)(ws + WS_SSQ)}; pg8::gemm_phase<EpiRes, pg8::StaticOrder>(lds, g, S, E, nullptr);
        __syncthreads();
        { const float* xs = p.in[1]; bf16_t* hb = (bf16_t*)(ws + WS_HB) + (size_t)MPR * 1024; float* sq = (float*)(ws + WS_SSQS);
          gemm_small<256>((const bf16_t*)(ws + WS_A) + (size_t)MPR * 1024, (const bf16_t*)(ws + WS_WOUT), 1024, 16, lds, [=](int r, int c, int cb, int fq, f32x4 a) {
              const size_t off = (size_t)r * 1024 + c; const f32x4 v = a + *(const f32x4*)(xs + off); u32x2 w; w.x = pk2(v[0], v[1]); w.y = pk2(v[2], v[3]); *(u32x2*)(hb + off) = w;
              float s = sq4(v); s += __shfl_xor(s, 16); s += __shfl_xor(s, 32); if (fq == 0) sq[(size_t)r * 64 + cb] = s; }); }
    } SEAM(5);
    if (IN(6)) {
        pg8::Gemm g{(const bf16_t*)(ws + WS_HB), (const bf16_t*)(ws + WS_WQ), MPR, 1024, 1024}; pg8::StaticOrder S; S.init(MPR, 1024, G, CX);
        EpiQ E{(bf16_t*)(ws + WS_A), (const float*)(ws + WS_SSQ)}; pg8::gemm_phase<EpiQ, pg8::StaticOrder>(lds, g, S, E, nullptr);
        __syncthreads();
        { bf16_t* Q = (bf16_t*)(ws + WS_A) + (size_t)MPR * 1024; const float* sq = (const float*)(ws + WS_SSQS);
          gemm_small<256>((const bf16_t*)(ws + WS_HB) + (size_t)MPR * 1024, (const bf16_t*)(ws + WS_WQ), 1024, 16, lds, [=](int r, int c, int cb, int fq, f32x4 a) {
              const f32x4 v = a * row_rs64(sq, r); u32x2 w; w.x = pk2(v[0], v[1]); w.y = pk2(v[2], v[3]); *(u32x2*)(Q + (size_t)r * 1024 + c) = w; }); }
    } SEAM(6);
    if (IN(7)) {
        if ((bx >> 3) & 1) { for (int it = bx; it < 512; it += G) attn_sample(p, lds, it); for (int it = bx; it < 256; it += G) attn_prompt(p, lds, it); }
        else { for (int it = bx; it < 256; it += G) attn_prompt(p, lds, it); for (int it = bx; it < 512; it += G) attn_sample(p, lds, it); }
    } SEAM(7);
    if (IN(8)) {
        pg8::Gemm g{(const bf16_t*)(ws + WS_A), (const bf16_t*)(ws + WS_WO), MPR, 1024, 1024}; pg8::StaticOrder S; S.init(MPR, 1024, G, CX);
        EpiRes E{nullptr, (bf16_t*)(ws + WS_HB), (float*)(ws + WS_SSQ) + (size_t)MT * 16};
        pg8::gemm_phase<EpiRes, pg8::StaticOrder>(lds, g, S, E, nullptr);
        __syncthreads();
        { bf16_t* hb = (bf16_t*)(ws + WS_HB) + (size_t)MPR * 1024; float* sq = (float*)(ws + WS_SSQS) + (size_t)512 * 64;
          gemm_small<256>((const bf16_t*)(ws + WS_A) + (size_t)MPR * 1024, (const bf16_t*)(ws + WS_WO), 1024, 16, lds, [=](int r, int c, int cb, int fq, f32x4 a) {
              const size_t off = (size_t)r * 1024 + c; const u32x2 hw = *(const u32x2*)(hb + off); const f32x4 v = a + (f32x4){bflo(hw.x), bfhi(hw.x), bflo(hw.y), bfhi(hw.y)};
              u32x2 w; w.x = pk2(v[0], v[1]); w.y = pk2(v[2], v[3]); *(u32x2*)(hb + off) = w;
              float s = sq4(v); s += __shfl_xor(s, 16); s += __shfl_xor(s, 32); if (fq == 0) sq[(size_t)r * 64 + cb] = s; }); }
    } SEAM(8);
    if (IN(9)) {
        pg8::Gemm g{(const bf16_t*)(ws + WS_HB), (const bf16_t*)(ws + WS_WGU), MT, 5632, 1024}; pg8::StaticOrder S; S.init(MT, 5632, G, CX);
        EpiGU E{(bf16_t*)(ws + WS_U), (const float*)(ws + WS_SSQ) + (size_t)MT * 16, (const float*)(ws + WS_SSQS) + (size_t)512 * 64, p.out + O_SCP, p.out + O_SCS, p.in[25], p.in[26], p.in[4], (float*)(ws + WS_GX), (float*)(ws + WS_UX), p.pad}; pg8::gemm_phase<EpiGU, pg8::StaticOrder>(lds, g, S, E, nullptr);
        __syncthreads();
    } if (IN(9) && IN(11)) { MKBAR(); xcd_barrier(bar); }
    if (IN(11)) {
        pg8::Gemm g{(const bf16_t*)(ws + WS_U), (const bf16_t*)(ws + WS_WD), MPR, 1024, 2816}; pg8::StaticOrder S; S.init(MPR, 1024, G, CX);
        if (!(p.pad & 2)) { Unit fu; for (int i = 0; S.next(i, fu); ++i) act_fixup(p, fu.pm); asm volatile("s_waitcnt vmcnt(0)" ::: "memory"); __syncthreads(); }
        EpiFin E{(const bf16_t*)(ws + WS_HB), (float*)(ws + WS_SSQ) + (size_t)2 * MT * 16, (unsigned*)(ws + WS_BAR) + (size_t)p.bar_region * XCD_BAR_WORDS, p.in[28], p.out + O_Y, p.pad,
                 (const bf16_t*)(ws + WS_U) + (size_t)MPR * 2816, (const bf16_t*)(ws + WS_WD), (float*)(ws + WS_SSQS) + (size_t)2 * 512 * 64};
        pg8::gemm_phase<EpiFin, pg8::StaticOrder>(lds, g, S, E, nullptr);
        __syncthreads();
    }
#undef IN
#undef SEAM
#undef CX
}
__global__ void __launch_bounds__(512) mega(Params p) {
    extern __shared__ __attribute__((aligned(16))) unsigned char lds_raw[];
    LAS unsigned char* lds = (LAS unsigned char*)lds_raw;
    if (p.ph_lo < 0) { cg::grid_group grid = cg::this_grid(); grid.sync(); }
    volatile LAS unsigned* st = (volatile LAS unsigned*)(lds + LDS_BYTES - 16);
    if (threadIdx.x < 4) st[threadIdx.x] = 0u;
    __syncthreads();
    if (threadIdx.x == 0) { unsigned* barw = (unsigned*)(p.ws + WS_BAR) + (size_t)p.bar_region * XCD_BAR_WORDS;
        st[2] = xb_add(&barw[XB_XCNT(xb_xcc_id())], 1u);
        st[3] = blockIdx.x; }
    __syncthreads();
    run_phases<0>(p, lds, p.ph_lo, p.ph_hi);
#ifdef EXTRA_SYNC
    for (int i = 0; i < EXTRA_SYNC; ++i) { MKBAR(); xcd_barrier(bar); }
#endif
}

extern "C" void kernel_launch(void* const* d_in, const int* in_sizes, int n_in, void* d_out, int out_size, void* d_ws, size_t ws_size, hipStream_t stream) {
    static int grid = 0;
    if (grid == 0) {
        if (n_in != 29 || ws_size < WS_END) { fprintf(stderr, "kernel_launch: unexpected n_in %d / ws %zu (need %zu)\n", n_in, ws_size, (size_t)WS_END); grid = -1; return; }
        int dev = 0, cus = 0, per_cu = 0;
        hipGetDevice(&dev); hipDeviceGetAttribute(&cus, hipDeviceAttributeMultiprocessorCount, dev);
        if (hipFuncSetAttribute((const void*)mega, hipFuncAttributeMaxDynamicSharedMemorySize, LDS_BYTES) != hipSuccess) { fprintf(stderr, "kernel_launch: hipFuncSetAttribute failed\n"); grid = -1; return; }
        if (hipOccupancyMaxActiveBlocksPerMultiprocessor(&per_cu, (const void*)mega, 512, LDS_BYTES) != hipSuccess || per_cu < 1) { fprintf(stderr, "kernel_launch: occupancy query gives %d\n", per_cu); (void)hipGetLastError(); per_cu = 1; }
        grid = cus;
    }
    if (grid < 0) return;
    Params p{};
    for (int i = 0; i < 29; ++i) p.in[i] = (const float*)d_in[i];
    p.out = (float*)d_out; p.ws = (unsigned char*)d_ws;
    (void)hipMemsetAsync((unsigned char*)d_ws + WS_BAR, 0, (size_t)2 * XCD_BAR_WORDS * 4, stream);
#if N_LAUNCH_MODE == 1
    p.ph_lo = 0; p.ph_hi = NPHASE;
    void* args[] = {&p};
    hipError_t e = hipLaunchCooperativeKernel((const void*)mega, dim3(grid), dim3(512), args, LDS_BYTES, stream);
    if (e != hipSuccess) fprintf(stderr, "cooperative launch failed: %s (grid %d)\n", hipGetErrorString(e), grid);
#if EXTRA_HI > 0
    Params p2 = p; p2.ph_lo = EXTRA_LO; p2.ph_hi = EXTRA_HI; p2.bar_region = 1; p2.pad = EXTRA_FLAGS; void* args2[] = {&p2};
    (void)hipLaunchCooperativeKernel((const void*)mega, dim3(grid), dim3(512), args2, LDS_BYTES, stream);
#endif
#else
    for (int ph = 0; ph < NPHASE; ++ph) { p.ph_lo = ph; p.ph_hi = ph + 1; hipLaunchKernelGGL(mega, dim3(grid), dim3(512), LDS_BYTES, stream, p); }
#endif
}
```

```cpp
#include <hip/hip_runtime.h>
namespace pg8 {
#define PG8_LAS __attribute__((address_space(3)))
typedef unsigned short bf16_t;
typedef short bf16x8 __attribute__((ext_vector_type(8)));
typedef float f32x4 __attribute__((ext_vector_type(4)));
typedef unsigned u32x4 __attribute__((ext_vector_type(4)));
constexpr int BM = 256, BK = 64, HALF = 128, HTB = HALF * BK * 2  , STAGE_BYTES = 8 * HTB, NXCD = 8, WGM = 8;

__host__ __device__ __forceinline__ int lds_byte(int r, int c) { const int st = (r >> 4) * 2 + (c >> 5), rr = r & 15, cc = c & 31, ob = rr * 64 + cc * 2; return st * 1024 + (ob ^ (((ob >> 9) & 1) << 5)); }
__host__ __device__ __forceinline__ void stage_rc(int b, int& R, int& C) { const int st = b / 1024, sb = b % 1024, swz = sb ^ (((sb >> 9) & 1) << 5); R = (st >> 1) * 16 + swz / 64; C = (st & 1) * 32 + (swz % 64) / 2; }
__host__ __device__ __forceinline__ int perm32(int rho) { const int n = rho >> 4, i = rho & 15; return 8 * (i >> 2) + 4 * n + (i & 3); }

struct Unit { int pm, pn; };
struct Gemm { const bf16_t* A; const bf16_t* Bt; int M, N, K; };

struct StaticOrder {
    int nM, nN, nwg, G, c;
    __host__ __device__ void init(int M, int N, int G_, int c_) { nM = M / BM; nN = N / BM; nwg = nM * nN; G = G_; c = c_; }
    __host__ __device__ __forceinline__ bool next(int i, Unit& u) const {
        const long L = (long)i * G + c; if (L >= nwg) return false;
        int wgid = (int)L; { const int q = nwg / NXCD, r = nwg % NXCD, xcd = wgid % NXCD, off = wgid / NXCD; wgid = (xcd < r ? xcd * (q + 1) : r * (q + 1) + (xcd - r) * q) + off; }
        const int nig = WGM * nN, gid = wgid / nig, fm = gid * WGM, gsz = (nM - fm) < WGM ? (nM - fm) : WGM;
        u.pm = fm + ((wgid % nig) % gsz); u.pn = (wgid % nig) / gsz; return true;
    }
    __device__ __forceinline__ void a_ready(const Unit&) const {}
    __device__ __forceinline__ void done(const Unit&) const {}
};
struct CountedOrder : StaticOrder {
    const unsigned* ready; unsigned need; unsigned* tmo;
    __device__ __forceinline__ void a_ready(const Unit& u) const {
        if (threadIdx.x < 64) {
            const unsigned long long t0 = __builtin_amdgcn_s_memrealtime(); unsigned polls = 0;
            while ((unsigned)__builtin_amdgcn_readfirstlane(__hip_atomic_load(ready + 64 * u.pm, __ATOMIC_RELAXED, __HIP_MEMORY_SCOPE_AGENT)) < need) {
                if ((++polls & 255u) == 0u && __builtin_amdgcn_readfirstlane(__hip_atomic_load(tmo, __ATOMIC_RELAXED, __HIP_MEMORY_SCOPE_AGENT)) != 0u) break;
                if (__builtin_amdgcn_s_memrealtime() - t0 > 2000000ull) {
                    if (threadIdx.x == 0) { unsigned expect = 0u; __hip_atomic_compare_exchange_strong(tmo + 1, &expect, 0x600u | (unsigned)(u.pm & 0xff), __ATOMIC_RELAXED, __ATOMIC_RELAXED, __HIP_MEMORY_SCOPE_AGENT); __hip_atomic_store(tmo, 1u, __ATOMIC_RELAXED, __HIP_MEMORY_SCOPE_AGENT); }
                    break; }
                __builtin_amdgcn_s_sleep(2); }
            __builtin_amdgcn_fence(__ATOMIC_ACQUIRE, "agent");
            asm volatile("s_waitcnt vmcnt(0)" ::: "memory");
        }
#if !defined(BROKEN_HOOK_NO_BARRIER)
        asm volatile("" ::: "memory"); __builtin_amdgcn_s_barrier(); asm volatile("" ::: "memory");
#endif
    }
};

__device__ __forceinline__ unsigned cvt_pk_bf16(float lo, float hi) { unsigned r; asm volatile("v_cvt_pk_bf16_f32 %0, %1, %2" : "=v"(r) : "v"(lo), "v"(hi)); return r; }
typedef float f32x2 __attribute__((ext_vector_type(2)));
__device__ __forceinline__ f32x2 gelu_pk(f32x2 v) {
    const f32x2 av = __builtin_elementwise_abs(v), d = av * 0.2316418882f + 1.0f;
    f32x2 t; t.x = __builtin_amdgcn_rcpf(d.x); t.y = __builtin_amdgcn_rcpf(d.y);
    f32x2 q = t * 0.5307027145f + (-0.7265760135f); q = q * t + 0.7107068705f; q = q * t + (-0.142248368f); q = q * t + 0.127414796f; q = q * t;
    const f32x2 s = (v * v) * (-0.72134752044f);
    f32x2 e; e.x = __builtin_amdgcn_exp2f(s.x); e.y = __builtin_amdgcn_exp2f(s.y);
    const f32x2 m = v * (q * e), r = v - m;
    f32x2 o; o.x = v.x < 0.f ? m.x : r.x; o.y = v.y < 0.f ? m.y : r.y; return o;
}

struct EpiF32 {
    static constexpr bool PERM = false, AFTER_DRAIN = false;
    float* C; int ldc; const float* bias;
    __device__ __forceinline__ void operator()(const f32x4 (&acc)[2][2][4][2], const Unit& u, int wr, int wc, int fr, int fq) const {
        const int row0 = u.pm * BM + wr * 64 + fr, col0 = u.pn * BM + wc * 32 + 4 * fq;
        f32x4 bv[2][2];
#pragma unroll
        for (int bj = 0; bj < 2; ++bj)
#pragma unroll
            for (int n = 0; n < 2; ++n) bv[bj][n] = bias ? *(const f32x4*)(bias + col0 + bj * HALF + n * 16) : (f32x4){0.f, 0.f, 0.f, 0.f};
#pragma unroll
        for (int ai = 0; ai < 2; ++ai)
#pragma unroll
            for (int m = 0; m < 4; ++m) { float* rowp = C + (size_t)(row0 + ai * HALF + m * 16) * ldc + col0;
#pragma unroll
                for (int bj = 0; bj < 2; ++bj)
#pragma unroll
                    for (int n = 0; n < 2; ++n) *(f32x4*)(rowp + bj * HALF + n * 16) = acc[ai][bj][m][n] + bv[bj][n]; }
    }
};
template <int ACT  > struct EpiBf16 {
    static constexpr bool PERM = true, AFTER_DRAIN = false;
    bf16_t* O; int ldc; const float* bias; int split_cols; size_t split_stride;
    __device__ __forceinline__ void operator()(const f32x4 (&acc)[2][2][4][2], const Unit& u, int wr, int wc, int fr, int fq) const {
        const int row0 = u.pm * BM + wr * 64 + fr; int colt = u.pn * BM; bf16_t* base = O;
        if (split_cols) { const int t = colt / split_cols; base += (size_t)t * split_stride; colt -= t * split_cols; }
        const int col0 = colt + wc * 32 + 8 * fq, bcol0 = u.pn * BM + wc * 32 + 8 * fq;
        f32x4 bv[2][2];
#pragma unroll
        for (int bj = 0; bj < 2; ++bj)
#pragma unroll
            for (int n = 0; n < 2; ++n) bv[bj][n] = bias ? *(const f32x4*)(bias + bcol0 + bj * HALF + 4 * n) : (f32x4){0.f, 0.f, 0.f, 0.f};
#pragma unroll
        for (int ai = 0; ai < 2; ++ai)
#pragma unroll
            for (int m = 0; m < 4; ++m) { bf16_t* rowp = base + (size_t)(row0 + ai * HALF + m * 16) * ldc + col0;
#pragma unroll
                for (int bj = 0; bj < 2; ++bj) { f32x4 v0 = acc[ai][bj][m][0] + bv[bj][0], v1 = acc[ai][bj][m][1] + bv[bj][1];
                    if (ACT == 1) { f32x2 a = gelu_pk((f32x2){v0[0], v0[1]}), b = gelu_pk((f32x2){v0[2], v0[3]}), c = gelu_pk((f32x2){v1[0], v1[1]}), d = gelu_pk((f32x2){v1[2], v1[3]});
                        v0 = (f32x4){a.x, a.y, b.x, b.y}; v1 = (f32x4){c.x, c.y, d.x, d.y}; }
                    if (ACT == 2) {
#pragma unroll
                        for (int j = 0; j < 4; ++j) { v0[j] = 0.5f * v0[j] * (1.0f + erff(v0[j] * 0.70710678f)); v1[j] = 0.5f * v1[j] * (1.0f + erff(v1[j] * 0.70710678f)); } }
                    u32x4 w; w.x = cvt_pk_bf16(v0[0], v0[1]); w.y = cvt_pk_bf16(v0[2], v0[3]); w.z = cvt_pk_bf16(v1[0], v1[1]); w.w = cvt_pk_bf16(v1[2], v1[3]);
                    *(u32x4*)(rowp + bj * HALF) = w; } }
    }
};

struct PanelStats {
    unsigned* xbuf;
    unsigned* cnt;
    unsigned* tmo;
    int ntn; float eps;
    unsigned code;
    __device__ __forceinline__ bool run(const f32x4 (&v)[2][2][4][2], const Unit& u, int wr, int wc, int fr, int fq, PG8_LAS unsigned char* lds, int wid, int lane) const {
        typedef float f32x2v __attribute__((ext_vector_type(2)));
        PG8_LAS f32x2v* P = (PG8_LAS f32x2v*)lds;
        PG8_LAS f32x2v* S = (PG8_LAS f32x2v*)(lds + 8192);
        PG8_LAS unsigned* flag = (PG8_LAS unsigned*)(lds + 8192 + 2048);
#pragma unroll
        for (int ai = 0; ai < 2; ++ai)
#pragma unroll
            for (int m = 0; m < 4; ++m) {
                float s = 0.f;
#pragma unroll
                for (int bj = 0; bj < 2; ++bj)
#pragma unroll
                    for (int n = 0; n < 2; ++n) { const f32x4 x = v[ai][bj][m][n]; s += (x[0] + x[1]) + (x[2] + x[3]); }
                s += __shfl_xor(s, 16); s += __shfl_xor(s, 32);
                const float mw = s * (1.0f / 64.0f); float q = 0.f;
#pragma unroll
                for (int bj = 0; bj < 2; ++bj)
#pragma unroll
                    for (int n = 0; n < 2; ++n) { const f32x4 d = v[ai][bj][m][n] - mw; q += (d[0] * d[0] + d[1] * d[1]) + (d[2] * d[2] + d[3] * d[3]); }
                q += __shfl_xor(q, 16); q += __shfl_xor(q, 32);
                if (fq == 0) P[(ai * HALF + wr * 64 + m * 16 + fr) * 4 + wc] = (f32x2v){mw, q};
            }
        asm volatile("s_waitcnt lgkmcnt(0)" ::: "memory"); __builtin_amdgcn_s_barrier(); asm volatile("" ::: "memory");
#if defined(BROKEN_NO_WAIT)
        if (blockIdx.x >= 64) { const long long t0 = clock64(); while (clock64() - t0 < 60000) __builtin_amdgcn_s_sleep(8); }
#endif
        const int row = wid * 32 + (lane & 31);
        if (lane < 32) {
            const f32x2v a = P[row * 4 + 0], b = P[row * 4 + 1], c = P[row * 4 + 2], d = P[row * 4 + 3];
            const float mt = (a.x + b.x + c.x + d.x) * 0.25f;
            const float da = a.x - mt, db = b.x - mt, dc = c.x - mt, dd = d.x - mt;
            const float m2 = (a.y + b.y) + (c.y + d.y) + 64.0f * ((da * da + db * db) + (dc * dc + dd * dd));
            unsigned long long* slot = (unsigned long long*)xbuf + ((size_t)(u.pm * BM + row) * 4 + u.pn);
            __hip_atomic_store(slot, ((unsigned long long)__float_as_uint(m2) << 32) | __float_as_uint(mt), __ATOMIC_RELAXED, __HIP_MEMORY_SCOPE_AGENT);
        }
        asm volatile("s_waitcnt vmcnt(0)" ::: "memory");
        if (lane == 0) __hip_atomic_fetch_add(cnt + 64 * u.pm, 1u, __ATOMIC_RELAXED, __HIP_MEMORY_SCOPE_AGENT);
        if (wid == 0) {
            bool dead = false; const unsigned long long t0 = __builtin_amdgcn_s_memrealtime(); const unsigned want = 8u * (unsigned)ntn;
            for (;;) {
#if defined(BROKEN_NO_WAIT)
                break;
#endif
                if ((unsigned)__builtin_amdgcn_readfirstlane(__hip_atomic_load(cnt + 64 * u.pm, __ATOMIC_RELAXED, __HIP_MEMORY_SCOPE_AGENT)) >= want) break;
                if (__builtin_amdgcn_s_memrealtime() - t0 > 2000000ull) {
                    if (lane == 0) { unsigned expect = 0u; __hip_atomic_compare_exchange_strong(tmo + 1, &expect, code | (unsigned)(u.pm & 0xff), __ATOMIC_RELAXED, __ATOMIC_RELAXED, __HIP_MEMORY_SCOPE_AGENT);
                                     __hip_atomic_store(tmo, 1u, __ATOMIC_RELAXED, __HIP_MEMORY_SCOPE_AGENT); }
                    dead = true; break; }
                __builtin_amdgcn_s_sleep(2);
            }
            __builtin_amdgcn_fence(__ATOMIC_ACQUIRE, "agent");
            if (lane == 0) flag[0] = dead ? 1u : 0u;
        }
        asm volatile("s_waitcnt vmcnt(0) lgkmcnt(0)" ::: "memory"); __builtin_amdgcn_s_barrier(); asm volatile("" ::: "memory");
        const bool bad = flag[0] != 0u;
        if (lane < 32) {
            const unsigned long long* slot = (const unsigned long long*)xbuf + (size_t)(u.pm * BM + row) * 4; float mt[4], m2[4]; float ms = 0.f;
#pragma unroll
            for (int t = 0; t < 4; ++t) { if (t < ntn) { const unsigned long long w = __hip_atomic_load(slot + t, __ATOMIC_RELAXED, __HIP_MEMORY_SCOPE_AGENT); mt[t] = __uint_as_float((unsigned)w); m2[t] = __uint_as_float((unsigned)(w >> 32)); } else { mt[t] = 0.f; m2[t] = 0.f; } ms += mt[t]; }
            const float mean = ms / (float)ntn; float q = 0.f;
#pragma unroll
            for (int t = 0; t < 4; ++t) if (t < ntn) { const float dm = mt[t] - mean; q += m2[t] + 256.0f * dm * dm; }
            S[row] = (f32x2v){mean, 1.0f / sqrtf(q / (256.0f * (float)ntn) + eps)};
        }
        asm volatile("s_waitcnt lgkmcnt(0)" ::: "memory"); __builtin_amdgcn_s_barrier(); asm volatile("" ::: "memory");
        return bad;
    }
};
struct EpiLnRes {
    static constexpr bool PERM = false, AFTER_DRAIN = true;
    const float* base; float* out; int ldc; const float* bias; PanelStats st; unsigned poison;
    __device__ __forceinline__ void refuse(size_t i0, size_t stride, int M, int N) const { const float q = __builtin_nanf(""); for (size_t i = i0; i < (size_t)M * N; i += stride) out[(i / N) * ldc + i % N] = q;
        if (i0 == 0) { unsigned expect = 0u; __hip_atomic_compare_exchange_strong(st.tmo + 1, &expect, 0x7f0u, __ATOMIC_RELAXED, __ATOMIC_RELAXED, __HIP_MEMORY_SCOPE_AGENT); __hip_atomic_store(st.tmo, 1u, __ATOMIC_RELAXED, __HIP_MEMORY_SCOPE_AGENT); } }
    __device__ __forceinline__ void fused(f32x4 (&acc)[2][2][4][2], const Unit& u, int wr, int wc, int fr, int fq, PG8_LAS unsigned char* lds, int wid, int lane) const {
        typedef float f32x2v __attribute__((ext_vector_type(2)));
        const PG8_LAS f32x2v* S = (const PG8_LAS f32x2v*)(lds + 8192);
        const int col0 = u.pn * BM + wc * 32 + 4 * fq;
#pragma unroll
        for (int bj = 0; bj < 2; ++bj)
#pragma unroll
            for (int n = 0; n < 2; ++n) { const f32x4 bv = bias ? *(const f32x4*)(bias + col0 + bj * HALF + n * 16) : (f32x4){0.f, 0.f, 0.f, 0.f};
#pragma unroll
                for (int ai = 0; ai < 2; ++ai)
#pragma unroll
                    for (int m = 0; m < 4; ++m) acc[ai][bj][m][n] += bv; }
        const bool bad = st.run(acc, u, wr, wc, fr, fq, lds, wid, lane) || poison != 0u;
        const float qnan = __builtin_nanf("");
#pragma unroll
        for (int ai = 0; ai < 2; ++ai)
#pragma unroll
            for (int m = 0; m < 4; ++m) { const int r = ai * HALF + wr * 64 + m * 16 + fr; const f32x2v sr = S[r]; const size_t off = (size_t)(u.pm * BM + r) * ldc + col0;
#pragma unroll
                for (int bj = 0; bj < 2; ++bj)
#pragma unroll
                    for (int n = 0; n < 2; ++n) { const f32x4 bs = *(const f32x4*)(base + off + bj * HALF + n * 16); f32x4 o = bs + (acc[ai][bj][m][n] - sr.x) * sr.y;
                        if (bad) o = (f32x4){qnan, qnan, qnan, qnan}; *(f32x4*)(out + off + bj * HALF + n * 16) = o; }
                asm volatile("" ::: "memory"); }
    }
};
struct EpiLnResLn {
    static constexpr bool PERM = false, AFTER_DRAIN = true;
    const float* base; float* out; bf16_t* xn; int ldc; const float* bias; PanelStats st1, st2; unsigned poison;
    __device__ __forceinline__ void refuse(size_t i0, size_t stride, int M, int N) const { const float q = __builtin_nanf(""); for (size_t i = i0; i < (size_t)M * N; i += stride) { const size_t o = (i / N) * ldc + i % N; out[o] = q; xn[o] = (bf16_t)0x7fc0u; }
        if (i0 == 0) { unsigned expect = 0u; __hip_atomic_compare_exchange_strong(st1.tmo + 1, &expect, 0x7f0u, __ATOMIC_RELAXED, __ATOMIC_RELAXED, __HIP_MEMORY_SCOPE_AGENT); __hip_atomic_store(st1.tmo, 1u, __ATOMIC_RELAXED, __HIP_MEMORY_SCOPE_AGENT); } }
    __device__ __forceinline__ void fused(f32x4 (&acc)[2][2][4][2], const Unit& u, int wr, int wc, int fr, int fq, PG8_LAS unsigned char* lds, int wid, int lane) const {
        typedef float f32x2v __attribute__((ext_vector_type(2))); typedef unsigned u32x2v __attribute__((ext_vector_type(2)));
        const PG8_LAS f32x2v* S = (const PG8_LAS f32x2v*)(lds + 8192);
        const int col0 = u.pn * BM + wc * 32 + 4 * fq;
#pragma unroll
        for (int bj = 0; bj < 2; ++bj)
#pragma unroll
            for (int n = 0; n < 2; ++n) { const f32x4 bv = bias ? *(const f32x4*)(bias + col0 + bj * HALF + n * 16) : (f32x4){0.f, 0.f, 0.f, 0.f};
#pragma unroll
                for (int ai = 0; ai < 2; ++ai)
#pragma unroll
                    for (int m = 0; m < 4; ++m) acc[ai][bj][m][n] += bv; }
        bool bad = st1.run(acc, u, wr, wc, fr, fq, lds, wid, lane) || poison != 0u;
        const float qnan = __builtin_nanf("");
#pragma unroll
        for (int ai = 0; ai < 2; ++ai)
#pragma unroll
            for (int m = 0; m < 4; ++m) { const int r = ai * HALF + wr * 64 + m * 16 + fr; const f32x2v sr = S[r]; const size_t off = (size_t)(u.pm * BM + r) * ldc + col0;
#pragma unroll
                for (int bj = 0; bj < 2; ++bj)
#pragma unroll
                    for (int n = 0; n < 2; ++n) { const f32x4 bs = *(const f32x4*)(base + off + bj * HALF + n * 16); acc[ai][bj][m][n] = bs + (acc[ai][bj][m][n] - sr.x) * sr.y; }
                asm volatile("" : "+v"(acc[ai][0][m][0]), "+v"(acc[ai][0][m][1]), "+v"(acc[ai][1][m][0]), "+v"(acc[ai][1][m][1]));
                if (m & 1) asm volatile("" ::: "memory"); }
        const bool bad1 = bad;
        bad = st2.run(acc, u, wr, wc, fr, fq, lds, wid, lane) || bad;
#pragma unroll
        for (int ai = 0; ai < 2; ++ai)
#pragma unroll
            for (int m = 0; m < 4; ++m) { const int r = ai * HALF + wr * 64 + m * 16 + fr; const f32x2v sr = S[r]; const size_t off = (size_t)(u.pm * BM + r) * ldc + col0;
#pragma unroll
                for (int bj = 0; bj < 2; ++bj)
#pragma unroll
                    for (int n = 0; n < 2; ++n) { const f32x4 x1 = acc[ai][bj][m][n]; *(f32x4*)(out + off + bj * HALF + n * 16) = bad1 ? (f32x4){qnan, qnan, qnan, qnan} : x1;
                        const f32x4 o = (x1 - sr.x) * sr.y; u32x2v w; w.x = cvt_pk_bf16(o[0], o[1]); w.y = cvt_pk_bf16(o[2], o[3]);
                        if (bad) { w.x = 0x7fc07fc0u; w.y = 0x7fc07fc0u; } *(u32x2v*)(xn + off + bj * HALF + n * 16) = w; }
                asm volatile("" ::: "memory"); }
    }
};

template <class Epi, class Sched, bool STAMP = false>
__device__ __forceinline__ void gemm_phase(PG8_LAS unsigned char* lds, const Gemm g, const Sched& S, const Epi& E, unsigned long long* stamps) {
    const int tid = threadIdx.x, wid = __builtin_amdgcn_readfirstlane(tid >> 6), lane = tid & 63, wr = wid >> 2, wc = wid & 3, fr = lane & 15, fq = lane >> 4;
    const int K = g.K, nt = K / BK;
    int ts_lo = 0, ts_hi = 0, nts = 0; const unsigned long long rt_entry = STAMP ? (unsigned long long)wall_clock64() : 0ull;
#define PG8_STAMP() do { if (STAMP && wid == 0 && nts < 64) { const unsigned long long _c = (unsigned long long)clock64(); \
        ts_lo = (lane == nts) ? (int)(unsigned)_c : ts_lo; ts_hi = (lane == nts) ? (int)(unsigned)(_c >> 32) : ts_hi; ++nts; } } while (0)
    PG8_STAMP();
    unsigned voffA[2], voffB[2];
#pragma unroll
    for (int i = 0; i < 2; ++i) { int R, C; stage_rc(tid * 16 + i * 8192, R, C); const int Rb = Epi::PERM ? ((R & ~31) + perm32(R & 31)) : R;
        voffA[i] = (unsigned)(R * K + C) * 2u; voffB[i] = (unsigned)(Rb * K + C) * 2u; }
    const size_t kstep = (size_t)(BK * 2);
    const size_t hstep = (size_t)HALF * K * 2;
    const size_t tstep = 2 * hstep;
    const unsigned ldsw = (unsigned)wid * 1024u;
    const int aoff = lds_byte(wr * 64 + fr, fq * 8), boff = lds_byte(wc * 32 + fr, fq * 8);
#define PG8_SA(b, h) (((b) * 2 + (h)) * HTB)
#define PG8_SB(b, h) ((4 + (b) * 2 + (h)) * HTB)
#define PG8_STAGE(bufoff, gbase, voff) do { _Pragma("unroll") for (int _i = 0; _i < 2; ++_i) \
        __builtin_amdgcn_global_load_lds((const unsigned*)((const char*)(gbase) + (voff)[_i]), (PG8_LAS unsigned*)(lds + (bufoff) + ldsw + _i * 8192), 16, 0, 0); } while (0)
#define PG8_LDA(dst, b, h) do { _Pragma("unroll") for (int m = 0; m < 4; ++m) _Pragma("unroll") for (int k = 0; k < 2; ++k) dst[m][k] = *(const PG8_LAS bf16x8*)(lds + PG8_SA(b, h) + aoff + m * 2048 + k * 1024); } while (0)
#define PG8_LDB(dst, b, h) do { _Pragma("unroll") for (int n = 0; n < 2; ++n) _Pragma("unroll") for (int k = 0; k < 2; ++k) dst[n][k] = *(const PG8_LAS bf16x8*)(lds + PG8_SB(b, h) + boff + n * 2048 + k * 1024); } while (0)
#define PG8_MMA(ai, bj, At, Bt) do { __builtin_amdgcn_s_setprio(1); _Pragma("unroll") for (int m = 0; m < 4; ++m) _Pragma("unroll") for (int n = 0; n < 2; ++n) _Pragma("unroll") for (int k = 0; k < 2; ++k) \
        acc[ai][bj][m][n] = __builtin_amdgcn_mfma_f32_16x16x32_bf16(Bt[n][k], At[m][k], acc[ai][bj][m][n], 0, 0, 0); __builtin_amdgcn_s_setprio(0); } while (0)
#define PG8_WAIT_V(n) asm volatile("s_waitcnt vmcnt(" #n ")" ::: "memory")
#define PG8_WAIT_L(n) asm volatile("s_waitcnt lgkmcnt(" #n ")" ::: "memory")
#define PG8_BAR __builtin_amdgcn_s_barrier()
#define PG8_SCHED __builtin_amdgcn_sched_barrier(0)
    Unit cur, nxt; int ui = 0;
    if (!S.next(0, cur)) return;
    f32x4 acc[2][2][4][2];
#pragma unroll
    for (int a = 0; a < 2; ++a)
#pragma unroll
        for (int b = 0; b < 2; ++b)
#pragma unroll
            for (int m = 0; m < 4; ++m)
#pragma unroll
                for (int n = 0; n < 2; ++n) acc[a][b][m][n] = (f32x4){0.f, 0.f, 0.f, 0.f};
    bf16x8 At[4][2], B0[2][2], B1[2][2];
    const char* cA = (const char*)g.A + (size_t)cur.pm * tstep; const char* cB = (const char*)g.Bt + (size_t)cur.pn * tstep;
    S.a_ready(cur);
    PG8_STAGE(PG8_SB(0, 0), cB, voffB); PG8_STAGE(PG8_SA(0, 0), cA, voffA); PG8_STAGE(PG8_SB(0, 1), cB + hstep, voffB); PG8_STAGE(PG8_SA(0, 1), cA + hstep, voffA);
    if (wr == 1) PG8_BAR;
    PG8_WAIT_V(4); PG8_BAR;
    PG8_STAGE(PG8_SB(1, 0), cB + kstep, voffB); PG8_STAGE(PG8_SA(1, 0), cA + kstep, voffA); PG8_STAGE(PG8_SB(1, 1), cB + hstep + kstep, voffB);
    PG8_WAIT_V(6); PG8_BAR;
    PG8_STAMP();
    for (;;) {
        const bool has_next = S.next(ui + 1, nxt);
        const char* nA = has_next ? (const char*)g.A + (size_t)nxt.pm * tstep : cA; const char* nB = has_next ? (const char*)g.Bt + (size_t)nxt.pn * tstep : cB;
        for (int t = 0; t < nt; t += 2) {
            const bool last = (t == nt - 2);
            const char* a1 = cA + (size_t)(t + 1) * kstep;
            const char* a2 = last ? nA : cA + (size_t)(t + 2) * kstep; const char* b2 = last ? nB : cB + (size_t)(t + 2) * kstep;
            const char* a3 = a2 + kstep; const char* b3 = b2 + kstep;
            if (last && has_next) S.a_ready(nxt);
            PG8_LDB(B0, 0, 0); PG8_SCHED; PG8_LDA(At, 0, 0); PG8_STAGE(PG8_SA(1, 1), a1 + hstep, voffA);
            PG8_WAIT_L(8); PG8_BAR; PG8_WAIT_L(0); PG8_MMA(0, 0, At, B0); PG8_BAR; PG8_SCHED;
            PG8_LDB(B1, 0, 1); PG8_STAGE(PG8_SB(0, 0), b2, voffB);
            PG8_BAR; PG8_WAIT_L(0); PG8_MMA(0, 1, At, B1); PG8_BAR;
            PG8_LDA(At, 0, 1); PG8_STAGE(PG8_SA(0, 0), a2, voffA);
            PG8_BAR; PG8_WAIT_L(0); PG8_MMA(1, 0, At, B0); PG8_BAR; PG8_SCHED;
            PG8_STAGE(PG8_SB(0, 1), b2 + hstep, voffB);
            PG8_WAIT_V(6); PG8_BAR; PG8_MMA(1, 1, At, B1); PG8_BAR;
            PG8_LDB(B0, 1, 0); PG8_SCHED; PG8_LDA(At, 1, 0); PG8_STAGE(PG8_SA(0, 1), a2 + hstep, voffA);
            PG8_WAIT_L(8); PG8_BAR; PG8_WAIT_L(0); PG8_MMA(0, 0, At, B0); PG8_BAR; PG8_SCHED;
            PG8_LDB(B1, 1, 1); PG8_STAGE(PG8_SB(1, 0), b3, voffB);
            PG8_BAR; PG8_WAIT_L(0); PG8_MMA(0, 1, At, B1); PG8_BAR;
            PG8_LDA(At, 1, 1); PG8_STAGE(PG8_SA(1, 0), a3, voffA);
            PG8_BAR; PG8_WAIT_L(0); PG8_MMA(1, 0, At, B0); PG8_BAR; PG8_SCHED;
            PG8_STAGE(PG8_SB(1, 1), b3 + hstep, voffB);
            PG8_WAIT_V(6); PG8_BAR; PG8_MMA(1, 1, At, B1); PG8_BAR;
        }
        PG8_STAMP();
        if constexpr (!Epi::AFTER_DRAIN) { E(acc, cur, wr, wc, fr, fq); S.done(cur); }
        PG8_STAMP();
        if (!has_next) break;
#pragma unroll
        for (int a = 0; a < 2; ++a)
#pragma unroll
            for (int b = 0; b < 2; ++b)
#pragma unroll
                for (int m = 0; m < 4; ++m)
#pragma unroll
                    for (int n = 0; n < 2; ++n) acc[a][b][m][n] = (f32x4){0.f, 0.f, 0.f, 0.f};
        cur = nxt; cA = nA; cB = nB; ++ui;
    }
    PG8_WAIT_V(0);
    if (wr == 0) PG8_BAR;
    PG8_BAR;
    if constexpr (Epi::AFTER_DRAIN) { E.fused(acc, cur, wr, wc, fr, fq, lds, wid, lane); S.done(cur); }
    PG8_STAMP();
    if (STAMP && wid == 0) { stamps[lane] = lane < nts ? (((unsigned long long)(unsigned)ts_hi << 32) | (unsigned)ts_lo) : 0ull;
        if (lane == 62) stamps[62] = rt_entry; if (lane == 63) stamps[63] = (unsigned long long)wall_clock64(); }
#undef PG8_STAMP
#undef PG8_SA
#undef PG8_SB
#undef PG8_STAGE
#undef PG8_LDA
#undef PG8_LDB
#undef PG8_MMA
#undef PG8_WAIT_V
#undef PG8_WAIT_L
#undef PG8_BAR
#undef PG8_SCHED
}
}

#include <hip/hip_cooperative_groups.h>
#include <cstdio>
namespace cg = cooperative_groups;
using pg8::bf16_t; using pg8::bf16x8; using pg8::f32x4; using pg8::Unit;
typedef float f32x16 __attribute__((ext_vector_type(16)));
typedef float f32x2 __attribute__((ext_vector_type(2)));
typedef unsigned u32x2 __attribute__((ext_vector_type(2)));
typedef unsigned u32x4v __attribute__((ext_vector_type(4)));
#define LAS __attribute__((address_space(3)))
#define XB_TMO      128
#define XB_XCNT(j)  (256  + 64 * (j))
#define XB_XSUB(j)  (1280 + 64 * (j))
#define XB_XGEN(j)  (2304 + 64 * (j))
#define XB_TOP      3328
#define XB_TOPGEN   3392
#define XCD_BAR_WORDS 3456
#define XB_SPIN_CAP (1u << 18)

__device__ __forceinline__ unsigned xb_ld(unsigned* p)              { return __hip_atomic_load(p, __ATOMIC_RELAXED, __HIP_MEMORY_SCOPE_AGENT); }
__device__ __forceinline__ unsigned xb_add(unsigned* p, unsigned v) { return __hip_atomic_fetch_add(p, v, __ATOMIC_RELAXED, __HIP_MEMORY_SCOPE_AGENT); }
__device__ __forceinline__ unsigned xb_xcc_id() { return (unsigned)__builtin_amdgcn_s_getreg((3 << 11) | 20) & 0xFu; }
#define XB_SPIN(cond, bar) do { unsigned _sp = 0; while (cond) { __builtin_amdgcn_s_sleep(1); \
    if ((++_sp & 255u) == 0u) { if (xb_ld(&(bar)[XB_TMO])) break; if (_sp > XB_SPIN_CAP) { atomicAdd(&(bar)[XB_TMO], 1u); break; } } } } while (0)

struct XcdBarrier {
    unsigned* bar; unsigned x;
    volatile LAS unsigned* st;
};

__device__ __forceinline__ XcdBarrier xcd_barrier_post(unsigned* bar, volatile LAS unsigned* st) {
    XcdBarrier b; b.bar = bar; b.x = xb_xcc_id(); b.st = st;
    if (threadIdx.x == 0) (void)xb_add(&bar[XB_XCNT(b.x)], 1u);
    return b;
}
__device__ __forceinline__ void xcd_barrier_complete(unsigned* bar, unsigned x, unsigned& nloc, unsigned& nx) {
    const unsigned G = gridDim.x * gridDim.y * gridDim.z;
    unsigned sum, cnt, mine, sp = 0u;
    for (;;) {
        sum = 0u; cnt = 0u; mine = 0u;
#pragma unroll
        for (unsigned j = 0; j < 16; ++j) { const unsigned c = xb_ld(&bar[XB_XCNT(j)]); sum += c; cnt += (c > 0u) ? 1u : 0u; mine = (j == x) ? c : mine; }
        if (sum == G) break;
        __builtin_amdgcn_s_sleep(1);
        if ((++sp & 255u) == 0u) { if (xb_ld(&bar[XB_TMO])) break; if (sp > XB_SPIN_CAP) { atomicAdd(&bar[XB_TMO], 1u); break; } }
    }
    nloc = mine > 0u ? mine : 1u; nx = cnt > 0u ? cnt : 1u;
}

__device__ __forceinline__ void xcd_barrier(const XcdBarrier& b) {
    asm volatile("s_waitcnt vmcnt(0)" ::: "memory");
    __syncthreads();
    if (threadIdx.x == 0) {
        unsigned* bar = b.bar;
        __builtin_amdgcn_s_waitcnt(0);
        unsigned nloc = b.st[0], nx = b.st[1];
        if (nloc == 0u) { xcd_barrier_complete(bar, b.x, nloc, nx); b.st[0] = nloc; b.st[1] = nx; }
        const unsigned old = xb_add(&bar[XB_XSUB(b.x)], 1u);
        const unsigned gen = old / nloc;
        if (old + 1u == (gen + 1u) * nloc) {
            __builtin_amdgcn_fence(__ATOMIC_RELEASE, "agent");
            asm volatile("s_waitcnt vmcnt(0)" ::: "memory");
            const unsigned og = xb_add(&bar[XB_TOP], 1u);
            const unsigned tg = og / nx;
            if (og + 1u == (tg + 1u) * nx) xb_add(&bar[XB_TOPGEN], 1u);
            else XB_SPIN(xb_ld(&bar[XB_TOPGEN]) == tg, bar);
            __builtin_amdgcn_fence(__ATOMIC_ACQUIRE, "agent");
            xb_add(&bar[XB_XGEN(b.x)], 1u);
            asm volatile("s_waitcnt vmcnt(0)" ::: "memory");
        } else {
            XB_SPIN(xb_ld(&bar[XB_XGEN(b.x)]) == gen, bar);
            __builtin_amdgcn_fence(__ATOMIC_ACQUIRE, "agent");
            asm volatile("s_waitcnt vmcnt(0)" ::: "memory");
        }
    }
    __syncthreads();
}

constexpr int MT = 16896, MPR = 16384, DM = 1024, NIN = 2816, DFF = 2816;
constexpr float EPS = 1e-6f;
constexpr int LDS_BYTES = 143360;
#ifndef N_LAUNCH_MODE
#define N_LAUNCH_MODE 1
#endif
constexpr int NPHASE = 13;
#ifndef EXTRA_LO
#define EXTRA_LO 0
#endif
#ifndef EXTRA_FLAGS
#define EXTRA_FLAGS 0
#endif
#ifndef EXTRA_HI
#define EXTRA_HI 0
#endif

constexpr size_t WS_WIN = 0;
constexpr size_t WS_WOUT = WS_WIN + (size_t)2816 * 1024 * 2;
constexpr size_t WS_WQ = WS_WOUT + (size_t)1024 * 1024 * 2;
constexpr size_t WS_WKV = WS_WQ + (size_t)1024 * 1024 * 2;
constexpr size_t WS_WO = WS_WKV + (size_t)2048 * 1024 * 2;
constexpr size_t WS_WGU = WS_WO + (size_t)1024 * 1024 * 2;
constexpr size_t WS_WD = WS_WGU + (size_t)5632 * 1024 * 2;
constexpr size_t WS_A = WS_WD + (size_t)1024 * 2816 * 2;
constexpr size_t WS_MN = WS_A + (size_t)MT * 1024 * 2;
constexpr size_t WS_MKB = WS_MN + (size_t)2048 * 1024 * 2;
constexpr size_t WS_MVT = WS_MKB + (size_t)2048 * 1024 * 2;
constexpr size_t WS_P = WS_MVT + (size_t)2048 * 1024 * 2;
constexpr size_t WS_U = WS_P + (size_t)MT * 2816 * 2;
constexpr size_t WS_DS = WS_U;
constexpr size_t WS_ST = WS_DS + (size_t)1024 * 8192 * 4;
constexpr size_t WS_AF = WS_ST + (size_t)1024 * 8192 * 2;
constexpr size_t WS_DEC = WS_AF + (size_t)MT * 16 * 4;
constexpr size_t WS_BQ = WS_DEC + (size_t)1024 * 64 * 4;
constexpr size_t WS_H = WS_U + (size_t)MT * 2816 * 2;
constexpr size_t WS_HB = WS_H + (size_t)MT * 1024 * 4;
constexpr size_t WS_SSQ = WS_HB + (size_t)MT * 1024 * 2;
constexpr size_t WS_SSQS = WS_SSQ + (size_t)3 * MT * 16 * 4;
constexpr size_t WS_BAR = WS_SSQS + (size_t)3 * 512 * 64 * 4;
constexpr size_t WS_GX = WS_BAR + (size_t)2 * XCD_BAR_WORDS * 4;
constexpr size_t WS_UX = WS_GX + (size_t)256 * 4 * 2816 * 4;
constexpr size_t WS_END = WS_UX + (size_t)256 * 2 * 2816 * 4;

constexpr size_t O_Y = 0;
constexpr size_t O_SGP = 17301504;
constexpr size_t O_SCP = 17563648;
constexpr size_t O_MK = 17608704;
constexpr size_t O_MV = 19705856;
constexpr size_t O_SGS = 21803008;
constexpr size_t O_SCS = 25997312;
constexpr size_t O_SV = 26718208;

struct Params { const float* in[29]; float* out; unsigned char* ws; int ph_lo, ph_hi, bar_region, pad; };

__device__ __forceinline__ unsigned pk2(float lo, float hi) { return pg8::cvt_pk_bf16(lo, hi); }
__device__ __forceinline__ bf16_t f2bf(float f) { return (bf16_t)(pk2(f, 0.f) & 0xffffu); }
__device__ __forceinline__ float bf2f(bf16_t b) { return __uint_as_float(((unsigned)b) << 16); }
__device__ __forceinline__ float bflo(unsigned w) { return __uint_as_float(w << 16); }
__device__ __forceinline__ float bfhi(unsigned w) { return __uint_as_float(w & 0xffff0000u); }
__device__ __forceinline__ float gelu_t(float x) { const float t = __builtin_fmaf(x * x, 0.044715f, 1.0f); const float e = __builtin_amdgcn_exp2f(x * t * -2.3022082f); return x * __builtin_amdgcn_rcpf(1.0f + e); }
__device__ __forceinline__ float silu_f(float x) { return x * __builtin_amdgcn_rcpf(1.0f + __builtin_amdgcn_exp2f(x * -1.44269504f)); }
__device__ __forceinline__ float logsig(float z) { return fminf(z, 0.f) - __logf(1.0f + __expf(-fabsf(z))); }
template <int CTRL> __device__ __forceinline__ float dppr(float x) { return __builtin_bit_cast(float, __builtin_amdgcn_update_dpp(0, __builtin_bit_cast(int, x), CTRL, 0xf, 0xf, true)); }
__device__ __forceinline__ float row_sum16(float s) { s += dppr<0x128>(s); s += dppr<0x124>(s); s += dppr<0x122>(s); s += dppr<0x121>(s); return s; }
__device__ __forceinline__ float wave_sum(float s) { s = row_sum16(s); s += __shfl_xor(s, 16); s += __shfl_xor(s, 32); return s; }
__device__ __forceinline__ float wave_max(float s) { for (int o = 32; o >= 1; o >>= 1) s = fmaxf(s, __shfl_xor(s, o)); return s; }
__device__ __forceinline__ f32x16 mma32(bf16x8 a, bf16x8 b, f32x16 c) { return __builtin_amdgcn_mfma_f32_32x32x16_bf16(a, b, c, 0, 0, 0); }
__device__ __forceinline__ f32x16 zero16() { f32x16 z; for (int i = 0; i < 16; ++i) z[i] = 0.f; return z; }
__device__ __forceinline__ float row_rs(const float* ssq, int row) {
    const f32x4* p = (const f32x4*)(ssq + (size_t)row * 16); f32x4 a = p[0], b = p[1], c = p[2], d = p[3];
    const float s = ((a[0] + a[1]) + (a[2] + a[3])) + ((b[0] + b[1]) + (b[2] + b[3])) + ((c[0] + c[1]) + (c[2] + c[3])) + ((d[0] + d[1]) + (d[2] + d[3]));
    return rsqrtf(s * (1.0f / 1024.0f) + EPS);
}

__device__ __forceinline__ float row_rs64(const float* ssq64, int r) {
    const f32x4* p = (const f32x4*)(ssq64 + (size_t)r * 64); float s = 0.f;
#pragma unroll
    for (int i = 0; i < 16; ++i) { const f32x4 a = p[i]; s += (a[0] + a[1]) + (a[2] + a[3]); }
    return rsqrtf(s * (1.0f / 1024.0f) + EPS);
}
__device__ __forceinline__ float row_rs2(const float* ssq16, const float* ssq64, int row) { return row < MPR ? row_rs(ssq16, row) : row_rs64(ssq64, row - MPR); }
template <int KC, class F>
__device__ __forceinline__ void gemm_small(const bf16_t* A, const bf16_t* Bt, int K, int ncb, LAS unsigned char* lds, F f) {
    constexpr int PITCH = KC * 2 + 16, PPR = KC / 8, NP = 96 * PPR, NPT = (NP + 511) / 512, BUF = 96 * PITCH; static_assert(KC % 32 == 0 && 2 * BUF <= 140000, "KC must be a multiple of the MFMA K; two buffers must fit");
    const int tid = threadIdx.x, lane = tid & 63, wave = tid >> 6, fr = lane & 15, fq = lane >> 4;
    for (int t = blockIdx.x; t < 16 * ncb; t += gridDim.x) { const int rb = t & 15, cb = t >> 4;
        f32x4 acc = (f32x4){0.f, 0.f, 0.f, 0.f};
        u32x4v v[NPT]; const bf16_t* src[NPT]; int dsto[NPT];
#pragma unroll
        for (int i = 0; i < NPT; ++i) { const int idx = tid + 512 * i, row = idx / PPR, pc = idx % PPR;
            src[i] = (row < 32 ? A + (size_t)(rb * 32 + row) * K : Bt + (size_t)(cb * 64 + row - 32) * K) + pc * 8; dsto[i] = row * PITCH + pc * 16;
            if (idx < NP) v[i] = *(const u32x4v*)(src[i]); }
        int buf = 0;
        for (int k0 = 0; k0 < K; k0 += KC) {
            LAS unsigned char* L = lds + buf * BUF;
#pragma unroll
            for (int i = 0; i < NPT; ++i) { const int idx = tid + 512 * i; if (idx < NP) *(LAS u32x4v*)(L + dsto[i]) = v[i]; }
            __syncthreads();
            if (k0 + KC < K) {
#pragma unroll
                for (int i = 0; i < NPT; ++i) { const int idx = tid + 512 * i; if (idx < NP) v[i] = *(const u32x4v*)(src[i] + k0 + KC); } }
            const LAS unsigned char* ap = L + ((wave & 1) * 16 + fr) * PITCH + fq * 16; const LAS unsigned char* bp = L + (32 + (wave >> 1) * 16 + fr) * PITCH + fq * 16;
#pragma unroll
            for (int k = 0; k < KC; k += 32) { const bf16x8 av = *(const LAS bf16x8*)(ap + k * 2); const bf16x8 bv = *(const LAS bf16x8*)(bp + k * 2);
                acc = __builtin_amdgcn_mfma_f32_16x16x32_bf16(bv, av, acc, 0, 0, 0); }
            buf ^= 1;
            __syncthreads();
        }
        __syncthreads();
        f(rb * 32 + (wave & 1) * 16 + fr, cb * 64 + (wave >> 1) * 16 + 4 * fq, cb * 4 + (wave >> 1), fq, acc);
    }
}
#define EPI_LOOP_ROWS for (int ai = 0; ai < 2; ++ai) _Pragma("unroll") for (int m = 0; m < 4; ++m)
__device__ __forceinline__ u32x4v pack8(const f32x4 a, const f32x4 c) { u32x4v w; w.x = pk2(a[0], a[1]); w.y = pk2(a[2], a[3]); w.z = pk2(c[0], c[1]); w.w = pk2(c[2], c[3]); return w; }
__device__ __forceinline__ float sq4(const f32x4 v) { return (v[0] * v[0] + v[1] * v[1]) + (v[2] * v[2] + v[3] * v[3]); }
template <int CTRL> __device__ __forceinline__ float dpp_f(float x) { return __builtin_bit_cast(float, __builtin_amdgcn_update_dpp(0, __builtin_bit_cast(int, x), CTRL, 0xf, 0xf, true)); }
template <int CTRL> __device__ __forceinline__ f32x4 dpp4(const f32x4 v) { return (f32x4){dpp_f<CTRL>(v[0]), dpp_f<CTRL>(v[1]), dpp_f<CTRL>(v[2]), dpp_f<CTRL>(v[3])}; }
__device__ __forceinline__ f32x4 gelu4(const f32x4 v) { return (f32x4){gelu_t(v[0]), gelu_t(v[1]), gelu_t(v[2]), gelu_t(v[3])}; }
__device__ __forceinline__ void rs_rows8(float (&rsv)[2][4], const float* ssq, int row0, int fq) {
    f32x4 q[2][4];
#pragma unroll
    for (int ai = 0; ai < 2; ++ai)
#pragma unroll
        for (int m = 0; m < 4; ++m) q[ai][m] = *(const f32x4*)(ssq + (size_t)(row0 + ai * 128 + m * 16) * 16 + 4 * fq);
#pragma unroll
    for (int ai = 0; ai < 2; ++ai)
#pragma unroll
        for (int m = 0; m < 4; ++m) { float t = (q[ai][m][0] + q[ai][m][1]) + (q[ai][m][2] + q[ai][m][3]); t += __shfl_xor(t, 16); t += __shfl_xor(t, 32); rsv[ai][m] = rsqrtf(t * (1.0f / 1024.0f) + EPS); }
}
__device__ __forceinline__ void rs_rows8_s(float (&rsv)[2][4], const float* ssq64, int r0, int fq) {
#pragma unroll
    for (int ai = 0; ai < 2; ++ai) { f32x4 q[4][4];
#pragma unroll
        for (int m = 0; m < 4; ++m) { const f32x4* pp = (const f32x4*)(ssq64 + (size_t)(r0 + ai * 128 + m * 16) * 64 + 16 * fq); q[m][0] = pp[0]; q[m][1] = pp[1]; q[m][2] = pp[2]; q[m][3] = pp[3]; }
#pragma unroll
        for (int m = 0; m < 4; ++m) { const f32x4 v = (q[m][0] + q[m][1]) + (q[m][2] + q[m][3]); float t = (v[0] + v[1]) + (v[2] + v[3]); t += __shfl_xor(t, 16); t += __shfl_xor(t, 32); rsv[ai][m] = rsqrtf(t * (1.0f / 1024.0f) + EPS); } }
}
struct EpiIn {
    static constexpr bool PERM = true, AFTER_DRAIN = false;
    bf16_t* P; float* af;
    __device__ __forceinline__ void operator()(const f32x4 (&acc)[2][2][4][2], const Unit& u, int wr, int wc, int fr, int fq) const {
        const int row0 = u.pm * 256 + wr * 64 + fr, col0 = u.pn * 256 + wc * 32 + 8 * fq;
#pragma unroll
        EPI_LOOP_ROWS { const int row = row0 + ai * 128 + m * 16;
#pragma unroll
            for (int bj = 0; bj < 2; ++bj) *(u32x4v*)(P + (size_t)row * NIN + col0 + bj * 128) = pack8(acc[ai][bj][m][0], acc[ai][bj][m][1]);
        }
    }
};
struct EpiKV {
    static constexpr bool PERM = true, AFTER_DRAIN = false;
    float* omk; float* omv; bf16_t* mkb; bf16_t* mvt;
    __device__ __forceinline__ void operator()(const f32x4 (&acc)[2][2][4][2], const Unit& u, int wr, int wc, int fr, int fq) const {
        const int row0 = u.pm * 256 + wr * 64 + fr, col0 = u.pn * 256 + wc * 32 + 8 * fq;
#pragma unroll
        EPI_LOOP_ROWS { const int row = row0 + ai * 128 + m * 16;
#pragma unroll
            for (int bj = 0; bj < 2; ++bj) { const f32x4 v0 = acc[ai][bj][m][0], v1 = acc[ai][bj][m][1]; const int col = col0 + bj * 128;
                if (col < 1024) { float* o = omk + (size_t)row * 1024 + col; *(f32x4*)o = v0; *(f32x4*)(o + 4) = v1; *(u32x4v*)(mkb + (size_t)row * 1024 + col) = pack8(v0, v1); }
                else { const int c2 = col - 1024; float* o = omv + (size_t)row * 1024 + c2; *(f32x4*)o = v0; *(f32x4*)(o + 4) = v1;
                    const int b = row >> 8, mt = row & 255, h = c2 >> 8, d = c2 & 255; bf16_t* t = mvt + ((size_t)(b * 4 + h) * 256 + d) * 256 + mt;
                    t[0] = f2bf(v0[0]); t[256] = f2bf(v0[1]); t[512] = f2bf(v0[2]); t[768] = f2bf(v0[3]); t[1024] = f2bf(v1[0]); t[1280] = f2bf(v1[1]); t[1536] = f2bf(v1[2]); t[1792] = f2bf(v1[3]); } }
        }
    }
};
__device__ __forceinline__ void unpack8(const u32x4v w, f32x4& a, f32x4& c) { a = (f32x4){bflo(w.x), bfhi(w.x), bflo(w.y), bfhi(w.y)}; c = (f32x4){bflo(w.z), bfhi(w.z), bflo(w.w), bfhi(w.w)}; }
struct EpiRes {
    static constexpr bool PERM = true, AFTER_DRAIN = false;
    const float* xf; bf16_t* hb; float* ssq;
    __device__ __forceinline__ void operator()(const f32x4 (&acc)[2][2][4][2], const Unit& u, int wr, int wc, int fr, int fq) const {
        const int row0 = u.pm * 256 + wr * 64 + fr, col0 = u.pn * 256 + wc * 32 + 8 * fq;
#pragma unroll
        for (int h2 = 0; h2 < 4; ++h2) { const int ai = h2 >> 1, mb = (h2 & 1) * 2;
            f32x4 bs[2][2][2];
            if (xf) {
#pragma unroll
                for (int mm = 0; mm < 2; ++mm)
#pragma unroll
                    for (int bj = 0; bj < 2; ++bj) { const float* pb = xf + (size_t)(row0 + ai * 128 + (mb + mm) * 16) * 1024 + col0 + bj * 128; bs[mm][bj][0] = *(const f32x4*)pb; bs[mm][bj][1] = *(const f32x4*)(pb + 4); }
            } else { u32x4v raw[2][2];
#pragma unroll
                for (int mm = 0; mm < 2; ++mm)
#pragma unroll
                    for (int bj = 0; bj < 2; ++bj) raw[mm][bj] = *(const u32x4v*)(hb + (size_t)(row0 + ai * 128 + (mb + mm) * 16) * 1024 + col0 + bj * 128);
#pragma unroll
                for (int mm = 0; mm < 2; ++mm)
#pragma unroll
                    for (int bj = 0; bj < 2; ++bj) unpack8(raw[mm][bj], bs[mm][bj][0], bs[mm][bj][1]); }
#pragma unroll
            for (int mm = 0; mm < 2; ++mm) { const int m = mb + mm, row = row0 + ai * 128 + m * 16; float s = 0.f;
#pragma unroll
                for (int bj = 0; bj < 2; ++bj) { const f32x4 v0 = acc[ai][bj][m][0] + bs[mm][bj][0], v1 = acc[ai][bj][m][1] + bs[mm][bj][1];
                    *(u32x4v*)(hb + (size_t)row * 1024 + col0 + bj * 128) = pack8(v0, v1); s += sq4(v0) + sq4(v1); }
                s += __shfl_xor(s, 16); s += __shfl_xor(s, 32);
                if (fq == 0) ssq[(size_t)row * 16 + u.pn * 4 + wc] = s; }
        }
    }
};
#define RLXA __ATOMIC_RELAXED, __HIP_MEMORY_SCOPE_AGENT
__device__ __forceinline__ void ld_coh16x4(f32x4& a, f32x4& b_, f32x4& c, f32x4& d, const float* pa, const float* pb, const float* pc, const float* pd) {
    asm volatile("global_load_dwordx4 %0, %4, off sc1\n\tglobal_load_dwordx4 %1, %5, off sc1\n\tglobal_load_dwordx4 %2, %6, off sc1\n\tglobal_load_dwordx4 %3, %7, off sc1\n\ts_waitcnt vmcnt(0)"
                 : "=&v"(a), "=&v"(b_), "=&v"(c), "=&v"(d) : "v"(pa), "v"(pb), "v"(pc), "v"(pd) : "memory");
}
__device__ __forceinline__ void spin_poll(unsigned* cnt, unsigned want) {
    unsigned sp = 0; while ((unsigned)__builtin_amdgcn_readfirstlane(__hip_atomic_load(cnt, RLXA)) < want) { __builtin_amdgcn_s_sleep(2); if (++sp > (1u << 22)) break; }
}
__device__ __forceinline__ void wg_wait2(unsigned* c1, unsigned w1, unsigned* c2, unsigned w2) {
    if (threadIdx.x < 64) { spin_poll(c1, w1); if (c2) spin_poll(c2, w2); __builtin_amdgcn_fence(__ATOMIC_ACQUIRE, "agent"); asm volatile("s_waitcnt vmcnt(0)" ::: "memory"); }
    __syncthreads();
}
struct EpiFin {
    static constexpr bool PERM = true, AFTER_DRAIN = true;
    const bf16_t* hb; float* ssq; unsigned* cnt; const float* gfin; float* out; int flags;
    const bf16_t* sA; const bf16_t* sBt; float* ssq64;
    __device__ __forceinline__ void fused(f32x4 (&acc)[2][2][4][2], const Unit& u, int wr, int wc, int fr, int fq, LAS unsigned char* lds_, int wid_, int lane_) const {
        const int row0 = u.pm * 256 + wr * 64 + fr, col0 = u.pn * 256 + wc * 32 + 8 * fq;
#pragma unroll
        for (int ai = 0; ai < 2; ++ai) { u32x4v raw[4][2];
#pragma unroll
            for (int m = 0; m < 4; ++m)
#pragma unroll
                for (int bj = 0; bj < 2; ++bj) raw[m][bj] = *(const u32x4v*)(hb + (size_t)(row0 + ai * 128 + m * 16) * 1024 + col0 + bj * 128);
#pragma unroll
            for (int m = 0; m < 4; ++m) { const int row = row0 + ai * 128 + m * 16; float s = 0.f;
#pragma unroll
                for (int bj = 0; bj < 2; ++bj) { f32x4 b0, b1; unpack8(raw[m][bj], b0, b1);
                    acc[ai][bj][m][0] += b0; acc[ai][bj][m][1] += b1; s += sq4(acc[ai][bj][m][0]) + sq4(acc[ai][bj][m][1]); }
                s += __shfl_xor(s, 16); s += __shfl_xor(s, 32);
                if (fq == 0) __hip_atomic_store((unsigned*)(ssq + (size_t)row * 16 + u.pn * 4 + wc), __float_as_uint(s), RLXA); }
        }
        asm volatile("s_waitcnt vmcnt(0)" ::: "memory");
        if ((threadIdx.x & 63) == 0) __hip_atomic_fetch_add(cnt + u.pm, 1u, RLXA);
        f32x4 sv = (f32x4){0.f, 0.f, 0.f, 0.f}; int sr = -1, sc = 0; unsigned* scw = cnt;
        { const bf16_t* hbs = hb + (size_t)MPR * 1024; float* sq = ssq64; unsigned* cnt2 = cnt + 64;
          gemm_small<256>(sA, sBt, 2816, 16, lds_, [&](int r, int c, int cb, int fq2, f32x4 a) {
              const size_t off = (size_t)r * 1024 + c; const u32x2 hw = *(const u32x2*)(hbs + off); const f32x4 v = a + (f32x4){bflo(hw.x), bfhi(hw.x), bflo(hw.y), bfhi(hw.y)};
              float s = sq4(v); s += __shfl_xor(s, 16); s += __shfl_xor(s, 32); if (fq2 == 0) __hip_atomic_store((unsigned*)(sq + (size_t)r * 64 + cb), __float_as_uint(s), RLXA);
              asm volatile("s_waitcnt vmcnt(0)" ::: "memory");
              scw = cnt2 + (r >> 5); if ((threadIdx.x & 63) == 0) __hip_atomic_fetch_add(scw, 1u, RLXA);
              sv = v; sr = r; sc = c; }); }
        wg_wait2(cnt + u.pm, 32u, sr >= 0 ? scw : nullptr, 128u);
        f32x4 g[2][2];
#pragma unroll
        for (int bj = 0; bj < 2; ++bj) { g[bj][0] = *(const f32x4*)(gfin + col0 + bj * 128); g[bj][1] = *(const f32x4*)(gfin + col0 + bj * 128 + 4); }
        f32x4 pq[2][4];
#pragma unroll
        for (int ai = 0; ai < 2; ++ai) { const float* b0 = ssq + (size_t)(row0 + ai * 128) * 16 + 4 * fq; ld_coh16x4(pq[ai][0], pq[ai][1], pq[ai][2], pq[ai][3], b0, b0 + 16 * 16, b0 + 32 * 16, b0 + 48 * 16); }
#pragma unroll
        EPI_LOOP_ROWS { const int row = row0 + ai * 128 + m * 16; const f32x4 q4 = pq[ai][m];
            float s = (q4[0] + q4[1]) + (q4[2] + q4[3]);
            s += __shfl_xor(s, 16); s += __shfl_xor(s, 32); const float rs = rsqrtf(s * (1.0f / 1024.0f) + EPS);
#pragma unroll
            for (int bj = 0; bj < 2; ++bj) { float* o = out + (size_t)row * 1024 + col0 + bj * 128; *(f32x4*)o = acc[ai][bj][m][0] * rs * g[bj][0]; *(f32x4*)(o + 4) = acc[ai][bj][m][1] * rs * g[bj][1]; }
        }
        if (sr >= 0) {

            const float* sp = ssq64 + (size_t)sr * 64 + 16 * fq; f32x4 q0, q1, q2, q3; ld_coh16x4(q0, q1, q2, q3, sp, sp + 4, sp + 8, sp + 12);
            const f32x4 qs = (q0 + q1) + (q2 + q3); float t = (qs[0] + qs[1]) + (qs[2] + qs[3]);
            t += __shfl_xor(t, 16); t += __shfl_xor(t, 32); const float rs = rsqrtf(t * (1.0f / 1024.0f) + EPS);
            *(f32x4*)(out + (size_t)(MPR + sr) * 1024 + sc) = sv * rs * *(const f32x4*)(gfin + sc);
        }
    }
};
struct EpiQ {
    static constexpr bool PERM = true, AFTER_DRAIN = false;
    bf16_t* Q; const float* ssq;
    __device__ __forceinline__ void operator()(const f32x4 (&acc)[2][2][4][2], const Unit& u, int wr, int wc, int fr, int fq) const {
        const int row0 = u.pm * 256 + wr * 64 + fr, col0 = u.pn * 256 + wc * 32 + 8 * fq;
        float rsv[2][4]; rs_rows8(rsv, ssq, row0, fq);
#pragma unroll
        EPI_LOOP_ROWS { const int row = row0 + ai * 128 + m * 16; const float rs = rsv[ai][m];
#pragma unroll
            for (int bj = 0; bj < 2; ++bj) *(u32x4v*)(Q + (size_t)row * 1024 + col0 + bj * 128) = pack8(acc[ai][bj][m][0] * rs, acc[ai][bj][m][1] * rs);
        }
    }
};
struct EpiGU {
    static constexpr bool PERM = true, AFTER_DRAIN = false;
    bf16_t* U; const float* ssq; const float* ssq64; float* scp; float* scs; const float* cw; const float* cbias; const float* sconv; float* GX; float* UX; int flags;
    __device__ __forceinline__ void operator()(const f32x4 (&acc)[2][2][4][2], const Unit& u, int wr, int wc, int fr, int fq) const {
        const int row0 = u.pm * 256 + wr * 64 + fr, ch0 = u.pn * 128 + wc * 32 + 8 * fq;
        if (flags & 48) {
            if (flags & 16) {
#pragma unroll
                EPI_LOOP_ROWS { const int row = row0 + ai * 128 + m * 16; *(u32x4v*)(U + (size_t)row * DFF + ch0) = pack8(acc[ai][0][m][0] * acc[ai][1][m][0], acc[ai][0][m][1] * acc[ai][1][m][1]); } }
            return; }
        float rsv[2][4]; if (u.pm < 64) rs_rows8(rsv, ssq, row0, fq); else rs_rows8_s(rsv, ssq64, row0 - MPR, fq);
        f32x4 w0[2], w1[2], w2[2], bb[2];
#pragma unroll
        for (int n = 0; n < 2; ++n) { w0[n] = *(const f32x4*)(cw + ch0 + 4 * n); w1[n] = *(const f32x4*)(cw + DFF + ch0 + 4 * n); w2[n] = *(const f32x4*)(cw + 2 * DFF + ch0 + 4 * n); bb[n] = *(const f32x4*)(cbias + ch0 + 4 * n); }
        if (u.pm < 64) {
#pragma unroll
            for (int ai = 0; ai < 2; ++ai) { f32x4 pr1[2], pr2[2];
#pragma unroll
                for (int n = 0; n < 2; ++n) { pr1[n] = (f32x4){0.f, 0.f, 0.f, 0.f}; pr2[n] = pr1[n]; }
#pragma unroll
                for (int m = 0; m < 4; ++m) { const int row = row0 + ai * 128 + m * 16; const float rs = rsv[ai][m]; const int t = row & 2047, t6 = row & 63;
                    f32x4 a[2];
#pragma unroll
                    for (int n = 0; n < 2; ++n) { const f32x4 g = acc[ai][0][m][n] * rs, up = acc[ai][1][m][n] * rs; const f32x4 r1 = dpp4<0x121>(g), r2 = dpp4<0x122>(g);
                        const f32x4 p1 = fr >= 1 ? r1 : pr1[n], p2 = fr >= 2 ? r2 : pr2[n]; pr1[n] = r1; pr2[n] = r2;
                        a[n] = gelu4(bb[n] + w0[n] * p2 + w1[n] * p1 + w2[n] * g) * up;
                        if (t >= 2046) *(f32x4*)(scp + (size_t)((row >> 11) * 2 + (t - 2046)) * DFF + ch0 + 4 * n) = g;
                        if (t6 < 2) { *(f32x4*)(GX + ((size_t)(row >> 6) * 4 + t6) * DFF + ch0 + 4 * n) = g; *(f32x4*)(UX + ((size_t)(row >> 6) * 2 + t6) * DFF + ch0 + 4 * n) = up; }
                        if (t6 >= 62) *(f32x4*)(GX + ((size_t)(row >> 6) * 4 + (t6 - 60)) * DFF + ch0 + 4 * n) = g; }
                    *(u32x4v*)(U + (size_t)row * DFF + ch0) = pack8(a[0], a[1]); } }
        } else {
            const int tt = fr & 3;
#pragma unroll
            EPI_LOOP_ROWS { const int row = row0 + ai * 128 + m * 16, r2i = row - MPR, bq = r2i >> 2; const float rs = rsv[ai][m];
                f32x4 a[2];
#pragma unroll
                for (int n = 0; n < 2; ++n) { const f32x4 g = acc[ai][0][m][n] * rs, up = acc[ai][1][m][n] * rs; const f32x4 r1 = dpp4<0x121>(g), r2 = dpp4<0x122>(g);
                    f32x4 p1 = r1, p2 = r2;
                    if (tt < 2) { const f32x4 s1 = *(const f32x4*)(sconv + (size_t)(bq * 2 + 1) * DFF + ch0 + 4 * n); if (tt == 0) { p1 = s1; p2 = *(const f32x4*)(sconv + (size_t)(bq * 2) * DFF + ch0 + 4 * n); } else p2 = s1; }
                    a[n] = gelu4(bb[n] + w0[n] * p2 + w1[n] * p1 + w2[n] * g) * up;
                    if (tt >= 2) *(f32x4*)(scs + (size_t)(bq * 2 + (tt - 2)) * DFF + ch0 + 4 * n) = g; }
                *(u32x4v*)(U + (size_t)row * DFF + ch0) = pack8(a[0], a[1]); }
        }
    }
};
__device__ __forceinline__ void act_fixup(const Params& p, int pm) {
    const float* GX = (const float*)(p.ws + WS_GX); const float* UX = (const float*)(p.ws + WS_UX); bf16_t* U = (bf16_t*)(p.ws + WS_U); const float* cw = p.in[25]; const float* cbias = p.in[26];
    for (int i0 = threadIdx.x; i0 < 4 * 704; i0 += 1024) {
        f32x4 w0[2], w1[2], w2[2], bb[2], g0[2], g1[2], u0[2], u1[2], gm2[2], gm1[2]; int t0v[2], chv[2]; bool ok[2];
#pragma unroll
        for (int k = 0; k < 2; ++k) { const int i = i0 + 512 * k; ok[k] = i < 4 * 704; const int ii = ok[k] ? i : i0; const int q = ii / 704, ch = (ii % 704) * 4, blk = pm * 4 + q, t0 = blk * 64; t0v[k] = t0; chv[k] = ch;
            w0[k] = *(const f32x4*)(cw + ch); w1[k] = *(const f32x4*)(cw + DFF + ch); w2[k] = *(const f32x4*)(cw + 2 * DFF + ch); bb[k] = *(const f32x4*)(cbias + ch);
            g0[k] = *(const f32x4*)(GX + ((size_t)blk * 4 + 0) * DFF + ch); g1[k] = *(const f32x4*)(GX + ((size_t)blk * 4 + 1) * DFF + ch);
            u0[k] = *(const f32x4*)(UX + ((size_t)blk * 2 + 0) * DFF + ch); u1[k] = *(const f32x4*)(UX + ((size_t)blk * 2 + 1) * DFF + ch);
            gm2[k] = (f32x4){0.f, 0.f, 0.f, 0.f}; gm1[k] = gm2[k];
            if ((t0 & 2047) != 0) { gm2[k] = *(const f32x4*)(GX + ((size_t)(blk - 1) * 4 + 2) * DFF + ch); gm1[k] = *(const f32x4*)(GX + ((size_t)(blk - 1) * 4 + 3) * DFF + ch); } }
#pragma unroll
        for (int k = 0; k < 2; ++k) if (ok[k]) {
            const f32x4 a0 = gelu4(bb[k] + w0[k] * gm2[k] + w1[k] * gm1[k] + w2[k] * g0[k]) * u0[k], a1 = gelu4(bb[k] + w0[k] * gm1[k] + w1[k] * g0[k] + w2[k] * g1[k]) * u1[k];
            u32x2 o0, o1; o0.x = pk2(a0[0], a0[1]); o0.y = pk2(a0[2], a0[3]); o1.x = pk2(a1[0], a1[1]); o1.y = pk2(a1[2], a1[3]);
            *(u32x2*)(U + (size_t)t0v[k] * DFF + chv[k]) = o0; *(u32x2*)(U + (size_t)(t0v[k] + 1) * DFF + chv[k]) = o1; }
    }
}

__device__ __forceinline__ int win_src_col(int n) { return n < 1536 ? n : (n < 2560 ? n + 16 : (n < 2576 ? n - 1024 : -1)); }
__device__ __forceinline__ void tr_strip(LAS float* T, const float* src, int ldn, bf16_t* dst, int K, int k0, int n0, const float* ksc, bool cmap, int rmode) {
    const int tid = threadIdx.x;
    f32x4 v[8];
    { const int n4 = (tid & 63) * 4; int sc = n0 + n4; if (cmap) sc = win_src_col(sc);
#pragma unroll
      for (int i = 0; i < 8; ++i) { const int kk = (tid >> 6) + 8 * i; v[i] = (f32x4){0.f, 0.f, 0.f, 0.f}; if (sc >= 0) v[i] = *(const f32x4*)(src + (size_t)(k0 + kk) * ldn + sc); }
#pragma unroll
      for (int i = 0; i < 8; ++i) { const int kk = (tid >> 6) + 8 * i; f32x4 w = v[i]; if (ksc) w = w * ksc[k0 + kk];
          T[kk * 257 + n4] = w[0]; T[kk * 257 + n4 + 1] = w[1]; T[kk * 257 + n4 + 2] = w[2]; T[kk * 257 + n4 + 3] = w[3]; } }
    __syncthreads();
    { const int n = tid >> 1, kh = (tid & 1) * 32;
#pragma unroll
      for (int q = 0; q < 4; ++q) { const int kb = kh + q * 8; u32x4v w;
          w.x = pk2(T[(kb + 0) * 257 + n], T[(kb + 1) * 257 + n]); w.y = pk2(T[(kb + 2) * 257 + n], T[(kb + 3) * 257 + n]);
          w.z = pk2(T[(kb + 4) * 257 + n], T[(kb + 5) * 257 + n]); w.w = pk2(T[(kb + 6) * 257 + n], T[(kb + 7) * 257 + n]);
          const int nn = n0 + n, drow = rmode ? ((nn >> 7) * 256 + (rmode == 2 ? 128 : 0) + (nn & 127)) : nn;
          *(u32x4v*)(dst + (size_t)drow * K + k0 + kb) = w; } }
    __syncthreads();
}
struct NormRow { f32x4 v[4]; };
__device__ __forceinline__ void norm_load(NormRow& R, const float* x, int lane) {
#pragma unroll
    for (int i = 0; i < 4; ++i) R.v[i] = __builtin_nontemporal_load((const f32x4*)(x + i * 256 + lane * 4));
}
constexpr int PREP_TA = 66048;
__device__ __forceinline__ void norm_a(const NormRow& R, float rs, const LAS float* Ta, float* af_row, int lane) {
    float acc[16];
#pragma unroll
    for (int c = 0; c < 16; ++c) { float s = 0.f;
#pragma unroll
        for (int i = 0; i < 4; ++i) { const f32x4 w = *(const LAS f32x4*)(Ta + c * 1024 + i * 256 + lane * 4); s += (R.v[i][0] * w[0] + R.v[i][1] * w[1]) + (R.v[i][2] * w[2] + R.v[i][3] * w[3]); }
        acc[c] = s; }
    const bool b5 = lane & 32, b4 = lane & 16, b3 = lane & 8, b2 = lane & 4;
    float a8[8], a4[4], a2[2], a1;
#pragma unroll
    for (int j = 0; j < 8; ++j) { const float send = b5 ? acc[j] : acc[j + 8]; const float keep = b5 ? acc[j + 8] : acc[j]; a8[j] = keep + __shfl_xor(send, 32); }
#pragma unroll
    for (int j = 0; j < 4; ++j) { const float send = b4 ? a8[j] : a8[j + 4]; const float keep = b4 ? a8[j + 4] : a8[j]; a4[j] = keep + __shfl_xor(send, 16); }
#pragma unroll
    for (int j = 0; j < 2; ++j) { const float send = b3 ? a4[j] : a4[j + 2]; const float keep = b3 ? a4[j + 2] : a4[j]; a2[j] = keep + __shfl_xor(send, 8); }
    { const float send = b2 ? a2[0] : a2[1]; const float keep = b2 ? a2[1] : a2[0]; a1 = keep + __shfl_xor(send, 4); }
    a1 += __shfl_xor(a1, 2); a1 += __shfl_xor(a1, 1);
    if ((lane & 3) == 0) af_row[(lane >> 2) & 15] = a1 * rs;
}
__device__ __forceinline__ void norm_fin(const NormRow& R, const float* g, bf16_t* o, int lane, const LAS float* Ta = nullptr, float* af_row = nullptr) {
    float s = 0.f;
#pragma unroll
    for (int i = 0; i < 4; ++i) s += (R.v[i][0] * R.v[i][0] + R.v[i][1] * R.v[i][1]) + (R.v[i][2] * R.v[i][2] + R.v[i][3] * R.v[i][3]);
    s = wave_sum(s); const float rs = rsqrtf(s * (1.0f / 1024.0f) + EPS);
#pragma unroll
    for (int i = 0; i < 4; ++i) { const f32x4 gg = *(const f32x4*)(g + i * 256 + lane * 4); const f32x4 y = R.v[i] * rs * gg; u32x2 w; w.x = pk2(y[0], y[1]); w.y = pk2(y[2], y[3]);
        *(u32x2*)(o + i * 256 + lane * 4) = w; }
    if (af_row) norm_a(R, rs, Ta, af_row, lane);
}
__device__ __forceinline__ void norm_addr(const Params& p, int r, const float*& x, const float*& g, bf16_t*& o) {
    if (r < MPR) { x = p.in[0] + (size_t)r * 1024; g = p.in[7]; o = (bf16_t*)(p.ws + WS_A) + (size_t)r * 1024; }
    else if (r < MT) { x = p.in[1] + (size_t)(r - MPR) * 1024; g = p.in[7]; o = (bf16_t*)(p.ws + WS_A) + (size_t)r * 1024; }
    else { x = p.in[2] + (size_t)(r - MT) * 1024; g = p.in[17]; o = (bf16_t*)(p.ws + WS_MN) + (size_t)(r - MT) * 1024; }
}
__device__ __forceinline__ void phase_prep(const Params& p, LAS unsigned char* lds) {
    unsigned char* ws = p.ws; LAS float* T = (LAS float*)lds;
    const int tid = threadIdx.x, lane = tid & 63, wave = tid >> 6;
    LAS float* Ta = (LAS float*)(lds + PREP_TA);
#pragma unroll
    for (int i = 0; i < 8; ++i) { const int idx = tid + 512 * i, k = idx >> 2, c4 = (idx & 3) * 4; const f32x4 w = *(const f32x4*)(p.in[8] + (size_t)k * 2576 + 1536 + c4) * p.in[7][k];
        Ta[(c4 + 0) * 1024 + k] = w[0]; Ta[(c4 + 1) * 1024 + k] = w[1]; Ta[(c4 + 2) * 1024 + k] = w[2]; Ta[(c4 + 3) * 1024 + k] = w[3]; }
    __syncthreads();
    for (int j = blockIdx.x; j < 1008; j += gridDim.x) {
        const float* src; int ldn, K, nt; bf16_t* dst; const float* ksc = nullptr; bool cmap = false; int jj = j, rmode = 0;
        if (jj < 160) { src = p.in[8]; ldn = 2576; K = 1024; nt = 10; dst = (bf16_t*)(ws + WS_WIN); cmap = true; }
        else if ((jj -= 160) < 64) { src = p.in[15]; ldn = 1024; K = 1024; nt = 4; dst = (bf16_t*)(ws + WS_WOUT); }
        else if ((jj -= 64) < 64) { src = p.in[18]; ldn = 1024; K = 1024; nt = 4; dst = (bf16_t*)(ws + WS_WQ); ksc = p.in[16]; }
        else if ((jj -= 64) < 64) { src = p.in[19]; ldn = 1024; K = 1024; nt = 4; dst = (bf16_t*)(ws + WS_WKV); }
        else if ((jj -= 64) < 64) { src = p.in[20]; ldn = 1024; K = 1024; nt = 4; dst = (bf16_t*)(ws + WS_WKV) + (size_t)1024 * 1024; }
        else if ((jj -= 64) < 64) { src = p.in[21]; ldn = 1024; K = 1024; nt = 4; dst = (bf16_t*)(ws + WS_WO); }
        else if ((jj -= 64) < 176) { src = p.in[23]; ldn = 2816; K = 1024; nt = 11; dst = (bf16_t*)(ws + WS_WGU); ksc = p.in[22]; rmode = 1; }
        else if ((jj -= 176) < 176) { src = p.in[24]; ldn = 2816; K = 1024; nt = 11; dst = (bf16_t*)(ws + WS_WGU); ksc = p.in[22]; rmode = 2; }
        else { jj -= 176; src = p.in[27]; ldn = 1024; K = 2816; nt = 4; dst = (bf16_t*)(ws + WS_WD); }
        const int kt = jj / nt, ntile = jj % nt;
        tr_strip(T, src, ldn, dst, K, kt * 64, ntile * 256, ksc, cmap, rmode);
    }
    const int stride = gridDim.x * 8;
    for (int r = blockIdx.x * 8 + wave; r < MT + 2048; r += 2 * stride) {
        const int r2 = r + stride; const bool has2 = r2 < MT + 2048;
        const float *x1, *g1, *x2 = nullptr, *g2 = nullptr; bf16_t *o1, *o2 = nullptr; NormRow A, B;
        norm_addr(p, r, x1, g1, o1); norm_load(A, x1, lane);
        if (has2) { norm_addr(p, r2, x2, g2, o2); norm_load(B, x2, lane); }
        float* af = (float*)(ws + WS_AF);
        norm_fin(A, g1, o1, lane, Ta, r < MT ? af + (size_t)r * 16 : nullptr);
        if (has2) norm_fin(B, g2, o2, lane, Ta, r2 < MT ? af + (size_t)r2 * 16 : nullptr);
    }
}

constexpr int G_Q = 0, G_K = 9216, G_B = 18432, G_A = 35072, G_WA = 39168, G_BA = 43264, G_VT = 43520, G_X = 61952  , G_ST = 71168, G_RED = 89600, G_SEG = 90624, G_R = 92672, G_END = 110080;
struct GlaPre { u32x4v q, k, v0, v1, s0, s1, r0, r1; f32x4 aw, b0, b1; float ba; };
template <bool OUT>
__device__ __forceinline__ void gla_issue(GlaPre& R, const Params& p, int item) {
    const int b = item >> 7, h = (item >> 5) & 3, c = item & 31; const int tid = threadIdx.x; const int row0 = b * 2048 + c * 64;
    const bf16_t* P = (const bf16_t*)(p.ws + WS_P); const float* af = (const float*)(p.ws + WS_AF);
    { const int i = tid >> 3, d8 = (tid & 7) * 8; const bf16_t* src = P + (size_t)(row0 + i) * NIN + h * 64 + d8; R.q = *(const u32x4v*)src; R.k = *(const u32x4v*)(src + 256); }
    if (!OUT) {
        if (tid < 256) { const int i = tid >> 2, r4 = (tid & 3) * 4; R.aw = *(const f32x4*)(af + (size_t)(row0 + i) * 16 + r4); }
        else { const int t2 = tid - 256, r = t2 >> 4, d4 = (t2 & 15) * 4; R.aw = *(const f32x4*)(p.in[9] + r * 256 + h * 64 + d4); }
        R.ba = p.in[10][h * 64 + (tid & 63)];
    } else { const float* bq = (const float*)(p.ws + WS_BQ) + (size_t)item * 4096 + (tid >> 3) * 64 + (tid & 7) * 8; R.b0 = *(const f32x4*)bq; R.b1 = *(const f32x4*)(bq + 4); }
    { const int j = tid & 63, v8 = (tid >> 6) * 8; R.v0 = *(const u32x4v*)(P + (size_t)(row0 + j) * NIN + 512 + h * 128 + v8); R.v1 = *(const u32x4v*)(P + (size_t)(row0 + j) * NIN + 512 + h * 128 + 64 + v8); }
    if (OUT) { const bf16_t* St = (const bf16_t*)(p.ws + WS_ST) + (size_t)item * 8192; const int dl = tid & 63, sv8 = (tid >> 6) * 8;
        R.s0 = *(const u32x4v*)(St + dl * 128 + sv8); R.s1 = *(const u32x4v*)(St + dl * 128 + 64 + sv8);
        const int j = tid >> 4, v8 = (tid & 15) * 8; R.r0 = *(const u32x4v*)(P + (size_t)(row0 + j) * NIN + 1024 + h * 128 + v8); R.r1 = *(const u32x4v*)(P + (size_t)(row0 + j + 32) * NIN + 1024 + h * 128 + v8); }
}
__device__ __forceinline__ void vt_scatter(LAS bf16_t* LVt, const u32x4v w, int v8, int j) {
    LVt[(v8 + 0) * 72 + j] = (bf16_t)(w.x & 0xffff); LVt[(v8 + 1) * 72 + j] = (bf16_t)(w.x >> 16); LVt[(v8 + 2) * 72 + j] = (bf16_t)(w.y & 0xffff); LVt[(v8 + 3) * 72 + j] = (bf16_t)(w.y >> 16);
    LVt[(v8 + 4) * 72 + j] = (bf16_t)(w.z & 0xffff); LVt[(v8 + 5) * 72 + j] = (bf16_t)(w.z >> 16); LVt[(v8 + 6) * 72 + j] = (bf16_t)(w.w & 0xffff); LVt[(v8 + 7) * 72 + j] = (bf16_t)(w.w >> 16);
}
template <bool OUT>
__device__ __forceinline__ void gla_fill(const GlaPre& R, LAS unsigned char* lds) {
    const int tid = threadIdx.x;
    LAS bf16_t* Lq = (LAS bf16_t*)(lds + G_Q); LAS bf16_t* Lk = (LAS bf16_t*)(lds + G_K); LAS float* Lb = (LAS float*)(lds + G_B);
    LAS float* La = (LAS float*)(lds + G_A); LAS float* Lwa = (LAS float*)(lds + G_WA); LAS float* Lba = (LAS float*)(lds + G_BA);
    LAS bf16_t* LVt = (LAS bf16_t*)(lds + G_VT); LAS float* Lseg = (LAS float*)(lds + G_SEG);
    { const int i = tid >> 3, d8 = (tid & 7) * 8; *(LAS u32x4v*)(Lq + i * 72 + d8) = R.q; *(LAS u32x4v*)(Lk + i * 72 + d8) = R.k; }
    if (!OUT) {
        if (tid < 256) { const int i = tid >> 2, r4 = (tid & 3) * 4; *(LAS f32x4*)(La + i * 16 + r4) = R.aw; }
        else { const int t2 = tid - 256, r = t2 >> 4, d4 = (t2 & 15) * 4; *(LAS f32x4*)(Lwa + r * 64 + d4) = R.aw; }
        if (tid < 64) Lba[tid] = R.ba;
    } else { const int i = tid >> 3, d8 = (tid & 7) * 8;
#pragma unroll
        for (int e = 0; e < 4; ++e) { Lb[i * 65 + d8 + e] = R.b0[e]; Lb[i * 65 + d8 + 4 + e] = R.b1[e]; } }
    { const int j = tid & 63, v8 = (tid >> 6) * 8; vt_scatter(LVt, R.v0, v8, j); vt_scatter(LVt, R.v1, v8 + 64, j); }
    if (OUT) { LAS bf16_t* LSt = (LAS bf16_t*)(lds + G_ST); LAS bf16_t* Lr = (LAS bf16_t*)(lds + G_R);
        { const int dl = tid & 63, sv8 = (tid >> 6) * 8; vt_scatter(LSt, R.s0, sv8, dl); vt_scatter(LSt, R.s1, sv8 + 64, dl); }
        const int j = tid >> 4, v8 = (tid & 15) * 8; *(LAS u32x4v*)(Lr + j * 136 + v8) = R.r0; *(LAS u32x4v*)(Lr + (j + 32) * 136 + v8) = R.r1; }
    __syncthreads();
}
__device__ __forceinline__ void gla_gates(LAS unsigned char* lds) {
    const int tid = threadIdx.x;
    LAS float* Lb = (LAS float*)(lds + G_B); LAS float* La = (LAS float*)(lds + G_A); LAS float* Lwa = (LAS float*)(lds + G_WA); LAS float* Lba = (LAS float*)(lds + G_BA); LAS float* Lseg = (LAS float*)(lds + G_SEG);
    const int d = tid & 63, seg = tid >> 6; float acc = 0.f; float pre[8];
#pragma unroll
    for (int ii = 0; ii < 8; ++ii) { const int i = seg * 8 + ii; float z = Lba[d];
#pragma unroll
        for (int r = 0; r < 16; ++r) z += La[i * 16 + r] * Lwa[r * 64 + d];
        acc += logsig(z) * (1.0f / 16.0f); pre[ii] = acc; }
    Lseg[seg * 64 + d] = acc;
    __syncthreads();
    float off = 0.f;
#pragma unroll
    for (int s = 0; s < 8; ++s) if (s < seg) off += Lseg[s * 64 + d];
#pragma unroll
    for (int ii = 0; ii < 8; ++ii) Lb[(seg * 8 + ii) * 65 + d] = pre[ii] + off;
    __syncthreads();
}
__device__ __forceinline__ void gla_local_loop(const Params& p, LAS unsigned char* lds, int first, int stride, int nitems) {
    const int tid = threadIdx.x, lane = tid & 63, wave = tid >> 6;
    GlaPre R; if (first < nitems) gla_issue<false>(R, p, first);
    for (int item = first; item < nitems; item += stride) {
        gla_fill<false>(R, lds);
        if (item + stride < nitems) gla_issue<false>(R, p, item + stride);
        gla_gates(lds);
        LAS bf16_t* Lk = (LAS bf16_t*)(lds + G_K); LAS float* Lb = (LAS float*)(lds + G_B); LAS bf16_t* LVt = (LAS bf16_t*)(lds + G_VT); LAS bf16_t* LKt = (LAS bf16_t*)(lds + G_X);
        { float* bq = (float*)(p.ws + WS_BQ) + (size_t)item * 4096 + (tid >> 3) * 64 + (tid & 7) * 8; const int i = tid >> 3, d8 = (tid & 7) * 8; f32x4 x0, x1;
#pragma unroll
          for (int e = 0; e < 4; ++e) { x0[e] = Lb[i * 65 + d8 + e]; x1[e] = Lb[i * 65 + d8 + 4 + e]; }
          *(f32x4*)bq = x0; *(f32x4*)(bq + 4) = x1; }
        float* dS = (float*)(p.ws + WS_DS) + (size_t)item * 8192; float* dec = (float*)(p.ws + WS_DEC) + (size_t)item * 64;
        { const int j = tid >> 3, d8 = (tid & 7) * 8; const u32x4v kq = *(const LAS u32x4v*)(Lk + j * 72 + d8); const unsigned kw[4] = {kq.x, kq.y, kq.z, kq.w};
#pragma unroll
          for (int e = 0; e < 8; ++e) { const float kv = (e & 1) ? bfhi(kw[e >> 1]) : bflo(kw[e >> 1]); LKt[(d8 + e) * 72 + j] = f2bf(kv * __expf(Lb[63 * 65 + d8 + e] - Lb[j * 65 + d8 + e])); } }
        if (tid < 64) dec[tid] = __expf(Lb[63 * 65 + tid]);
        __syncthreads();
        const int db = wave & 1, vb = wave >> 1, r = lane & 31, hh = lane >> 5;
        f32x16 acc = zero16();
#pragma unroll
        for (int ks = 0; ks < 4; ++ks) { const bf16x8 a = *(const LAS bf16x8*)(LKt + (db * 32 + r) * 72 + ks * 16 + 8 * hh); const bf16x8 bb = *(const LAS bf16x8*)(LVt + (vb * 32 + r) * 72 + ks * 16 + 8 * hh); acc = mma32(a, bb, acc); }
#pragma unroll
        for (int i = 0; i < 16; ++i) { const int d = db * 32 + (i & 3) + 8 * (i >> 2) + 4 * hh; dS[d * 128 + vb * 32 + r] = acc[i]; }
        __syncthreads();
    }
}
__device__ __forceinline__ void gla_out_loop(const Params& p, LAS unsigned char* lds, int first, int stride, int nitems) {
    const int tid = threadIdx.x, lane = tid & 63, wave = tid >> 6;
    GlaPre R; if (first < nitems) gla_issue<true>(R, p, first);
    for (int item = first; item < nitems; item += stride) {
        const int b = item >> 7, h = (item >> 5) & 3, c = item & 31; const int row0 = b * 2048 + c * 64;
        gla_fill<true>(R, lds);
        if (item + stride < nitems) gla_issue<true>(R, p, item + stride);
        LAS bf16_t* Lq = (LAS bf16_t*)(lds + G_Q); LAS bf16_t* Lk = (LAS bf16_t*)(lds + G_K); LAS float* Lb = (LAS float*)(lds + G_B); LAS bf16_t* LVt = (LAS bf16_t*)(lds + G_VT);
        LAS bf16_t* Lsc = (LAS bf16_t*)(lds + G_X); LAS bf16_t* LSt = (LAS bf16_t*)(lds + G_ST); LAS float* Lred = (LAS float*)(lds + G_RED); LAS bf16_t* Lr = (LAS bf16_t*)(lds + G_R);
        bf16_t* mix = (bf16_t*)(p.ws + WS_A);
        { const int i = tid >> 3, d8 = (tid & 7) * 8;
          const u32x4v qv = *(const LAS u32x4v*)(Lq + i * 72 + d8), kv = *(const LAS u32x4v*)(Lk + i * 72 + d8); const unsigned qw[4] = {qv.x, qv.y, qv.z, qv.w}, kw[4] = {kv.x, kv.y, kv.z, kv.w}; unsigned qo[4], ko[4];
#pragma unroll
          for (int e2 = 0; e2 < 4; ++e2) { const float b0 = Lb[i * 65 + d8 + 2 * e2], b1 = Lb[i * 65 + d8 + 2 * e2 + 1];
              qo[e2] = pk2(bflo(qw[e2]) * __expf(b0) * 0.125f, bfhi(qw[e2]) * __expf(b1) * 0.125f); ko[e2] = pk2(bflo(kw[e2]) * __expf(-b0), bfhi(kw[e2]) * __expf(-b1)); }
          u32x4v qn, kn; qn.x = qo[0]; qn.y = qo[1]; qn.z = qo[2]; qn.w = qo[3]; kn.x = ko[0]; kn.y = ko[1]; kn.z = ko[2]; kn.w = ko[3];
          *(LAS u32x4v*)(Lq + i * 72 + d8) = qn; *(LAS u32x4v*)(Lk + i * 72 + d8) = kn; }
        __syncthreads();
        const int r = lane & 31, hh = lane >> 5;
        if (wave < 4) { const int ib = wave & 1, jb = wave >> 1;
            f32x16 acc = zero16();
            if (jb <= ib) {
#pragma unroll
                for (int ks = 0; ks < 4; ++ks) { const bf16x8 a = *(const LAS bf16x8*)(Lq + (ib * 32 + r) * 72 + ks * 16 + 8 * hh); const bf16x8 bb = *(const LAS bf16x8*)(Lk + (jb * 32 + r) * 72 + ks * 16 + 8 * hh); acc = mma32(a, bb, acc); } }
#pragma unroll
            for (int i = 0; i < 16; ++i) { const int ii = ib * 32 + (i & 3) + 8 * (i >> 2) + 4 * hh, jj = jb * 32 + r; Lsc[ii * 72 + jj] = f2bf(jj <= ii ? acc[i] : 0.f); } }
        __syncthreads();
        const int ib = wave & 1, vb = wave >> 1;
        f32x16 acc = zero16();
#pragma unroll
        for (int ks = 0; ks < 4; ++ks) { const bf16x8 a = *(const LAS bf16x8*)(Lsc + (ib * 32 + r) * 72 + ks * 16 + 8 * hh); const bf16x8 bb = *(const LAS bf16x8*)(LVt + (vb * 32 + r) * 72 + ks * 16 + 8 * hh); acc = mma32(a, bb, acc); }
#pragma unroll
        for (int ks = 0; ks < 4; ++ks) { const bf16x8 a = *(const LAS bf16x8*)(Lq + (ib * 32 + r) * 72 + ks * 16 + 8 * hh); const bf16x8 bb = *(const LAS bf16x8*)(LSt + (vb * 32 + r) * 72 + ks * 16 + 8 * hh); acc = mma32(a, bb, acc); }
#pragma unroll
        for (int i = 0; i < 16; ++i) { float s = row_sum16(acc[i] * acc[i]); s += __shfl_xor(s, 16);
            if (r == 0) Lred[(ib * 32 + (i & 3) + 8 * (i >> 2) + 4 * hh) * 4 + vb] = s; }
        __syncthreads();
        const float gg = p.in[11][h * 128 + vb * 32 + r];
#pragma unroll
        for (int i = 0; i < 16; ++i) { const int ii = ib * 32 + (i & 3) + 8 * (i >> 2) + 4 * hh; const f32x4 q = *(const LAS f32x4*)(Lred + ii * 4);
            const float rs = rsqrtf(((q[0] + q[1]) + (q[2] + q[3])) * (1.0f / 128.0f) + EPS);
            const float rg = bf2f(Lr[ii * 136 + vb * 32 + r]);
            mix[(size_t)(row0 + ii) * 1024 + h * 128 + vb * 32 + r] = f2bf(acc[i] * rs * gg * silu_f(rg)); }
        __syncthreads();
    }
}
__device__ __forceinline__ void gla_scan(const Params& p) {
    for (int gt = blockIdx.x * 512 + threadIdx.x; gt < 131072; gt += gridDim.x * 512) {
    const int bh = gt >> 12, rem = gt & 4095, v = rem & 127, d = (rem >> 7) * 2;
    const float* dS = (const float*)(p.ws + WS_DS); const float* dec = (const float*)(p.ws + WS_DEC); bf16_t* St = (bf16_t*)(p.ws + WS_ST);
    float s0 = 0.f, s1 = 0.f;
#pragma unroll 8
    for (int c = 0; c < 32; ++c) { const size_t item = (size_t)bh * 32 + c;
        { const unsigned w = pk2(s0, s1); St[item * 8192 + d * 128 + v] = (bf16_t)(w & 0xffffu); St[item * 8192 + (d + 1) * 128 + v] = (bf16_t)(w >> 16); }
        const float a0 = dec[item * 64 + d], a1 = dec[item * 64 + d + 1];
        s0 = a0 * s0 + dS[item * 8192 + d * 128 + v]; s1 = a1 * s1 + dS[item * 8192 + (d + 1) * 128 + v]; }
    float* o = p.out + O_SGP + (size_t)bh * 8192; o[d * 128 + v] = s0; o[(d + 1) * 128 + v] = s1; }
}

__device__ __forceinline__ void sgu_item(const Params& p, LAS unsigned char* lds, int item) {
    const int b = item >> 6, nck = (item >> 2) & 15, h = item & 3; const int tid = threadIdx.x, lane = tid & 63, wave = tid >> 6;
    LAS bf16_t* LW = (LAS bf16_t*)lds; LAS bf16_t* LsvT = (LAS bf16_t*)(lds + 34816);
    const bf16_t* P = (const bf16_t*)(p.ws + WS_P); bf16_t* mix = (bf16_t*)(p.ws + WS_A); const int row0 = b * 2048 + nck * 128;
    const float* Wsrc = p.in[13] + (size_t)h * 16384;
#pragma unroll
    for (int k = 0; k < 8; ++k) { const int idx = tid + 512 * k, i = idx >> 5, j4 = (idx & 31) * 4; const f32x4 w = *(const f32x4*)(Wsrc + i * 128 + j4);
        u32x2 o; o.x = pk2(j4 <= i ? w[0] : 0.f, j4 + 1 <= i ? w[1] : 0.f); o.y = pk2(j4 + 2 <= i ? w[2] : 0.f, j4 + 3 <= i ? w[3] : 0.f); *(LAS u32x2*)(LW + i * 136 + j4) = o; }
    { const int j = tid >> 2, q4 = tid & 3; const bf16_t* src = P + (size_t)(row0 + j) * NIN + 2048 + h * 128 + q4 * 32; float g[32]; float ss = 0.f;
#pragma unroll
      for (int k = 0; k < 4; ++k) { const u32x4v w = *(const u32x4v*)(src + k * 8); const unsigned ww[4] = {w.x, w.y, w.z, w.w};
#pragma unroll
          for (int e = 0; e < 4; ++e) { const float a = gelu_t(bflo(ww[e])), c = gelu_t(bfhi(ww[e])); g[k * 8 + e * 2] = a; g[k * 8 + e * 2 + 1] = c; ss += a * a + c * c; } }
      ss += __shfl_xor(ss, 1); ss += __shfl_xor(ss, 2); const float rs = rsqrtf(ss * (1.0f / 128.0f) + EPS);
#pragma unroll
      for (int e = 0; e < 32; ++e) { const int d = q4 * 32 + e; LsvT[d * 136 + j] = f2bf(g[e] * rs * p.in[12][h * 128 + d]); } }
    __syncthreads();
    const int r = lane & 31, hh = lane >> 5, ib = wave & 3;
    bf16_t uraw[2][16]; float bsv[16];
#pragma unroll
    for (int i = 0; i < 16; ++i) { const int ii = ib * 32 + (i & 3) + 8 * (i >> 2) + 4 * hh; bsv[i] = p.in[14][h * 128 + ii];
#pragma unroll
        for (int t = 0; t < 2; ++t) uraw[t][i] = P[(size_t)(row0 + ii) * NIN + 1536 + h * 128 + ((wave >> 2) * 2 + t) * 32 + r]; }
    f32x16 accs[2];
#pragma unroll
    for (int t = 0; t < 2; ++t) { const int db = (wave >> 2) * 2 + t; f32x16 acc = zero16();
        for (int ks = 0; ks <= ib * 2 + 1; ++ks) { const bf16x8 a = *(const LAS bf16x8*)(LW + (ib * 32 + r) * 136 + ks * 16 + 8 * hh); const bf16x8 bb = *(const LAS bf16x8*)(LsvT + (db * 32 + r) * 136 + ks * 16 + 8 * hh); acc = mma32(a, bb, acc); }
        accs[t] = acc; }
#pragma unroll
    for (int t = 0; t < 2; ++t) { const int db = (wave >> 2) * 2 + t;
#pragma unroll
        for (int i = 0; i < 16; ++i) { const int ii = ib * 32 + (i & 3) + 8 * (i >> 2) + 4 * hh, d = db * 32 + r; const float z = accs[t][i] + bsv[i];
            const float u = gelu_t(bf2f(uraw[t][i])); mix[(size_t)(row0 + ii) * 1024 + 512 + h * 128 + d] = f2bf(u * z); } }
    __syncthreads();
}

constexpr int SM_Q = 0, SM_K = 4096, SM_B = 8192, SM_V = 12288, SM_A = 20480, SM_RED = 21504, SM_O = 22016, SM_END = 30208;
__device__ __forceinline__ void sample_mixer(const Params& p, LAS unsigned char* lds, int b, int hp) {
    const int tid = threadIdx.x, lane = tid & 63, wave = tid >> 6; const int rowb = MPR + b * 4;
    const bf16_t* P = (const bf16_t*)(p.ws + WS_P); const float* af = (const float*)(p.ws + WS_AF); bf16_t* mix = (bf16_t*)(p.ws + WS_A);
    LAS float* Lq = (LAS float*)(lds + SM_Q); LAS float* Lk = (LAS float*)(lds + SM_K); LAS float* Lb = (LAS float*)(lds + SM_B); LAS float* Lv = (LAS float*)(lds + SM_V);
    LAS float* LA = (LAS float*)(lds + SM_A); LAS float* Lred = (LAS float*)(lds + SM_RED); LAS float* Lo = (LAS float*)(lds + SM_O);
    if (hp == 0) { const int ch = tid, h = tid >> 7; float g[4], u[4];
#pragma unroll
      for (int t = 0; t < 4; ++t) { g[t] = gelu_t(bf2f(P[(size_t)(rowb + t) * NIN + 2048 + ch])); u[t] = gelu_t(bf2f(P[(size_t)(rowb + t) * NIN + 1536 + ch])); const float s = wave_sum(g[t] * g[t]); if (lane == 0) Lred[wave * 4 + t] = s; }
      __syncthreads();
      const float gs = p.in[12][ch]; float sv[4];
#pragma unroll
      for (int t = 0; t < 4; ++t) { const float tot = Lred[(2 * h) * 4 + t] + Lred[(2 * h + 1) * 4 + t]; sv[t] = g[t] * rsqrtf(tot * (1.0f / 128.0f) + EPS) * gs; p.out[O_SV + (size_t)(b * 4 + t) * 512 + ch] = sv[t]; }
#pragma unroll
      for (int i = 0; i < 4; ++i) { float z = p.in[14][h * 128 + i];
#pragma unroll
          for (int j = 0; j < 4; ++j) if (j <= i) z += p.in[13][(size_t)h * 16384 + i * 128 + j] * sv[j];
          mix[(size_t)(rowb + i) * 1024 + 512 + ch] = f2bf(u[i] * z); }
      __syncthreads();
    }
#pragma unroll
    for (int k = 0; k < 2; ++k) { const int idx = tid + 512 * k, t = idx >> 8, c = idx & 255;
        Lq[t * 256 + c] = bf2f(P[(size_t)(rowb + t) * NIN + c]); Lk[t * 256 + c] = bf2f(P[(size_t)(rowb + t) * NIN + 256 + c]);
        float z = p.in[10][c];
#pragma unroll
        for (int r = 0; r < 16; ++r) z += af[(size_t)(rowb + t) * 16 + r] * p.in[9][r * 256 + c];
        Lb[t * 256 + c] = logsig(z) * (1.0f / 16.0f); }
#pragma unroll
    for (int t = 0; t < 4; ++t) Lv[t * 512 + tid] = bf2f(P[(size_t)(rowb + t) * NIN + 512 + tid]);
    __syncthreads();
    if (tid < 256) { float a = 0.f;
#pragma unroll
        for (int t = 0; t < 4; ++t) { a += Lb[t * 256 + tid]; Lb[t * 256 + tid] = a; } }
    __syncthreads();
    { const int h = tid >> 7, pr = (tid >> 3) & 15, i = pr >> 2, j = pr & 3, part = tid & 7; float s = 0.f;
      if (j <= i) {
#pragma unroll
          for (int e = 0; e < 8; ++e) { const int c = h * 64 + part * 8 + e; s += Lq[i * 256 + c] * Lk[j * 256 + c] * __expf(Lb[i * 256 + c] - Lb[j * 256 + c]); } }
      s += __shfl_xor(s, 1); s += __shfl_xor(s, 2); s += __shfl_xor(s, 4);
      if (part == 0) LA[h * 16 + pr] = s * 0.125f; }
    __syncthreads();
    LAS float* Le3 = (LAS float*)(lds + SM_END);
    { float qn[2], kn[2];
#pragma unroll
      for (int k = 0; k < 2; ++k) { const int idx = tid + 512 * k, t = idx >> 8, c = idx & 255; const float bt = Lb[t * 256 + c], b3 = Lb[3 * 256 + c];
          qn[k] = Lq[t * 256 + c] * __expf(bt) * 0.125f; kn[k] = Lk[t * 256 + c] * __expf(b3 - bt); }
      const float e3 = tid < 256 ? __expf(Lb[3 * 256 + tid]) : 0.f;
      __syncthreads();
#pragma unroll
      for (int k = 0; k < 2; ++k) { const int idx = tid + 512 * k; Lq[idx] = qn[k]; Lk[idx] = kn[k]; }
      if (tid < 256) Le3[tid] = e3; }
    __syncthreads();
    const int v = tid & 127, dq = tid >> 7;
    for (int h = 2 * hp; h < 2 * hp + 2; ++h) {
        const float* S0 = p.in[3] + (size_t)(b * 4 + h) * 8192; float* So = p.out + O_SGS + (size_t)(b * 4 + h) * 8192;
        float op[4] = {0.f, 0.f, 0.f, 0.f}; float vv[4];
#pragma unroll
        for (int t = 0; t < 4; ++t) vv[t] = Lv[t * 512 + h * 128 + v];
        float s0v[16];
#pragma unroll
        for (int dd = 0; dd < 16; ++dd) s0v[dd] = __builtin_nontemporal_load(S0 + (dq * 16 + dd) * 128 + v);
#pragma unroll
        for (int dd = 0; dd < 16; ++dd) { const int d = dq * 16 + dd, c = h * 64 + d; const float s0 = s0v[dd];
            float sn = Le3[c] * s0;
#pragma unroll
            for (int t = 0; t < 4; ++t) { op[t] += Lq[t * 256 + c] * s0; sn += Lk[t * 256 + c] * vv[t]; }
            So[d * 128 + v] = sn; }
#pragma unroll
        for (int t = 0; t < 4; ++t) Lo[(dq * 4 + t) * 128 + v] = op[t];
        __syncthreads();
        { const int i = tid >> 7; float o = Lo[(0 * 4 + i) * 128 + v] + Lo[(1 * 4 + i) * 128 + v] + Lo[(2 * 4 + i) * 128 + v] + Lo[(3 * 4 + i) * 128 + v];
#pragma unroll
          for (int j = 0; j < 4; ++j) if (j <= i) o += LA[h * 16 + i * 4 + j] * Lv[j * 512 + h * 128 + v];
          const float s = wave_sum(o * o); if (lane == 0) Lred[wave] = s;
          __syncthreads();
          const float tot = Lred[2 * i] + Lred[2 * i + 1]; const float rg = bf2f(P[(size_t)(rowb + i) * NIN + 1024 + h * 128 + v]);
          mix[(size_t)(rowb + i) * 1024 + h * 128 + v] = f2bf(o * rsqrtf(tot * (1.0f / 128.0f) + EPS) * p.in[11][h * 128 + v] * silu_f(rg)); }
        __syncthreads();
    }
}

__device__ __forceinline__ void attn_prompt(const Params& p, LAS unsigned char* lds, int item) {
    const int b = item >> 5, h = (item >> 3) & 3, rt = item & 7; const int tid = threadIdx.x, lane = tid & 63, wave = tid >> 6, r = lane & 31, hh = lane >> 5;
    LAS bf16_t* LK = (LAS bf16_t*)lds; bf16_t* qx = (bf16_t*)(p.ws + WS_A);
    const bf16_t* mkb = (const bf16_t*)(p.ws + WS_MKB) + (size_t)b * 256 * 1024 + h * 256; const bf16_t* mvt = (const bf16_t*)(p.ws + WS_MVT) + (size_t)(b * 4 + h) * 65536;
    const int r0 = b * 2048 + rt * 256 + wave * 32; const bf16_t* qrow = qx + (size_t)(r0 + r) * 1024 + h * 256 + 8 * hh;
    bf16x8 qf[16];
#pragma unroll
    for (int ks = 0; ks < 16; ++ks) qf[ks] = *(const bf16x8*)(qrow + ks * 16);
#pragma unroll 4
    for (int k = 0; k < 16; ++k) { const int idx = tid + 512 * k, m = idx >> 5, d8 = (idx & 31) * 8; *(LAS u32x4v*)(LK + m * 264 + d8) = *(const u32x4v*)(mkb + (size_t)m * 1024 + d8); }
    __syncthreads();
    f32x16 s[8];
#pragma unroll
    for (int mb = 0; mb < 8; ++mb) s[mb] = zero16();
#pragma unroll
    for (int ks = 0; ks < 16; ++ks) {
#pragma unroll
        for (int mb = 0; mb < 8; ++mb) { const bf16x8 kf = *(const LAS bf16x8*)(LK + (mb * 32 + r) * 264 + ks * 16 + 8 * hh); s[mb] = mma32(kf, qf[ks], s[mb]); } }
    float mx = -3.0e38f;
#pragma unroll
    for (int mb = 0; mb < 8; ++mb)
#pragma unroll
        for (int i = 0; i < 16; ++i) mx = fmaxf(mx, s[mb][i]);
    mx = fmaxf(mx, __shfl_xor(mx, 32)); float sum = 0.f;
#pragma unroll
    for (int mb = 0; mb < 8; ++mb)
#pragma unroll
        for (int i = 0; i < 16; ++i) { const float e = __expf((s[mb][i] - mx) * 0.0625f); s[mb][i] = e; sum += e; }
    sum += __shfl_xor(sum, 32); const float inv = __builtin_amdgcn_rcpf(sum);
    bf16x8 pf[8][2];
#pragma unroll
    for (int mb = 0; mb < 8; ++mb)
#pragma unroll
        for (int sI = 0; sI < 2; ++sI) { u32x4v w; w.x = pk2(s[mb][8 * sI + 0] * inv, s[mb][8 * sI + 1] * inv); w.y = pk2(s[mb][8 * sI + 2] * inv, s[mb][8 * sI + 3] * inv);
            w.z = pk2(s[mb][8 * sI + 4] * inv, s[mb][8 * sI + 5] * inv); w.w = pk2(s[mb][8 * sI + 6] * inv, s[mb][8 * sI + 7] * inv); pf[mb][sI] = __builtin_bit_cast(bf16x8, w); }
    __syncthreads();
#pragma unroll 4
    for (int k = 0; k < 16; ++k) { const int idx = tid + 512 * k, d = idx >> 5, m8 = (idx & 31) * 8; *(LAS u32x4v*)(LK + d * 264 + m8) = *(const u32x4v*)(mvt + (size_t)d * 256 + m8); }
    __syncthreads();
    for (int dh = 0; dh < 2; ++dh) {
        f32x16 o[4];
#pragma unroll
        for (int q = 0; q < 4; ++q) o[q] = zero16();
#pragma unroll
        for (int mb = 0; mb < 8; ++mb)
#pragma unroll
            for (int sI = 0; sI < 2; ++sI)
#pragma unroll
                for (int q = 0; q < 4; ++q) { const LAS bf16_t* vp = LK + ((dh * 4 + q) * 32 + r) * 264 + mb * 32 + 16 * sI + 4 * hh;
                    const u32x2 lo = *(const LAS u32x2*)vp, hi = *(const LAS u32x2*)(vp + 8); u32x4v w; w.x = lo.x; w.y = lo.y; w.z = hi.x; w.w = hi.y;
                    o[q] = mma32(pf[mb][sI], __builtin_bit_cast(bf16x8, w), o[q]); }
#pragma unroll
        for (int q = 0; q < 4; ++q)
#pragma unroll
            for (int i = 0; i < 16; ++i) { const int ii = (i & 3) + 8 * (i >> 2) + 4 * hh; qx[(size_t)(r0 + ii) * 1024 + h * 256 + (dh * 4 + q) * 32 + r] = f2bf(o[q][i]); }
    }
    __syncthreads();
}
__device__ __forceinline__ void attn_sample(const Params& p, LAS unsigned char* lds, int item) {
    const int b = item >> 2, h = item & 3; const int tid = threadIdx.x, lane = tid & 63, wave = tid >> 6; const int rowb = MPR + b * 4;
    bf16_t* qx = (bf16_t*)(p.ws + WS_A); LAS float* Ls = (LAS float*)lds;   LAS float* Lred = (LAS float*)(lds + 4096); LAS float* Lo = (LAS float*)(lds + 8192);
    const float* Kc = p.in[5] + ((size_t)b * 256 * 4 + h) * 256; const float* Vc = p.in[6] + ((size_t)b * 256 * 4 + h) * 256;
    f32x4 q[4];
#pragma unroll
    for (int t = 0; t < 4; ++t) { const u32x2 w = *(const u32x2*)(qx + (size_t)(rowb + t) * 1024 + h * 256 + lane * 4); q[t] = (f32x4){bflo(w.x), bfhi(w.x), bflo(w.y), bfhi(w.y)}; }
    const bool b5 = lane & 32, b4 = lane & 16, b3 = lane & 8, b2 = lane & 4, b1 = lane & 2;
    for (int mb = 0; mb < 4; ++mb) {
        f32x4 kv[8];
#pragma unroll
        for (int rr = 0; rr < 8; ++rr) kv[rr] = __builtin_nontemporal_load((const f32x4*)(Kc + (size_t)(wave * 32 + mb * 8 + rr) * 1024 + lane * 4));
        float a[32];
#pragma unroll
        for (int rr = 0; rr < 8; ++rr)
#pragma unroll
            for (int t = 0; t < 4; ++t) a[rr * 4 + t] = (kv[rr][0] * q[t][0] + kv[rr][1] * q[t][1]) + (kv[rr][2] * q[t][2] + kv[rr][3] * q[t][3]);
        float c16[16], c8[8], c4[4], c2[2], c1;
#pragma unroll
        for (int j = 0; j < 16; ++j) { const float send = b5 ? a[j] : a[j + 16]; const float keep = b5 ? a[j + 16] : a[j]; c16[j] = keep + __shfl_xor(send, 32); }
#pragma unroll
        for (int j = 0; j < 8; ++j) { const float send = b4 ? c16[j] : c16[j + 8]; const float keep = b4 ? c16[j + 8] : c16[j]; c8[j] = keep + __shfl_xor(send, 16); }
#pragma unroll
        for (int j = 0; j < 4; ++j) { const float send = b3 ? c8[j] : c8[j + 4]; const float keep = b3 ? c8[j + 4] : c8[j]; c4[j] = keep + __shfl_xor(send, 8); }
#pragma unroll
        for (int j = 0; j < 2; ++j) { const float send = b2 ? c4[j] : c4[j + 2]; const float keep = b2 ? c4[j + 2] : c4[j]; c2[j] = keep + __shfl_xor(send, 4); }
        { const float send = b1 ? c2[0] : c2[1]; const float keep = b1 ? c2[1] : c2[0]; c1 = keep + __shfl_xor(send, 2); }
        c1 += __shfl_xor(c1, 1);
        if ((lane & 1) == 0) { const int j = (lane >> 1) & 31; Ls[(j & 3) * 256 + wave * 32 + mb * 8 + (j >> 2)] = c1 * 0.0625f; }
    }
    __syncthreads();
    { const int t = tid >> 7, m0 = tid & 127; const float a = Ls[t * 256 + m0], c = Ls[t * 256 + m0 + 128]; const float mx = wave_max(fmaxf(a, c)); if (lane == 0) Lred[wave] = mx;
      __syncthreads();
      const float mxx = fmaxf(Lred[2 * t], Lred[2 * t + 1]); const float ea = __expf(a - mxx), ec = __expf(c - mxx); const float sm = wave_sum(ea + ec); if (lane == 0) Lred[16 + wave] = sm;
      __syncthreads();
      const float inv = __builtin_amdgcn_rcpf(Lred[16 + 2 * t] + Lred[16 + 2 * t + 1]); Ls[t * 256 + m0] = ea * inv; Ls[t * 256 + m0 + 128] = ec * inv; }
    __syncthreads();
    f32x4 o[4];
#pragma unroll
    for (int t = 0; t < 4; ++t) o[t] = (f32x4){0.f, 0.f, 0.f, 0.f};
#pragma unroll 2
    for (int mm = 0; mm < 32; mm += 4) { const int m = wave * 32 + mm; f32x4 vv[4], pp[4];
#pragma unroll
        for (int rr = 0; rr < 4; ++rr) vv[rr] = __builtin_nontemporal_load((const f32x4*)(Vc + (size_t)(m + rr) * 1024 + lane * 4));
#pragma unroll
        for (int t = 0; t < 4; ++t) pp[t] = *(const LAS f32x4*)(Ls + t * 256 + m);
#pragma unroll
        for (int rr = 0; rr < 4; ++rr)
#pragma unroll
            for (int t = 0; t < 4; ++t) o[t] += vv[rr] * pp[t][rr]; }
#pragma unroll
    for (int t = 0; t < 4; ++t) *(LAS f32x4*)(Lo + (wave * 4 + t) * 256 + lane * 4) = o[t];
    __syncthreads();
#pragma unroll
    for (int k = 0; k < 2; ++k) { const int idx = tid + 512 * k, t = idx >> 8, d = idx & 255; float s = 0.f;
#pragma unroll
        for (int w = 0; w < 8; ++w) s += Lo[(w * 4 + t) * 256 + d];
        qx[(size_t)(rowb + t) * 1024 + h * 256 + d] = f2bf(s); }
    __syncthreads();
}

__device__ __forceinline__ void phase_act(const Params& p) {
    const bf16_t* G = (const bf16_t*)(p.ws + WS_P); bf16_t* U = (bf16_t*)(p.ws + WS_U);
    const float* cw = p.in[25]; const float* cb = p.in[26];
    const int nthr = gridDim.x * 512, gt = blockIdx.x * 512 + threadIdx.x;
    for (int it = gt; it < 1024 * 352; it += nthr) { const int run = it / 352, cc = (it % 352) * 8; const int row0 = run * 16; const bool first = (row0 & 2047) == 0;
        float w0[8], w1[8], w2[8], bb[8], g2[8], g1[8];
#pragma unroll
        for (int e = 0; e < 8; ++e) { w0[e] = cw[cc + e]; w1[e] = cw[DFF + cc + e]; w2[e] = cw[2 * DFF + cc + e]; bb[e] = cb[cc + e]; g2[e] = 0.f; g1[e] = 0.f; }
        if (!first) { const u32x4v a = *(const u32x4v*)(G + (size_t)(row0 - 2) * DFF + cc), c = *(const u32x4v*)(G + (size_t)(row0 - 1) * DFF + cc);
            g2[0] = bflo(a.x); g2[1] = bfhi(a.x); g2[2] = bflo(a.y); g2[3] = bfhi(a.y); g2[4] = bflo(a.z); g2[5] = bfhi(a.z); g2[6] = bflo(a.w); g2[7] = bfhi(a.w);
            g1[0] = bflo(c.x); g1[1] = bfhi(c.x); g1[2] = bflo(c.y); g1[3] = bfhi(c.y); g1[4] = bflo(c.z); g1[5] = bfhi(c.z); g1[6] = bflo(c.w); g1[7] = bfhi(c.w); }
#pragma unroll 4
        for (int t = 0; t < 16; ++t) { const size_t off = (size_t)(row0 + t) * DFF + cc; const u32x4v a = *(const u32x4v*)(G + off), uu = *(const u32x4v*)(U + off);
            float g0[8] = {bflo(a.x), bfhi(a.x), bflo(a.y), bfhi(a.y), bflo(a.z), bfhi(a.z), bflo(a.w), bfhi(a.w)};
            const float uf[8] = {bflo(uu.x), bfhi(uu.x), bflo(uu.y), bfhi(uu.y), bflo(uu.z), bfhi(uu.z), bflo(uu.w), bfhi(uu.w)}; float r[8];
#pragma unroll
            for (int e = 0; e < 8; ++e) { r[e] = gelu_t(bb[e] + w0[e] * g2[e] + w1[e] * g1[e] + w2[e] * g0[e]) * uf[e]; g2[e] = g1[e]; g1[e] = g0[e]; }
            u32x4v o; o.x = pk2(r[0], r[1]); o.y = pk2(r[2], r[3]); o.z = pk2(r[4], r[5]); o.w = pk2(r[6], r[7]); *(u32x4v*)(U + off) = o; }
    }
    for (int it = gt; it < 128 * 352; it += nthr) { const int b = it / 352, cc = (it % 352) * 8; const int row0 = MPR + b * 4;
        float w0[8], w1[8], w2[8], bb[8], g2[8], g1[8];
#pragma unroll
        for (int e = 0; e < 8; ++e) { w0[e] = cw[cc + e]; w1[e] = cw[DFF + cc + e]; w2[e] = cw[2 * DFF + cc + e]; bb[e] = cb[cc + e]; g2[e] = p.in[4][(size_t)(b * 2) * DFF + cc + e]; g1[e] = p.in[4][(size_t)(b * 2 + 1) * DFF + cc + e]; }
#pragma unroll
        for (int t = 0; t < 4; ++t) { const size_t off = (size_t)(row0 + t) * DFF + cc; const u32x4v a = *(const u32x4v*)(G + off), uu = *(const u32x4v*)(U + off);
            float g0[8] = {bflo(a.x), bfhi(a.x), bflo(a.y), bfhi(a.y), bflo(a.z), bfhi(a.z), bflo(a.w), bfhi(a.w)};
            const float uf[8] = {bflo(uu.x), bfhi(uu.x), bflo(uu.y), bfhi(uu.y), bflo(uu.z), bfhi(uu.z), bflo(uu.w), bfhi(uu.w)}; float r[8];
#pragma unroll
            for (int e = 0; e < 8; ++e) { r[e] = gelu_t(bb[e] + w0[e] * g2[e] + w1[e] * g1[e] + w2[e] * g0[e]) * uf[e]; g2[e] = g1[e]; g1[e] = g0[e]; }
            u32x4v o; o.x = pk2(r[0], r[1]); o.y = pk2(r[2], r[3]); o.z = pk2(r[4], r[5]); o.w = pk2(r[6], r[7]); *(u32x4v*)(U + off) = o; }
    }
}
__device__ __forceinline__ void phase_final(const Params& p) {
    const float* h32 = (const float*)(p.ws + WS_H); const float* ssq = (const float*)(p.ws + WS_SSQ) + (size_t)2 * MT * 16; const float* g = p.in[28];
    const int lane = threadIdx.x & 63, wave = threadIdx.x >> 6;
    const float* ssq64 = (const float*)(p.ws + WS_SSQS) + (size_t)2 * 512 * 64;
    for (int r = blockIdx.x * 8 + wave; r < MT; r += gridDim.x * 8) { const float rs = row_rs2(ssq, ssq64, r);
#pragma unroll
        for (int i = 0; i < 4; ++i) { const size_t off = (size_t)r * 1024 + i * 256 + lane * 4; *(f32x4*)(p.out + O_Y + off) = *(const f32x4*)(h32 + off) * rs * *(const f32x4*)(g + i * 256 + lane * 4); } }
}

template <int DUMMY>
__device__ __forceinline__ void run_phases(const Params& p, LAS unsigned char* lds, const int lo, const int hi) {
    unsigned char* ws = p.ws; const int G = gridDim.x, bx = blockIdx.x;
#define IN(k) (lo <= (k) && (k) < hi)
#define MKBAR() XcdBarrier bar; bar.bar = (unsigned*)(p.ws + WS_BAR) + (size_t)p.bar_region * XCD_BAR_WORDS; bar.x = xb_xcc_id(); bar.st = (volatile LAS unsigned*)(lds + LDS_BYTES - 16)
#define SEAM(k) do { if (IN(k) && IN((k) + 1)) { MKBAR(); xcd_barrier(bar); } } while (0)
    if (IN(0)) { phase_prep(p, lds); } SEAM(0);
    if (IN(0) && IN(1)) {
        volatile LAS unsigned* stw = (volatile LAS unsigned*)(lds + LDS_BYTES - 16);
        if (threadIdx.x == 0 && (G % 8) == 0) { unsigned* barw = (unsigned*)(p.ws + WS_BAR) + (size_t)p.bar_region * XCD_BAR_WORDS; const unsigned x = xb_xcc_id(); unsigned pre = 0;
            for (unsigned j = 0; j < 16; ++j) { const unsigned cj = xb_ld(&barw[XB_XCNT(j)]); if (j < x) pre += cj; }
            const unsigned clin = pre + stw[2], per = (unsigned)G / 8u; stw[3] = (clin % per) * 8u + clin / per; }
        __syncthreads();
    }
#define CX ((int)((volatile LAS unsigned*)(lds + LDS_BYTES - 16))[3])
    if (IN(1)) {
        { pg8::Gemm g{(const bf16_t*)(ws + WS_A), (const bf16_t*)(ws + WS_WIN), MT, 2560, 1024}; pg8::StaticOrder S; S.init(MT, 2560, G, CX);
          EpiIn E{(bf16_t*)(ws + WS_P), (float*)(ws + WS_AF)}; pg8::gemm_phase<EpiIn, pg8::StaticOrder>(lds, g, S, E, nullptr); }
        __syncthreads();
        { pg8::Gemm g{(const bf16_t*)(ws + WS_MN), (const bf16_t*)(ws + WS_WKV), 2048, 2048, 1024}; pg8::StaticOrder S; S.init(2048, 2048, G, (CX + 104) % G);
          EpiKV E{p.out + O_MK, p.out + O_MV, (bf16_t*)(ws + WS_MKB), (bf16_t*)(ws + WS_MVT)}; pg8::gemm_phase<EpiKV, pg8::StaticOrder>(lds, g, S, E, nullptr); }
        __syncthreads();
    } SEAM(1);
    if (IN(2)) {
        gla_local_loop(p, lds, bx, G, 1024);
        for (int it = bx; it < 512; it += G) sgu_item(p, lds, it);
        for (int it = G - 1 - bx; it < 256; it += G) sample_mixer(p, lds, it >> 1, it & 1);
    } SEAM(2);
    if (IN(3)) { gla_scan(p); } SEAM(3);
    if (IN(4)) { gla_out_loop(p, lds, bx, G, 1024); } SEAM(4);
    if (IN(5)) {
        pg8::Gemm g{(const bf16_t*)(ws + WS_A), (const bf16_t*)(ws + WS_WOUT), MPR, 1024, 1024}; pg8::StaticOrder S; S.init(MPR, 1024, G, CX);
        EpiRes E{p.in[0], (bf16_t*)(ws + WS_HB), (float*)(ws + WS_SSQ)}; pg8::gemm_phase<EpiRes, pg8::StaticOrder>(lds, g, S, E, nullptr);
        __syncthreads();
        { const float* xs = p.in[1]; bf16_t* hb = (bf16_t*)(ws + WS_HB) + (size_t)MPR * 1024; float* sq = (float*)(ws + WS_SSQS);
          gemm_small<256>((const bf16_t*)(ws + WS_A) + (size_t)MPR * 1024, (const bf16_t*)(ws + WS_WOUT), 1024, 16, lds, [=](int r, int c, int cb, int fq, f32x4 a) {
              const size_t off = (size_t)r * 1024 + c; const f32x4 v = a + *(const f32x4*)(xs + off); u32x2 w; w.x = pk2(v[0], v[1]); w.y = pk2(v[2], v[3]); *(u32x2*)(hb + off) = w;
              float s = sq4(v); s += __shfl_xor(s, 16); s += __shfl_xor(s, 32); if (fq == 0) sq[(size_t)r * 64 + cb] = s; }); }
    } SEAM(5);
    if (IN(6)) {
        pg8::Gemm g{(const bf16_t*)(ws + WS_HB), (const bf16_t*)(ws + WS_WQ), MPR, 1024, 1024}; pg8::StaticOrder S; S.init(MPR, 1024, G, CX);
        EpiQ E{(bf16_t*)(ws + WS_A), (const float*)(ws + WS_SSQ)}; pg8::gemm_phase<EpiQ, pg8::StaticOrder>(lds, g, S, E, nullptr);
        __syncthreads();
        { bf16_t* Q = (bf16_t*)(ws + WS_A) + (size_t)MPR * 1024; const float* sq = (const float*)(ws + WS_SSQS);
          gemm_small<256>((const bf16_t*)(ws + WS_HB) + (size_t)MPR * 1024, (const bf16_t*)(ws + WS_WQ), 1024, 16, lds, [=](int r, int c, int cb, int fq, f32x4 a) {
              const f32x4 v = a * row_rs64(sq, r); u32x2 w; w.x = pk2(v[0], v[1]); w.y = pk2(v[2], v[3]); *(u32x2*)(Q + (size_t)r * 1024 + c) = w; }); }
    } SEAM(6);
    if (IN(7)) {
        if ((bx >> 3) & 1) { for (int it = bx; it < 512; it += G) attn_sample(p, lds, it); for (int it = bx; it < 256; it += G) attn_prompt(p, lds, it); }
        else { for (int it = bx; it < 256; it += G) attn_prompt(p, lds, it); for (int it = bx; it < 512; it += G) attn_sample(p, lds, it); }
    } SEAM(7);
    if (IN(8)) {
        pg8::Gemm g{(const bf16_t*)(ws + WS_A), (const bf16_t*)(ws + WS_WO), MPR, 1024, 1024}; pg8::StaticOrder S; S.init(MPR, 1024, G, CX);
        EpiRes E{nullptr, (bf16_t*)(ws + WS_HB), (float*)(ws + WS_SSQ) + (size_t)MT * 16};
        pg8::gemm_phase<EpiRes, pg8::StaticOrder>(lds, g, S, E, nullptr);
        __syncthreads();
        { bf16_t* hb = (bf16_t*)(ws + WS_HB) + (size_t)MPR * 1024; float* sq = (float*)(ws + WS_SSQS) + (size_t)512 * 64;
          gemm_small<256>((const bf16_t*)(ws + WS_A) + (size_t)MPR * 1024, (const bf16_t*)(ws + WS_WO), 1024, 16, lds, [=](int r, int c, int cb, int fq, f32x4 a) {
              const size_t off = (size_t)r * 1024 + c; const u32x2 hw = *(const u32x2*)(hb + off); const f32x4 v = a + (f32x4){bflo(hw.x), bfhi(hw.x), bflo(hw.y), bfhi(hw.y)};
              u32x2 w; w.x = pk2(v[0], v[1]); w.y = pk2(v[2], v[3]); *(u32x2*)(hb + off) = w;
              float s = sq4(v); s += __shfl_xor(s, 16); s += __shfl_xor(s, 32); if (fq == 0) sq[(size_t)r * 64 + cb] = s; }); }
    } SEAM(8);
    if (IN(9)) {
        pg8::Gemm g{(const bf16_t*)(ws + WS_HB), (const bf16_t*)(ws + WS_WGU), MT, 5632, 1024}; pg8::StaticOrder S; S.init(MT, 5632, G, CX);
        EpiGU E{(bf16_t*)(ws + WS_U), (const float*)(ws + WS_SSQ) + (size_t)MT * 16, (const float*)(ws + WS_SSQS) + (size_t)512 * 64, p.out + O_SCP, p.out + O_SCS, p.in[25], p.in[26], p.in[4], (float*)(ws + WS_GX), (float*)(ws + WS_UX), p.pad}; pg8::gemm_phase<EpiGU, pg8::StaticOrder>(lds, g, S, E, nullptr);
        __syncthreads();
    } if (IN(9) && IN(11)) { MKBAR(); xcd_barrier(bar); }
    if (IN(11)) {
        pg8::Gemm g{(const bf16_t*)(ws + WS_U), (const bf16_t*)(ws + WS_WD), MPR, 1024, 2816}; pg8::StaticOrder S; S.init(MPR, 1024, G, CX);
        if (!(p.pad & 2)) { Unit fu; for (int i = 0; S.next(i, fu); ++i) act_fixup(p, fu.pm); asm volatile("s_waitcnt vmcnt(0)" ::: "memory"); __syncthreads(); }
        EpiFin E{(const bf16_t*)(ws + WS_HB), (float*)(ws + WS_SSQ) + (size_t)2 * MT * 16, (unsigned*)(ws + WS_BAR) + (size_t)p.bar_region * XCD_BAR_WORDS, p.in[28], p.out + O_Y, p.pad,
                 (const bf16_t*)(ws + WS_U) + (size_t)MPR * 2816, (const bf16_t*)(ws + WS_WD), (float*)(ws + WS_SSQS) + (size_t)2 * 512 * 64};
        pg8::gemm_phase<EpiFin, pg8::StaticOrder>(lds, g, S, E, nullptr);
        __syncthreads();
    }
#undef IN
#undef SEAM
#undef CX
}
__global__ void __launch_bounds__(512) mega(Params p) {
    extern __shared__ __attribute__((aligned(16))) unsigned char lds_raw[];
    LAS unsigned char* lds = (LAS unsigned char*)lds_raw;
    if (p.ph_lo < 0) { cg::grid_group grid = cg::this_grid(); grid.sync(); }
    volatile LAS unsigned* st = (volatile LAS unsigned*)(lds + LDS_BYTES - 16);
    if (threadIdx.x < 4) st[threadIdx.x] = 0u;
    __syncthreads();
    if (threadIdx.x == 0) { unsigned* barw = (unsigned*)(p.ws + WS_BAR) + (size_t)p.bar_region * XCD_BAR_WORDS;
        st[2] = xb_add(&barw[XB_XCNT(xb_xcc_id())], 1u);
        st[3] = blockIdx.x; }
    __syncthreads();
    run_phases<0>(p, lds, p.ph_lo, p.ph_hi);
#ifdef EXTRA_SYNC
    for (int i = 0; i < EXTRA_SYNC; ++i) { MKBAR(); xcd_barrier(bar); }
#endif
}

extern "C" void kernel_launch(void* const* d_in, const int* in_sizes, int n_in, void* d_out, int out_size, void* d_ws, size_t ws_size, hipStream_t stream) {
    static int grid = 0;
    if (grid == 0) {
        if (n_in != 29 || ws_size < WS_END) { fprintf(stderr, "kernel_launch: unexpected n_in %d / ws %zu (need %zu)\n", n_in, ws_size, (size_t)WS_END); grid = -1; return; }
        int dev = 0, cus = 0, per_cu = 0;
        hipGetDevice(&dev); hipDeviceGetAttribute(&cus, hipDeviceAttributeMultiprocessorCount, dev);
        if (hipFuncSetAttribute((const void*)mega, hipFuncAttributeMaxDynamicSharedMemorySize, LDS_BYTES) != hipSuccess) { fprintf(stderr, "kernel_launch: hipFuncSetAttribute failed\n"); grid = -1; return; }
        if (hipOccupancyMaxActiveBlocksPerMultiprocessor(&per_cu, (const void*)mega, 512, LDS_BYTES) != hipSuccess || per_cu < 1) { fprintf(stderr, "kernel_launch: occupancy query gives %d\n", per_cu); (void)hipGetLastError(); per_cu = 1; }
        grid = cus;
    }
    if (grid < 0) return;
    Params p{};
    for (int i = 0; i < 29; ++i) p.in[i] = (const float*)d_in[i];
    p.out = (float*)d_out; p.ws = (unsigned char*)d_ws;
    (void)hipMemsetAsync((unsigned char*)d_ws + WS_BAR, 0, (size_t)2 * XCD_BAR_WORDS * 4, stream);
#if N_LAUNCH_MODE == 1
    p.ph_lo = 0; p.ph_hi = NPHASE;
    void* args[] = {&p};
    hipError_t e = hipLaunchCooperativeKernel((const void*)mega, dim3(grid), dim3(512), args, LDS_BYTES, stream);
    if (e != hipSuccess) fprintf(stderr, "cooperative launch failed: %s (grid %d)\n", hipGetErrorString(e), grid);
#if EXTRA_HI > 0
    Params p2 = p; p2.ph_lo = EXTRA_LO; p2.ph_hi = EXTRA_HI; p2.bar_region = 1; p2.pad = EXTRA_FLAGS; void* args2[] = {&p2};
    (void)hipLaunchCooperativeKernel((const void*)mega, dim3(grid), dim3(512), args2, LDS_BYTES, stream);
#endif
#else
    for (int ph = 0; ph < NPHASE; ++ph) { p.ph_lo = ph; p.ph_hi = ph + 1; hipLaunchKernelGGL(mega, dim3(grid), dim3(512), LDS_BYTES, stream, p); }
#endif
}
```
